# Optimizing an MI355X kernel written in HIP

```python
import math
import jax
import jax.numpy as jnp
from jax import lax

D_MODEL = 1024
BATCH = 8
SEQ = 8192
DEPTH = 2

GRID_W = 64
CTX_LEN = 256
GDN_HEADS = 8
GDN_DK = 128
GDN_DV = 128
GDN_QK = GDN_HEADS * GDN_DK
GDN_V = GDN_HEADS * GDN_DV
GDN_QKV = 2 * GDN_QK + GDN_V
SSM_INNER = 2 * D_MODEL
SSM_HEAD_DIM = 64
SSM_HEADS = SSM_INNER // SSM_HEAD_DIM
SSM_GROUPS = 8
SSM_HPG = SSM_HEADS // SSM_GROUPS
SSM_STATE = 128
SSM_GN = SSM_GROUPS * SSM_STATE
SSM_XBC = SSM_INNER + 2 * SSM_GN
CONV_K = 5
CHUNK = 64
D_FF = 4 * D_MODEL
DEEPNORM_ALPHA = (2 * DEPTH) ** 0.25
DEEPNORM_BETA = (8 * DEPTH) ** -0.25
LN_EPS = 1e-5
NORM_EPS = 1e-6
IN_SPLITS = (GDN_QKV, GDN_V, 2 * GDN_HEADS, 2 * GDN_HEADS, SSM_INNER, SSM_XBC, 2 * SSM_HEADS, D_MODEL, D_MODEL)
IN_DIM = sum(IN_SPLITS)

kernel_name = 'hybrid_gdn_ssd_deepnorm_dit'


def split_cols(t):
    pts, acc = [], 0
    for s in IN_SPLITS[:-1]:
        acc += s
        pts.append(acc)
    return jnp.split(t, pts, axis=-1)


def layer_norm(t, g, b):
    tf = t.astype(jnp.float32)
    mu = jnp.mean(tf, -1, keepdims=True)
    var = jnp.mean(jnp.square(tf - mu), -1, keepdims=True)
    return ((tf - mu) * lax.rsqrt(var + LN_EPS)).astype(t.dtype) * g + b


def l2norm(t):
    return t * lax.rsqrt(jnp.sum(t * t, -1, keepdims=True) + NORM_EPS)


def dwconv(t, w):
    pad = w.shape[0] // 2
    L = t.shape[-2]
    tp = jnp.pad(t, [(0, 0)] * (t.ndim - 2) + [(pad, pad), (0, 0)])
    out = tp[..., 0:L, :] * w[0]
    for j in range(1, w.shape[0]):
        out = out + tp[..., j:j + L, :] * w[j]
    return out


def chunk_front(t, axis):
    n = t.shape[axis] // CHUNK
    t = t.reshape(t.shape[:axis] + (n, CHUNK) + t.shape[axis + 1:])
    return jnp.moveaxis(t, axis, 0)


def unchunk(t, axis):
    t = jnp.moveaxis(t, 0, axis)
    return t.reshape(t.shape[:axis] + (-1,) + t.shape[axis + 2:])


def mlp(h, w1, b1, w2, b2):
    return jnp.square(jax.nn.relu(h @ w1 + b1)) @ w2 + b2


def gdn_prep(qkv, a_raw, b_raw, A_log, dt_bias):
    Bsz, L, _ = qkv.shape
    qkv = qkv.astype(jnp.float32)

    def heads(t, d):
        return t.reshape(Bsz, L, GDN_HEADS, d).transpose(0, 2, 1, 3)

    q = l2norm(heads(qkv[..., :GDN_QK], GDN_DK)) * GDN_DK ** -0.5
    k = l2norm(heads(qkv[..., GDN_QK:2 * GDN_QK], GDN_DK))
    v = heads(qkv[..., 2 * GDN_QK:], GDN_DV)
    a = a_raw.astype(jnp.float32).reshape(Bsz, L, 2, GDN_HEADS)
    bt = b_raw.astype(jnp.float32).reshape(Bsz, L, 2, GDN_HEADS)
    g = (-jnp.exp(A_log.astype(jnp.float32)) * jax.nn.softplus(a + dt_bias.astype(jnp.float32))).transpose(2, 0, 3, 1)
    beta = jax.nn.sigmoid(bt).transpose(2, 0, 3, 1)
    return q, k, v, g, beta


def gdn_chunk_scan(q, k, v, g, beta, S0, with_out):
    strict = jnp.tril(jnp.ones((CHUNK, CHUNK), bool), -1)
    incl = jnp.tril(jnp.ones((CHUNK, CHUNK), bool))
    eye = jnp.eye(CHUNK, dtype=jnp.float32)
    xs = (chunk_front(q, 2), chunk_front(k, 2), chunk_front(v, 2), chunk_front(g, 2), chunk_front(beta, 2))

    def step(S, inp):
        qc, kc, vc, gc, bc = inp
        gcum = jnp.cumsum(gc, axis=-1)
        glast = gcum[..., -1:]
        diff = gcum[..., :, None] - gcum[..., None, :]
        kk = jnp.einsum('bhid,bhjd->bhij', kc, kc)
        a_mat = jnp.where(strict, bc[..., :, None] * kk * jnp.exp(jnp.where(strict, diff, 0.0)), 0.0)
        rhs = jnp.concatenate([(bc * jnp.exp(gcum))[..., None] * kc, bc[..., None] * vc], axis=-1)
        wu = lax.linalg.triangular_solve(eye + a_mat, rhs, left_side=True, lower=True, unit_diagonal=True)
        w_blk, u_blk = wu[..., :GDN_DK], wu[..., GDN_DK:]
        v_new = u_blk - jnp.einsum('bhck,bhkv->bhcv', w_blk, S)
        S_next = jnp.exp(glast)[..., None] * S + jnp.einsum('bhck,bhcv->bhkv', kc * jnp.exp(glast - gcum)[..., None], v_new)
        if not with_out:
            return S_next, None
        qk = jnp.where(incl, jnp.einsum('bhid,bhjd->bhij', qc, kc) * jnp.exp(jnp.where(incl, diff, 0.0)), 0.0)
        o = jnp.einsum('bhck,bhkv->bhcv', qc * jnp.exp(gcum)[..., None], S) + jnp.einsum('bhij,bhjv->bhiv', qk, v_new)
        return S_next, o

    S_final, o = lax.scan(step, S0, xs)
    return S_final, (unchunk(o, 2) if with_out else None)


def gdn_bidir(lat, ctx, with_ctx_out):
    q, k, v, g, beta = lat
    qc, kc, vc, gc, bc = ctx
    S0 = jnp.zeros((q.shape[0], GDN_HEADS, GDN_DK, GDN_DV), jnp.float32)
    f = lambda t: jnp.flip(t, axis=2)
    s_f, oc_f = gdn_chunk_scan(qc, kc, vc, gc[0], bc[0], S0, with_ctx_out)
    s_b, oc_b = gdn_chunk_scan(f(qc), f(kc), f(vc), f(gc[1]), f(bc[1]), S0, with_ctx_out)
    _, o_f = gdn_chunk_scan(q, k, v, g[0], beta[0], s_f, True)
    _, o_b = gdn_chunk_scan(f(q), f(k), f(v), f(g[1]), f(beta[1]), s_b, True)
    o = o_f + f(o_b)
    o_c = (oc_f + f(oc_b)) if with_ctx_out else None
    return o, o_c


def gdn_gated_norm(o, gate, w):
    o = jnp.swapaxes(o, 1, 2)
    o = o * lax.rsqrt(jnp.mean(o * o, -1, keepdims=True) + NORM_EPS)
    Bsz, L = o.shape[:2]
    return (o.astype(gate.dtype) * w * jax.nn.silu(gate.reshape(Bsz, L, GDN_HEADS, GDN_DV))).reshape(Bsz, L, GDN_V)


def ssm_prep(xbc, dt_raw, A_log, dt_bias):
    Bsz, L, _ = xbc.shape
    xbc = xbc.astype(jnp.float32)
    xs = xbc[..., :SSM_INNER].reshape(Bsz, L, SSM_GROUPS, SSM_HPG, SSM_HEAD_DIM)
    Bm = xbc[..., SSM_INNER:SSM_INNER + SSM_GN].reshape(Bsz, L, SSM_GROUPS, SSM_STATE)
    Cm = xbc[..., SSM_INNER + SSM_GN:].reshape(Bsz, L, SSM_GROUPS, SSM_STATE)
    dt = jax.nn.softplus(dt_raw.astype(jnp.float32).reshape(Bsz, L, 2, SSM_HEADS) + dt_bias.astype(jnp.float32))
    dt = jnp.moveaxis(dt, 2, 0).reshape(2, Bsz, L, SSM_GROUPS, SSM_HPG)
    a_neg = -jnp.exp(A_log.astype(jnp.float32)).reshape(2, SSM_GROUPS, SSM_HPG)
    return xs, dt, a_neg, Bm, Cm


def ssd_chunk_scan(x, dt, a_neg, Bm, Cm, S0, with_out):
    incl = jnp.tril(jnp.ones((CHUNK, CHUNK), bool))
    xs = (chunk_front(x * dt[..., None], 1), chunk_front(dt * a_neg, 1), chunk_front(Bm, 1), chunk_front(Cm, 1))

    def step(S, inp):
        xdt, la, bc, cc = inp
        gcum = jnp.cumsum(la, axis=1)
        glast = gcum[:, -1]
        S_next = jnp.exp(glast)[..., None, None] * S + jnp.einsum('bcgn,bcgh,bcghp->bghnp', bc, jnp.exp(glast[:, None] - gcum), xdt)
        if not with_out:
            return S_next, None
        gt = jnp.moveaxis(gcum, 1, -1)
        diff = gt[..., :, None] - gt[..., None, :]
        decay = jnp.where(incl, jnp.exp(jnp.where(incl, diff, 0.0)), 0.0)
        cb = jnp.einsum('bign,bjgn->bgij', cc, bc)
        y = jnp.einsum('bgij,bghij,bjghp->bighp', cb, decay, xdt) + jnp.einsum('bign,bigh,bghnp->bighp', cc, jnp.exp(gcum), S)
        return S_next, y

    S_final, y = lax.scan(step, S0, xs)
    return S_final, (unchunk(y, 1) if with_out else None)


def ssd_bidir(lat, ctx, a_neg, D_skip, with_ctx_out):
    x, dt, Bm, Cm = lat
    xc, dtc, Bc, Cc = ctx
    S0 = jnp.zeros((x.shape[0], SSM_GROUPS, SSM_HPG, SSM_STATE, SSM_HEAD_DIM), jnp.float32)
    f = lambda t: jnp.flip(t, axis=1)
    d = D_skip.astype(jnp.float32).reshape(SSM_GROUPS, SSM_HPG, 1)
    s_f, yc_f = ssd_chunk_scan(xc, dtc[0], a_neg[0], Bc, Cc, S0, with_ctx_out)
    s_b, yc_b = ssd_chunk_scan(f(xc), f(dtc[1]), a_neg[1], f(Bc), f(Cc), S0, with_ctx_out)
    _, y_f = ssd_chunk_scan(x, dt[0], a_neg[0], Bm, Cm, s_f, True)
    _, y_b = ssd_chunk_scan(f(x), f(dt[1]), a_neg[1], f(Bm), f(Cm), s_b, True)
    y = y_f + f(y_b) + d * x
    y_c = (yc_f + f(yc_b) + d * xc) if with_ctx_out else None
    return y, y_c


def ssm_gated_norm(y, z, w):
    t = y * jax.nn.silu(z.astype(jnp.float32))
    shp = t.shape
    t = t.reshape(shp[:-1] + (SSM_GROUPS, -1))
    t = t * lax.rsqrt(jnp.mean(t * t, -1, keepdims=True) + NORM_EPS)
    return t.reshape(shp).astype(z.dtype) * w


def raster_to_cols_grid(t, rows):
    Bsz, L, C = t.shape
    return t.reshape(Bsz, rows, GRID_W, C).transpose(0, 2, 1, 3)


def cols_to_raster(t, rows):
    Bsz, L, C = t.shape
    return t.reshape(Bsz, GRID_W, rows, C).transpose(0, 2, 1, 3).reshape(Bsz, L, C)


def mixer(h, hc, rows, w_in, gdn_conv_w, gdn_A_log, gdn_dt_bias, gdn_norm_w,
          ssm_conv_w, ssm_conv_b, ssm_A_log, ssm_dt_bias, ssm_D, ssm_norm_w,
          w_proj_gdn, w_proj_ssm, w_out, with_ctx_out):
    Bsz, L, _ = h.shape
    qkv, gout, a_raw, b_raw, z, xbc, dt_raw, gate_a, gate_b = split_cols(h @ w_in)
    qkv_c, gout_c, a_c, b_c, z_c, xbc_c, dt_c, gate_ac, gate_bc = split_cols(hc @ w_in)

    qkv = jax.nn.silu(dwconv(qkv.reshape(Bsz, rows, GRID_W, GDN_QKV), gdn_conv_w).reshape(Bsz, L, GDN_QKV))
    qkv_c = jax.nn.silu(dwconv(qkv_c, gdn_conv_w))
    o, o_c = gdn_bidir(gdn_prep(qkv, a_raw, b_raw, gdn_A_log, gdn_dt_bias),
                       gdn_prep(qkv_c, a_c, b_c, gdn_A_log, gdn_dt_bias), with_ctx_out)
    y_a = gdn_gated_norm(o, gout, gdn_norm_w)

    xbc = jax.nn.silu(dwconv(raster_to_cols_grid(xbc, rows), ssm_conv_w) + ssm_conv_b).reshape(Bsz, L, SSM_XBC)
    dt_cols = raster_to_cols_grid(dt_raw, rows).reshape(Bsz, L, 2 * SSM_HEADS)
    xbc_c = jax.nn.silu(dwconv(xbc_c, ssm_conv_w) + ssm_conv_b)
    xs, dt, a_neg, Bm, Cm = ssm_prep(xbc, dt_cols, ssm_A_log, ssm_dt_bias)
    xs_c, dt_cc, _, Bc, Cc = ssm_prep(xbc_c, dt_c, ssm_A_log, ssm_dt_bias)
    y, y_c = ssd_bidir((xs, dt, Bm, Cm), (xs_c, dt_cc, Bc, Cc), a_neg, ssm_D, with_ctx_out)
    y_b = ssm_gated_norm(cols_to_raster(y.reshape(Bsz, L, SSM_INNER), rows), z, ssm_norm_w)

    out = (jax.nn.sigmoid(gate_a) * (y_a @ w_proj_gdn) + jax.nn.sigmoid(gate_b) * (y_b @ w_proj_ssm)) @ w_out
    if not with_ctx_out:
        return out, None
    Lc = hc.shape[1]
    y_ac = gdn_gated_norm(o_c, gout_c, gdn_norm_w)
    y_bc = ssm_gated_norm(y_c.reshape(Bsz, Lc, SSM_INNER), z_c, ssm_norm_w)
    out_c = (jax.nn.sigmoid(gate_ac) * (y_ac @ w_proj_gdn) + jax.nn.sigmoid(gate_bc) * (y_bc @ w_proj_ssm)) @ w_out
    return out, out_c


def inv_softplus_dt(k, shape):
    dt = jnp.exp(jax.random.uniform(k, shape, jnp.float32, math.log(1e-3), math.log(1e-1)))
    return dt + jnp.log(-jnp.expm1(-dt))


def setup_inputs(seed: int = 0) -> dict:
    key = jax.random.key(seed)
    ks = jax.random.split(key, 32)
    f32 = jnp.float32
    nrm = lambda k, shape, s: jax.random.normal(k, shape, f32) * s
    return {
        'x': nrm(ks[0], (BATCH, SEQ, D_MODEL), 1.0),
        'c': nrm(ks[1], (BATCH, D_MODEL), 1.0),
        'ctx': nrm(ks[2], (BATCH, CTX_LEN, D_MODEL), 1.0),
        'c_ctx': nrm(ks[3], (D_MODEL,), 1.0),
        'w_mod': nrm(ks[4], (DEPTH, D_MODEL, 6 * D_MODEL), 0.5 * D_MODEL ** -0.5),
        'b_mod': nrm(ks[5], (DEPTH, 6 * D_MODEL), 0.01),
        'w_in': nrm(ks[6], (DEPTH, D_MODEL, IN_DIM), D_MODEL ** -0.5),
        'gdn_conv_w': nrm(ks[7], (DEPTH, CONV_K, GDN_QKV), CONV_K ** -0.5),
        'gdn_A_log': jnp.log(jax.random.uniform(ks[8], (DEPTH, 2, GDN_HEADS), f32, 1.0, 16.0)),
        'gdn_dt_bias': inv_softplus_dt(ks[9], (DEPTH, 2, GDN_HEADS)),
        'gdn_norm_w': 1.0 + nrm(ks[10], (DEPTH, GDN_DV), 0.02),
        'ssm_conv_w': nrm(ks[11], (DEPTH, CONV_K, SSM_XBC), CONV_K ** -0.5),
        'ssm_conv_b': nrm(ks[12], (DEPTH, SSM_XBC), 0.01),
        'ssm_A_log': jnp.log(jax.random.uniform(ks[13], (DEPTH, 2, SSM_HEADS), f32, 1.0, 16.0)),
        'ssm_dt_bias': inv_softplus_dt(ks[14], (DEPTH, 2, SSM_HEADS)),
        'ssm_D': 1.0 + nrm(ks[15], (DEPTH, SSM_HEADS), 0.02),
        'ssm_norm_w': 1.0 + nrm(ks[16], (DEPTH, SSM_INNER), 0.02),
        'w_proj_gdn': nrm(ks[17], (DEPTH, GDN_V, D_MODEL), GDN_V ** -0.5),
        'w_proj_ssm': nrm(ks[18], (DEPTH, SSM_INNER, D_MODEL), SSM_INNER ** -0.5),
        'w_out': nrm(ks[19], (DEPTH, D_MODEL, D_MODEL), D_MODEL ** -0.5 * DEEPNORM_BETA),
        'ln1_g': 1.0 + nrm(ks[20], (DEPTH, D_MODEL), 0.02),
        'ln1_b': nrm(ks[21], (DEPTH, D_MODEL), 0.01),
        'w_ff1': nrm(ks[22], (DEPTH, D_MODEL, D_FF), D_MODEL ** -0.5),
        'b_ff1': nrm(ks[23], (DEPTH, D_FF), 0.01),
        'w_ff2': nrm(ks[24], (DEPTH, D_FF, D_MODEL), D_FF ** -0.5 * DEEPNORM_BETA),
        'b_ff2': nrm(ks[25], (DEPTH, D_MODEL), 0.01),
        'ln2_g': 1.0 + nrm(ks[26], (DEPTH, D_MODEL), 0.02),
        'ln2_b': nrm(ks[27], (DEPTH, D_MODEL), 0.01),
    }


def reference(x, c, ctx, c_ctx, w_mod, b_mod, w_in, gdn_conv_w, gdn_A_log, gdn_dt_bias, gdn_norm_w,
              ssm_conv_w, ssm_conv_b, ssm_A_log, ssm_dt_bias, ssm_D, ssm_norm_w,
              w_proj_gdn, w_proj_ssm, w_out, ln1_g, ln1_b, w_ff1, b_ff1, w_ff2, b_ff2, ln2_g, ln2_b):
    rows = x.shape[1] // GRID_W
    for l in range(DEPTH):
        last = l == DEPTH - 1
        mod = jax.nn.silu(c) @ w_mod[l] + b_mod[l]
        mod_c = jax.nn.silu(c_ctx) @ w_mod[l] + b_mod[l]
        sh1, sc1, g1, sh2, sc2, g2 = jnp.split(mod[:, None, :], 6, axis=-1)
        sh1c, sc1c, g1c, sh2c, sc2c, g2c = jnp.split(mod_c, 6)
        mix, mix_c = mixer(x * (1.0 + sc1) + sh1, ctx * (1.0 + sc1c) + sh1c, rows, w_in[l],
                           gdn_conv_w[l], gdn_A_log[l], gdn_dt_bias[l], gdn_norm_w[l],
                           ssm_conv_w[l], ssm_conv_b[l], ssm_A_log[l], ssm_dt_bias[l], ssm_D[l], ssm_norm_w[l],
                           w_proj_gdn[l], w_proj_ssm[l], w_out[l], not last)
        x = layer_norm(DEEPNORM_ALPHA * x + g1 * mix, ln1_g[l], ln1_b[l])
        x = layer_norm(DEEPNORM_ALPHA * x + g2 * mlp(x * (1.0 + sc2) + sh2, w_ff1[l], b_ff1[l], w_ff2[l], b_ff2[l]), ln2_g[l], ln2_b[l])
        if not last:
            ctx = layer_norm(DEEPNORM_ALPHA * ctx + g1c * mix_c, ln1_g[l], ln1_b[l])
            ctx = layer_norm(DEEPNORM_ALPHA * ctx + g2c * mlp(ctx * (1.0 + sc2c) + sh2c, w_ff1[l], b_ff1[l], w_ff2[l], b_ff2[l]), ln2_g[l], ln2_b[l])
    return x
```

```cpp
#include <hip/hip_runtime.h>
#include <hip/hip_cooperative_groups.h>
#include <cstdio>
namespace cg = cooperative_groups;

typedef unsigned short bf16_t;
typedef short bf16x8 __attribute__((ext_vector_type(8)));
typedef float f32x4 __attribute__((ext_vector_type(4)));
typedef float f32x2 __attribute__((ext_vector_type(2)));
typedef unsigned u32x4 __attribute__((ext_vector_type(4)));

constexpr int D = 1024, SEQ = 8192, LC = 256;
constexpr int G = 2, NGRP = 4;
constexpr int MLAT = G * SEQ, MCTX = G * LC, MG = MLAT + MCTX;
constexpr int IN_DIM = 12384, LDP = 12416;
constexpr int C_GOUT = 3072, C_A = 4096, C_B = 4112, C_Z = 4128, C_XBC = 6176, C_DT = 10272, C_GA = 10336, C_GB = 11360;
constexpr float DN_ALPHA = 1.4142135623730951f;

constexpr size_t SZ_WIN = (size_t)LDP * 1024 * 2;
constexpr size_t OFF_WIN = 0;
constexpr size_t OFF_WPG = OFF_WIN + SZ_WIN;
constexpr size_t OFF_WPS = OFF_WPG + 2097152;
constexpr size_t OFF_WOUT = OFF_WPS + 4194304;
constexpr size_t OFF_WFF1 = OFF_WOUT + 2097152;
constexpr size_t OFF_WFF2 = OFF_WFF1 + 8388608;
constexpr size_t OFF_MODP = OFF_WFF2 + 8388608;
constexpr size_t OFF_MOD = OFF_MODP + (size_t)2 * 16 * 9 * 6144 * 4;
constexpr size_t OFF_XSC = OFF_MOD + (size_t)2 * 9 * 6144 * 4;
constexpr size_t OFF_H = OFF_XSC + (size_t)2048 * 1024 * 4;
constexpr size_t OFF_P = OFF_H + (size_t)MG * 1024 * 2;
constexpr size_t OFF_QKV = OFF_P + (size_t)MG * LDP * 2;
constexpr size_t OFF_XBC = OFF_QKV + (size_t)MG * 3072 * 2;
constexpr size_t OFF_GBF = OFF_XBC + (size_t)MG * 4096 * 2;
constexpr size_t OFF_DTF = OFF_GBF + (size_t)MG * 32 * 4;
constexpr size_t OFF_OF = OFF_DTF + (size_t)MG * 128 * 4;
constexpr size_t OFF_OB = OFF_OF + (size_t)MG * 1024 * 2;
constexpr size_t OFF_YF = OFF_OB + (size_t)MG * 1024 * 2;
constexpr size_t OFF_YB = OFF_YF + (size_t)MG * 2048 * 2;
constexpr size_t WS_TOTAL = OFF_YB + (size_t)MG * 2048 * 2;
static_assert(WS_TOTAL <= ((size_t)1024 << 20), "workspace plan exceeds 1 GiB");

struct Params {
  const float *x, *c, *ctx, *c_ctx, *w_mod, *b_mod, *w_in, *gdn_conv_w, *gdn_A_log, *gdn_dt_bias, *gdn_norm_w;
  const float *ssm_conv_w, *ssm_conv_b, *ssm_A_log, *ssm_dt_bias, *ssm_D, *ssm_norm_w, *w_proj_gdn, *w_proj_ssm, *w_out;
  const float *ln1_g, *ln1_b, *w_ff1, *b_ff1, *w_ff2, *b_ff2, *ln2_g, *ln2_b;
  float* out;
  unsigned char* ws;
};

constexpr int SMEM_BYTES = 57600;


__device__ __forceinline__ int TIDX() { int t = threadIdx.x; asm volatile("" : "+v"(t)); return t; }
__device__ __forceinline__ int BIDX() { int t = blockIdx.x; asm volatile("" : "+s"(t)); return t; }
__device__ __forceinline__ int GDIM() { int t = gridDim.x; asm volatile("" : "+s"(t)); return t; }
__device__ __forceinline__ float bf2f(bf16_t b) { return __uint_as_float(((unsigned)b) << 16); }
__device__ __forceinline__ bf16_t f2bf(float f) { unsigned u = __float_as_uint(f); u += 0x7fffu + ((u >> 16) & 1u); return (bf16_t)(u >> 16); }
__device__ __forceinline__ unsigned pack2(float a, float b) { return (unsigned)f2bf(a) | ((unsigned)f2bf(b) << 16); }
__device__ __forceinline__ float lo16(unsigned v) { return __uint_as_float(v << 16); }
__device__ __forceinline__ float hi16(unsigned v) { return __uint_as_float(v & 0xffff0000u); }
#define UNPACK8(v, f) { f[0] = lo16(v.x); f[1] = hi16(v.x); f[2] = lo16(v.y); f[3] = hi16(v.y); f[4] = lo16(v.z); f[5] = hi16(v.z); f[6] = lo16(v.w); f[7] = hi16(v.w); }
__device__ __forceinline__ uint4 pack8(const float* f) { uint4 r; r.x = pack2(f[0], f[1]); r.y = pack2(f[2], f[3]); r.z = pack2(f[4], f[5]); r.w = pack2(f[6], f[7]); return r; }
__device__ __forceinline__ float sigmoidf_(float x) { return 1.f / (1.f + __expf(-x)); }
__device__ __forceinline__ float siluf_(float x) { return x / (1.f + __expf(-x)); }
__device__ __forceinline__ float softplusf_(float x) { return x > 20.f ? x : log1pf(__expf(x)); }
template <int CTRL> __device__ __forceinline__ float dppf(float x) { return __builtin_bit_cast(float, __builtin_amdgcn_mov_dpp(__builtin_bit_cast(int, x), CTRL, 0xf, 0xf, true)); }
__device__ __forceinline__ float reduce16(float x) { x += dppf<0xB1>(x); x += dppf<0x4E>(x); x += dppf<0x141>(x); x += dppf<0x140>(x); return x; }

__device__ __forceinline__ float* xs_row(const Params& p, int g, int r) {
  return (r < MLAT) ? p.out + ((size_t)g * MLAT + r) * D : (float*)(p.ws + OFF_XSC) + ((size_t)g * MCTX + (r - MLAT)) * D;
}
__device__ __forceinline__ const float* xin_row(const Params& p, int l, int g, int r) {
  if (l == 0) return (r < MLAT) ? p.x + ((size_t)g * MLAT + r) * D : p.ctx + ((size_t)g * MCTX + (r - MLAT)) * D;
  return xs_row(p, g, r);
}
__device__ __forceinline__ int mod_row(int g, int r) { return r < MLAT ? g * G + r / SEQ : 8; }

__device__ void transpose_phase(const float* __restrict__ src, bf16_t* __restrict__ dst, int K, int N, int Npad, float* tile) {
  const int tid = TIDX(), tk = K / 64, tn = Npad / 64;
  const int c = tid & 63, r4 = tid >> 6;
  for (int t = BIDX(); t < tk * tn; t += GDIM()) {
    const int kt = t % tk, nt = t / tk, k0 = kt * 64, n0 = nt * 64;
    __syncthreads();
#pragma unroll 4
    for (int i = 0; i < 16; ++i) { const int r = i * 4 + r4, n = n0 + c; tile[r * 65 + c] = (n < N) ? src[(size_t)(k0 + r) * N + n] : 0.f; }
    __syncthreads();
#pragma unroll 4
    for (int i = 0; i < 16; ++i) { const int nn = i * 4 + r4; dst[(size_t)(n0 + nn) * K + k0 + c] = f2bf(tile[c * 65 + nn]); }
  }
}

__device__ void modpart_phase(const Params& p, float* sm) {
  const int tid = TIDX();
  float* MODP = (float*)(p.ws + OFF_MODP);
  for (int item = BIDX(); item < 2 * 24 * 16; item += GDIM()) {
    const int l = item / 384, rem = item % 384, cbk = rem / 16, ks = rem % 16;
    __syncthreads();
    for (int i = tid; i < 9 * 64; i += 256) { const int r = i / 64, k = ks * 64 + (i % 64); const float v = (r < 8) ? p.c[r * D + k] : p.c_ctx[k]; sm[i] = siluf_(v); }
    __syncthreads();
    const int col = cbk * 256 + tid;
    float acc[9];
#pragma unroll
    for (int r = 0; r < 9; ++r) acc[r] = 0.f;
    const float* wp = p.w_mod + ((size_t)l * D + ks * 64) * 6144 + col;
#pragma unroll 8
    for (int k = 0; k < 64; ++k) { const float w = wp[(size_t)k * 6144];
#pragma unroll
      for (int r = 0; r < 9; ++r) acc[r] += sm[r * 64 + k] * w; }
#pragma unroll
    for (int r = 0; r < 9; ++r) MODP[(((size_t)l * 16 + ks) * 9 + r) * 6144 + col] = acc[r];
  }
}
__device__ void modfinal_phase(const Params& p) {
  const float* MODP = (const float*)(p.ws + OFF_MODP);
  float* MOD = (float*)(p.ws + OFF_MOD);
  for (int i = BIDX() * 256 + TIDX(); i < 2 * 9 * 6144; i += GDIM() * 256) {
    const int l = i / (9 * 6144), rem = i % (9 * 6144), col = rem % 6144;
    float s = p.b_mod[l * 6144 + col];
    for (int ks = 0; ks < 16; ++ks) s += MODP[((size_t)l * 16 + ks) * 9 * 6144 + rem];
    MOD[i] = s;
  }
}

__device__ void modulate_phase(const Params& p, int l, int g) {
  const float* MOD = (const float*)(p.ws + OFF_MOD) + (size_t)l * 9 * 6144;
  bf16_t* H = (bf16_t*)(p.ws + OFF_H);
  for (int i = BIDX() * 256 + TIDX(); i < MG * 128; i += GDIM() * 256) {
    const int r = i >> 7, ch = (i & 127) * 8;
    const float* xr = xin_row(p, l, g, r) + ch;
    const float* m = MOD + (size_t)mod_row(g, r) * 6144;
    const float4 x0 = *(const float4*)xr, x1 = *(const float4*)(xr + 4);
    const float4 sh0 = *(const float4*)(m + ch), sh1 = *(const float4*)(m + ch + 4);
    const float4 sc0 = *(const float4*)(m + 1024 + ch), sc1 = *(const float4*)(m + 1024 + ch + 4);
    float f[8] = {x0.x * (1.f + sc0.x) + sh0.x, x0.y * (1.f + sc0.y) + sh0.y, x0.z * (1.f + sc0.z) + sh0.z, x0.w * (1.f + sc0.w) + sh0.w,
                  x1.x * (1.f + sc1.x) + sh1.x, x1.y * (1.f + sc1.y) + sh1.y, x1.z * (1.f + sc1.z) + sh1.z, x1.w * (1.f + sc1.w) + sh1.w};
    *(uint4*)(H + (size_t)r * D + ch) = pack8(f);
  }
}

__device__ __forceinline__ void gemm_kloop(f32x4 (&acc)[4][4], const bf16_t* __restrict__ A, int lda, const bf16_t* __restrict__ Bt, int ldb,
                                           int m0, int n0, int K, bf16_t* sA, bf16_t* sB) {
  const int tid = TIDX(), lane = tid & 63, w = tid >> 6, wr = w >> 1, wc = w & 1;
  const int lr = tid >> 3, lk = (tid & 7) * 8;
  const bf16_t* ap = A + (size_t)(m0 + lr) * lda + lk;
  const bf16_t* bp = Bt + (size_t)(n0 + lr) * ldb + lk;
  u32x4 ra[4], rb[4];
#pragma unroll
  for (int i = 0; i < 4; ++i) { ra[i] = *(const u32x4*)(ap + (size_t)i * 32 * lda); rb[i] = *(const u32x4*)(bp + (size_t)i * 32 * ldb); }
  __syncthreads();
#pragma unroll
  for (int i = 0; i < 4; ++i) { *(u32x4*)(sA + (lr + 32 * i) * 72 + lk) = ra[i]; *(u32x4*)(sB + (lr + 32 * i) * 72 + lk) = rb[i]; }
  __syncthreads();
  const int nk = K >> 6, fr = lane & 15, fq = lane >> 4;
  const bf16_t* sAr = sA + (wr * 64 + fr) * 72 + fq * 8;
  const bf16_t* sBr = sB + (wc * 64 + fr) * 72 + fq * 8;
  for (int kt = 0; kt < nk; ++kt) {
    if (kt + 1 < nk) {
      const int ko = (kt + 1) * 64;
#pragma unroll
      for (int i = 0; i < 4; ++i) { ra[i] = *(const u32x4*)(ap + (size_t)i * 32 * lda + ko); rb[i] = *(const u32x4*)(bp + (size_t)i * 32 * ldb + ko); }
    }
#pragma unroll
    for (int kk = 0; kk < 2; ++kk) {
      bf16x8 af[4], bfr[4];
#pragma unroll
      for (int i = 0; i < 4; ++i) { af[i] = *(const bf16x8*)(sAr + i * 16 * 72 + kk * 32); bfr[i] = *(const bf16x8*)(sBr + i * 16 * 72 + kk * 32); }
#pragma unroll
      for (int i = 0; i < 4; ++i)
#pragma unroll
        for (int j = 0; j < 4; ++j) acc[i][j] = __builtin_amdgcn_mfma_f32_16x16x32_bf16(bfr[j], af[i], acc[i][j], 0, 0, 0);
    }
    __syncthreads();
    if (kt + 1 < nk) {
#pragma unroll
      for (int i = 0; i < 4; ++i) { *(u32x4*)(sA + (lr + 32 * i) * 72 + lk) = ra[i]; *(u32x4*)(sB + (lr + 32 * i) * 72 + lk) = rb[i]; }
    }
    __syncthreads();
  }
}

__device__ __forceinline__ bool tile_coord(int it, int nM, int nN, int& mt, int& nt) {
  const int nb = GDIM(), v = BIDX();
  long s;
  if ((nb & 7) == 0) { const int per = nb >> 3; s = (long)it * nb + (v & 7) * per + (v >> 3); } else s = (long)it * nb + v;
  if (s >= (long)nM * nN) return false;
  const int band = (int)(s / (8 * nN)), r = (int)(s - (long)band * 8 * nN);
  const int bsz = (nM - band * 8) < 8 ? (nM - band * 8) : 8;
  nt = r / bsz; mt = band * 8 + (r % bsz);
  return true;
}

#define ZERO_ACC(acc) { _Pragma("unroll") for (int i_ = 0; i_ < 4; ++i_) { _Pragma("unroll") for (int j_ = 0; j_ < 4; ++j_) acc[i_][j_] = (f32x4){0.f, 0.f, 0.f, 0.f}; } }
#define EPI_LOOP(...) { const int lane_ = TIDX() & 63, w_ = TIDX() >> 6; \
  _Pragma("unroll") for (int i_ = 0; i_ < 4; ++i_) { const int row = m0 + (w_ >> 1) * 64 + i_ * 16 + (lane_ & 15); \
  _Pragma("unroll") for (int j_ = 0; j_ < 4; ++j_) { const int col = n0 + (w_ & 1) * 64 + j_ * 16 + (lane_ >> 4) * 4; f32x4& v = acc[i_][j_]; __VA_ARGS__ } } }

__device__ void gemm_inproj_phase(const Params& p, bf16_t* sm) {
  const bf16_t* H = (const bf16_t*)(p.ws + OFF_H); const bf16_t* W = (const bf16_t*)(p.ws + OFF_WIN);
  bf16_t* P = (bf16_t*)(p.ws + OFF_P);
  const int nM = MG / 128, nN = LDP / 128;
  for (int it = 0;; ++it) {
    int mt, nt; if (!tile_coord(it, nM, nN, mt, nt)) break;
    const int m0 = mt * 128, n0 = nt * 128;
    f32x4 acc[4][4]; ZERO_ACC(acc);
    gemm_kloop(acc, H, D, W, D, m0, n0, D, sm, sm + 128 * 72);
    EPI_LOOP({ uint2 o; o.x = pack2(v[0], v[1]); o.y = pack2(v[2], v[3]); *(uint2*)(P + (size_t)row * LDP + col) = o; })
  }
}
__device__ void gemm_proj_phase(const Params& p, int M, bf16_t* sm) {
  const bf16_t* YA = (const bf16_t*)(p.ws + OFF_QKV); const bf16_t* YBn = YA + (size_t)MG * 1024;
  const bf16_t* Wg = (const bf16_t*)(p.ws + OFF_WPG); const bf16_t* Ws = (const bf16_t*)(p.ws + OFF_WPS);
  const bf16_t* P = (const bf16_t*)(p.ws + OFF_P);
  bf16_t* U = (bf16_t*)(p.ws + OFF_H);
  const int nM = M / 128, nN = 8;
  for (int it = 0;; ++it) {
    int mt, nt; if (!tile_coord(it, nM, nN, mt, nt)) break;
    const int m0 = mt * 128, n0 = nt * 128;
    f32x4 acc[4][4]; ZERO_ACC(acc);
    gemm_kloop(acc, YA, 1024, Wg, 1024, m0, n0, 1024, sm, sm + 128 * 72);
    EPI_LOOP({ const uint2 ga = *(const uint2*)(P + (size_t)row * LDP + C_GA + col); const uint2 gb = *(const uint2*)(P + (size_t)row * LDP + C_GB + col);
      v[0] *= (1.f + __expf(-lo16(gb.x))) / (1.f + __expf(-lo16(ga.x))); v[1] *= (1.f + __expf(-hi16(gb.x))) / (1.f + __expf(-hi16(ga.x)));
      v[2] *= (1.f + __expf(-lo16(gb.y))) / (1.f + __expf(-lo16(ga.y))); v[3] *= (1.f + __expf(-hi16(gb.y))) / (1.f + __expf(-hi16(ga.y))); })
    gemm_kloop(acc, YBn, 2048, Ws, 2048, m0, n0, 2048, sm, sm + 128 * 72);
    EPI_LOOP({ const uint2 gb = *(const uint2*)(P + (size_t)row * LDP + C_GB + col);
      uint2 o; o.x = pack2(v[0] * sigmoidf_(lo16(gb.x)), v[1] * sigmoidf_(hi16(gb.x))); o.y = pack2(v[2] * sigmoidf_(lo16(gb.y)), v[3] * sigmoidf_(hi16(gb.y)));
      *(uint2*)(U + (size_t)row * D + col) = o; })
  }
}
__device__ void gemm_wout_phase(const Params& p, int l, int g, int M, bf16_t* sm) {
  const bf16_t* U = (const bf16_t*)(p.ws + OFF_H); const bf16_t* W = (const bf16_t*)(p.ws + OFF_WOUT);
  const float* MOD = (const float*)(p.ws + OFF_MOD) + (size_t)l * 9 * 6144;
  const int nM = M / 128, nN = 8;
  for (int it = 0;; ++it) {
    int mt, nt; if (!tile_coord(it, nM, nN, mt, nt)) break;
    const int m0 = mt * 128, n0 = nt * 128;
    f32x4 acc[4][4]; ZERO_ACC(acc);
    gemm_kloop(acc, U, D, W, D, m0, n0, D, sm, sm + 128 * 72);
    EPI_LOOP({ const float4 xr = *(const float4*)(xin_row(p, l, g, row) + col); const float4 g1 = *(const float4*)(MOD + (size_t)mod_row(g, row) * 6144 + 2048 + col);
      float4 o; o.x = DN_ALPHA * xr.x + g1.x * v[0]; o.y = DN_ALPHA * xr.y + g1.y * v[1]; o.z = DN_ALPHA * xr.z + g1.z * v[2]; o.w = DN_ALPHA * xr.w + g1.w * v[3];
      *(float4*)(xs_row(p, g, row) + col) = o; })
  }
}
__device__ void gemm_ff1_phase(const Params& p, int l, int M, bf16_t* sm) {
  const bf16_t* H = (const bf16_t*)(p.ws + OFF_H); const bf16_t* W = (const bf16_t*)(p.ws + OFF_WFF1);
  bf16_t* HID = (bf16_t*)(p.ws + OFF_P);
  const float* b1 = p.b_ff1 + (size_t)l * 4096;
  const int nM = M / 128, nN = 32;
  for (int it = 0;; ++it) {
    int mt, nt; if (!tile_coord(it, nM, nN, mt, nt)) break;
    const int m0 = mt * 128, n0 = nt * 128;
    f32x4 acc[4][4]; ZERO_ACC(acc);
    gemm_kloop(acc, H, D, W, D, m0, n0, D, sm, sm + 128 * 72);
    EPI_LOOP({ const float4 b = *(const float4*)(b1 + col);
      float t0 = fmaxf(v[0] + b.x, 0.f), t1 = fmaxf(v[1] + b.y, 0.f), t2 = fmaxf(v[2] + b.z, 0.f), t3 = fmaxf(v[3] + b.w, 0.f);
      uint2 o; o.x = pack2(t0 * t0, t1 * t1); o.y = pack2(t2 * t2, t3 * t3); *(uint2*)(HID + (size_t)row * 4096 + col) = o; })
  }
}
__device__ void gemm_ff2_phase(const Params& p, int l, int g, int M, bf16_t* sm) {
  const bf16_t* HID = (const bf16_t*)(p.ws + OFF_P); const bf16_t* W = (const bf16_t*)(p.ws + OFF_WFF2);
  const float* MOD = (const float*)(p.ws + OFF_MOD) + (size_t)l * 9 * 6144;
  const float* b2 = p.b_ff2 + (size_t)l * 1024;
  const int nM = M / 128, nN = 8;
  for (int it = 0;; ++it) {
    int mt, nt; if (!tile_coord(it, nM, nN, mt, nt)) break;
    const int m0 = mt * 128, n0 = nt * 128;
    f32x4 acc[4][4]; ZERO_ACC(acc);
    gemm_kloop(acc, HID, 4096, W, 4096, m0, n0, 4096, sm, sm + 128 * 72);
    EPI_LOOP({ float* xp = xs_row(p, g, row) + col; const float4 xr = *(const float4*)xp; const float4 b = *(const float4*)(b2 + col);
      const float4 g2 = *(const float4*)(MOD + (size_t)mod_row(g, row) * 6144 + 5120 + col);
      float4 o; o.x = DN_ALPHA * xr.x + g2.x * (v[0] + b.x); o.y = DN_ALPHA * xr.y + g2.y * (v[1] + b.y); o.z = DN_ALPHA * xr.z + g2.z * (v[2] + b.z); o.w = DN_ALPHA * xr.w + g2.w * (v[3] + b.w);
      *(float4*)xp = o; })
  }
}

__device__ void ln_phase(const Params& p, int l, int g, int M, const float* gam, const float* bet, bool write_h2) {
  const int lane = TIDX() & 63;
  const float* MOD = (const float*)(p.ws + OFF_MOD) + (size_t)l * 9 * 6144;
  bf16_t* H = (bf16_t*)(p.ws + OFF_H);
  for (int r = BIDX() * 4 + (TIDX() >> 6); r < M; r += GDIM() * 4) {
    float* xr = xs_row(p, g, r);
    float4 v[4];
    float s = 0.f;
#pragma unroll
    for (int i = 0; i < 4; ++i) { v[i] = *(const float4*)(xr + (i * 64 + lane) * 4); s += v[i].x + v[i].y + v[i].z + v[i].w; }
#pragma unroll
    for (int o = 32; o >= 1; o >>= 1) s += __shfl_xor(s, o);
    const float mu = s * (1.f / 1024.f);
    float q = 0.f;
#pragma unroll
    for (int i = 0; i < 4; ++i) { v[i].x -= mu; v[i].y -= mu; v[i].z -= mu; v[i].w -= mu; q += v[i].x * v[i].x + v[i].y * v[i].y + v[i].z * v[i].z + v[i].w * v[i].w; }
#pragma unroll
    for (int o = 32; o >= 1; o >>= 1) q += __shfl_xor(q, o);
    const float rs = rsqrtf(q * (1.f / 1024.f) + 1e-5f);
    const float* m = MOD + (size_t)mod_row(g, r) * 6144;
#pragma unroll
    for (int i = 0; i < 4; ++i) {
      const int ch = (i * 64 + lane) * 4;
      const float4 gg = *(const float4*)(gam + ch), bb = *(const float4*)(bet + ch);
      float4 o; o.x = v[i].x * rs * gg.x + bb.x; o.y = v[i].y * rs * gg.y + bb.y; o.z = v[i].z * rs * gg.z + bb.z; o.w = v[i].w * rs * gg.w + bb.w;
      *(float4*)(xr + ch) = o;
      if (write_h2) {
        const float4 sh = *(const float4*)(m + 3072 + ch), sc = *(const float4*)(m + 4096 + ch);
        uint2 h; h.x = pack2(o.x * (1.f + sc.x) + sh.x, o.y * (1.f + sc.y) + sh.y); h.y = pack2(o.z * (1.f + sc.z) + sh.z, o.w * (1.f + sc.w) + sh.w);
        *(uint2*)(H + (size_t)r * D + ch) = h;
      }
    }
  }
}

__device__ void conv_phase(const Params& p, int l) {
  const bf16_t* P = (const bf16_t*)(p.ws + OFF_P);
  bf16_t* QKV = (bf16_t*)(p.ws + OFF_QKV); bf16_t* XBC = (bf16_t*)(p.ws + OFF_XBC);
  float* GBF = (float*)(p.ws + OFF_GBF); float* DTF = (float*)(p.ws + OFF_DTF);
  const int gtid = BIDX() * 256 + TIDX(), gsz = GDIM() * 256;
  const float* cw = p.gdn_conv_w + (size_t)l * 5 * 3072;
  for (int idx = gtid; idx < MG * 384; idx += gsz) {
    const int r = idx / 384, chunk = idx % 384, ch0 = chunk * 8;
    int pos, seglen;
    if (r < MLAT) { pos = r & 63; seglen = 64; } else { pos = (r - MLAT) & 255; seglen = 256; }
    float acc[8];
#pragma unroll
    for (int e = 0; e < 8; ++e) acc[e] = 0.f;
#pragma unroll
    for (int j = 0; j < 5; ++j) {
      const int pp = pos + j - 2;
      if (pp >= 0 && pp < seglen) {
        const uint4 raw = *(const uint4*)(P + (size_t)(r + j - 2) * LDP + ch0);
        float f[8]; UNPACK8(raw, f);
        const float4 w0 = *(const float4*)(cw + j * 3072 + ch0), w1 = *(const float4*)(cw + j * 3072 + ch0 + 4);
        acc[0] += f[0] * w0.x; acc[1] += f[1] * w0.y; acc[2] += f[2] * w0.z; acc[3] += f[3] * w0.w;
        acc[4] += f[4] * w1.x; acc[5] += f[5] * w1.y; acc[6] += f[6] * w1.z; acc[7] += f[7] * w1.w;
      }
    }
    float ss = 0.f;
#pragma unroll
    for (int e = 0; e < 8; ++e) { acc[e] = siluf_(acc[e]); ss += acc[e] * acc[e]; }
    ss += __shfl_xor(ss, 1); ss += __shfl_xor(ss, 2); ss += __shfl_xor(ss, 4); ss += __shfl_xor(ss, 8);
    float sc = 1.f;
    if (chunk < 256) { sc = rsqrtf(ss + 1e-6f); if (chunk < 128) sc *= 0.08838834764831845f; }
#pragma unroll
    for (int e = 0; e < 8; ++e) acc[e] *= sc;
    *(uint4*)(QKV + (size_t)r * 3072 + ch0) = pack8(acc);
  }
  const float* sw = p.ssm_conv_w + (size_t)l * 5 * 4096; const float* sb = p.ssm_conv_b + (size_t)l * 4096;
  for (int idx = gtid; idx < MG * 512; idx += gsz) {
    const int r = idx >> 9, ch0 = (idx & 511) * 8;
    int pos, seglen, stride;
    if (r < MLAT) { pos = (r & 8191) >> 6; seglen = 128; stride = 64; } else { pos = (r - MLAT) & 255; seglen = 256; stride = 1; }
    const float4 b0 = *(const float4*)(sb + ch0), b1 = *(const float4*)(sb + ch0 + 4);
    float acc[8] = {b0.x, b0.y, b0.z, b0.w, b1.x, b1.y, b1.z, b1.w};
#pragma unroll
    for (int j = 0; j < 5; ++j) {
      const int pp = pos + j - 2;
      if (pp >= 0 && pp < seglen) {
        const uint4 raw = *(const uint4*)(P + (size_t)(r + (j - 2) * stride) * LDP + C_XBC + ch0);
        float f[8]; UNPACK8(raw, f);
        const float4 w0 = *(const float4*)(sw + j * 4096 + ch0), w1 = *(const float4*)(sw + j * 4096 + ch0 + 4);
        acc[0] += f[0] * w0.x; acc[1] += f[1] * w0.y; acc[2] += f[2] * w0.z; acc[3] += f[3] * w0.w;
        acc[4] += f[4] * w1.x; acc[5] += f[5] * w1.y; acc[6] += f[6] * w1.z; acc[7] += f[7] * w1.w;
      }
    }
#pragma unroll
    for (int e = 0; e < 8; ++e) acc[e] = siluf_(acc[e]);
    *(uint4*)(XBC + (size_t)r * 4096 + ch0) = pack8(acc);
  }
  for (int idx = gtid; idx < MG * 16; idx += gsz) {
    const int r = idx >> 4, dh = idx & 15;
    const float a_raw = bf2f(P[(size_t)r * LDP + C_A + dh]), b_raw = bf2f(P[(size_t)r * LDP + C_B + dh]);
    const float gg = -__expf(p.gdn_A_log[l * 16 + dh]) * softplusf_(a_raw + p.gdn_dt_bias[l * 16 + dh]);
    GBF[(size_t)r * 32 + dh] = __expf(gg);
    GBF[(size_t)r * 32 + 16 + dh] = sigmoidf_(b_raw);
  }
  for (int idx = gtid; idx < MG * 64; idx += gsz) {
    const int r = idx >> 6, dh = idx & 63;
    const float dtr = bf2f(P[(size_t)r * LDP + C_DT + dh]);
    const float dt = softplusf_(dtr + p.ssm_dt_bias[l * 64 + dh]);
    DTF[(size_t)r * 128 + dh] = dt;
    DTF[(size_t)r * 128 + 64 + dh] = __expf(-dt * __expf(p.ssm_A_log[l * 64 + dh]));
  }
}

__device__ void gdn_scan_item(const Params& p, int item, float* sm) {
  const int tid = TIDX();
  const int b_l = item >> 7, h = (item >> 4) & 7, dir = (item >> 3) & 1, cb = item & 7;
  const int col = tid >> 4, sub = tid & 15;
  float* KQ = sm; float* Vs = KQ + 2 * 6144; float* ABs = Vs + 2 * 256; float* Ost = ABs + 2 * 32;
  const bf16_t* QKV = (const bf16_t*)(p.ws + OFF_QKV);
  const float* GBF = (const float*)(p.ws + OFF_GBF);
  bf16_t* OUT = (bf16_t*)(p.ws + (dir ? OFF_OB : OFF_OF));
  auto rowof = [&](int s) -> int {
    if (s < 256) { const int i = dir ? 255 - s : s; return MLAT + b_l * 256 + i; }
    const int i = s - 256; const int t = dir ? 8191 - i : i; return b_l * 8192 + t; };
  const int ltok = tid >> 5, lpart = tid & 31;
  const int lco = (lpart < 16) ? (h * 128 + lpart * 8) : (1024 + h * 128 + (lpart - 16) * 8);
  const int ldst = ((lpart < 16) ? 192 : 0) + (lpart & 15) * 12;
  u32x4 rkq0, rkq1, rv = (u32x4){0u, 0u, 0u, 0u}; float rab = 0.f;
  auto gload = [&](int c) {
    const int s0 = c * 16;
    rkq0 = *(const u32x4*)(QKV + (size_t)rowof(s0 + ltok) * 3072 + lco);
    rkq1 = *(const u32x4*)(QKV + (size_t)rowof(s0 + 8 + ltok) * 3072 + lco);
    if (tid < 32) rv = *(const u32x4*)(QKV + (size_t)rowof(s0 + (tid >> 1)) * 3072 + 2048 + h * 128 + cb * 16 + (tid & 1) * 8);
    else if (tid >= 64 && tid < 96) rab = GBF[(size_t)rowof(s0 + ((tid - 64) >> 1)) * 32 + ((tid - 64) & 1) * 16 + dir * 8 + h];
  };
  auto lstore = [&](int buf) {
    float* d0 = KQ + buf * 6144 + ltok * 384 + ldst;
    *(f32x4*)d0 = (f32x4){lo16(rkq0[0]), hi16(rkq0[0]), lo16(rkq0[1]), hi16(rkq0[1])};
    *(f32x4*)(d0 + 4) = (f32x4){lo16(rkq0[2]), hi16(rkq0[2]), lo16(rkq0[3]), hi16(rkq0[3])};
    float* d1 = d0 + 8 * 384;
    *(f32x4*)d1 = (f32x4){lo16(rkq1[0]), hi16(rkq1[0]), lo16(rkq1[1]), hi16(rkq1[1])};
    *(f32x4*)(d1 + 4) = (f32x4){lo16(rkq1[2]), hi16(rkq1[2]), lo16(rkq1[3]), hi16(rkq1[3])};
    if (tid < 32) { float* dv = Vs + buf * 256 + (tid >> 1) * 16 + (tid & 1) * 8;
      *(f32x4*)dv = (f32x4){lo16(rv[0]), hi16(rv[0]), lo16(rv[1]), hi16(rv[1])};
      *(f32x4*)(dv + 4) = (f32x4){lo16(rv[2]), hi16(rv[2]), lo16(rv[3]), hi16(rv[3])}; }
    else if (tid >= 64 && tid < 96) ABs[buf * 32 + (tid - 64)] = rab;
  };
  f32x2 S[4];
#pragma unroll
  for (int i = 0; i < 4; ++i) S[i] = (f32x2){0.f, 0.f};
  __syncthreads();
  gload(0); lstore(0);
  __syncthreads();
  constexpr int NCH = (256 + 8192) / 16;
  for (int c = 0; c < NCH; ++c) {
    const int buf = c & 1;
    if (c + 1 < NCH) gload(c + 1);
    const float* kq = KQ + buf * 6144 + sub * 12;
    const float* vs = Vs + buf * 256 + col;
    const float* ab = ABs + buf * 32;
    float* ost = Ost + buf * 256 + col;
#pragma unroll 4
    for (int j = 0; j < 16; ++j) {
      const float* kb = kq + j * 384;
      const f32x4 ka = *(const f32x4*)kb, kc = *(const f32x4*)(kb + 4), qa = *(const f32x4*)(kb + 192), qc = *(const f32x4*)(kb + 196);
      const f32x2 K2[4] = {(f32x2){ka[0], ka[1]}, (f32x2){ka[2], ka[3]}, (f32x2){kc[0], kc[1]}, (f32x2){kc[2], kc[3]}};
      const f32x2 Q2[4] = {(f32x2){qa[0], qa[1]}, (f32x2){qa[2], qa[3]}, (f32x2){qc[0], qc[1]}, (f32x2){qc[2], qc[3]}};
      const float a = ab[j * 2], beta = ab[j * 2 + 1], v = vs[j * 16];
      f32x2 d0 = S[0] * K2[0], d1 = S[1] * K2[1];
      d0 += S[2] * K2[2]; d1 += S[3] * K2[3];
      d0 += d1;
      const float ks = reduce16(d0[0] + d0[1]);
      const float cc = beta * (v - a * ks);
      const f32x2 a2 = (f32x2){a, a}, c2 = (f32x2){cc, cc};
#pragma unroll
      for (int i = 0; i < 4; ++i) S[i] = K2[i] * c2 + a2 * S[i];
      f32x2 o0 = S[0] * Q2[0], o1 = S[1] * Q2[1];
      o0 += S[2] * Q2[2]; o1 += S[3] * Q2[3];
      o0 += o1;
      const float o = reduce16(o0[0] + o0[1]);
      if (sub == 0) ost[j * 16] = o;
    }
    if (c + 1 < NCH) lstore(buf ^ 1);
    __syncthreads();
    if (tid < 32) {
      const float* src = Ost + buf * 256 + (tid >> 1) * 16 + (tid & 1) * 8;
      float f[8];
#pragma unroll
      for (int e = 0; e < 8; ++e) f[e] = src[e];
      *(uint4*)(OUT + (size_t)rowof(c * 16 + (tid >> 1)) * 1024 + h * 128 + cb * 16 + (tid & 1) * 8) = pack8(f);
    }
  }
}

__device__ void ssd_scan_item(const Params& p, int id, float* sm) {
  const int tid = TIDX();
  const int b_l = id >> 7, head = (id >> 2) & 31, dir = (id >> 1) & 1, chf = id & 1, grp = head >> 2;
  const int cp = tid >> 4, sub = tid & 15;
  float* BC = sm; float* Xs = BC + 2 * 6144; float* DTs = Xs + 2 * 512; float* Yst = DTs + 2 * 32;
  const bf16_t* XBC = (const bf16_t*)(p.ws + OFF_XBC);
  const float* DTF = (const float*)(p.ws + OFF_DTF);
  bf16_t* OUT = (bf16_t*)(p.ws + (dir ? OFF_YB : OFF_YF));
  auto rowof = [&](int s) -> int {
    if (s < 256) { const int i = dir ? 255 - s : s; return MLAT + b_l * 256 + i; }
    const int j = s - 256; const int pos = dir ? 8191 - j : j; const int cl = pos >> 7, gr = pos & 127; return b_l * 8192 + gr * 64 + cl; };
  const int ltok = tid >> 5, lpart = tid & 31;
  const int lco = (lpart < 16) ? (2048 + grp * 128 + lpart * 8) : (3072 + grp * 128 + (lpart - 16) * 8);
  const int ldst = ((lpart < 16) ? 0 : 192) + (lpart & 15) * 12;
  u32x4 r0, r1, rx = (u32x4){0u, 0u, 0u, 0u}; float rdt = 0.f;
  auto gload = [&](int c) {
    const int s0 = c * 16;
    r0 = *(const u32x4*)(XBC + (size_t)rowof(s0 + ltok) * 4096 + lco);
    r1 = *(const u32x4*)(XBC + (size_t)rowof(s0 + 8 + ltok) * 4096 + lco);
    if (tid < 64) rx = *(const u32x4*)(XBC + (size_t)rowof(s0 + (tid >> 2)) * 4096 + head * 64 + chf * 32 + (tid & 3) * 8);
    else if (tid >= 128 && tid < 160) rdt = DTF[(size_t)rowof(s0 + ((tid - 128) >> 1)) * 128 + ((tid - 128) & 1) * 64 + dir * 32 + head];
  };
  auto lstore = [&](int buf) {
    float* d0 = BC + buf * 6144 + ltok * 384 + ldst;
    *(f32x4*)d0 = (f32x4){lo16(r0[0]), hi16(r0[0]), lo16(r0[1]), hi16(r0[1])};
    *(f32x4*)(d0 + 4) = (f32x4){lo16(r0[2]), hi16(r0[2]), lo16(r0[3]), hi16(r0[3])};
    float* d1 = d0 + 8 * 384;
    *(f32x4*)d1 = (f32x4){lo16(r1[0]), hi16(r1[0]), lo16(r1[1]), hi16(r1[1])};
    *(f32x4*)(d1 + 4) = (f32x4){lo16(r1[2]), hi16(r1[2]), lo16(r1[3]), hi16(r1[3])};
    if (tid < 64) { float* dx = Xs + buf * 512 + (tid >> 2) * 32 + (tid & 3) * 8;
      *(f32x4*)dx = (f32x4){lo16(rx[0]), hi16(rx[0]), lo16(rx[1]), hi16(rx[1])};
      *(f32x4*)(dx + 4) = (f32x4){lo16(rx[2]), hi16(rx[2]), lo16(rx[3]), hi16(rx[3])}; }
    else if (tid >= 128 && tid < 160) DTs[buf * 32 + (tid - 128)] = rdt;
  };
  f32x2 h0[4], h1[4];
#pragma unroll
  for (int i = 0; i < 4; ++i) { h0[i] = (f32x2){0.f, 0.f}; h1[i] = (f32x2){0.f, 0.f}; }
  __syncthreads();
  gload(0); lstore(0);
  __syncthreads();
  constexpr int NCH = (256 + 8192) / 16;
  for (int c = 0; c < NCH; ++c) {
    const int buf = c & 1;
    if (c + 1 < NCH) gload(c + 1);
    const float* bc = BC + buf * 6144 + sub * 12;
    const float* xs = Xs + buf * 512 + cp * 2;
    const float* dts = DTs + buf * 32;
    float* yst = Yst + buf * 512 + cp * 2;
#pragma unroll 4
    for (int j = 0; j < 16; ++j) {
      const float* bb = bc + j * 384;
      const f32x4 ba = *(const f32x4*)bb, bd = *(const f32x4*)(bb + 4), ca = *(const f32x4*)(bb + 192), cd = *(const f32x4*)(bb + 196);
      const f32x2 B2[4] = {(f32x2){ba[0], ba[1]}, (f32x2){ba[2], ba[3]}, (f32x2){bd[0], bd[1]}, (f32x2){bd[2], bd[3]}};
      const f32x2 C2[4] = {(f32x2){ca[0], ca[1]}, (f32x2){ca[2], ca[3]}, (f32x2){cd[0], cd[1]}, (f32x2){cd[2], cd[3]}};
      const float dt = dts[j * 2], dA = dts[j * 2 + 1];
      const f32x2 xv = *(const f32x2*)(xs + j * 32);
      const float xd0 = xv[0] * dt, xd1 = xv[1] * dt;
      const f32x2 x0 = (f32x2){xd0, xd0}, x1 = (f32x2){xd1, xd1}, da2 = (f32x2){dA, dA};
#pragma unroll
      for (int i = 0; i < 4; ++i) { h0[i] = B2[i] * x0 + da2 * h0[i]; h1[i] = B2[i] * x1 + da2 * h1[i]; }
      f32x2 y0 = h0[0] * C2[0], y1 = h1[0] * C2[0];
#pragma unroll
      for (int i = 1; i < 4; ++i) { y0 += h0[i] * C2[i]; y1 += h1[i] * C2[i]; }
      const float ya = reduce16(y0[0] + y0[1]), yb = reduce16(y1[0] + y1[1]);
      if (sub == 0) *(f32x2*)(yst + j * 32) = (f32x2){ya, yb};
    }
    if (c + 1 < NCH) lstore(buf ^ 1);
    __syncthreads();
    if (tid < 64) {
      const float* src = Yst + buf * 512 + (tid >> 2) * 32 + (tid & 3) * 8;
      float f[8];
#pragma unroll
      for (int e = 0; e < 8; ++e) f[e] = src[e];
      *(uint4*)(OUT + (size_t)rowof(c * 16 + (tid >> 2)) * 2048 + head * 64 + chf * 32 + (tid & 3) * 8) = pack8(f);
    }
  }
}

__device__ void scan_phase(const Params& p, float* sm) {
  for (int item = BIDX(); item < 512; item += GDIM()) {
    if (item < 256) gdn_scan_item(p, item, sm); else ssd_scan_item(p, item - 256, sm);
    __syncthreads();
  }
}

__device__ void gnorm_phase(const Params& p, int l, int M) {
  const bf16_t* P = (const bf16_t*)(p.ws + OFF_P);
  const bf16_t* OF = (const bf16_t*)(p.ws + OFF_OF); const bf16_t* OB = (const bf16_t*)(p.ws + OFF_OB);
  const bf16_t* YF = (const bf16_t*)(p.ws + OFF_YF); const bf16_t* YB = (const bf16_t*)(p.ws + OFF_YB);
  const bf16_t* XBC = (const bf16_t*)(p.ws + OFF_XBC);
  bf16_t* YA = (bf16_t*)(p.ws + OFF_QKV); bf16_t* YBn = YA + (size_t)MG * 1024;
  const int gtid = BIDX() * 256 + TIDX(), gsz = GDIM() * 256;
  const float* nw = p.gdn_norm_w + l * 128;
  for (int idx = gtid; idx < M * 128; idx += gsz) {
    const int r = idx >> 7, c8 = (idx & 127) * 8;
    const uint4 a = *(const uint4*)(OF + (size_t)r * 1024 + c8), b = *(const uint4*)(OB + (size_t)r * 1024 + c8);
    const uint4 gt = *(const uint4*)(P + (size_t)r * LDP + C_GOUT + c8);
    float fa[8], fb[8], fg[8]; UNPACK8(a, fa); UNPACK8(b, fb); UNPACK8(gt, fg);
    float ss = 0.f;
#pragma unroll
    for (int e = 0; e < 8; ++e) { fa[e] += fb[e]; ss += fa[e] * fa[e]; }
    ss += __shfl_xor(ss, 1); ss += __shfl_xor(ss, 2); ss += __shfl_xor(ss, 4); ss += __shfl_xor(ss, 8);
    const float rs = rsqrtf(ss * (1.f / 128.f) + 1e-6f);
    const float4 w0 = *(const float4*)(nw + (c8 & 127)), w1 = *(const float4*)(nw + (c8 & 127) + 4);
    const float wv[8] = {w0.x, w0.y, w0.z, w0.w, w1.x, w1.y, w1.z, w1.w};
#pragma unroll
    for (int e = 0; e < 8; ++e) fa[e] = fa[e] * rs * wv[e] * siluf_(fg[e]);
    *(uint4*)(YA + (size_t)r * 1024 + c8) = pack8(fa);
  }
  const float* sw = p.ssm_norm_w + l * 2048; const float* Dk = p.ssm_D + l * 32;
  for (int idx = gtid; idx < M * 256; idx += gsz) {
    const int r = idx >> 8, c8 = (idx & 255) * 8;
    const uint4 a = *(const uint4*)(YF + (size_t)r * 2048 + c8), b = *(const uint4*)(YB + (size_t)r * 2048 + c8);
    const uint4 xx = *(const uint4*)(XBC + (size_t)r * 4096 + c8);
    const uint4 zz = *(const uint4*)(P + (size_t)r * LDP + C_Z + c8);
    float fa[8], fb[8], fx[8], fz[8]; UNPACK8(a, fa); UNPACK8(b, fb); UNPACK8(xx, fx); UNPACK8(zz, fz);
    const float dsk = Dk[c8 >> 6];
    float ss = 0.f;
#pragma unroll
    for (int e = 0; e < 8; ++e) { fa[e] = (fa[e] + fb[e] + dsk * fx[e]) * siluf_(fz[e]); ss += fa[e] * fa[e]; }
    ss += __shfl_xor(ss, 1); ss += __shfl_xor(ss, 2); ss += __shfl_xor(ss, 4); ss += __shfl_xor(ss, 8); ss += __shfl_xor(ss, 16);
    const float rs = rsqrtf(ss * (1.f / 256.f) + 1e-6f);
    const float4 w0 = *(const float4*)(sw + c8), w1 = *(const float4*)(sw + c8 + 4);
    const float wv[8] = {w0.x, w0.y, w0.z, w0.w, w1.x, w1.y, w1.z, w1.w};
#pragma unroll
    for (int e = 0; e < 8; ++e) fa[e] = fa[e] * rs * wv[e];
    *(uint4*)(YBn + (size_t)r * 2048 + c8) = pack8(fa);
  }
}

#ifndef STOP_AFTER
#define STOP_AFTER 0
#endif
#define SYNC() { grid.sync(); if (++nsync == STOP_AFTER) return; }
__global__ void __launch_bounds__(256, 2) mega(Params p) {
  cg::grid_group grid = cg::this_grid();
  int nsync = 0;
  __shared__ __attribute__((aligned(16))) unsigned char smem[SMEM_BYTES];
  float* smf = (float*)smem; bf16_t* smh = (bf16_t*)smem;
  for (int l = 0; l < 2; ++l) {
    transpose_phase(p.w_in + (size_t)l * 1024 * IN_DIM, (bf16_t*)(p.ws + OFF_WIN), 1024, IN_DIM, LDP, smf);
    transpose_phase(p.w_proj_gdn + (size_t)l * 1024 * 1024, (bf16_t*)(p.ws + OFF_WPG), 1024, 1024, 1024, smf);
    transpose_phase(p.w_proj_ssm + (size_t)l * 2048 * 1024, (bf16_t*)(p.ws + OFF_WPS), 2048, 1024, 1024, smf);
    transpose_phase(p.w_out + (size_t)l * 1024 * 1024, (bf16_t*)(p.ws + OFF_WOUT), 1024, 1024, 1024, smf);
    transpose_phase(p.w_ff1 + (size_t)l * 1024 * 4096, (bf16_t*)(p.ws + OFF_WFF1), 1024, 4096, 4096, smf);
    transpose_phase(p.w_ff2 + (size_t)l * 4096 * 1024, (bf16_t*)(p.ws + OFF_WFF2), 4096, 1024, 1024, smf);
    if (l == 0) { modpart_phase(p, smf); SYNC(); modfinal_phase(p); }
    SYNC();
    const bool last = (l == 1);
    const int Mpost = last ? MLAT : MG;
    for (int g = 0; g < NGRP; ++g) {
      modulate_phase(p, l, g); SYNC();
      gemm_inproj_phase(p, smh); SYNC();
      conv_phase(p, l); SYNC();
      scan_phase(p, smf); SYNC();
      gnorm_phase(p, l, Mpost); SYNC();
      gemm_proj_phase(p, Mpost, smh); SYNC();
      gemm_wout_phase(p, l, g, Mpost, smh); SYNC();
      ln_phase(p, l, g, Mpost, p.ln1_g + l * D, p.ln1_b + l * D, true); SYNC();
      gemm_ff1_phase(p, l, Mpost, smh); SYNC();
      gemm_ff2_phase(p, l, g, Mpost, smh); SYNC();
      ln_phase(p, l, g, Mpost, p.ln2_g + l * D, p.ln2_b + l * D, false); SYNC();
    }
  }
}

extern "C" void kernel_launch(void* const* d_in, const int* in_sizes, int n_in, void* d_out, int out_size, void* d_ws, size_t ws_size,
                              hipStream_t stream) {
  static int grid_blocks = 0;
  if (!grid_blocks) {
    int dev = 0, cus = 0, per_cu = 0;
    (void)hipGetDevice(&dev);
    (void)hipDeviceGetAttribute(&cus, hipDeviceAttributeMultiprocessorCount, dev);
    (void)hipOccupancyMaxActiveBlocksPerMultiprocessor(&per_cu, mega, 256, 0);
    if (per_cu > 2) per_cu = 2;
    grid_blocks = cus * per_cu;
    if (ws_size < WS_TOTAL) fprintf(stderr, "workspace too small: %zu < %zu\n", ws_size, WS_TOTAL);
  }
  Params p{};
  const float** pp = (const float**)&p;
  for (int i = 0; i < 28; ++i) pp[i] = (const float*)d_in[i];
  p.out = (float*)d_out;
  p.ws = (unsigned char*)d_ws;
  void* args[] = {&p};
  hipError_t e = hipLaunchCooperativeKernel((void*)mega, dim3(grid_blocks), dim3(256), args, 0, stream);
  if (e != hipSuccess) fprintf(stderr, "cooperative launch failed: %s (grid %d)\n", hipGetErrorString(e), grid_blocks);
}
```

```cpp
#include <hip/hip_runtime.h>
#include <hip/hip_cooperative_groups.h>
#include <cstdio>
namespace cg = cooperative_groups;

typedef unsigned short bf16_t;
typedef short bf16x8 __attribute__((ext_vector_type(8)));
typedef float f32x4 __attribute__((ext_vector_type(4)));
typedef float f32x2 __attribute__((ext_vector_type(2)));
typedef unsigned u32x4 __attribute__((ext_vector_type(4)));

constexpr int D = 1024, SEQ = 8192, LC = 256;
constexpr int G = 2, NGRP = 4;
constexpr int MLAT = G * SEQ, MCTX = G * LC, MG = MLAT + MCTX;
constexpr int IN_DIM = 12384, LDP = 12416;
constexpr int C_GOUT = 3072, C_A = 4096, C_B = 4112, C_Z = 4128, C_XBC = 6176, C_DT = 10272, C_GA = 10336, C_GB = 11360;
constexpr float DN_ALPHA = 1.4142135623730951f;

constexpr size_t SZ_WIN = (size_t)LDP * 1024 * 2;
constexpr size_t OFF_WIN = 0;
constexpr size_t OFF_WPG = OFF_WIN + SZ_WIN;
constexpr size_t OFF_WPS = OFF_WPG + 2097152;
constexpr size_t OFF_WOUT = OFF_WPS + 4194304;
constexpr size_t OFF_WFF1 = OFF_WOUT + 2097152;
constexpr size_t OFF_WFF2 = OFF_WFF1 + 8388608;
constexpr size_t OFF_MODP = OFF_WFF2 + 8388608;
constexpr size_t OFF_MOD = OFF_MODP + (size_t)2 * 16 * 9 * 6144 * 4;
constexpr size_t OFF_XSC = OFF_MOD + (size_t)2 * 9 * 6144 * 4;
constexpr size_t OFF_H = OFF_XSC + (size_t)2048 * 1024 * 4;
constexpr size_t OFF_P = OFF_H + (size_t)MG * 1024 * 2;
constexpr size_t OFF_QKV = OFF_P + (size_t)MG * LDP * 2;
constexpr size_t OFF_XBC = OFF_QKV + (size_t)MG * 3072 * 2;
constexpr size_t OFF_GBF = OFF_XBC + (size_t)MG * 4096 * 2;
constexpr size_t OFF_DTF = OFF_GBF + (size_t)MG * 32 * 4;
constexpr size_t OFF_OF = OFF_DTF + (size_t)MG * 128 * 4;
constexpr size_t OFF_OB = OFF_OF + (size_t)MG * 1024 * 2;
constexpr size_t OFF_YF = OFF_OB + (size_t)MG * 1024 * 2;
constexpr size_t OFF_YB = OFF_YF + (size_t)MG * 2048 * 2;
constexpr size_t WS_TOTAL = OFF_YB + (size_t)MG * 2048 * 2;
static_assert(WS_TOTAL <= ((size_t)1024 << 20), "workspace plan exceeds 1 GiB");

struct Params {
  const float *x, *c, *ctx, *c_ctx, *w_mod, *b_mod, *w_in, *gdn_conv_w, *gdn_A_log, *gdn_dt_bias, *gdn_norm_w;
  const float *ssm_conv_w, *ssm_conv_b, *ssm_A_log, *ssm_dt_bias, *ssm_D, *ssm_norm_w, *w_proj_gdn, *w_proj_ssm, *w_out;
  const float *ln1_g, *ln1_b, *w_ff1, *b_ff1, *w_ff2, *b_ff2, *ln2_g, *ln2_b;
  float* out;
  unsigned char* ws;
};

constexpr int SMEM_BYTES = 73728;


__device__ __forceinline__ int TIDX() { int t = threadIdx.x; asm volatile("" : "+v"(t)); return t; }
__device__ __forceinline__ int BIDX() { int t = blockIdx.x; asm volatile("" : "+s"(t)); return t; }
__device__ __forceinline__ int GDIM() { int t = gridDim.x; asm volatile("" : "+s"(t)); return t; }
__device__ __forceinline__ float bf2f(bf16_t b) { return __uint_as_float(((unsigned)b) << 16); }
__device__ __forceinline__ bf16_t f2bf(float f) { unsigned u = __float_as_uint(f); u += 0x7fffu + ((u >> 16) & 1u); return (bf16_t)(u >> 16); }
__device__ __forceinline__ unsigned pack2(float a, float b) { return (unsigned)f2bf(a) | ((unsigned)f2bf(b) << 16); }
__device__ __forceinline__ float lo16(unsigned v) { return __uint_as_float(v << 16); }
__device__ __forceinline__ float hi16(unsigned v) { return __uint_as_float(v & 0xffff0000u); }
#define UNPACK8(v, f) { f[0] = lo16(v.x); f[1] = hi16(v.x); f[2] = lo16(v.y); f[3] = hi16(v.y); f[4] = lo16(v.z); f[5] = hi16(v.z); f[6] = lo16(v.w); f[7] = hi16(v.w); }
__device__ __forceinline__ uint4 pack8(const float* f) { uint4 r; r.x = pack2(f[0], f[1]); r.y = pack2(f[2], f[3]); r.z = pack2(f[4], f[5]); r.w = pack2(f[6], f[7]); return r; }
__device__ __forceinline__ float sigmoidf_(float x) { return 1.f / (1.f + __expf(-x)); }
__device__ __forceinline__ float siluf_(float x) { return x / (1.f + __expf(-x)); }
__device__ __forceinline__ float softplusf_(float x) { return x > 20.f ? x : log1pf(__expf(x)); }
template <int CTRL> __device__ __forceinline__ float dppf(float x) { return __builtin_bit_cast(float, __builtin_amdgcn_mov_dpp(__builtin_bit_cast(int, x), CTRL, 0xf, 0xf, true)); }
__device__ __forceinline__ float reduce16(float x) { x += dppf<0xB1>(x); x += dppf<0x4E>(x); x += dppf<0x141>(x); x += dppf<0x140>(x); return x; }

__device__ __forceinline__ float* xs_row(const Params& p, int g, int r) {
  return (r < MLAT) ? p.out + ((size_t)g * MLAT + r) * D : (float*)(p.ws + OFF_XSC) + ((size_t)g * MCTX + (r - MLAT)) * D;
}
__device__ __forceinline__ const float* xin_row(const Params& p, int l, int g, int r) {
  if (l == 0) return (r < MLAT) ? p.x + ((size_t)g * MLAT + r) * D : p.ctx + ((size_t)g * MCTX + (r - MLAT)) * D;
  return xs_row(p, g, r);
}
__device__ __forceinline__ int mod_row(int g, int r) { return r < MLAT ? g * G + r / SEQ : 8; }
__device__ __forceinline__ int ssd_rowof(int b_l, int dir, int s) {
  if (s < 256) { const int i = dir ? 255 - s : s; return MLAT + b_l * 256 + i; }
  const int j = s - 256; const int pos = dir ? 8191 - j : j; return b_l * 8192 + (pos & 127) * 64 + (pos >> 7);
}

__device__ void transpose_phase(const float* __restrict__ src, bf16_t* __restrict__ dst, int K, int N, int Npad, float* tile) {
  const int tid = TIDX(), tk = K / 64, tn = Npad / 64;
  const int c = tid & 63, r4 = tid >> 6;
  for (int t = BIDX(); t < tk * tn; t += GDIM()) {
    const int kt = t % tk, nt = t / tk, k0 = kt * 64, n0 = nt * 64;
    __syncthreads();
#pragma unroll 4
    for (int i = 0; i < 16; ++i) { const int r = i * 4 + r4, n = n0 + c; tile[r * 65 + c] = (n < N) ? src[(size_t)(k0 + r) * N + n] : 0.f; }
    __syncthreads();
#pragma unroll 4
    for (int i = 0; i < 16; ++i) { const int nn = i * 4 + r4; dst[(size_t)(n0 + nn) * K + k0 + c] = f2bf(tile[c * 65 + nn]); }
  }
}

__device__ void modpart_phase(const Params& p, float* sm) {
  const int tid = TIDX();
  float* MODP = (float*)(p.ws + OFF_MODP);
  for (int item = BIDX(); item < 2 * 24 * 16; item += GDIM()) {
    const int l = item / 384, rem = item % 384, cbk = rem / 16, ks = rem % 16;
    __syncthreads();
    for (int i = tid; i < 9 * 64; i += 256) { const int r = i / 64, k = ks * 64 + (i % 64); const float v = (r < 8) ? p.c[r * D + k] : p.c_ctx[k]; sm[i] = siluf_(v); }
    __syncthreads();
    const int col = cbk * 256 + tid;
    float acc[9];
#pragma unroll
    for (int r = 0; r < 9; ++r) acc[r] = 0.f;
    const float* wp = p.w_mod + ((size_t)l * D + ks * 64) * 6144 + col;
#pragma unroll 8
    for (int k = 0; k < 64; ++k) { const float w = wp[(size_t)k * 6144];
#pragma unroll
      for (int r = 0; r < 9; ++r) acc[r] += sm[r * 64 + k] * w; }
#pragma unroll
    for (int r = 0; r < 9; ++r) MODP[(((size_t)l * 16 + ks) * 9 + r) * 6144 + col] = acc[r];
  }
}
__device__ void modfinal_phase(const Params& p) {
  const float* MODP = (const float*)(p.ws + OFF_MODP);
  float* MOD = (float*)(p.ws + OFF_MOD);
  for (int i = BIDX() * 256 + TIDX(); i < 2 * 9 * 6144; i += GDIM() * 256) {
    const int l = i / (9 * 6144), rem = i % (9 * 6144), col = rem % 6144;
    float s = p.b_mod[l * 6144 + col];
    for (int ks = 0; ks < 16; ++ks) s += MODP[((size_t)l * 16 + ks) * 9 * 6144 + rem];
    MOD[i] = s;
  }
}

__device__ void modulate_phase(const Params& p, int l, int g) {
  const float* MOD = (const float*)(p.ws + OFF_MOD) + (size_t)l * 9 * 6144;
  bf16_t* H = (bf16_t*)(p.ws + OFF_H);
  for (int i = BIDX() * 256 + TIDX(); i < MG * 128; i += GDIM() * 256) {
    const int r = i >> 7, ch = (i & 127) * 8;
    const float* xr = xin_row(p, l, g, r) + ch;
    const float* m = MOD + (size_t)mod_row(g, r) * 6144;
    const float4 x0 = *(const float4*)xr, x1 = *(const float4*)(xr + 4);
    const float4 sh0 = *(const float4*)(m + ch), sh1 = *(const float4*)(m + ch + 4);
    const float4 sc0 = *(const float4*)(m + 1024 + ch), sc1 = *(const float4*)(m + 1024 + ch + 4);
    float f[8] = {x0.x * (1.f + sc0.x) + sh0.x, x0.y * (1.f + sc0.y) + sh0.y, x0.z * (1.f + sc0.z) + sh0.z, x0.w * (1.f + sc0.w) + sh0.w,
                  x1.x * (1.f + sc1.x) + sh1.x, x1.y * (1.f + sc1.y) + sh1.y, x1.z * (1.f + sc1.z) + sh1.z, x1.w * (1.f + sc1.w) + sh1.w};
    *(uint4*)(H + (size_t)r * D + ch) = pack8(f);
  }
}

__device__ __forceinline__ void gemm_kloop(f32x4 (&acc)[4][4], const bf16_t* __restrict__ A, int lda, const bf16_t* __restrict__ Bt, int ldb,
                                           int m0, int n0, int K, bf16_t* sm) {
  const int tid = TIDX(), lane = tid & 63, w = tid >> 6, wr = w >> 1, wc = w & 1;
  const int lr = tid >> 3, lk = (tid & 7) * 8;
  const bf16_t* ap = A + (size_t)(m0 + lr) * lda + lk;
  const bf16_t* bp = Bt + (size_t)(n0 + lr) * ldb + lk;
  u32x4 ra[4], rb[4];
#pragma unroll
  for (int i = 0; i < 4; ++i) { ra[i] = *(const u32x4*)(ap + (size_t)i * 32 * lda); rb[i] = *(const u32x4*)(bp + (size_t)i * 32 * ldb); }
  __syncthreads();
#pragma unroll
  for (int i = 0; i < 4; ++i) { *(u32x4*)(sm + (lr + 32 * i) * 72 + lk) = ra[i]; *(u32x4*)(sm + 9216 + (lr + 32 * i) * 72 + lk) = rb[i]; }
  __syncthreads();
  const int nk = K >> 6, fr = lane & 15, fq = lane >> 4;
  const int aoff = (wr * 64 + fr) * 72 + fq * 8, boff = 9216 + (wc * 64 + fr) * 72 + fq * 8;
  for (int kt = 0; kt < nk; ++kt) {
    const bf16_t* cur = sm + (kt & 1) * 18432;
    bf16_t* nxt = sm + ((kt + 1) & 1) * 18432;
    if (kt + 1 < nk) {
      const int ko = (kt + 1) * 64;
#pragma unroll
      for (int i = 0; i < 4; ++i) { ra[i] = *(const u32x4*)(ap + (size_t)i * 32 * lda + ko); rb[i] = *(const u32x4*)(bp + (size_t)i * 32 * ldb + ko); }
    }
#pragma unroll
    for (int kk = 0; kk < 2; ++kk) {
      bf16x8 af[4], bfr[4];
#pragma unroll
      for (int i = 0; i < 4; ++i) { af[i] = *(const bf16x8*)(cur + aoff + i * 16 * 72 + kk * 32); bfr[i] = *(const bf16x8*)(cur + boff + i * 16 * 72 + kk * 32); }
#pragma unroll
      for (int i = 0; i < 4; ++i)
#pragma unroll
        for (int j = 0; j < 4; ++j) acc[i][j] = __builtin_amdgcn_mfma_f32_16x16x32_bf16(bfr[j], af[i], acc[i][j], 0, 0, 0);
    }
    if (kt + 1 < nk) {
#pragma unroll
      for (int i = 0; i < 4; ++i) { *(u32x4*)(nxt + (lr + 32 * i) * 72 + lk) = ra[i]; *(u32x4*)(nxt + 9216 + (lr + 32 * i) * 72 + lk) = rb[i]; }
    }
    __syncthreads();
  }
}

__device__ __forceinline__ bool tile_coord(int it, int nM, int nN, int& mt, int& nt) {
  const int nb = GDIM(), v = BIDX();
  long s;
  if ((nb & 7) == 0) { const int per = nb >> 3; s = (long)it * nb + (v & 7) * per + (v >> 3); } else s = (long)it * nb + v;
  if (s >= (long)nM * nN) return false;
  const int band = (int)(s / (8 * nN)), r = (int)(s - (long)band * 8 * nN);
  const int bsz = (nM - band * 8) < 8 ? (nM - band * 8) : 8;
  nt = r / bsz; mt = band * 8 + (r % bsz);
  return true;
}

#define ZERO_ACC(acc) { _Pragma("unroll") for (int i_ = 0; i_ < 4; ++i_) { _Pragma("unroll") for (int j_ = 0; j_ < 4; ++j_) acc[i_][j_] = (f32x4){0.f, 0.f, 0.f, 0.f}; } }
#define EPI_LOOP(...) { const int lane_ = TIDX() & 63, w_ = TIDX() >> 6; \
  _Pragma("unroll") for (int i_ = 0; i_ < 4; ++i_) { const int row = m0 + (w_ >> 1) * 64 + i_ * 16 + (lane_ & 15); \
  _Pragma("unroll") for (int j_ = 0; j_ < 4; ++j_) { const int col = n0 + (w_ & 1) * 64 + j_ * 16 + (lane_ >> 4) * 4; f32x4& v = acc[i_][j_]; __VA_ARGS__ } } }

__device__ void gemm_inproj_phase(const Params& p, bf16_t* sm) {
  const bf16_t* H = (const bf16_t*)(p.ws + OFF_H); const bf16_t* W = (const bf16_t*)(p.ws + OFF_WIN);
  bf16_t* P = (bf16_t*)(p.ws + OFF_P);
  const int nM = MG / 128, nN = LDP / 128;
  for (int it = 0;; ++it) {
    int mt, nt; if (!tile_coord(it, nM, nN, mt, nt)) break;
    const int m0 = mt * 128, n0 = nt * 128;
    f32x4 acc[4][4]; ZERO_ACC(acc);
    gemm_kloop(acc, H, D, W, D, m0, n0, D, sm);
    EPI_LOOP({ uint2 o; o.x = pack2(v[0], v[1]); o.y = pack2(v[2], v[3]); *(uint2*)(P + (size_t)row * LDP + col) = o; })
  }
}
__device__ void gemm_proj_phase(const Params& p, int M, bf16_t* sm) {
  const bf16_t* YA = (const bf16_t*)(p.ws + OFF_QKV); const bf16_t* YBn = YA + (size_t)MG * 1024;
  const bf16_t* Wg = (const bf16_t*)(p.ws + OFF_WPG); const bf16_t* Ws = (const bf16_t*)(p.ws + OFF_WPS);
  const bf16_t* P = (const bf16_t*)(p.ws + OFF_P);
  bf16_t* U = (bf16_t*)(p.ws + OFF_H);
  const int nM = M / 128, nN = 8;
  for (int it = 0;; ++it) {
    int mt, nt; if (!tile_coord(it, nM, nN, mt, nt)) break;
    const int m0 = mt * 128, n0 = nt * 128;
    f32x4 acc[4][4]; ZERO_ACC(acc);
    gemm_kloop(acc, YA, 1024, Wg, 1024, m0, n0, 1024, sm);
    EPI_LOOP({ const uint2 ga = *(const uint2*)(P + (size_t)row * LDP + C_GA + col); const uint2 gb = *(const uint2*)(P + (size_t)row * LDP + C_GB + col);
      v[0] *= (1.f + __expf(-lo16(gb.x))) / (1.f + __expf(-lo16(ga.x))); v[1] *= (1.f + __expf(-hi16(gb.x))) / (1.f + __expf(-hi16(ga.x)));
      v[2] *= (1.f + __expf(-lo16(gb.y))) / (1.f + __expf(-lo16(ga.y))); v[3] *= (1.f + __expf(-hi16(gb.y))) / (1.f + __expf(-hi16(ga.y))); })
    gemm_kloop(acc, YBn, 2048, Ws, 2048, m0, n0, 2048, sm);
    EPI_LOOP({ const uint2 gb = *(const uint2*)(P + (size_t)row * LDP + C_GB + col);
      uint2 o; o.x = pack2(v[0] * sigmoidf_(lo16(gb.x)), v[1] * sigmoidf_(hi16(gb.x))); o.y = pack2(v[2] * sigmoidf_(lo16(gb.y)), v[3] * sigmoidf_(hi16(gb.y)));
      *(uint2*)(U + (size_t)row * D + col) = o; })
  }
}
__device__ void gemm_wout_phase(const Params& p, int l, int g, int M, bf16_t* sm) {
  const bf16_t* U = (const bf16_t*)(p.ws + OFF_H); const bf16_t* W = (const bf16_t*)(p.ws + OFF_WOUT);
  const float* MOD = (const float*)(p.ws + OFF_MOD) + (size_t)l * 9 * 6144;
  const int nM = M / 128, nN = 8;
  for (int it = 0;; ++it) {
    int mt, nt; if (!tile_coord(it, nM, nN, mt, nt)) break;
    const int m0 = mt * 128, n0 = nt * 128;
    f32x4 acc[4][4]; ZERO_ACC(acc);
    gemm_kloop(acc, U, D, W, D, m0, n0, D, sm);
    EPI_LOOP({ const float4 xr = *(const float4*)(xin_row(p, l, g, row) + col); const float4 g1 = *(const float4*)(MOD + (size_t)mod_row(g, row) * 6144 + 2048 + col);
      float4 o; o.x = DN_ALPHA * xr.x + g1.x * v[0]; o.y = DN_ALPHA * xr.y + g1.y * v[1]; o.z = DN_ALPHA * xr.z + g1.z * v[2]; o.w = DN_ALPHA * xr.w + g1.w * v[3];
      *(float4*)(xs_row(p, g, row) + col) = o; })
  }
}
__device__ void gemm_ff1_phase(const Params& p, int l, int M, bf16_t* sm) {
  const bf16_t* H = (const bf16_t*)(p.ws + OFF_H); const bf16_t* W = (const bf16_t*)(p.ws + OFF_WFF1);
  bf16_t* HID = (bf16_t*)(p.ws + OFF_P);
  const float* b1 = p.b_ff1 + (size_t)l * 4096;
  const int nM = M / 128, nN = 32;
  for (int it = 0;; ++it) {
    int mt, nt; if (!tile_coord(it, nM, nN, mt, nt)) break;
    const int m0 = mt * 128, n0 = nt * 128;
    f32x4 acc[4][4]; ZERO_ACC(acc);
    gemm_kloop(acc, H, D, W, D, m0, n0, D, sm);
    EPI_LOOP({ const float4 b = *(const float4*)(b1 + col);
      float t0 = fmaxf(v[0] + b.x, 0.f), t1 = fmaxf(v[1] + b.y, 0.f), t2 = fmaxf(v[2] + b.z, 0.f), t3 = fmaxf(v[3] + b.w, 0.f);
      uint2 o; o.x = pack2(t0 * t0, t1 * t1); o.y = pack2(t2 * t2, t3 * t3); *(uint2*)(HID + (size_t)row * 4096 + col) = o; })
  }
}
__device__ void gemm_ff2_phase(const Params& p, int l, int g, int M, bf16_t* sm) {
  const bf16_t* HID = (const bf16_t*)(p.ws + OFF_P); const bf16_t* W = (const bf16_t*)(p.ws + OFF_WFF2);
  const float* MOD = (const float*)(p.ws + OFF_MOD) + (size_t)l * 9 * 6144;
  const float* b2 = p.b_ff2 + (size_t)l * 1024;
  const int nM = M / 128, nN = 8;
  for (int it = 0;; ++it) {
    int mt, nt; if (!tile_coord(it, nM, nN, mt, nt)) break;
    const int m0 = mt * 128, n0 = nt * 128;
    f32x4 acc[4][4]; ZERO_ACC(acc);
    gemm_kloop(acc, HID, 4096, W, 4096, m0, n0, 4096, sm);
    EPI_LOOP({ float* xp = xs_row(p, g, row) + col; const float4 xr = *(const float4*)xp; const float4 b = *(const float4*)(b2 + col);
      const float4 g2 = *(const float4*)(MOD + (size_t)mod_row(g, row) * 6144 + 5120 + col);
      float4 o; o.x = DN_ALPHA * xr.x + g2.x * (v[0] + b.x); o.y = DN_ALPHA * xr.y + g2.y * (v[1] + b.y); o.z = DN_ALPHA * xr.z + g2.z * (v[2] + b.z); o.w = DN_ALPHA * xr.w + g2.w * (v[3] + b.w);
      *(float4*)xp = o; })
  }
}

__device__ void ln_phase(const Params& p, int l, int g, int M, const float* gam, const float* bet, bool write_h2) {
  const int lane = TIDX() & 63;
  const float* MOD = (const float*)(p.ws + OFF_MOD) + (size_t)l * 9 * 6144;
  bf16_t* H = (bf16_t*)(p.ws + OFF_H);
  for (int r = BIDX() * 4 + (TIDX() >> 6); r < M; r += GDIM() * 4) {
    float* xr = xs_row(p, g, r);
    float4 v[4];
    float s = 0.f;
#pragma unroll
    for (int i = 0; i < 4; ++i) { v[i] = *(const float4*)(xr + (i * 64 + lane) * 4); s += v[i].x + v[i].y + v[i].z + v[i].w; }
#pragma unroll
    for (int o = 32; o >= 1; o >>= 1) s += __shfl_xor(s, o);
    const float mu = s * (1.f / 1024.f);
    float q = 0.f;
#pragma unroll
    for (int i = 0; i < 4; ++i) { v[i].x -= mu; v[i].y -= mu; v[i].z -= mu; v[i].w -= mu; q += v[i].x * v[i].x + v[i].y * v[i].y + v[i].z * v[i].z + v[i].w * v[i].w; }
#pragma unroll
    for (int o = 32; o >= 1; o >>= 1) q += __shfl_xor(q, o);
    const float rs = rsqrtf(q * (1.f / 1024.f) + 1e-5f);
    const float* m = MOD + (size_t)mod_row(g, r) * 6144;
#pragma unroll
    for (int i = 0; i < 4; ++i) {
      const int ch = (i * 64 + lane) * 4;
      const float4 gg = *(const float4*)(gam + ch), bb = *(const float4*)(bet + ch);
      float4 o; o.x = v[i].x * rs * gg.x + bb.x; o.y = v[i].y * rs * gg.y + bb.y; o.z = v[i].z * rs * gg.z + bb.z; o.w = v[i].w * rs * gg.w + bb.w;
      *(float4*)(xr + ch) = o;
      if (write_h2) {
        const float4 sh = *(const float4*)(m + 3072 + ch), sc = *(const float4*)(m + 4096 + ch);
        uint2 h; h.x = pack2(o.x * (1.f + sc.x) + sh.x, o.y * (1.f + sc.y) + sh.y); h.y = pack2(o.z * (1.f + sc.z) + sh.z, o.w * (1.f + sc.w) + sh.w);
        *(uint2*)(H + (size_t)r * D + ch) = h;
      }
    }
  }
}

__device__ void conv_phase(const Params& p, int l) {
  const bf16_t* P = (const bf16_t*)(p.ws + OFF_P);
  bf16_t* QKV = (bf16_t*)(p.ws + OFF_QKV); bf16_t* XBC = (bf16_t*)(p.ws + OFF_XBC);
  float* GBF = (float*)(p.ws + OFF_GBF); float* DTF = (float*)(p.ws + OFF_DTF);
  const int gtid = BIDX() * 256 + TIDX(), gsz = GDIM() * 256;
  const float* cw = p.gdn_conv_w + (size_t)l * 5 * 3072;
  for (int idx = gtid; idx < MG * 384; idx += gsz) {
    const int r = idx / 384, chunk = idx % 384, ch0 = chunk * 8;
    int pos, seglen;
    if (r < MLAT) { pos = r & 63; seglen = 64; } else { pos = (r - MLAT) & 255; seglen = 256; }
    float acc[8];
#pragma unroll
    for (int e = 0; e < 8; ++e) acc[e] = 0.f;
#pragma unroll
    for (int j = 0; j < 5; ++j) {
      const int pp = pos + j - 2;
      if (pp >= 0 && pp < seglen) {
        const uint4 raw = *(const uint4*)(P + (size_t)(r + j - 2) * LDP + ch0);
        float f[8]; UNPACK8(raw, f);
        const float4 w0 = *(const float4*)(cw + j * 3072 + ch0), w1 = *(const float4*)(cw + j * 3072 + ch0 + 4);
        acc[0] += f[0] * w0.x; acc[1] += f[1] * w0.y; acc[2] += f[2] * w0.z; acc[3] += f[3] * w0.w;
        acc[4] += f[4] * w1.x; acc[5] += f[5] * w1.y; acc[6] += f[6] * w1.z; acc[7] += f[7] * w1.w;
      }
    }
    float ss = 0.f;
#pragma unroll
    for (int e = 0; e < 8; ++e) { acc[e] = siluf_(acc[e]); ss += acc[e] * acc[e]; }
    ss += __shfl_xor(ss, 1); ss += __shfl_xor(ss, 2); ss += __shfl_xor(ss, 4); ss += __shfl_xor(ss, 8);
    float sc = 1.f;
    if (chunk < 256) { sc = rsqrtf(ss + 1e-6f); if (chunk < 128) sc *= 0.08838834764831845f; }
#pragma unroll
    for (int e = 0; e < 8; ++e) acc[e] *= sc;
    *(uint4*)(QKV + (size_t)r * 3072 + ch0) = pack8(acc);
  }
  const float* sw = p.ssm_conv_w + (size_t)l * 5 * 4096; const float* sb = p.ssm_conv_b + (size_t)l * 4096;
  for (int idx = gtid; idx < MG * 512; idx += gsz) {
    const int r = idx >> 9, ch0 = (idx & 511) * 8;
    int pos, seglen, stride;
    if (r < MLAT) { pos = (r & 8191) >> 6; seglen = 128; stride = 64; } else { pos = (r - MLAT) & 255; seglen = 256; stride = 1; }
    const float4 b0 = *(const float4*)(sb + ch0), b1 = *(const float4*)(sb + ch0 + 4);
    float acc[8] = {b0.x, b0.y, b0.z, b0.w, b1.x, b1.y, b1.z, b1.w};
#pragma unroll
    for (int j = 0; j < 5; ++j) {
      const int pp = pos + j - 2;
      if (pp >= 0 && pp < seglen) {
        const uint4 raw = *(const uint4*)(P + (size_t)(r + (j - 2) * stride) * LDP + C_XBC + ch0);
        float f[8]; UNPACK8(raw, f);
        const float4 w0 = *(const float4*)(sw + j * 4096 + ch0), w1 = *(const float4*)(sw + j * 4096 + ch0 + 4);
        acc[0] += f[0] * w0.x; acc[1] += f[1] * w0.y; acc[2] += f[2] * w0.z; acc[3] += f[3] * w0.w;
        acc[4] += f[4] * w1.x; acc[5] += f[5] * w1.y; acc[6] += f[6] * w1.z; acc[7] += f[7] * w1.w;
      }
    }
#pragma unroll
    for (int e = 0; e < 8; ++e) acc[e] = siluf_(acc[e]);
    *(uint4*)(XBC + (size_t)r * 4096 + ch0) = pack8(acc);
  }
  for (int idx = gtid; idx < MG * 16; idx += gsz) {
    const int r = idx >> 4, dh = idx & 15;
    const float a_raw = bf2f(P[(size_t)r * LDP + C_A + dh]), b_raw = bf2f(P[(size_t)r * LDP + C_B + dh]);
    const float gg = -__expf(p.gdn_A_log[l * 16 + dh]) * softplusf_(a_raw + p.gdn_dt_bias[l * 16 + dh]);
    GBF[(size_t)r * 32 + dh] = __expf(gg);
    GBF[(size_t)r * 32 + 16 + dh] = sigmoidf_(b_raw);
  }
  for (int idx = gtid; idx < MG * 64; idx += gsz) {
    const int r = idx >> 6, dh = idx & 63;
    const float dtr = bf2f(P[(size_t)r * LDP + C_DT + dh]);
    const float dt = softplusf_(dtr + p.ssm_dt_bias[l * 64 + dh]);
    DTF[(size_t)r * 128 + dh] = dt;
  }
  for (int idx = gtid; idx < G * 2 * 264 * 32; idx += gsz) {
    const int head = idx & 31; int t = idx >> 5; const int chunk = t % 264; t /= 264; const int dir = t & 1, b_l = t >> 1;
    const int dh = dir * 32 + head;
    const float bias = p.ssm_dt_bias[l * 64 + dh], aneg = -__expf(p.ssm_A_log[l * 64 + dh]);
    float cum = 0.f;
    for (int u = 0; u < 32; ++u) {
      const size_t row = (size_t)ssd_rowof(b_l, dir, chunk * 32 + u);
      const float dt = softplusf_(bf2f(P[row * LDP + C_DT + dh]) + bias);
      cum += dt * aneg;
      DTF[row * 128 + 64 + dh] = cum;
    }
  }
}

__device__ void gdn_scan_item(const Params& p, int item, float* sm) {
  const int tid = TIDX();
  const int b_l = item >> 7, h = (item >> 4) & 7, dir = (item >> 3) & 1, cb = item & 7;
  const int col = tid >> 4, sub = tid & 15;
  float* KQ = sm; float* Vs = KQ + 2 * 6144; float* ABs = Vs + 2 * 256; float* Ost = ABs + 2 * 32;
  const bf16_t* QKV = (const bf16_t*)(p.ws + OFF_QKV);
  const float* GBF = (const float*)(p.ws + OFF_GBF);
  bf16_t* OUT = (bf16_t*)(p.ws + (dir ? OFF_OB : OFF_OF));
  auto rowof = [&](int s) -> int {
    if (s < 256) { const int i = dir ? 255 - s : s; return MLAT + b_l * 256 + i; }
    const int i = s - 256; const int t = dir ? 8191 - i : i; return b_l * 8192 + t; };
  const int ltok = tid >> 5, lpart = tid & 31;
  const int lco = (lpart < 16) ? (h * 128 + lpart * 8) : (1024 + h * 128 + (lpart - 16) * 8);
  const int ldst = ((lpart < 16) ? 192 : 0) + (lpart & 15) * 12;
  struct Stage { u32x4 kq0, kq1, v; float ab; };
  Stage st0, st1;
  st0.v = (u32x4){0u, 0u, 0u, 0u}; st0.ab = 0.f; st1.v = st0.v; st1.ab = 0.f; st0.kq0 = st0.v; st0.kq1 = st0.v; st1.kq0 = st0.v; st1.kq1 = st0.v;
  constexpr int NCH = (256 + 8192) / 16;
  auto gload = [&](Stage& st, int c) {
    if (c >= NCH) return;
    const int s0 = c * 16;
    st.kq0 = *(const u32x4*)(QKV + (size_t)rowof(s0 + ltok) * 3072 + lco);
    st.kq1 = *(const u32x4*)(QKV + (size_t)rowof(s0 + 8 + ltok) * 3072 + lco);
    if (tid < 32) st.v = *(const u32x4*)(QKV + (size_t)rowof(s0 + (tid >> 1)) * 3072 + 2048 + h * 128 + cb * 16 + (tid & 1) * 8);
    else if (tid >= 64 && tid < 96) st.ab = GBF[(size_t)rowof(s0 + ((tid - 64) >> 1)) * 32 + ((tid - 64) & 1) * 16 + dir * 8 + h];
  };
  auto lstore = [&](const Stage& st, int buf) {
    float* d0 = KQ + buf * 6144 + ltok * 384 + ldst;
    *(f32x4*)d0 = (f32x4){lo16(st.kq0[0]), hi16(st.kq0[0]), lo16(st.kq0[1]), hi16(st.kq0[1])};
    *(f32x4*)(d0 + 4) = (f32x4){lo16(st.kq0[2]), hi16(st.kq0[2]), lo16(st.kq0[3]), hi16(st.kq0[3])};
    float* d1 = d0 + 8 * 384;
    *(f32x4*)d1 = (f32x4){lo16(st.kq1[0]), hi16(st.kq1[0]), lo16(st.kq1[1]), hi16(st.kq1[1])};
    *(f32x4*)(d1 + 4) = (f32x4){lo16(st.kq1[2]), hi16(st.kq1[2]), lo16(st.kq1[3]), hi16(st.kq1[3])};
    if (tid < 32) { float* dv = Vs + buf * 256 + (tid >> 1) * 16 + (tid & 1) * 8;
      *(f32x4*)dv = (f32x4){lo16(st.v[0]), hi16(st.v[0]), lo16(st.v[1]), hi16(st.v[1])};
      *(f32x4*)(dv + 4) = (f32x4){lo16(st.v[2]), hi16(st.v[2]), lo16(st.v[3]), hi16(st.v[3])}; }
    else if (tid >= 64 && tid < 96) ABs[buf * 32 + (tid - 64)] = st.ab;
  };
  f32x2 S[4];
#pragma unroll
  for (int i = 0; i < 4; ++i) S[i] = (f32x2){0.f, 0.f};
  auto compute = [&](int buf) {
    const float* kq = KQ + buf * 6144 + sub * 12;
    const float* vs = Vs + buf * 256 + col;
    const float* ab = ABs + buf * 32;
    f32x4 ka = *(const f32x4*)kq, kc = *(const f32x4*)(kq + 4), qa = *(const f32x4*)(kq + 192), qc = *(const f32x4*)(kq + 196);
    float a = ab[0], beta = ab[1], v = vs[0];
    float okeep = 0.f;
#pragma unroll
    for (int j = 0; j < 16; ++j) {
      f32x4 nka = ka, nkc = kc, nqa = qa, nqc = qc; float na = a, nbeta = beta, nv = v;
      if (j + 1 < 16) {
        const float* kb = kq + (j + 1) * 384;
        nka = *(const f32x4*)kb; nkc = *(const f32x4*)(kb + 4); nqa = *(const f32x4*)(kb + 192); nqc = *(const f32x4*)(kb + 196);
        na = ab[(j + 1) * 2]; nbeta = ab[(j + 1) * 2 + 1]; nv = vs[(j + 1) * 16];
      }
      const f32x2 K2[4] = {(f32x2){ka[0], ka[1]}, (f32x2){ka[2], ka[3]}, (f32x2){kc[0], kc[1]}, (f32x2){kc[2], kc[3]}};
      const f32x2 Q2[4] = {(f32x2){qa[0], qa[1]}, (f32x2){qa[2], qa[3]}, (f32x2){qc[0], qc[1]}, (f32x2){qc[2], qc[3]}};
      f32x2 d0 = S[0] * K2[0], d1 = S[1] * K2[1];
      d0 += S[2] * K2[2]; d1 += S[3] * K2[3];
      d0 += d1;
      const float ks = reduce16(d0[0] + d0[1]);
      const float cc = beta * (v - a * ks);
      const f32x2 a2 = (f32x2){a, a}, c2 = (f32x2){cc, cc};
#pragma unroll
      for (int i = 0; i < 4; ++i) S[i] = K2[i] * c2 + a2 * S[i];
      f32x2 o0 = S[0] * Q2[0], o1 = S[1] * Q2[1];
      o0 += S[2] * Q2[2]; o1 += S[3] * Q2[3];
      o0 += o1;
      const float o = reduce16(o0[0] + o0[1]);
      okeep = (sub == j) ? o : okeep;
      ka = nka; kc = nkc; qa = nqa; qc = nqc; a = na; beta = nbeta; v = nv;
    }
    Ost[buf * 256 + sub * 16 + col] = okeep;
  };
  auto flush = [&](int c) {
    if (tid < 32) {
      const float* src = Ost + (c & 1) * 256 + (tid >> 1) * 16 + (tid & 1) * 8;
      float f[8];
#pragma unroll
      for (int e = 0; e < 8; ++e) f[e] = src[e];
      *(uint4*)(OUT + (size_t)rowof(c * 16 + (tid >> 1)) * 1024 + h * 128 + cb * 16 + (tid & 1) * 8) = pack8(f);
    }
  };
  __syncthreads();
  gload(st0, 0); lstore(st0, 0);
  __syncthreads();
  gload(st0, 1); gload(st1, 2);
  for (int c = 0; c < NCH; c += 2) {
    compute(0);
    lstore(st0, 1); gload(st0, c + 3);
    __syncthreads();
    flush(c);
    compute(1);
    if (c + 2 < NCH) lstore(st1, 0);
    gload(st1, c + 4);
    __syncthreads();
    flush(c + 1);
  }
}

__device__ void ssd_chunk_item(const Params& p, int id, unsigned char* smraw) {
  const int tid = TIDX(), lane = tid & 63, w = tid >> 6, fr = lane & 15, fq = lane >> 4;
  const int b_l = id >> 6, head = (id >> 1) & 31, dir = id & 1, grp = head >> 2;
  bf16_t* sC = (bf16_t*)smraw;
  bf16_t* sB = sC + 32 * 136;
  bf16_t* sBT = sB + 32 * 136;
  bf16_t* sXT = sBT + 128 * 40;
  bf16_t* sM = sXT + 64 * 40;
  bf16_t* sST = sM + 32 * 40;
  float* sG = (float*)(sST + 64 * 136);
  const bf16_t* XBC = (const bf16_t*)(p.ws + OFF_XBC);
  const float* DTF = (const float*)(p.ws + OFF_DTF);
  bf16_t* OUT = (bf16_t*)(p.ws + (dir ? OFF_YB : OFF_YF));
  const int ltok = tid & 31, lpart = tid >> 5;
  struct Stage { u32x4 b0, b1, c0, c1, x; float dt, g, gl; };
  Stage st0, st1;
  constexpr int NCH = (256 + 8192) / 32;
  auto gload = [&](Stage& st, int c) {
    if (c >= NCH) return;
    const int s0 = c * 32;
    const size_t row = (size_t)ssd_rowof(b_l, dir, s0 + ltok);
    const bf16_t* xr = XBC + row * 4096;
    st.b0 = *(const u32x4*)(xr + 2048 + grp * 128 + lpart * 8);
    st.b1 = *(const u32x4*)(xr + 2048 + grp * 128 + (lpart + 8) * 8);
    st.c0 = *(const u32x4*)(xr + 3072 + grp * 128 + lpart * 8);
    st.c1 = *(const u32x4*)(xr + 3072 + grp * 128 + (lpart + 8) * 8);
    st.x = *(const u32x4*)(xr + head * 64 + lpart * 8);
    st.dt = DTF[row * 128 + dir * 32 + head];
    st.g = DTF[row * 128 + 64 + dir * 32 + head];
    st.gl = DTF[(size_t)ssd_rowof(b_l, dir, s0 + 31) * 128 + 64 + dir * 32 + head];
  };
  auto lstore = [&](const Stage& st) {
    *(u32x4*)(sB + ltok * 136 + lpart * 8) = st.b0;
    *(u32x4*)(sB + ltok * 136 + (lpart + 8) * 8) = st.b1;
    *(u32x4*)(sC + ltok * 136 + lpart * 8) = st.c0;
    *(u32x4*)(sC + ltok * 136 + (lpart + 8) * 8) = st.c1;
    const float wj = __expf(st.gl - st.g);
    bf16_t* t0 = sBT + (lpart * 8) * 40 + ltok;
    bf16_t* t1 = sBT + ((lpart + 8) * 8) * 40 + ltok;
    bf16_t* tx = sXT + (lpart * 8) * 40 + ltok;
#pragma unroll
    for (int e = 0; e < 4; ++e) {
      t0[(2 * e) * 40] = f2bf(lo16(st.b0[e]) * wj); t0[(2 * e + 1) * 40] = f2bf(hi16(st.b0[e]) * wj);
      t1[(2 * e) * 40] = f2bf(lo16(st.b1[e]) * wj); t1[(2 * e + 1) * 40] = f2bf(hi16(st.b1[e]) * wj);
      tx[(2 * e) * 40] = f2bf(lo16(st.x[e]) * st.dt); tx[(2 * e + 1) * 40] = f2bf(hi16(st.x[e]) * st.dt);
    }
    if (tid < 32) sG[tid] = st.g;
  };
  f32x4 S[8];
#pragma unroll
  for (int i = 0; i < 8; ++i) S[i] = (f32x4){0.f, 0.f, 0.f, 0.f};
  __syncthreads();
  for (int i = lane; i < 16 * 136 / 2; i += 64) ((unsigned*)(sST + w * 16 * 136))[i] = 0u;
  gload(st0, 0); lstore(st0);
  __syncthreads();
  gload(st0, 1); gload(st1, 2);
  for (int c = 0; c < NCH; ++c) {
    {
      const int ti = w >> 1, tj = w & 1;
      f32x4 cb = (f32x4){0.f, 0.f, 0.f, 0.f};
      if (tj <= ti) {
#pragma unroll
        for (int ks = 0; ks < 4; ++ks) {
          const bf16x8 af = *(const bf16x8*)(sC + (ti * 16 + fr) * 136 + ks * 32 + fq * 8);
          const bf16x8 bf = *(const bf16x8*)(sB + (tj * 16 + fr) * 136 + ks * 32 + fq * 8);
          cb = __builtin_amdgcn_mfma_f32_16x16x32_bf16(bf, af, cb, 0, 0, 0);
        }
      }
      const int i = ti * 16 + fr, j0 = tj * 16 + fq * 4;
      const float gi = sG[i];
      float m[4];
#pragma unroll
      for (int r = 0; r < 4; ++r) { const int j = j0 + r; const float gj = sG[j]; m[r] = (j <= i) ? cb[r] * __expf(gi - gj) : 0.f; }
      uint2 o; o.x = pack2(m[0], m[1]); o.y = pack2(m[2], m[3]);
      *(uint2*)(sM + i * 40 + j0) = o;
    }
    __syncthreads();
    const bf16x8 xfrag = *(const bf16x8*)(sXT + (w * 16 + fr) * 40 + fq * 8);
    const float eglast = __expf(sG[31]);
#pragma unroll
    for (int ti = 0; ti < 2; ++ti) {
      f32x4 y = (f32x4){0.f, 0.f, 0.f, 0.f};
#pragma unroll
      for (int ks = 0; ks < 4; ++ks) {
        const bf16x8 af = *(const bf16x8*)(sC + (ti * 16 + fr) * 136 + ks * 32 + fq * 8);
        const bf16x8 bf = *(const bf16x8*)(sST + (w * 16 + fr) * 136 + ks * 32 + fq * 8);
        y = __builtin_amdgcn_mfma_f32_16x16x32_bf16(bf, af, y, 0, 0, 0);
      }
      const int i = ti * 16 + fr;
      const float eg = __expf(sG[i]);
      y *= eg;
      const bf16x8 mf = *(const bf16x8*)(sM + i * 40 + fq * 8);
      y = __builtin_amdgcn_mfma_f32_16x16x32_bf16(xfrag, mf, y, 0, 0, 0);
      uint2 o; o.x = pack2(y[0], y[1]); o.y = pack2(y[2], y[3]);
      *(uint2*)(OUT + (size_t)ssd_rowof(b_l, dir, c * 32 + i) * 2048 + head * 64 + w * 16 + fq * 4) = o;
    }
#pragma unroll
    for (int tn = 0; tn < 8; ++tn) {
      const bf16x8 bf = *(const bf16x8*)(sBT + (tn * 16 + fr) * 40 + fq * 8);
      S[tn] *= eglast;
      S[tn] = __builtin_amdgcn_mfma_f32_16x16x32_bf16(bf, xfrag, S[tn], 0, 0, 0);
    }
#pragma unroll
    for (int tn = 0; tn < 8; ++tn) {
      uint2 o; o.x = pack2(S[tn][0], S[tn][1]); o.y = pack2(S[tn][2], S[tn][3]);
      *(uint2*)(sST + (w * 16 + fr) * 136 + tn * 16 + fq * 4) = o;
    }
    __syncthreads();
    if (c + 1 < NCH) { if (c & 1) lstore(st1); else lstore(st0); }
    if (c & 1) gload(st1, c + 3); else gload(st0, c + 3);
    __syncthreads();
  }
}

__device__ void scan_phase(const Params& p, unsigned char* sm) {
  for (int item = BIDX(); item < 384; item += GDIM()) {
    if (item < 256) gdn_scan_item(p, item, (float*)sm); else ssd_chunk_item(p, item - 256, sm);
    __syncthreads();
  }
}

__device__ void gnorm_phase(const Params& p, int l, int M) {
  const bf16_t* P = (const bf16_t*)(p.ws + OFF_P);
  const bf16_t* OF = (const bf16_t*)(p.ws + OFF_OF); const bf16_t* OB = (const bf16_t*)(p.ws + OFF_OB);
  const bf16_t* YF = (const bf16_t*)(p.ws + OFF_YF); const bf16_t* YB = (const bf16_t*)(p.ws + OFF_YB);
  const bf16_t* XBC = (const bf16_t*)(p.ws + OFF_XBC);
  bf16_t* YA = (bf16_t*)(p.ws + OFF_QKV); bf16_t* YBn = YA + (size_t)MG * 1024;
  const int gtid = BIDX() * 256 + TIDX(), gsz = GDIM() * 256;
  const float* nw = p.gdn_norm_w + l * 128;
  for (int idx = gtid; idx < M * 128; idx += gsz) {
    const int r = idx >> 7, c8 = (idx & 127) * 8;
    const uint4 a = *(const uint4*)(OF + (size_t)r * 1024 + c8), b = *(const uint4*)(OB + (size_t)r * 1024 + c8);
    const uint4 gt = *(const uint4*)(P + (size_t)r * LDP + C_GOUT + c8);
    float fa[8], fb[8], fg[8]; UNPACK8(a, fa); UNPACK8(b, fb); UNPACK8(gt, fg);
    float ss = 0.f;
#pragma unroll
    for (int e = 0; e < 8; ++e) { fa[e] += fb[e]; ss += fa[e] * fa[e]; }
    ss += __shfl_xor(ss, 1); ss += __shfl_xor(ss, 2); ss += __shfl_xor(ss, 4); ss += __shfl_xor(ss, 8);
    const float rs = rsqrtf(ss * (1.f / 128.f) + 1e-6f);
    const float4 w0 = *(const float4*)(nw + (c8 & 127)), w1 = *(const float4*)(nw + (c8 & 127) + 4);
    const float wv[8] = {w0.x, w0.y, w0.z, w0.w, w1.x, w1.y, w1.z, w1.w};
#pragma unroll
    for (int e = 0; e < 8; ++e) fa[e] = fa[e] * rs * wv[e] * siluf_(fg[e]);
    *(uint4*)(YA + (size_t)r * 1024 + c8) = pack8(fa);
  }
  const float* sw = p.ssm_norm_w + l * 2048; const float* Dk = p.ssm_D + l * 32;
  for (int idx = gtid; idx < M * 256; idx += gsz) {
    const int r = idx >> 8, c8 = (idx & 255) * 8;
    const uint4 a = *(const uint4*)(YF + (size_t)r * 2048 + c8), b = *(const uint4*)(YB + (size_t)r * 2048 + c8);
    const uint4 xx = *(const uint4*)(XBC + (size_t)r * 4096 + c8);
    const uint4 zz = *(const uint4*)(P + (size_t)r * LDP + C_Z + c8);
    float fa[8], fb[8], fx[8], fz[8]; UNPACK8(a, fa); UNPACK8(b, fb); UNPACK8(xx, fx); UNPACK8(zz, fz);
    const float dsk = Dk[c8 >> 6];
    float ss = 0.f;
#pragma unroll
    for (int e = 0; e < 8; ++e) { fa[e] = (fa[e] + fb[e] + dsk * fx[e]) * siluf_(fz[e]); ss += fa[e] * fa[e]; }
    ss += __shfl_xor(ss, 1); ss += __shfl_xor(ss, 2); ss += __shfl_xor(ss, 4); ss += __shfl_xor(ss, 8); ss += __shfl_xor(ss, 16);
    const float rs = rsqrtf(ss * (1.f / 256.f) + 1e-6f);
    const float4 w0 = *(const float4*)(sw + c8), w1 = *(const float4*)(sw + c8 + 4);
    const float wv[8] = {w0.x, w0.y, w0.z, w0.w, w1.x, w1.y, w1.z, w1.w};
#pragma unroll
    for (int e = 0; e < 8; ++e) fa[e] = fa[e] * rs * wv[e];
    *(uint4*)(YBn + (size_t)r * 2048 + c8) = pack8(fa);
  }
}

#ifndef STOP_AFTER
#define STOP_AFTER 0
#endif
#define SYNC() { grid.sync(); if (++nsync == STOP_AFTER) return; }
__global__ void __launch_bounds__(256, 2) mega(Params p) {
  cg::grid_group grid = cg::this_grid();
  int nsync = 0;
  __shared__ __attribute__((aligned(16))) unsigned char smem[SMEM_BYTES];
  float* smf = (float*)smem; bf16_t* smh = (bf16_t*)smem;
  for (int l = 0; l < 2; ++l) {
    transpose_phase(p.w_in + (size_t)l * 1024 * IN_DIM, (bf16_t*)(p.ws + OFF_WIN), 1024, IN_DIM, LDP, smf);
    transpose_phase(p.w_proj_gdn + (size_t)l * 1024 * 1024, (bf16_t*)(p.ws + OFF_WPG), 1024, 1024, 1024, smf);
    transpose_phase(p.w_proj_ssm + (size_t)l * 2048 * 1024, (bf16_t*)(p.ws + OFF_WPS), 2048, 1024, 1024, smf);
    transpose_phase(p.w_out + (size_t)l * 1024 * 1024, (bf16_t*)(p.ws + OFF_WOUT), 1024, 1024, 1024, smf);
    transpose_phase(p.w_ff1 + (size_t)l * 1024 * 4096, (bf16_t*)(p.ws + OFF_WFF1), 1024, 4096, 4096, smf);
    transpose_phase(p.w_ff2 + (size_t)l * 4096 * 1024, (bf16_t*)(p.ws + OFF_WFF2), 4096, 1024, 1024, smf);
    if (l == 0) { modpart_phase(p, smf); SYNC(); modfinal_phase(p); }
    SYNC();
    const bool last = (l == 1);
    const int Mpost = last ? MLAT : MG;
    for (int g = 0; g < NGRP; ++g) {
      modulate_phase(p, l, g); SYNC();
      gemm_inproj_phase(p, smh); SYNC();
      conv_phase(p, l); SYNC();
      scan_phase(p, smem); SYNC();
      gnorm_phase(p, l, Mpost); SYNC();
      gemm_proj_phase(p, Mpost, smh); SYNC();
      gemm_wout_phase(p, l, g, Mpost, smh); SYNC();
      ln_phase(p, l, g, Mpost, p.ln1_g + l * D, p.ln1_b + l * D, true); SYNC();
      gemm_ff1_phase(p, l, Mpost, smh); SYNC();
      gemm_ff2_phase(p, l, g, Mpost, smh); SYNC();
      ln_phase(p, l, g, Mpost, p.ln2_g + l * D, p.ln2_b + l * D, false); SYNC();
    }
  }
}

extern "C" void kernel_launch(void* const* d_in, const int* in_sizes, int n_in, void* d_out, int out_size, void* d_ws, size_t ws_size,
                              hipStream_t stream) {
  static int grid_blocks = 0;
  if (!grid_blocks) {
    int dev = 0, cus = 0, per_cu = 0;
    (void)hipGetDevice(&dev);
    (void)hipDeviceGetAttribute(&cus, hipDeviceAttributeMultiprocessorCount, dev);
    (void)hipOccupancyMaxActiveBlocksPerMultiprocessor(&per_cu, mega, 256, 0);
    if (per_cu > 2) per_cu = 2;
    grid_blocks = cus * per_cu;
    if (ws_size < WS_TOTAL) fprintf(stderr, "workspace too small: %zu < %zu\n", ws_size, WS_TOTAL);
  }
  Params p{};
  const float** pp = (const float**)&p;
  for (int i = 0; i < 28; ++i) pp[i] = (const float*)d_in[i];
  p.out = (float*)d_out;
  p.ws = (unsigned char*)d_ws;
  void* args[] = {&p};
  hipError_t e = hipLaunchCooperativeKernel((void*)mega, dim3(grid_blocks), dim3(256), args, 0, stream);
  if (e != hipSuccess) fprintf(stderr, "cooperative launch failed: %s (grid %d)\n", hipGetErrorString(e), grid_blocks);
}
```

```cpp
#include <hip/hip_runtime.h>
#include <hip/hip_cooperative_groups.h>
#include <cstdio>
namespace cg = cooperative_groups;

typedef unsigned short bf16_t;
typedef short bf16x8 __attribute__((ext_vector_type(8)));
typedef float f32x4 __attribute__((ext_vector_type(4)));
typedef float f32x2 __attribute__((ext_vector_type(2)));
typedef unsigned u32x4 __attribute__((ext_vector_type(4)));

constexpr int D = 1024, SEQ = 8192, LC = 256;
constexpr int G = 2, NGRP = 4;
constexpr int MLAT = G * SEQ, MCTX = G * LC, MG = MLAT + MCTX;
constexpr int IN_DIM = 12384, LDP = 12416;
constexpr int C_GOUT = 3072, C_A = 4096, C_B = 4112, C_Z = 4128, C_XBC = 6176, C_DT = 10272, C_GA = 10336, C_GB = 11360;
constexpr float DN_ALPHA = 1.4142135623730951f;

constexpr size_t SZ_WIN = (size_t)LDP * 1024 * 2;
constexpr size_t OFF_WIN = 0;
constexpr size_t OFF_WPG = OFF_WIN + SZ_WIN;
constexpr size_t OFF_WPS = OFF_WPG + 2097152;
constexpr size_t OFF_WOUT = OFF_WPS + 4194304;
constexpr size_t OFF_WFF1 = OFF_WOUT + 2097152;
constexpr size_t OFF_WFF2 = OFF_WFF1 + 8388608;
constexpr size_t OFF_MODP = OFF_WFF2 + 8388608;
constexpr size_t OFF_MOD = OFF_MODP + (size_t)2 * 16 * 9 * 6144 * 4;
constexpr size_t OFF_XSC = OFF_MOD + (size_t)2 * 9 * 6144 * 4;
constexpr size_t OFF_H = OFF_XSC + (size_t)2048 * 1024 * 4;
constexpr size_t OFF_P = OFF_H + (size_t)MG * 1024 * 2;
constexpr size_t OFF_QKV = OFF_P + (size_t)MG * LDP * 2;
constexpr size_t OFF_XBC = OFF_QKV + (size_t)MG * 3072 * 2;
constexpr size_t OFF_GBF = OFF_XBC + (size_t)MG * 4096 * 2;
constexpr size_t OFF_DTF = OFF_GBF + (size_t)MG * 32 * 4;
constexpr size_t OFF_OF = OFF_DTF + (size_t)MG * 128 * 4;
constexpr size_t OFF_OB = OFF_OF + (size_t)MG * 1024 * 2;
constexpr size_t OFF_YF = OFF_OB + (size_t)MG * 1024 * 2;
constexpr size_t OFF_YB = OFF_YF + (size_t)MG * 2048 * 2;
constexpr size_t WS_TOTAL = OFF_YB + (size_t)MG * 2048 * 2;
static_assert(WS_TOTAL <= ((size_t)1024 << 20), "workspace plan exceeds 1 GiB");

struct Params {
  const float *x, *c, *ctx, *c_ctx, *w_mod, *b_mod, *w_in, *gdn_conv_w, *gdn_A_log, *gdn_dt_bias, *gdn_norm_w;
  const float *ssm_conv_w, *ssm_conv_b, *ssm_A_log, *ssm_dt_bias, *ssm_D, *ssm_norm_w, *w_proj_gdn, *w_proj_ssm, *w_out;
  const float *ln1_g, *ln1_b, *w_ff1, *b_ff1, *w_ff2, *b_ff2, *ln2_g, *ln2_b;
  float* out;
  unsigned char* ws;
};

constexpr int SMEM_BYTES = 73728;


__device__ __forceinline__ int TIDX() { int t = threadIdx.x; asm volatile("" : "+v"(t)); return t; }
__device__ __forceinline__ int BIDX() { int t = blockIdx.x; asm volatile("" : "+s"(t)); return t; }
__device__ __forceinline__ int GDIM() { int t = gridDim.x; asm volatile("" : "+s"(t)); return t; }
__device__ __forceinline__ float bf2f(bf16_t b) { return __uint_as_float(((unsigned)b) << 16); }
__device__ __forceinline__ bf16_t f2bf(float f) { unsigned u = __float_as_uint(f); u += 0x7fffu + ((u >> 16) & 1u); return (bf16_t)(u >> 16); }
typedef __bf16 bf16v2 __attribute__((ext_vector_type(2)));
__device__ __forceinline__ unsigned pack2(float a, float b) { const f32x2 v = (f32x2){a, b}; const bf16v2 h = __builtin_convertvector(v, bf16v2); return __builtin_bit_cast(unsigned, h); }
__device__ __forceinline__ float lo16(unsigned v) { return __uint_as_float(v << 16); }
__device__ __forceinline__ float hi16(unsigned v) { return __uint_as_float(v & 0xffff0000u); }
#define UNPACK8(v, f) { f[0] = lo16(v.x); f[1] = hi16(v.x); f[2] = lo16(v.y); f[3] = hi16(v.y); f[4] = lo16(v.z); f[5] = hi16(v.z); f[6] = lo16(v.w); f[7] = hi16(v.w); }
__device__ __forceinline__ uint4 pack8(const float* f) { uint4 r; r.x = pack2(f[0], f[1]); r.y = pack2(f[2], f[3]); r.z = pack2(f[4], f[5]); r.w = pack2(f[6], f[7]); return r; }
__device__ __forceinline__ float sigmoidf_(float x) { return __builtin_amdgcn_rcpf(1.f + __expf(-x)); }
__device__ __forceinline__ float siluf_(float x) { return x * __builtin_amdgcn_rcpf(1.f + __expf(-x)); }
__device__ __forceinline__ float softplusf_(float x) { return x > 20.f ? x : log1pf(__expf(x)); }
template <int CTRL> __device__ __forceinline__ float dppf(float x) { return __builtin_bit_cast(float, __builtin_amdgcn_mov_dpp(__builtin_bit_cast(int, x), CTRL, 0xf, 0xf, true)); }
__device__ __forceinline__ float reduce16(float x) { x += dppf<0xB1>(x); x += dppf<0x4E>(x); x += dppf<0x141>(x); x += dppf<0x140>(x); return x; }

__device__ __forceinline__ float* xs_row(const Params& p, int g, int r) {
  return (r < MLAT) ? p.out + ((size_t)g * MLAT + r) * D : (float*)(p.ws + OFF_XSC) + ((size_t)g * MCTX + (r - MLAT)) * D;
}
__device__ __forceinline__ const float* xin_row(const Params& p, int l, int g, int r) {
  if (l == 0) return (r < MLAT) ? p.x + ((size_t)g * MLAT + r) * D : p.ctx + ((size_t)g * MCTX + (r - MLAT)) * D;
  return xs_row(p, g, r);
}
__device__ __forceinline__ int mod_row(int g, int r) { return r < MLAT ? g * G + r / SEQ : 8; }
__device__ __forceinline__ int ssd_rowof(int b_l, int dir, int s) {
  if (s < 256) { const int i = dir ? 255 - s : s; return MLAT + b_l * 256 + i; }
  const int j = s - 256; const int pos = dir ? 8191 - j : j; return b_l * 8192 + (pos & 127) * 64 + (pos >> 7);
}

__device__ void transpose_phase(const float* __restrict__ src, bf16_t* __restrict__ dst, int K, int N, int Npad, float* tile) {
  const int tid = TIDX(), tk = K / 64, tn = Npad / 64;
  const int c = tid & 63, r4 = tid >> 6;
  for (int t = BIDX(); t < tk * tn; t += GDIM()) {
    const int kt = t % tk, nt = t / tk, k0 = kt * 64, n0 = nt * 64;
    __syncthreads();
#pragma unroll 4
    for (int i = 0; i < 16; ++i) { const int r = i * 4 + r4, n = n0 + c; tile[r * 65 + c] = (n < N) ? src[(size_t)(k0 + r) * N + n] : 0.f; }
    __syncthreads();
#pragma unroll 4
    for (int i = 0; i < 16; ++i) { const int nn = i * 4 + r4; dst[(size_t)(n0 + nn) * K + k0 + c] = f2bf(tile[c * 65 + nn]); }
  }
}

__device__ void modpart_phase(const Params& p, float* sm) {
  const int tid = TIDX();
  float* MODP = (float*)(p.ws + OFF_MODP);
  for (int item = BIDX(); item < 2 * 24 * 16; item += GDIM()) {
    const int l = item / 384, rem = item % 384, cbk = rem / 16, ks = rem % 16;
    __syncthreads();
    for (int i = tid; i < 9 * 64; i += 256) { const int r = i / 64, k = ks * 64 + (i % 64); const float v = (r < 8) ? p.c[r * D + k] : p.c_ctx[k]; sm[i] = siluf_(v); }
    __syncthreads();
    const int col = cbk * 256 + tid;
    float acc[9];
#pragma unroll
    for (int r = 0; r < 9; ++r) acc[r] = 0.f;
    const float* wp = p.w_mod + ((size_t)l * D + ks * 64) * 6144 + col;
#pragma unroll 8
    for (int k = 0; k < 64; ++k) { const float w = wp[(size_t)k * 6144];
#pragma unroll
      for (int r = 0; r < 9; ++r) acc[r] += sm[r * 64 + k] * w; }
#pragma unroll
    for (int r = 0; r < 9; ++r) MODP[(((size_t)l * 16 + ks) * 9 + r) * 6144 + col] = acc[r];
  }
}
__device__ void modfinal_phase(const Params& p) {
  const float* MODP = (const float*)(p.ws + OFF_MODP);
  float* MOD = (float*)(p.ws + OFF_MOD);
  for (int i = BIDX() * 256 + TIDX(); i < 2 * 9 * 6144; i += GDIM() * 256) {
    const int l = i / (9 * 6144), rem = i % (9 * 6144), col = rem % 6144;
    float s = p.b_mod[l * 6144 + col];
    for (int ks = 0; ks < 16; ++ks) s += MODP[((size_t)l * 16 + ks) * 9 * 6144 + rem];
    MOD[i] = s;
  }
}

__device__ void modulate_phase(const Params& p, int l, int g) {
  const float* MOD = (const float*)(p.ws + OFF_MOD) + (size_t)l * 9 * 6144;
  bf16_t* H = (bf16_t*)(p.ws + OFF_H);
  for (int i = BIDX() * 256 + TIDX(); i < MG * 128; i += GDIM() * 256) {
    const int r = i >> 7, ch = (i & 127) * 8;
    const float* xr = xin_row(p, l, g, r) + ch;
    const float* m = MOD + (size_t)mod_row(g, r) * 6144;
    const float4 x0 = *(const float4*)xr, x1 = *(const float4*)(xr + 4);
    const float4 sh0 = *(const float4*)(m + ch), sh1 = *(const float4*)(m + ch + 4);
    const float4 sc0 = *(const float4*)(m + 1024 + ch), sc1 = *(const float4*)(m + 1024 + ch + 4);
    float f[8] = {x0.x * (1.f + sc0.x) + sh0.x, x0.y * (1.f + sc0.y) + sh0.y, x0.z * (1.f + sc0.z) + sh0.z, x0.w * (1.f + sc0.w) + sh0.w,
                  x1.x * (1.f + sc1.x) + sh1.x, x1.y * (1.f + sc1.y) + sh1.y, x1.z * (1.f + sc1.z) + sh1.z, x1.w * (1.f + sc1.w) + sh1.w};
    *(uint4*)(H + (size_t)r * D + ch) = pack8(f);
  }
}

struct Seg { const bf16_t* ap; const bf16_t* bp; int lda, ldb, nk; };

__device__ __forceinline__ bool tile_coord(int it, int nM, int nN, int& mt, int& nt) {
  const int nb = GDIM(), v = BIDX();
  long s;
  if ((nb & 7) == 0) { const int per = nb >> 3; s = (long)it * nb + (v & 7) * per + (v >> 3); } else s = (long)it * nb + v;
  if (s >= (long)nM * nN) return false;
  const int band = (int)(s / (8 * nN)), r = (int)(s - (long)band * 8 * nN);
  const int bsz = (nM - band * 8) < 8 ? (nM - band * 8) : 8;
  nt = r / bsz; mt = band * 8 + (r % bsz);
  return true;
}

#define ZERO_ACC(acc) { _Pragma("unroll") for (int i_ = 0; i_ < 4; ++i_) { _Pragma("unroll") for (int j_ = 0; j_ < 4; ++j_) acc[i_][j_] = (f32x4){0.f, 0.f, 0.f, 0.f}; } }
#define EPI_LOOP(...) { const int lane_ = TIDX() & 63, w_ = TIDX() >> 6; \
  _Pragma("unroll") for (int i_ = 0; i_ < 4; ++i_) { const int row = m0 + (w_ >> 1) * 64 + i_ * 16 + (lane_ & 15); \
  _Pragma("unroll") for (int j_ = 0; j_ < 4; ++j_) { const int col = n0 + (w_ & 1) * 64 + j_ * 16 + (lane_ >> 4) * 4; f32x4& v = acc[i_][j_]; __VA_ARGS__ } } }

template <class Prob>
__device__ __forceinline__ void gemm_stream(Prob& pr, bf16_t* sm) {
  const int tid = TIDX(), lane = tid & 63, w = tid >> 6, wr = w >> 1, wc = w & 1;
  const int lr = tid >> 3, lk = (tid & 7) * 8;
  const int fr = lane & 15, fq = lane >> 4;
  const int aoff = (wr * 64 + fr) * 72 + fq * 8, boff = 9216 + (wc * 64 + fr) * 72 + fq * 8;
  const int soff = lr * 72 + lk;
  Seg cur, nxt;
  if (!pr.seg(0, cur, lr, lk)) return;
  bool has_nxt = pr.seg(1, nxt, lr, lk);
  u32x4 r0a[4], r0b[4], r1a[4], r1b[4];
#pragma unroll
  for (int i = 0; i < 4; ++i) { r0a[i] = (u32x4){0u, 0u, 0u, 0u}; r0b[i] = r0a[i]; r1a[i] = r0a[i]; r1b[i] = r0a[i]; }
  f32x4 acc[4][4];
#define GS_LOAD(RA, RB, KT) { const int kt_ = (KT); const bf16_t* ap_ = nullptr; const bf16_t* bp_ = nullptr; int lda_ = 0, ldb_ = 0; bool ok_ = true; \
    if (kt_ < cur.nk) { ap_ = cur.ap + kt_ * 64; bp_ = cur.bp + kt_ * 64; lda_ = cur.lda; ldb_ = cur.ldb; } \
    else if (has_nxt) { ap_ = nxt.ap + (kt_ - cur.nk) * 64; bp_ = nxt.bp + (kt_ - cur.nk) * 64; lda_ = nxt.lda; ldb_ = nxt.ldb; } else ok_ = false; \
    if (ok_) { _Pragma("unroll") for (int i = 0; i < 4; ++i) { RA[i] = *(const u32x4*)(ap_ + (size_t)i * 32 * lda_); RB[i] = *(const u32x4*)(bp_ + (size_t)i * 32 * ldb_); } } }
#define GS_STORE(RA, RB, KT, STAGE) { if ((KT) < cur.nk || has_nxt) { bf16_t* st_ = (STAGE) + soff; \
    _Pragma("unroll") for (int i = 0; i < 4; ++i) { *(u32x4*)(st_ + i * 32 * 72) = RA[i]; *(u32x4*)(st_ + 9216 + i * 32 * 72) = RB[i]; } } }
#define GS_COMPUTE(STAGE) { const bf16_t* cs_ = (STAGE); _Pragma("unroll") for (int kk = 0; kk < 2; ++kk) { bf16x8 af[4], bfr[4]; \
    _Pragma("unroll") for (int i = 0; i < 4; ++i) { af[i] = *(const bf16x8*)(cs_ + aoff + i * 16 * 72 + kk * 32); bfr[i] = *(const bf16x8*)(cs_ + boff + i * 16 * 72 + kk * 32); } \
    _Pragma("unroll") for (int i = 0; i < 4; ++i) { _Pragma("unroll") for (int j = 0; j < 4; ++j) acc[i][j] = __builtin_amdgcn_mfma_f32_16x16x32_bf16(bfr[j], af[i], acc[i][j], 0, 0, 0); } } }
  GS_LOAD(r0a, r0b, 0)
  __syncthreads();
  GS_STORE(r0a, r0b, 0, sm)
  __syncthreads();
  GS_LOAD(r0a, r0b, 1)
  GS_LOAD(r1a, r1b, 2)
  for (int idx = 0;; ++idx) {
    pr.begin(idx, acc);
    for (int kt = 0; kt < cur.nk; kt += 2) {
      GS_COMPUTE(sm)
      GS_STORE(r0a, r0b, kt + 1, sm + 18432)
      GS_LOAD(r0a, r0b, kt + 3)
      __syncthreads();
      GS_COMPUTE(sm + 18432)
      GS_STORE(r1a, r1b, kt + 2, sm)
      GS_LOAD(r1a, r1b, kt + 4)
      __syncthreads();
    }
    pr.end(idx, acc);
    if (!has_nxt) break;
    cur = nxt; has_nxt = pr.seg(idx + 2, nxt, lr, lk);
  }
#undef GS_LOAD
#undef GS_STORE
#undef GS_COMPUTE
}

__device__ void gemm_inproj_phase(const Params& p, bf16_t* sm) {
  struct Pr {
    const bf16_t* A; const bf16_t* W; bf16_t* P; int nM, nN;
    __device__ bool seg(int idx, Seg& s, int lr, int lk) const { int mt, nt; if (!tile_coord(idx, nM, nN, mt, nt)) return false;
      s.ap = A + (size_t)(mt * 128 + lr) * D + lk; s.bp = W + (size_t)(nt * 128 + lr) * D + lk; s.lda = D; s.ldb = D; s.nk = 16; return true; }
    __device__ void begin(int, f32x4 (&acc)[4][4]) const { ZERO_ACC(acc) }
    __device__ void end(int idx, f32x4 (&acc)[4][4]) const { int mt, nt; tile_coord(idx, nM, nN, mt, nt); const int m0 = mt * 128, n0 = nt * 128;
      EPI_LOOP({ uint2 o; o.x = pack2(v[0], v[1]); o.y = pack2(v[2], v[3]); *(uint2*)(P + (size_t)row * LDP + col) = o; }) }
  } pr{(const bf16_t*)(p.ws + OFF_H), (const bf16_t*)(p.ws + OFF_WIN), (bf16_t*)(p.ws + OFF_P), MG / 128, LDP / 128};
  gemm_stream(pr, sm);
}
__device__ void gemm_proj_phase(const Params& p, int M, bf16_t* sm) {
  struct Pr {
    const bf16_t* YA; const bf16_t* YBn; const bf16_t* Wg; const bf16_t* Ws; const bf16_t* P; bf16_t* U; int nM, nN;
    __device__ bool seg(int idx, Seg& s, int lr, int lk) const { int mt, nt; if (!tile_coord(idx >> 1, nM, nN, mt, nt)) return false;
      if ((idx & 1) == 0) { s.ap = YA + (size_t)(mt * 128 + lr) * 1024 + lk; s.bp = Wg + (size_t)(nt * 128 + lr) * 1024 + lk; s.lda = 1024; s.ldb = 1024; s.nk = 16; }
      else { s.ap = YBn + (size_t)(mt * 128 + lr) * 2048 + lk; s.bp = Ws + (size_t)(nt * 128 + lr) * 2048 + lk; s.lda = 2048; s.ldb = 2048; s.nk = 32; }
      return true; }
    __device__ void begin(int idx, f32x4 (&acc)[4][4]) const { if ((idx & 1) == 0) ZERO_ACC(acc) }
    __device__ void end(int idx, f32x4 (&acc)[4][4]) const { int mt, nt; tile_coord(idx >> 1, nM, nN, mt, nt); const int m0 = mt * 128, n0 = nt * 128;
      if ((idx & 1) == 0) {
        EPI_LOOP({ const uint2 ga = *(const uint2*)(P + (size_t)row * LDP + C_GA + col); const uint2 gb = *(const uint2*)(P + (size_t)row * LDP + C_GB + col);
          v[0] *= (1.f + __expf(-lo16(gb.x))) / (1.f + __expf(-lo16(ga.x))); v[1] *= (1.f + __expf(-hi16(gb.x))) / (1.f + __expf(-hi16(ga.x)));
          v[2] *= (1.f + __expf(-lo16(gb.y))) / (1.f + __expf(-lo16(ga.y))); v[3] *= (1.f + __expf(-hi16(gb.y))) / (1.f + __expf(-hi16(ga.y))); })
      } else {
        EPI_LOOP({ const uint2 gb = *(const uint2*)(P + (size_t)row * LDP + C_GB + col);
          uint2 o; o.x = pack2(v[0] * sigmoidf_(lo16(gb.x)), v[1] * sigmoidf_(hi16(gb.x))); o.y = pack2(v[2] * sigmoidf_(lo16(gb.y)), v[3] * sigmoidf_(hi16(gb.y)));
          *(uint2*)(U + (size_t)row * D + col) = o; })
      } }
  } pr{(const bf16_t*)(p.ws + OFF_QKV), (const bf16_t*)(p.ws + OFF_QKV) + (size_t)MG * 1024, (const bf16_t*)(p.ws + OFF_WPG), (const bf16_t*)(p.ws + OFF_WPS),
       (const bf16_t*)(p.ws + OFF_P), (bf16_t*)(p.ws + OFF_H), M / 128, 8};
  gemm_stream(pr, sm);
}
__device__ void gemm_wout_phase(const Params& p, int l, int g, int M, bf16_t* sm) {
  struct Pr {
    const Params& p; int l, g; const bf16_t* U; const bf16_t* W; const float* MOD; int nM, nN;
    __device__ bool seg(int idx, Seg& s, int lr, int lk) const { int mt, nt; if (!tile_coord(idx, nM, nN, mt, nt)) return false;
      s.ap = U + (size_t)(mt * 128 + lr) * D + lk; s.bp = W + (size_t)(nt * 128 + lr) * D + lk; s.lda = D; s.ldb = D; s.nk = 16; return true; }
    __device__ void begin(int, f32x4 (&acc)[4][4]) const { ZERO_ACC(acc) }
    __device__ void end(int idx, f32x4 (&acc)[4][4]) const { int mt, nt; tile_coord(idx, nM, nN, mt, nt); const int m0 = mt * 128, n0 = nt * 128;
      EPI_LOOP({ const float4 xr = *(const float4*)(xin_row(p, l, g, row) + col); const float4 g1 = *(const float4*)(MOD + (size_t)mod_row(g, row) * 6144 + 2048 + col);
        float4 o; o.x = DN_ALPHA * xr.x + g1.x * v[0]; o.y = DN_ALPHA * xr.y + g1.y * v[1]; o.z = DN_ALPHA * xr.z + g1.z * v[2]; o.w = DN_ALPHA * xr.w + g1.w * v[3];
        *(float4*)(xs_row(p, g, row) + col) = o; }) }
  } pr{p, l, g, (const bf16_t*)(p.ws + OFF_H), (const bf16_t*)(p.ws + OFF_WOUT), (const float*)(p.ws + OFF_MOD) + (size_t)l * 9 * 6144, M / 128, 8};
  gemm_stream(pr, sm);
}
__device__ void gemm_ff1_phase(const Params& p, int l, int M, bf16_t* sm) {
  struct Pr {
    const bf16_t* H; const bf16_t* W; bf16_t* HID; const float* b1; int nM, nN;
    __device__ bool seg(int idx, Seg& s, int lr, int lk) const { int mt, nt; if (!tile_coord(idx, nM, nN, mt, nt)) return false;
      s.ap = H + (size_t)(mt * 128 + lr) * D + lk; s.bp = W + (size_t)(nt * 128 + lr) * D + lk; s.lda = D; s.ldb = D; s.nk = 16; return true; }
    __device__ void begin(int, f32x4 (&acc)[4][4]) const { ZERO_ACC(acc) }
    __device__ void end(int idx, f32x4 (&acc)[4][4]) const { int mt, nt; tile_coord(idx, nM, nN, mt, nt); const int m0 = mt * 128, n0 = nt * 128;
      EPI_LOOP({ const float4 b = *(const float4*)(b1 + col);
        float t0 = fmaxf(v[0] + b.x, 0.f), t1 = fmaxf(v[1] + b.y, 0.f), t2 = fmaxf(v[2] + b.z, 0.f), t3 = fmaxf(v[3] + b.w, 0.f);
        uint2 o; o.x = pack2(t0 * t0, t1 * t1); o.y = pack2(t2 * t2, t3 * t3); *(uint2*)(HID + (size_t)row * 4096 + col) = o; }) }
  } pr{(const bf16_t*)(p.ws + OFF_H), (const bf16_t*)(p.ws + OFF_WFF1), (bf16_t*)(p.ws + OFF_P), p.b_ff1 + (size_t)l * 4096, M / 128, 32};
  gemm_stream(pr, sm);
}
__device__ void gemm_ff2_phase(const Params& p, int l, int g, int M, bf16_t* sm) {
  struct Pr {
    const Params& p; int g; const bf16_t* HID; const bf16_t* W; const float* MOD; const float* b2; int nM, nN;
    __device__ bool seg(int idx, Seg& s, int lr, int lk) const { int mt, nt; if (!tile_coord(idx, nM, nN, mt, nt)) return false;
      s.ap = HID + (size_t)(mt * 128 + lr) * 4096 + lk; s.bp = W + (size_t)(nt * 128 + lr) * 4096 + lk; s.lda = 4096; s.ldb = 4096; s.nk = 64; return true; }
    __device__ void begin(int, f32x4 (&acc)[4][4]) const { ZERO_ACC(acc) }
    __device__ void end(int idx, f32x4 (&acc)[4][4]) const { int mt, nt; tile_coord(idx, nM, nN, mt, nt); const int m0 = mt * 128, n0 = nt * 128;
      EPI_LOOP({ float* xp = xs_row(p, g, row) + col; const float4 xr = *(const float4*)xp; const float4 b = *(const float4*)(b2 + col);
        const float4 g2 = *(const float4*)(MOD + (size_t)mod_row(g, row) * 6144 + 5120 + col);
        float4 o; o.x = DN_ALPHA * xr.x + g2.x * (v[0] + b.x); o.y = DN_ALPHA * xr.y + g2.y * (v[1] + b.y); o.z = DN_ALPHA * xr.z + g2.z * (v[2] + b.z); o.w = DN_ALPHA * xr.w + g2.w * (v[3] + b.w);
        *(float4*)xp = o; }) }
  } pr{p, g, (const bf16_t*)(p.ws + OFF_P), (const bf16_t*)(p.ws + OFF_WFF2), (const float*)(p.ws + OFF_MOD) + (size_t)l * 9 * 6144, p.b_ff2 + (size_t)l * 1024, M / 128, 8};
  gemm_stream(pr, sm);
}

__device__ void ln_phase(const Params& p, int l, int g, int M, const float* gam, const float* bet, bool write_h2) {
  const int lane = TIDX() & 63;
  const float* MOD = (const float*)(p.ws + OFF_MOD) + (size_t)l * 9 * 6144;
  bf16_t* H = (bf16_t*)(p.ws + OFF_H);
  for (int r = BIDX() * 4 + (TIDX() >> 6); r < M; r += GDIM() * 4) {
    float* xr = xs_row(p, g, r);
    float4 v[4];
    float s = 0.f;
#pragma unroll
    for (int i = 0; i < 4; ++i) { v[i] = *(const float4*)(xr + (i * 64 + lane) * 4); s += v[i].x + v[i].y + v[i].z + v[i].w; }
#pragma unroll
    for (int o = 32; o >= 1; o >>= 1) s += __shfl_xor(s, o);
    const float mu = s * (1.f / 1024.f);
    float q = 0.f;
#pragma unroll
    for (int i = 0; i < 4; ++i) { v[i].x -= mu; v[i].y -= mu; v[i].z -= mu; v[i].w -= mu; q += v[i].x * v[i].x + v[i].y * v[i].y + v[i].z * v[i].z + v[i].w * v[i].w; }
#pragma unroll
    for (int o = 32; o >= 1; o >>= 1) q += __shfl_xor(q, o);
    const float rs = rsqrtf(q * (1.f / 1024.f) + 1e-5f);
    const float* m = MOD + (size_t)mod_row(g, r) * 6144;
#pragma unroll
    for (int i = 0; i < 4; ++i) {
      const int ch = (i * 64 + lane) * 4;
      const float4 gg = *(const float4*)(gam + ch), bb = *(const float4*)(bet + ch);
      float4 o; o.x = v[i].x * rs * gg.x + bb.x; o.y = v[i].y * rs * gg.y + bb.y; o.z = v[i].z * rs * gg.z + bb.z; o.w = v[i].w * rs * gg.w + bb.w;
      *(float4*)(xr + ch) = o;
      if (write_h2) {
        const float4 sh = *(const float4*)(m + 3072 + ch), sc = *(const float4*)(m + 4096 + ch);
        uint2 h; h.x = pack2(o.x * (1.f + sc.x) + sh.x, o.y * (1.f + sc.y) + sh.y); h.y = pack2(o.z * (1.f + sc.z) + sh.z, o.w * (1.f + sc.w) + sh.w);
        *(uint2*)(H + (size_t)r * D + ch) = h;
      }
    }
  }
}

__device__ void conv_phase(const Params& p, int l) {
  const bf16_t* P = (const bf16_t*)(p.ws + OFF_P);
  bf16_t* QKV = (bf16_t*)(p.ws + OFF_QKV); bf16_t* XBC = (bf16_t*)(p.ws + OFF_XBC);
  float* GBF = (float*)(p.ws + OFF_GBF); float* DTF = (float*)(p.ws + OFF_DTF);
  const int nb = GDIM(), bid = BIDX(), tid = TIDX();
  const int vb = ((nb & 7) == 0) ? (bid & 7) * (nb >> 3) + (bid >> 3) : bid;
  const int gtid = vb * 256 + tid, gsz = nb * 256;
  {
    const float* cw = p.gdn_conv_w + (size_t)l * 5 * 3072;
    const int c = tid & 127, hh = tid >> 7;
    for (int item = vb; item < (MG / 32) * 3; item += nb) {
      const int third = item % 3, pp = item / 3;
      const int ch0 = third * 1024 + c * 8;
      const int t0 = (pp * 2 + hh) * 16;
      int lo, hi;
      if (t0 < MLAT) { lo = t0 & ~63; hi = lo + 64; } else { lo = MLAT + ((t0 - MLAT) & ~255); hi = lo + 256; }
      u32x4 raw[20];
#pragma unroll
      for (int i = 0; i < 20; ++i) { const int row = t0 - 2 + i; raw[i] = (row >= lo && row < hi) ? *(const u32x4*)(P + (size_t)row * LDP + ch0) : (u32x4){0u, 0u, 0u, 0u}; }
      float wt[5][8];
#pragma unroll
      for (int j = 0; j < 5; ++j) { const float4 w0 = *(const float4*)(cw + j * 3072 + ch0), w1 = *(const float4*)(cw + j * 3072 + ch0 + 4);
        wt[j][0] = w0.x; wt[j][1] = w0.y; wt[j][2] = w0.z; wt[j][3] = w0.w; wt[j][4] = w1.x; wt[j][5] = w1.y; wt[j][6] = w1.z; wt[j][7] = w1.w; }
      const float qsc = (third == 0) ? 0.08838834764831845f : 1.f;
#pragma unroll
      for (int t = 0; t < 16; ++t) {
        float acc[8];
#pragma unroll
        for (int e = 0; e < 8; ++e) acc[e] = 0.f;
#pragma unroll
        for (int j = 0; j < 5; ++j) {
          const u32x4 rw = raw[t + j];
#pragma unroll
          for (int e = 0; e < 4; ++e) { acc[2 * e] += lo16(rw[e]) * wt[j][2 * e]; acc[2 * e + 1] += hi16(rw[e]) * wt[j][2 * e + 1]; }
        }
        float ss = 0.f;
#pragma unroll
        for (int e = 0; e < 8; ++e) { acc[e] = siluf_(acc[e]); ss += acc[e] * acc[e]; }
        ss += __shfl_xor(ss, 1); ss += __shfl_xor(ss, 2); ss += __shfl_xor(ss, 4); ss += __shfl_xor(ss, 8);
        const float sc = (third < 2) ? rsqrtf(ss + 1e-6f) * qsc : 1.f;
#pragma unroll
        for (int e = 0; e < 8; ++e) acc[e] *= sc;
        *(uint4*)(QKV + (size_t)(t0 + t) * 3072 + ch0) = pack8(acc);
      }
    }
  }
  {
    const float* sw = p.ssm_conv_w + (size_t)l * 5 * 4096; const float* sb = p.ssm_conv_b + (size_t)l * 4096;
    constexpr int nLat = G * 64 * 8 * 2, nCtx = (MCTX / 16) * 2;
    float wt[5][8], bs[8];
    int cur_half = -1;
    for (int item = vb; item < nLat + nCtx; item += nb) {
      int half, base, stride, p0, seglen;
      if (item < nLat) { half = item & 1; const int piece = (item >> 1) & 7, cl = (item >> 4) & 63, b_l = item >> 10; base = b_l * 8192 + cl; stride = 64; p0 = piece * 16; seglen = 128; }
      else { const int i2 = item - nLat; half = i2 & 1; const int piece = i2 >> 1; base = MLAT + (piece >> 4) * 256; stride = 1; p0 = (piece & 15) * 16; seglen = 256; }
      const int ch0 = (half * 256 + tid) * 8;
      u32x4 raw[20];
#pragma unroll
      for (int i = 0; i < 20; ++i) { const int pq = p0 - 2 + i; raw[i] = (pq >= 0 && pq < seglen) ? *(const u32x4*)(P + (size_t)(base + pq * stride) * LDP + C_XBC + ch0) : (u32x4){0u, 0u, 0u, 0u}; }
      if (half != cur_half) {
        cur_half = half;
        const float4 b0 = *(const float4*)(sb + ch0), b1 = *(const float4*)(sb + ch0 + 4);
        bs[0] = b0.x; bs[1] = b0.y; bs[2] = b0.z; bs[3] = b0.w; bs[4] = b1.x; bs[5] = b1.y; bs[6] = b1.z; bs[7] = b1.w;
#pragma unroll
        for (int j = 0; j < 5; ++j) { const float4 w0 = *(const float4*)(sw + j * 4096 + ch0), w1 = *(const float4*)(sw + j * 4096 + ch0 + 4);
          wt[j][0] = w0.x; wt[j][1] = w0.y; wt[j][2] = w0.z; wt[j][3] = w0.w; wt[j][4] = w1.x; wt[j][5] = w1.y; wt[j][6] = w1.z; wt[j][7] = w1.w; }
      }
#pragma unroll
      for (int t = 0; t < 16; ++t) {
        float acc[8];
#pragma unroll
        for (int e = 0; e < 8; ++e) acc[e] = bs[e];
#pragma unroll
        for (int j = 0; j < 5; ++j) {
          const u32x4 rw = raw[t + j];
#pragma unroll
          for (int e = 0; e < 4; ++e) { acc[2 * e] += lo16(rw[e]) * wt[j][2 * e]; acc[2 * e + 1] += hi16(rw[e]) * wt[j][2 * e + 1]; }
        }
#pragma unroll
        for (int e = 0; e < 8; ++e) acc[e] = siluf_(acc[e]);
        *(uint4*)(XBC + (size_t)(base + (p0 + t) * stride) * 4096 + ch0) = pack8(acc);
      }
    }
  }
  for (int idx = gtid; idx < MG * 16; idx += gsz) {
    const int r = idx >> 4, dh = idx & 15;
    const float a_raw = bf2f(P[(size_t)r * LDP + C_A + dh]), b_raw = bf2f(P[(size_t)r * LDP + C_B + dh]);
    const float gg = -__expf(p.gdn_A_log[l * 16 + dh]) * softplusf_(a_raw + p.gdn_dt_bias[l * 16 + dh]);
    GBF[(size_t)r * 32 + dh] = __expf(gg);
    GBF[(size_t)r * 32 + 16 + dh] = sigmoidf_(b_raw);
  }
  for (int idx = gtid; idx < G * 2 * 264 * 32; idx += gsz) {
    const int head = idx & 31; int t = idx >> 5; const int chunk = t % 264; t /= 264; const int dir = t & 1, b_l = t >> 1;
    const int dh = dir * 32 + head;
    const float bias = p.ssm_dt_bias[l * 64 + dh], aneg = -__expf(p.ssm_A_log[l * 64 + dh]);
    float dtv[32];
#pragma unroll
    for (int u = 0; u < 32; ++u) dtv[u] = bf2f(P[(size_t)ssd_rowof(b_l, dir, chunk * 32 + u) * LDP + C_DT + dh]);
    float cum = 0.f;
#pragma unroll
    for (int u = 0; u < 32; ++u) {
      const size_t row = (size_t)ssd_rowof(b_l, dir, chunk * 32 + u);
      const float dt = softplusf_(dtv[u] + bias);
      cum += dt * aneg;
      DTF[row * 128 + dh] = dt;
      DTF[row * 128 + 64 + dh] = cum;
    }
  }
}

__device__ void gdn_scan_item(const Params& p, int item, float* sm) {
  const int tid = TIDX();
  const int b_l = item >> 7, h = (item >> 4) & 7, dir = (item >> 3) & 1, cb = item & 7;
  const int col = tid >> 4, sub = tid & 15;
  float* KQ = sm; float* Vs = KQ + 2 * 6144; float* ABs = Vs + 2 * 256; float* Ost = ABs + 2 * 32;
  const bf16_t* QKV = (const bf16_t*)(p.ws + OFF_QKV);
  const float* GBF = (const float*)(p.ws + OFF_GBF);
  bf16_t* OUT = (bf16_t*)(p.ws + (dir ? OFF_OB : OFF_OF));
  auto rowof = [&](int s) -> int {
    if (s < 256) { const int i = dir ? 255 - s : s; return MLAT + b_l * 256 + i; }
    const int i = s - 256; const int t = dir ? 8191 - i : i; return b_l * 8192 + t; };
  const int ltok = tid >> 5, lpart = tid & 31;
  const int lco = (lpart < 16) ? (h * 128 + lpart * 8) : (1024 + h * 128 + (lpart - 16) * 8);
  const int ldst = ((lpart < 16) ? 192 : 0) + (lpart & 15) * 12;
  struct Stage { u32x4 kq0, kq1, v; float ab; };
  Stage st0, st1;
  st0.v = (u32x4){0u, 0u, 0u, 0u}; st0.ab = 0.f; st1.v = st0.v; st1.ab = 0.f; st0.kq0 = st0.v; st0.kq1 = st0.v; st1.kq0 = st0.v; st1.kq1 = st0.v;
  constexpr int NCH = (256 + 8192) / 16;
  auto gload = [&](Stage& st, int c) {
    if (c >= NCH) return;
    const int s0 = c * 16;
    st.kq0 = *(const u32x4*)(QKV + (size_t)rowof(s0 + ltok) * 3072 + lco);
    st.kq1 = *(const u32x4*)(QKV + (size_t)rowof(s0 + 8 + ltok) * 3072 + lco);
    if (tid < 32) st.v = *(const u32x4*)(QKV + (size_t)rowof(s0 + (tid >> 1)) * 3072 + 2048 + h * 128 + cb * 16 + (tid & 1) * 8);
    else if (tid >= 64 && tid < 96) st.ab = GBF[(size_t)rowof(s0 + ((tid - 64) >> 1)) * 32 + ((tid - 64) & 1) * 16 + dir * 8 + h];
  };
  auto lstore = [&](const Stage& st, int buf) {
    float* d0 = KQ + buf * 6144 + ltok * 384 + ldst;
    *(f32x4*)d0 = (f32x4){lo16(st.kq0[0]), hi16(st.kq0[0]), lo16(st.kq0[1]), hi16(st.kq0[1])};
    *(f32x4*)(d0 + 4) = (f32x4){lo16(st.kq0[2]), hi16(st.kq0[2]), lo16(st.kq0[3]), hi16(st.kq0[3])};
    float* d1 = d0 + 8 * 384;
    *(f32x4*)d1 = (f32x4){lo16(st.kq1[0]), hi16(st.kq1[0]), lo16(st.kq1[1]), hi16(st.kq1[1])};
    *(f32x4*)(d1 + 4) = (f32x4){lo16(st.kq1[2]), hi16(st.kq1[2]), lo16(st.kq1[3]), hi16(st.kq1[3])};
    if (tid < 32) { float* dv = Vs + buf * 256 + (tid >> 1) * 16 + (tid & 1) * 8;
      *(f32x4*)dv = (f32x4){lo16(st.v[0]), hi16(st.v[0]), lo16(st.v[1]), hi16(st.v[1])};
      *(f32x4*)(dv + 4) = (f32x4){lo16(st.v[2]), hi16(st.v[2]), lo16(st.v[3]), hi16(st.v[3])}; }
    else if (tid >= 64 && tid < 96) ABs[buf * 32 + (tid - 64)] = st.ab;
  };
  f32x2 S[4];
#pragma unroll
  for (int i = 0; i < 4; ++i) S[i] = (f32x2){0.f, 0.f};
  auto compute = [&](int buf) {
    const float* kq = KQ + buf * 6144 + sub * 12;
    const float* vs = Vs + buf * 256 + col;
    const float* ab = ABs + buf * 32;
    f32x4 ka = *(const f32x4*)kq, kc = *(const f32x4*)(kq + 4), qa = *(const f32x4*)(kq + 192), qc = *(const f32x4*)(kq + 196);
    float a = ab[0], beta = ab[1], v = vs[0];
    float okeep = 0.f;
#pragma unroll
    for (int j = 0; j < 16; ++j) {
      f32x4 nka = ka, nkc = kc, nqa = qa, nqc = qc; float na = a, nbeta = beta, nv = v;
      if (j + 1 < 16) {
        const float* kb = kq + (j + 1) * 384;
        nka = *(const f32x4*)kb; nkc = *(const f32x4*)(kb + 4); nqa = *(const f32x4*)(kb + 192); nqc = *(const f32x4*)(kb + 196);
        na = ab[(j + 1) * 2]; nbeta = ab[(j + 1) * 2 + 1]; nv = vs[(j + 1) * 16];
      }
      const f32x2 K2[4] = {(f32x2){ka[0], ka[1]}, (f32x2){ka[2], ka[3]}, (f32x2){kc[0], kc[1]}, (f32x2){kc[2], kc[3]}};
      const f32x2 Q2[4] = {(f32x2){qa[0], qa[1]}, (f32x2){qa[2], qa[3]}, (f32x2){qc[0], qc[1]}, (f32x2){qc[2], qc[3]}};
      f32x2 d0 = S[0] * K2[0], d1 = S[1] * K2[1];
      d0 += S[2] * K2[2]; d1 += S[3] * K2[3];
      d0 += d1;
      const float ks = reduce16(d0[0] + d0[1]);
      const float cc = beta * (v - a * ks);
      const f32x2 a2 = (f32x2){a, a}, c2 = (f32x2){cc, cc};
#pragma unroll
      for (int i = 0; i < 4; ++i) S[i] = K2[i] * c2 + a2 * S[i];
      f32x2 o0 = S[0] * Q2[0], o1 = S[1] * Q2[1];
      o0 += S[2] * Q2[2]; o1 += S[3] * Q2[3];
      o0 += o1;
      const float o = reduce16(o0[0] + o0[1]);
      okeep = (sub == j) ? o : okeep;
      ka = nka; kc = nkc; qa = nqa; qc = nqc; a = na; beta = nbeta; v = nv;
    }
    Ost[buf * 256 + sub * 16 + col] = okeep;
  };
  auto flush = [&](int c) {
    if (tid < 32) {
      const float* src = Ost + (c & 1) * 256 + (tid >> 1) * 16 + (tid & 1) * 8;
      float f[8];
#pragma unroll
      for (int e = 0; e < 8; ++e) f[e] = src[e];
      *(uint4*)(OUT + (size_t)rowof(c * 16 + (tid >> 1)) * 1024 + h * 128 + cb * 16 + (tid & 1) * 8) = pack8(f);
    }
  };
  __syncthreads();
  gload(st0, 0); lstore(st0, 0);
  __syncthreads();
  gload(st0, 1); gload(st1, 2);
  for (int c = 0; c < NCH; c += 2) {
    compute(0);
    lstore(st0, 1); gload(st0, c + 3);
    __syncthreads();
    flush(c);
    compute(1);
    if (c + 2 < NCH) lstore(st1, 0);
    gload(st1, c + 4);
    __syncthreads();
    flush(c + 1);
  }
}

__device__ void ssd_chunk_item(const Params& p, int id, unsigned char* smraw) {
  const int tid = TIDX(), lane = tid & 63, w = tid >> 6, fr = lane & 15, fq = lane >> 4;
  const int b_l = id >> 6, head = (id >> 1) & 31, dir = id & 1, grp = head >> 2;
  bf16_t* sC = (bf16_t*)smraw;
  bf16_t* sB = sC + 32 * 136;
  bf16_t* sBT = sB + 32 * 136;
  bf16_t* sXT = sBT + 128 * 40;
  bf16_t* sM = sXT + 64 * 40;
  bf16_t* sST = sM + 32 * 40;
  float* sG = (float*)(sST + 64 * 136);
  const bf16_t* XBC = (const bf16_t*)(p.ws + OFF_XBC);
  const float* DTF = (const float*)(p.ws + OFF_DTF);
  bf16_t* OUT = (bf16_t*)(p.ws + (dir ? OFF_YB : OFF_YF));
  const int ltok = tid & 31, lpart = tid >> 5;
  struct Stage { u32x4 b0, b1, c0, c1, x; float dt, g, gl; };
  Stage st0, st1;
  constexpr int NCH = (256 + 8192) / 32;
  auto gload = [&](Stage& st, int c) {
    if (c >= NCH) return;
    const int s0 = c * 32;
    const size_t row = (size_t)ssd_rowof(b_l, dir, s0 + ltok);
    const bf16_t* xr = XBC + row * 4096;
    st.b0 = *(const u32x4*)(xr + 2048 + grp * 128 + lpart * 8);
    st.b1 = *(const u32x4*)(xr + 2048 + grp * 128 + (lpart + 8) * 8);
    st.c0 = *(const u32x4*)(xr + 3072 + grp * 128 + lpart * 8);
    st.c1 = *(const u32x4*)(xr + 3072 + grp * 128 + (lpart + 8) * 8);
    st.x = *(const u32x4*)(xr + head * 64 + lpart * 8);
    st.dt = DTF[row * 128 + dir * 32 + head];
    st.g = DTF[row * 128 + 64 + dir * 32 + head];
    st.gl = DTF[(size_t)ssd_rowof(b_l, dir, s0 + 31) * 128 + 64 + dir * 32 + head];
  };
  auto lstore = [&](const Stage& st) {
    *(u32x4*)(sB + ltok * 136 + lpart * 8) = st.b0;
    *(u32x4*)(sB + ltok * 136 + (lpart + 8) * 8) = st.b1;
    *(u32x4*)(sC + ltok * 136 + lpart * 8) = st.c0;
    *(u32x4*)(sC + ltok * 136 + (lpart + 8) * 8) = st.c1;
    const float wj = __expf(st.gl - st.g);
    bf16_t* t0 = sBT + (lpart * 8) * 40 + ltok;
    bf16_t* t1 = sBT + ((lpart + 8) * 8) * 40 + ltok;
    bf16_t* tx = sXT + (lpart * 8) * 40 + ltok;
#pragma unroll
    for (int e = 0; e < 4; ++e) {
      t0[(2 * e) * 40] = f2bf(lo16(st.b0[e]) * wj); t0[(2 * e + 1) * 40] = f2bf(hi16(st.b0[e]) * wj);
      t1[(2 * e) * 40] = f2bf(lo16(st.b1[e]) * wj); t1[(2 * e + 1) * 40] = f2bf(hi16(st.b1[e]) * wj);
      tx[(2 * e) * 40] = f2bf(lo16(st.x[e]) * st.dt); tx[(2 * e + 1) * 40] = f2bf(hi16(st.x[e]) * st.dt);
    }
    if (tid < 32) sG[tid] = st.g;
  };
  f32x4 S[8];
#pragma unroll
  for (int i = 0; i < 8; ++i) S[i] = (f32x4){0.f, 0.f, 0.f, 0.f};
  __syncthreads();
  for (int i = lane; i < 16 * 136 / 2; i += 64) ((unsigned*)(sST + w * 16 * 136))[i] = 0u;
  gload(st0, 0); lstore(st0);
  __syncthreads();
  gload(st0, 1); gload(st1, 2);
  for (int c = 0; c < NCH; ++c) {
    {
      const int ti = w >> 1, tj = w & 1;
      f32x4 cb = (f32x4){0.f, 0.f, 0.f, 0.f};
      if (tj <= ti) {
#pragma unroll
        for (int ks = 0; ks < 4; ++ks) {
          const bf16x8 af = *(const bf16x8*)(sC + (ti * 16 + fr) * 136 + ks * 32 + fq * 8);
          const bf16x8 bf = *(const bf16x8*)(sB + (tj * 16 + fr) * 136 + ks * 32 + fq * 8);
          cb = __builtin_amdgcn_mfma_f32_16x16x32_bf16(bf, af, cb, 0, 0, 0);
        }
      }
      const int i = ti * 16 + fr, j0 = tj * 16 + fq * 4;
      const float gi = sG[i];
      float m[4];
#pragma unroll
      for (int r = 0; r < 4; ++r) { const int j = j0 + r; const float gj = sG[j]; m[r] = (j <= i) ? cb[r] * __expf(gi - gj) : 0.f; }
      uint2 o; o.x = pack2(m[0], m[1]); o.y = pack2(m[2], m[3]);
      *(uint2*)(sM + i * 40 + j0) = o;
    }
    __syncthreads();
    const bf16x8 xfrag = *(const bf16x8*)(sXT + (w * 16 + fr) * 40 + fq * 8);
    const float eglast = __expf(sG[31]);
#pragma unroll
    for (int ti = 0; ti < 2; ++ti) {
      f32x4 y = (f32x4){0.f, 0.f, 0.f, 0.f};
#pragma unroll
      for (int ks = 0; ks < 4; ++ks) {
        const bf16x8 af = *(const bf16x8*)(sC + (ti * 16 + fr) * 136 + ks * 32 + fq * 8);
        const bf16x8 bf = *(const bf16x8*)(sST + (w * 16 + fr) * 136 + ks * 32 + fq * 8);
        y = __builtin_amdgcn_mfma_f32_16x16x32_bf16(bf, af, y, 0, 0, 0);
      }
      const int i = ti * 16 + fr;
      const float eg = __expf(sG[i]);
      y *= eg;
      const bf16x8 mf = *(const bf16x8*)(sM + i * 40 + fq * 8);
      y = __builtin_amdgcn_mfma_f32_16x16x32_bf16(xfrag, mf, y, 0, 0, 0);
      uint2 o; o.x = pack2(y[0], y[1]); o.y = pack2(y[2], y[3]);
      *(uint2*)(OUT + (size_t)ssd_rowof(b_l, dir, c * 32 + i) * 2048 + head * 64 + w * 16 + fq * 4) = o;
    }
#pragma unroll
    for (int tn = 0; tn < 8; ++tn) {
      const bf16x8 bf = *(const bf16x8*)(sBT + (tn * 16 + fr) * 40 + fq * 8);
      S[tn] *= eglast;
      S[tn] = __builtin_amdgcn_mfma_f32_16x16x32_bf16(bf, xfrag, S[tn], 0, 0, 0);
    }
#pragma unroll
    for (int tn = 0; tn < 8; ++tn) {
      uint2 o; o.x = pack2(S[tn][0], S[tn][1]); o.y = pack2(S[tn][2], S[tn][3]);
      *(uint2*)(sST + (w * 16 + fr) * 136 + tn * 16 + fq * 4) = o;
    }
    __syncthreads();
    if (c + 1 < NCH) { if (c & 1) lstore(st1); else lstore(st0); }
    if (c & 1) gload(st1, c + 3); else gload(st0, c + 3);
    __syncthreads();
  }
}

__device__ void scan_phase(const Params& p, unsigned char* sm) {
  for (int item = BIDX(); item < 384; item += GDIM()) {
    if (item < 256) gdn_scan_item(p, item, (float*)sm); else ssd_chunk_item(p, item - 256, sm);
    __syncthreads();
  }
}

__device__ void gnorm_phase(const Params& p, int l, int M) {
  const bf16_t* P = (const bf16_t*)(p.ws + OFF_P);
  const bf16_t* OF = (const bf16_t*)(p.ws + OFF_OF); const bf16_t* OB = (const bf16_t*)(p.ws + OFF_OB);
  const bf16_t* YF = (const bf16_t*)(p.ws + OFF_YF); const bf16_t* YB = (const bf16_t*)(p.ws + OFF_YB);
  const bf16_t* XBC = (const bf16_t*)(p.ws + OFF_XBC);
  bf16_t* YA = (bf16_t*)(p.ws + OFF_QKV); bf16_t* YBn = YA + (size_t)MG * 1024;
  const int gtid = BIDX() * 256 + TIDX(), gsz = GDIM() * 256;
  const float* nw = p.gdn_norm_w + l * 128;
  for (int idx = gtid; idx < M * 128; idx += gsz) {
    const int r = idx >> 7, c8 = (idx & 127) * 8;
    const uint4 a = *(const uint4*)(OF + (size_t)r * 1024 + c8), b = *(const uint4*)(OB + (size_t)r * 1024 + c8);
    const uint4 gt = *(const uint4*)(P + (size_t)r * LDP + C_GOUT + c8);
    float fa[8], fb[8], fg[8]; UNPACK8(a, fa); UNPACK8(b, fb); UNPACK8(gt, fg);
    float ss = 0.f;
#pragma unroll
    for (int e = 0; e < 8; ++e) { fa[e] += fb[e]; ss += fa[e] * fa[e]; }
    ss += __shfl_xor(ss, 1); ss += __shfl_xor(ss, 2); ss += __shfl_xor(ss, 4); ss += __shfl_xor(ss, 8);
    const float rs = rsqrtf(ss * (1.f / 128.f) + 1e-6f);
    const float4 w0 = *(const float4*)(nw + (c8 & 127)), w1 = *(const float4*)(nw + (c8 & 127) + 4);
    const float wv[8] = {w0.x, w0.y, w0.z, w0.w, w1.x, w1.y, w1.z, w1.w};
#pragma unroll
    for (int e = 0; e < 8; ++e) fa[e] = fa[e] * rs * wv[e] * siluf_(fg[e]);
    *(uint4*)(YA + (size_t)r * 1024 + c8) = pack8(fa);
  }
  const float* sw = p.ssm_norm_w + l * 2048; const float* Dk = p.ssm_D + l * 32;
  for (int idx = gtid; idx < M * 256; idx += gsz) {
    const int r = idx >> 8, c8 = (idx & 255) * 8;
    const uint4 a = *(const uint4*)(YF + (size_t)r * 2048 + c8), b = *(const uint4*)(YB + (size_t)r * 2048 + c8);
    const uint4 xx = *(const uint4*)(XBC + (size_t)r * 4096 + c8);
    const uint4 zz = *(const uint4*)(P + (size_t)r * LDP + C_Z + c8);
    float fa[8], fb[8], fx[8], fz[8]; UNPACK8(a, fa); UNPACK8(b, fb); UNPACK8(xx, fx); UNPACK8(zz, fz);
    const float dsk = Dk[c8 >> 6];
    float ss = 0.f;
#pragma unroll
    for (int e = 0; e < 8; ++e) { fa[e] = (fa[e] + fb[e] + dsk * fx[e]) * siluf_(fz[e]); ss += fa[e] * fa[e]; }
    ss += __shfl_xor(ss, 1); ss += __shfl_xor(ss, 2); ss += __shfl_xor(ss, 4); ss += __shfl_xor(ss, 8); ss += __shfl_xor(ss, 16);
    const float rs = rsqrtf(ss * (1.f / 256.f) + 1e-6f);
    const float4 w0 = *(const float4*)(sw + c8), w1 = *(const float4*)(sw + c8 + 4);
    const float wv[8] = {w0.x, w0.y, w0.z, w0.w, w1.x, w1.y, w1.z, w1.w};
#pragma unroll
    for (int e = 0; e < 8; ++e) fa[e] = fa[e] * rs * wv[e];
    *(uint4*)(YBn + (size_t)r * 2048 + c8) = pack8(fa);
  }
}

#ifndef STOP_AFTER
#define STOP_AFTER 0
#endif
#define SYNC() { grid.sync(); if (++nsync == STOP_AFTER) return; }
__global__ void __launch_bounds__(256, 2) mega(Params p) {
  cg::grid_group grid = cg::this_grid();
  int nsync = 0;
  __shared__ __attribute__((aligned(16))) unsigned char smem[SMEM_BYTES];
  float* smf = (float*)smem; bf16_t* smh = (bf16_t*)smem;
  for (int l = 0; l < 2; ++l) {
    transpose_phase(p.w_in + (size_t)l * 1024 * IN_DIM, (bf16_t*)(p.ws + OFF_WIN), 1024, IN_DIM, LDP, smf);
    transpose_phase(p.w_proj_gdn + (size_t)l * 1024 * 1024, (bf16_t*)(p.ws + OFF_WPG), 1024, 1024, 1024, smf);
    transpose_phase(p.w_proj_ssm + (size_t)l * 2048 * 1024, (bf16_t*)(p.ws + OFF_WPS), 2048, 1024, 1024, smf);
    transpose_phase(p.w_out + (size_t)l * 1024 * 1024, (bf16_t*)(p.ws + OFF_WOUT), 1024, 1024, 1024, smf);
    transpose_phase(p.w_ff1 + (size_t)l * 1024 * 4096, (bf16_t*)(p.ws + OFF_WFF1), 1024, 4096, 4096, smf);
    transpose_phase(p.w_ff2 + (size_t)l * 4096 * 1024, (bf16_t*)(p.ws + OFF_WFF2), 4096, 1024, 1024, smf);
    if (l == 0) { modpart_phase(p, smf); SYNC(); modfinal_phase(p); }
    SYNC();
    const bool last = (l == 1);
    const int Mpost = last ? MLAT : MG;
    for (int g = 0; g < NGRP; ++g) {
      modulate_phase(p, l, g); SYNC();
      gemm_inproj_phase(p, smh); SYNC();
      conv_phase(p, l); SYNC();
      scan_phase(p, smem); SYNC();
      gnorm_phase(p, l, Mpost); SYNC();
      gemm_proj_phase(p, Mpost, smh); SYNC();
      gemm_wout_phase(p, l, g, Mpost, smh); SYNC();
      ln_phase(p, l, g, Mpost, p.ln1_g + l * D, p.ln1_b + l * D, true); SYNC();
      gemm_ff1_phase(p, l, Mpost, smh); SYNC();
      gemm_ff2_phase(p, l, g, Mpost, smh); SYNC();
      ln_phase(p, l, g, Mpost, p.ln2_g + l * D, p.ln2_b + l * D, false); SYNC();
    }
  }
}

extern "C" void kernel_launch(void* const* d_in, const int* in_sizes, int n_in, void* d_out, int out_size, void* d_ws, size_t ws_size,
                              hipStream_t stream) {
  static int grid_blocks = 0;
  if (!grid_blocks) {
    int dev = 0, cus = 0, per_cu = 0;
    (void)hipGetDevice(&dev);
    (void)hipDeviceGetAttribute(&cus, hipDeviceAttributeMultiprocessorCount, dev);
    (void)hipOccupancyMaxActiveBlocksPerMultiprocessor(&per_cu, mega, 256, 0);
    if (per_cu > 2) per_cu = 2;
    grid_blocks = cus * per_cu;
    if (ws_size < WS_TOTAL) fprintf(stderr, "workspace too small: %zu < %zu\n", ws_size, WS_TOTAL);
  }
  Params p{};
  const float** pp = (const float**)&p;
  for (int i = 0; i < 28; ++i) pp[i] = (const float*)d_in[i];
  p.out = (float*)d_out;
  p.ws = (unsigned char*)d_ws;
  void* args[] = {&p};
  hipError_t e = hipLaunchCooperativeKernel((void*)mega, dim3(grid_blocks), dim3(256), args, 0, stream);
  if (e != hipSuccess) fprintf(stderr, "cooperative launch failed: %s (grid %d)\n", hipGetErrorString(e), grid_blocks);
}
```

```cpp
#include <hip/hip_runtime.h>
#include <hip/hip_cooperative_groups.h>
#include <cstdio>
namespace cg = cooperative_groups;

typedef unsigned short bf16_t;
typedef short bf16x8 __attribute__((ext_vector_type(8)));
typedef float f32x4 __attribute__((ext_vector_type(4)));
typedef float f32x2 __attribute__((ext_vector_type(2)));
typedef unsigned u32x4 __attribute__((ext_vector_type(4)));

constexpr int D = 1024, SEQ = 8192, LC = 256;
constexpr int G = 2, NGRP = 4;
constexpr int MLAT = G * SEQ, MCTX = G * LC, MG = MLAT + MCTX;
constexpr int IN_DIM = 12384, LDP = 12416;
constexpr int C_GOUT = 3072, C_A = 4096, C_B = 4112, C_Z = 4128, C_XBC = 6176, C_DT = 10272, C_GA = 10336, C_GB = 11360;
constexpr float DN_ALPHA = 1.4142135623730951f;

constexpr size_t SZ_WIN = (size_t)LDP * 1024 * 2;
constexpr size_t OFF_WIN = 0;
constexpr size_t OFF_WPG = OFF_WIN + SZ_WIN;
constexpr size_t OFF_WPS = OFF_WPG + 2097152;
constexpr size_t OFF_WOUT = OFF_WPS + 4194304;
constexpr size_t OFF_WFF1 = OFF_WOUT + 2097152;
constexpr size_t OFF_WFF2 = OFF_WFF1 + 8388608;
constexpr size_t OFF_MODP = OFF_WFF2 + 8388608;
constexpr size_t OFF_MOD = OFF_MODP + (size_t)2 * 16 * 9 * 6144 * 4;
constexpr size_t OFF_XSC = OFF_MOD + (size_t)2 * 9 * 6144 * 4;
constexpr size_t OFF_H = OFF_XSC + (size_t)2048 * 1024 * 4;
constexpr size_t OFF_P = OFF_H + (size_t)MG * 1024 * 2;
constexpr size_t OFF_QKV = OFF_P + (size_t)MG * LDP * 2;
constexpr size_t OFF_XBC = OFF_QKV + (size_t)MG * 3072 * 2;
constexpr size_t OFF_GBF = OFF_XBC + (size_t)MG * 4096 * 2;
constexpr size_t OFF_DTF = OFF_GBF + (size_t)MG * 32 * 4;
constexpr size_t OFF_OF = OFF_DTF + (size_t)MG * 128 * 4;
constexpr size_t OFF_OB = OFF_OF + (size_t)MG * 1024 * 2;
constexpr size_t OFF_YF = OFF_OB + (size_t)MG * 1024 * 2;
constexpr size_t OFF_YB = OFF_YF + (size_t)MG * 2048 * 2;
constexpr size_t OFF_TMB = OFF_YB + (size_t)MG * 2048 * 2;
constexpr int GDN_NITEM = G * 8 * 2 * 264;
constexpr size_t WS_TOTAL = OFF_TMB + (size_t)GDN_NITEM * 2048 * 2;
static_assert(WS_TOTAL <= ((size_t)1024 << 20), "workspace plan exceeds 1 GiB");

struct Params {
  const float *x, *c, *ctx, *c_ctx, *w_mod, *b_mod, *w_in, *gdn_conv_w, *gdn_A_log, *gdn_dt_bias, *gdn_norm_w;
  const float *ssm_conv_w, *ssm_conv_b, *ssm_A_log, *ssm_dt_bias, *ssm_D, *ssm_norm_w, *w_proj_gdn, *w_proj_ssm, *w_out;
  const float *ln1_g, *ln1_b, *w_ff1, *b_ff1, *w_ff2, *b_ff2, *ln2_g, *ln2_b;
  float* out;
  unsigned char* ws;
};

constexpr int SMEM_BYTES = 73728;


__device__ __forceinline__ int TIDX() { int t = threadIdx.x; asm volatile("" : "+v"(t)); return t; }
__device__ __forceinline__ int BIDX() { int t = blockIdx.x; asm volatile("" : "+s"(t)); return t; }
__device__ __forceinline__ int GDIM() { int t = gridDim.x; asm volatile("" : "+s"(t)); return t; }
__device__ __forceinline__ float bf2f(bf16_t b) { return __uint_as_float(((unsigned)b) << 16); }
__device__ __forceinline__ bf16_t f2bf(float f) { unsigned u = __float_as_uint(f); u += 0x7fffu + ((u >> 16) & 1u); return (bf16_t)(u >> 16); }
typedef __bf16 bf16v2 __attribute__((ext_vector_type(2)));
__device__ __forceinline__ unsigned pack2(float a, float b) { const f32x2 v = (f32x2){a, b}; const bf16v2 h = __builtin_convertvector(v, bf16v2); return __builtin_bit_cast(unsigned, h); }
__device__ __forceinline__ float lo16(unsigned v) { return __uint_as_float(v << 16); }
__device__ __forceinline__ float hi16(unsigned v) { return __uint_as_float(v & 0xffff0000u); }
#define UNPACK8(v, f) { f[0] = lo16(v.x); f[1] = hi16(v.x); f[2] = lo16(v.y); f[3] = hi16(v.y); f[4] = lo16(v.z); f[5] = hi16(v.z); f[6] = lo16(v.w); f[7] = hi16(v.w); }
__device__ __forceinline__ uint4 pack8(const float* f) { uint4 r; r.x = pack2(f[0], f[1]); r.y = pack2(f[2], f[3]); r.z = pack2(f[4], f[5]); r.w = pack2(f[6], f[7]); return r; }
__device__ __forceinline__ float sigmoidf_(float x) { return __builtin_amdgcn_rcpf(1.f + __expf(-x)); }
__device__ __forceinline__ float siluf_(float x) { return x * __builtin_amdgcn_rcpf(1.f + __expf(-x)); }
__device__ __forceinline__ float softplusf_(float x) { return x > 20.f ? x : log1pf(__expf(x)); }
template <int CTRL> __device__ __forceinline__ float dppf(float x) { return __builtin_bit_cast(float, __builtin_amdgcn_mov_dpp(__builtin_bit_cast(int, x), CTRL, 0xf, 0xf, true)); }
__device__ __forceinline__ float reduce16(float x) { x += dppf<0xB1>(x); x += dppf<0x4E>(x); x += dppf<0x141>(x); x += dppf<0x140>(x); return x; }

__device__ __forceinline__ float* xs_row(const Params& p, int g, int r) {
  return (r < MLAT) ? p.out + ((size_t)g * MLAT + r) * D : (float*)(p.ws + OFF_XSC) + ((size_t)g * MCTX + (r - MLAT)) * D;
}
__device__ __forceinline__ const float* xin_row(const Params& p, int l, int g, int r) {
  if (l == 0) return (r < MLAT) ? p.x + ((size_t)g * MLAT + r) * D : p.ctx + ((size_t)g * MCTX + (r - MLAT)) * D;
  return xs_row(p, g, r);
}
__device__ __forceinline__ int mod_row(int g, int r) { return r < MLAT ? g * G + r / SEQ : 8; }
__device__ __forceinline__ int gdn_rowof(int b_l, int dir, int s) {
  if (s < 256) { const int i = dir ? 255 - s : s; return MLAT + b_l * 256 + i; }
  const int i = s - 256; return b_l * 8192 + (dir ? 8191 - i : i);
}
__device__ __forceinline__ int ssd_rowof(int b_l, int dir, int s) {
  if (s < 256) { const int i = dir ? 255 - s : s; return MLAT + b_l * 256 + i; }
  const int j = s - 256; const int pos = dir ? 8191 - j : j; return b_l * 8192 + (pos & 127) * 64 + (pos >> 7);
}

__device__ __forceinline__ void transpose_phase(const float* __restrict__ src, bf16_t* __restrict__ dst, int K, int N, int Npad, float* tile) {
  const int tid = TIDX(), tk = K / 64, tn = Npad / 64;
  const int c = tid & 63, r4 = tid >> 6;
  for (int t = BIDX(); t < tk * tn; t += GDIM()) {
    const int kt = t % tk, nt = t / tk, k0 = kt * 64, n0 = nt * 64;
    __syncthreads();
#pragma unroll 4
    for (int i = 0; i < 16; ++i) { const int r = i * 4 + r4, n = n0 + c; tile[r * 65 + c] = (n < N) ? src[(size_t)(k0 + r) * N + n] : 0.f; }
    __syncthreads();
#pragma unroll 4
    for (int i = 0; i < 16; ++i) { const int nn = i * 4 + r4; dst[(size_t)(n0 + nn) * K + k0 + c] = f2bf(tile[c * 65 + nn]); }
  }
}

__device__ __forceinline__ void modpart_phase(const Params& p, float* sm) {
  const int tid = TIDX();
  float* MODP = (float*)(p.ws + OFF_MODP);
  for (int item = BIDX(); item < 2 * 24 * 16; item += GDIM()) {
    const int l = item / 384, rem = item % 384, cbk = rem / 16, ks = rem % 16;
    __syncthreads();
    for (int i = tid; i < 9 * 64; i += 256) { const int r = i / 64, k = ks * 64 + (i % 64); const float v = (r < 8) ? p.c[r * D + k] : p.c_ctx[k]; sm[i] = siluf_(v); }
    __syncthreads();
    const int col = cbk * 256 + tid;
    float acc[9];
#pragma unroll
    for (int r = 0; r < 9; ++r) acc[r] = 0.f;
    const float* wp = p.w_mod + ((size_t)l * D + ks * 64) * 6144 + col;
#pragma unroll 8
    for (int k = 0; k < 64; ++k) { const float w = wp[(size_t)k * 6144];
#pragma unroll
      for (int r = 0; r < 9; ++r) acc[r] += sm[r * 64 + k] * w; }
#pragma unroll
    for (int r = 0; r < 9; ++r) MODP[(((size_t)l * 16 + ks) * 9 + r) * 6144 + col] = acc[r];
  }
}
__device__ __forceinline__ void modfinal_phase(const Params& p) {
  const float* MODP = (const float*)(p.ws + OFF_MODP);
  float* MOD = (float*)(p.ws + OFF_MOD);
  for (int i = BIDX() * 256 + TIDX(); i < 2 * 9 * 6144; i += GDIM() * 256) {
    const int l = i / (9 * 6144), rem = i % (9 * 6144), col = rem % 6144;
    float s = p.b_mod[l * 6144 + col];
    for (int ks = 0; ks < 16; ++ks) s += MODP[((size_t)l * 16 + ks) * 9 * 6144 + rem];
    MOD[i] = s;
  }
}

__device__ __forceinline__ void modulate_phase(const Params& p, int l, int g) {
  const float* MOD = (const float*)(p.ws + OFF_MOD) + (size_t)l * 9 * 6144;
  bf16_t* H = (bf16_t*)(p.ws + OFF_H);
  for (int i = BIDX() * 256 + TIDX(); i < MG * 128; i += GDIM() * 256) {
    const int r = i >> 7, ch = (i & 127) * 8;
    const float* xr = xin_row(p, l, g, r) + ch;
    const float* m = MOD + (size_t)mod_row(g, r) * 6144;
    const float4 x0 = *(const float4*)xr, x1 = *(const float4*)(xr + 4);
    const float4 sh0 = *(const float4*)(m + ch), sh1 = *(const float4*)(m + ch + 4);
    const float4 sc0 = *(const float4*)(m + 1024 + ch), sc1 = *(const float4*)(m + 1024 + ch + 4);
    float f[8] = {x0.x * (1.f + sc0.x) + sh0.x, x0.y * (1.f + sc0.y) + sh0.y, x0.z * (1.f + sc0.z) + sh0.z, x0.w * (1.f + sc0.w) + sh0.w,
                  x1.x * (1.f + sc1.x) + sh1.x, x1.y * (1.f + sc1.y) + sh1.y, x1.z * (1.f + sc1.z) + sh1.z, x1.w * (1.f + sc1.w) + sh1.w};
    *(uint4*)(H + (size_t)r * D + ch) = pack8(f);
  }
}

struct Seg { const bf16_t* ap; const bf16_t* bp; int lda, ldb, nk; };

__device__ __forceinline__ bool tile_coord(int it, int nM, int nN, int& mt, int& nt) {
  const int nb = GDIM(), v = BIDX();
  long s;
  if ((nb & 7) == 0) { const int per = nb >> 3; s = (long)it * nb + (v & 7) * per + (v >> 3); } else s = (long)it * nb + v;
  if (s >= (long)nM * nN) return false;
  const int band = (int)(s / (8 * nN)), r = (int)(s - (long)band * 8 * nN);
  const int bsz = (nM - band * 8) < 8 ? (nM - band * 8) : 8;
  nt = r / bsz; mt = band * 8 + (r % bsz);
  return true;
}

#define ZERO_ACC(acc) { _Pragma("unroll") for (int i_ = 0; i_ < 4; ++i_) { _Pragma("unroll") for (int j_ = 0; j_ < 4; ++j_) acc[i_][j_] = (f32x4){0.f, 0.f, 0.f, 0.f}; } }
#define EPI_LOOP(...) { const int lane_ = TIDX() & 63, w_ = TIDX() >> 6; \
  _Pragma("unroll") for (int i_ = 0; i_ < 4; ++i_) { const int row = m0 + (w_ >> 1) * 64 + i_ * 16 + (lane_ & 15); \
  _Pragma("unroll") for (int j_ = 0; j_ < 4; ++j_) { const int col = n0 + (w_ & 1) * 64 + j_ * 16 + (lane_ >> 4) * 4; f32x4& v = acc[i_][j_]; __VA_ARGS__ } } }

template <class Prob>
__device__ __forceinline__ void gemm_stream(Prob& pr, bf16_t* sm) {
  const int tid = TIDX(), lane = tid & 63, w = tid >> 6, wr = w >> 1, wc = w & 1;
  const int lr = tid >> 3, lk = (tid & 7) * 8;
  const int fr = lane & 15, fq = lane >> 4;
  const int aoff = (wr * 64 + fr) * 72 + fq * 8, boff = 9216 + (wc * 64 + fr) * 72 + fq * 8;
  const int soff = lr * 72 + lk;
  Seg cur, nxt;
  if (!pr.seg(0, cur, lr, lk)) return;
  bool has_nxt = pr.seg(1, nxt, lr, lk);
  u32x4 r0a[4], r0b[4], r1a[4], r1b[4];
#pragma unroll
  for (int i = 0; i < 4; ++i) { r0a[i] = (u32x4){0u, 0u, 0u, 0u}; r0b[i] = r0a[i]; r1a[i] = r0a[i]; r1b[i] = r0a[i]; }
  f32x4 acc[4][4];
#define GS_LOAD(RA, RB, KT) { const int kt_ = (KT); const bf16_t* ap_ = nullptr; const bf16_t* bp_ = nullptr; int lda_ = 0, ldb_ = 0; bool ok_ = true; \
    if (kt_ < cur.nk) { ap_ = cur.ap + kt_ * 64; bp_ = cur.bp + kt_ * 64; lda_ = cur.lda; ldb_ = cur.ldb; } \
    else if (has_nxt) { ap_ = nxt.ap + (kt_ - cur.nk) * 64; bp_ = nxt.bp + (kt_ - cur.nk) * 64; lda_ = nxt.lda; ldb_ = nxt.ldb; } else ok_ = false; \
    if (ok_) { _Pragma("unroll") for (int i = 0; i < 4; ++i) { RA[i] = *(const u32x4*)(ap_ + (size_t)i * 32 * lda_); RB[i] = *(const u32x4*)(bp_ + (size_t)i * 32 * ldb_); } } }
#define GS_STORE(RA, RB, KT, STAGE) { if ((KT) < cur.nk || has_nxt) { bf16_t* st_ = (STAGE) + soff; \
    _Pragma("unroll") for (int i = 0; i < 4; ++i) { *(u32x4*)(st_ + i * 32 * 72) = RA[i]; *(u32x4*)(st_ + 9216 + i * 32 * 72) = RB[i]; } } }
#define GS_COMPUTE(STAGE) { const bf16_t* cs_ = (STAGE); _Pragma("unroll") for (int kk = 0; kk < 2; ++kk) { bf16x8 af[4], bfr[4]; \
    _Pragma("unroll") for (int i = 0; i < 4; ++i) { af[i] = *(const bf16x8*)(cs_ + aoff + i * 16 * 72 + kk * 32); bfr[i] = *(const bf16x8*)(cs_ + boff + i * 16 * 72 + kk * 32); } \
    _Pragma("unroll") for (int i = 0; i < 4; ++i) { _Pragma("unroll") for (int j = 0; j < 4; ++j) acc[i][j] = __builtin_amdgcn_mfma_f32_16x16x32_bf16(bfr[j], af[i], acc[i][j], 0, 0, 0); } } }
  GS_LOAD(r0a, r0b, 0)
  __syncthreads();
  GS_STORE(r0a, r0b, 0, sm)
  __syncthreads();
  GS_LOAD(r0a, r0b, 1)
  GS_LOAD(r1a, r1b, 2)
  for (int idx = 0;; ++idx) {
    pr.begin(idx, acc);
    for (int kt = 0; kt < cur.nk; kt += 2) {
      GS_COMPUTE(sm)
      GS_STORE(r0a, r0b, kt + 1, sm + 18432)
      GS_LOAD(r0a, r0b, kt + 3)
      __syncthreads();
      GS_COMPUTE(sm + 18432)
      GS_STORE(r1a, r1b, kt + 2, sm)
      GS_LOAD(r1a, r1b, kt + 4)
      __syncthreads();
    }
    pr.end(idx, acc);
    if (!has_nxt) break;
    cur = nxt; has_nxt = pr.seg(idx + 2, nxt, lr, lk);
  }
#undef GS_LOAD
#undef GS_STORE
#undef GS_COMPUTE
}

__device__ __forceinline__ void gemm_inproj_phase(const Params& p, bf16_t* sm) {
  struct Pr {
    const bf16_t* A; const bf16_t* W; bf16_t* P; int nM, nN;
    __device__ bool seg(int idx, Seg& s, int lr, int lk) const { int mt, nt; if (!tile_coord(idx, nM, nN, mt, nt)) return false;
      s.ap = A + (size_t)(mt * 128 + lr) * D + lk; s.bp = W + (size_t)(nt * 128 + lr) * D + lk; s.lda = D; s.ldb = D; s.nk = 16; return true; }
    __device__ void begin(int, f32x4 (&acc)[4][4]) const { ZERO_ACC(acc) }
    __device__ void end(int idx, f32x4 (&acc)[4][4]) const { int mt, nt; tile_coord(idx, nM, nN, mt, nt); const int m0 = mt * 128, n0 = nt * 128;
      EPI_LOOP({ uint2 o; o.x = pack2(v[0], v[1]); o.y = pack2(v[2], v[3]); *(uint2*)(P + (size_t)row * LDP + col) = o; }) }
  } pr{(const bf16_t*)(p.ws + OFF_H), (const bf16_t*)(p.ws + OFF_WIN), (bf16_t*)(p.ws + OFF_P), MG / 128, LDP / 128};
  gemm_stream(pr, sm);
}
__device__ __forceinline__ void gemm_proj_phase(const Params& p, int M, bf16_t* sm) {
  struct Pr {
    const bf16_t* YA; const bf16_t* YBn; const bf16_t* Wg; const bf16_t* Ws; const bf16_t* P; bf16_t* U; int nM, nN;
    __device__ bool seg(int idx, Seg& s, int lr, int lk) const { int mt, nt; if (!tile_coord(idx >> 1, nM, nN, mt, nt)) return false;
      if ((idx & 1) == 0) { s.ap = YA + (size_t)(mt * 128 + lr) * 1024 + lk; s.bp = Wg + (size_t)(nt * 128 + lr) * 1024 + lk; s.lda = 1024; s.ldb = 1024; s.nk = 16; }
      else { s.ap = YBn + (size_t)(mt * 128 + lr) * 2048 + lk; s.bp = Ws + (size_t)(nt * 128 + lr) * 2048 + lk; s.lda = 2048; s.ldb = 2048; s.nk = 32; }
      return true; }
    __device__ void begin(int idx, f32x4 (&acc)[4][4]) const { if ((idx & 1) == 0) ZERO_ACC(acc) }
    __device__ void end(int idx, f32x4 (&acc)[4][4]) const { int mt, nt; tile_coord(idx >> 1, nM, nN, mt, nt); const int m0 = mt * 128, n0 = nt * 128;
      if ((idx & 1) == 0) {
        EPI_LOOP({ const uint2 ga = *(const uint2*)(P + (size_t)row * LDP + C_GA + col); const uint2 gb = *(const uint2*)(P + (size_t)row * LDP + C_GB + col);
          v[0] *= (1.f + __expf(-lo16(gb.x))) / (1.f + __expf(-lo16(ga.x))); v[1] *= (1.f + __expf(-hi16(gb.x))) / (1.f + __expf(-hi16(ga.x)));
          v[2] *= (1.f + __expf(-lo16(gb.y))) / (1.f + __expf(-lo16(ga.y))); v[3] *= (1.f + __expf(-hi16(gb.y))) / (1.f + __expf(-hi16(ga.y))); })
      } else {
        EPI_LOOP({ const uint2 gb = *(const uint2*)(P + (size_t)row * LDP + C_GB + col);
          uint2 o; o.x = pack2(v[0] * sigmoidf_(lo16(gb.x)), v[1] * sigmoidf_(hi16(gb.x))); o.y = pack2(v[2] * sigmoidf_(lo16(gb.y)), v[3] * sigmoidf_(hi16(gb.y)));
          *(uint2*)(U + (size_t)row * D + col) = o; })
      } }
  } pr{(const bf16_t*)(p.ws + OFF_QKV), (const bf16_t*)(p.ws + OFF_QKV) + (size_t)MG * 1024, (const bf16_t*)(p.ws + OFF_WPG), (const bf16_t*)(p.ws + OFF_WPS),
       (const bf16_t*)(p.ws + OFF_P), (bf16_t*)(p.ws + OFF_H), M / 128, 8};
  gemm_stream(pr, sm);
}
__device__ __forceinline__ void gemm_wout_phase(const Params& p, int l, int g, int M, bf16_t* sm) {
  struct Pr {
    const Params& p; int l, g; const bf16_t* U; const bf16_t* W; const float* MOD; int nM, nN;
    __device__ bool seg(int idx, Seg& s, int lr, int lk) const { int mt, nt; if (!tile_coord(idx, nM, nN, mt, nt)) return false;
      s.ap = U + (size_t)(mt * 128 + lr) * D + lk; s.bp = W + (size_t)(nt * 128 + lr) * D + lk; s.lda = D; s.ldb = D; s.nk = 16; return true; }
    __device__ void begin(int, f32x4 (&acc)[4][4]) const { ZERO_ACC(acc) }
    __device__ void end(int idx, f32x4 (&acc)[4][4]) const { int mt, nt; tile_coord(idx, nM, nN, mt, nt); const int m0 = mt * 128, n0 = nt * 128;
      EPI_LOOP({ const float4 xr = *(const float4*)(xin_row(p, l, g, row) + col); const float4 g1 = *(const float4*)(MOD + (size_t)mod_row(g, row) * 6144 + 2048 + col);
        float4 o; o.x = DN_ALPHA * xr.x + g1.x * v[0]; o.y = DN_ALPHA * xr.y + g1.y * v[1]; o.z = DN_ALPHA * xr.z + g1.z * v[2]; o.w = DN_ALPHA * xr.w + g1.w * v[3];
        *(float4*)(xs_row(p, g, row) + col) = o; }) }
  } pr{p, l, g, (const bf16_t*)(p.ws + OFF_H), (const bf16_t*)(p.ws + OFF_WOUT), (const float*)(p.ws + OFF_MOD) + (size_t)l * 9 * 6144, M / 128, 8};
  gemm_stream(pr, sm);
}
__device__ __forceinline__ void gemm_ff1_phase(const Params& p, int l, int M, bf16_t* sm) {
  struct Pr {
    const bf16_t* H; const bf16_t* W; bf16_t* HID; const float* b1; int nM, nN;
    __device__ bool seg(int idx, Seg& s, int lr, int lk) const { int mt, nt; if (!tile_coord(idx, nM, nN, mt, nt)) return false;
      s.ap = H + (size_t)(mt * 128 + lr) * D + lk; s.bp = W + (size_t)(nt * 128 + lr) * D + lk; s.lda = D; s.ldb = D; s.nk = 16; return true; }
    __device__ void begin(int, f32x4 (&acc)[4][4]) const { ZERO_ACC(acc) }
    __device__ void end(int idx, f32x4 (&acc)[4][4]) const { int mt, nt; tile_coord(idx, nM, nN, mt, nt); const int m0 = mt * 128, n0 = nt * 128;
      EPI_LOOP({ const float4 b = *(const float4*)(b1 + col);
        float t0 = fmaxf(v[0] + b.x, 0.f), t1 = fmaxf(v[1] + b.y, 0.f), t2 = fmaxf(v[2] + b.z, 0.f), t3 = fmaxf(v[3] + b.w, 0.f);
        uint2 o; o.x = pack2(t0 * t0, t1 * t1); o.y = pack2(t2 * t2, t3 * t3); *(uint2*)(HID + (size_t)row * 4096 + col) = o; }) }
  } pr{(const bf16_t*)(p.ws + OFF_H), (const bf16_t*)(p.ws + OFF_WFF1), (bf16_t*)(p.ws + OFF_P), p.b_ff1 + (size_t)l * 4096, M / 128, 32};
  gemm_stream(pr, sm);
}
__device__ __forceinline__ void gemm_ff2_phase(const Params& p, int l, int g, int M, bf16_t* sm) {
  struct Pr {
    const Params& p; int g; const bf16_t* HID; const bf16_t* W; const float* MOD; const float* b2; int nM, nN;
    __device__ bool seg(int idx, Seg& s, int lr, int lk) const { int mt, nt; if (!tile_coord(idx, nM, nN, mt, nt)) return false;
      s.ap = HID + (size_t)(mt * 128 + lr) * 4096 + lk; s.bp = W + (size_t)(nt * 128 + lr) * 4096 + lk; s.lda = 4096; s.ldb = 4096; s.nk = 64; return true; }
    __device__ void begin(int, f32x4 (&acc)[4][4]) const { ZERO_ACC(acc) }
    __device__ void end(int idx, f32x4 (&acc)[4][4]) const { int mt, nt; tile_coord(idx, nM, nN, mt, nt); const int m0 = mt * 128, n0 = nt * 128;
      EPI_LOOP({ float* xp = xs_row(p, g, row) + col; const float4 xr = *(const float4*)xp; const float4 b = *(const float4*)(b2 + col);
        const float4 g2 = *(const float4*)(MOD + (size_t)mod_row(g, row) * 6144 + 5120 + col);
        float4 o; o.x = DN_ALPHA * xr.x + g2.x * (v[0] + b.x); o.y = DN_ALPHA * xr.y + g2.y * (v[1] + b.y); o.z = DN_ALPHA * xr.z + g2.z * (v[2] + b.z); o.w = DN_ALPHA * xr.w + g2.w * (v[3] + b.w);
        *(float4*)xp = o; }) }
  } pr{p, g, (const bf16_t*)(p.ws + OFF_P), (const bf16_t*)(p.ws + OFF_WFF2), (const float*)(p.ws + OFF_MOD) + (size_t)l * 9 * 6144, p.b_ff2 + (size_t)l * 1024, M / 128, 8};
  gemm_stream(pr, sm);
}

__device__ __forceinline__ void ln_phase(const Params& p, int l, int g, int M, const float* gam, const float* bet, bool write_h2) {
  const int lane = TIDX() & 63;
  const float* MOD = (const float*)(p.ws + OFF_MOD) + (size_t)l * 9 * 6144;
  bf16_t* H = (bf16_t*)(p.ws + OFF_H);
  for (int r = BIDX() * 4 + (TIDX() >> 6); r < M; r += GDIM() * 4) {
    float* xr = xs_row(p, g, r);
    float4 v[4];
    float s = 0.f;
#pragma unroll
    for (int i = 0; i < 4; ++i) { v[i] = *(const float4*)(xr + (i * 64 + lane) * 4); s += v[i].x + v[i].y + v[i].z + v[i].w; }
#pragma unroll
    for (int o = 32; o >= 1; o >>= 1) s += __shfl_xor(s, o);
    const float mu = s * (1.f / 1024.f);
    float q = 0.f;
#pragma unroll
    for (int i = 0; i < 4; ++i) { v[i].x -= mu; v[i].y -= mu; v[i].z -= mu; v[i].w -= mu; q += v[i].x * v[i].x + v[i].y * v[i].y + v[i].z * v[i].z + v[i].w * v[i].w; }
#pragma unroll
    for (int o = 32; o >= 1; o >>= 1) q += __shfl_xor(q, o);
    const float rs = rsqrtf(q * (1.f / 1024.f) + 1e-5f);
    const float* m = MOD + (size_t)mod_row(g, r) * 6144;
#pragma unroll
    for (int i = 0; i < 4; ++i) {
      const int ch = (i * 64 + lane) * 4;
      const float4 gg = *(const float4*)(gam + ch), bb = *(const float4*)(bet + ch);
      float4 o; o.x = v[i].x * rs * gg.x + bb.x; o.y = v[i].y * rs * gg.y + bb.y; o.z = v[i].z * rs * gg.z + bb.z; o.w = v[i].w * rs * gg.w + bb.w;
      *(float4*)(xr + ch) = o;
      if (write_h2) {
        const float4 sh = *(const float4*)(m + 3072 + ch), sc = *(const float4*)(m + 4096 + ch);
        uint2 h; h.x = pack2(o.x * (1.f + sc.x) + sh.x, o.y * (1.f + sc.y) + sh.y); h.y = pack2(o.z * (1.f + sc.z) + sh.z, o.w * (1.f + sc.w) + sh.w);
        *(uint2*)(H + (size_t)r * D + ch) = h;
      }
    }
  }
}

__device__ __forceinline__ void conv_phase(const Params& p, int l) {
  const bf16_t* P = (const bf16_t*)(p.ws + OFF_P);
  bf16_t* QKV = (bf16_t*)(p.ws + OFF_QKV); bf16_t* XBC = (bf16_t*)(p.ws + OFF_XBC);
  float* GBF = (float*)(p.ws + OFF_GBF); float* DTF = (float*)(p.ws + OFF_DTF);
  const int nb = GDIM(), bid = BIDX(), tid = TIDX();
  const int vb = ((nb & 7) == 0) ? (bid & 7) * (nb >> 3) + (bid >> 3) : bid;
  const int gtid = vb * 256 + tid, gsz = nb * 256;
  {
    const float* cw = p.gdn_conv_w + (size_t)l * 5 * 3072;
    const int c = tid & 127, hh = tid >> 7;
    for (int item = vb; item < (MG / 32) * 3; item += nb) {
      const int third = item % 3, pp = item / 3;
      const int ch0 = third * 1024 + c * 8;
      const int t0 = (pp * 2 + hh) * 16;
      int lo, hi;
      if (t0 < MLAT) { lo = t0 & ~63; hi = lo + 64; } else { lo = MLAT + ((t0 - MLAT) & ~255); hi = lo + 256; }
      u32x4 raw[20];
#pragma unroll
      for (int i = 0; i < 20; ++i) { const int row = t0 - 2 + i; raw[i] = (row >= lo && row < hi) ? *(const u32x4*)(P + (size_t)row * LDP + ch0) : (u32x4){0u, 0u, 0u, 0u}; }
      float wt[5][8];
#pragma unroll
      for (int j = 0; j < 5; ++j) { const float4 w0 = *(const float4*)(cw + j * 3072 + ch0), w1 = *(const float4*)(cw + j * 3072 + ch0 + 4);
        wt[j][0] = w0.x; wt[j][1] = w0.y; wt[j][2] = w0.z; wt[j][3] = w0.w; wt[j][4] = w1.x; wt[j][5] = w1.y; wt[j][6] = w1.z; wt[j][7] = w1.w; }
      const float qsc = (third == 0) ? 0.08838834764831845f : 1.f;
#pragma unroll
      for (int t = 0; t < 16; ++t) {
        float acc[8];
#pragma unroll
        for (int e = 0; e < 8; ++e) acc[e] = 0.f;
#pragma unroll
        for (int j = 0; j < 5; ++j) {
          const u32x4 rw = raw[t + j];
#pragma unroll
          for (int e = 0; e < 4; ++e) { acc[2 * e] += lo16(rw[e]) * wt[j][2 * e]; acc[2 * e + 1] += hi16(rw[e]) * wt[j][2 * e + 1]; }
        }
        float ss = 0.f;
#pragma unroll
        for (int e = 0; e < 8; ++e) { acc[e] = siluf_(acc[e]); ss += acc[e] * acc[e]; }
        ss += __shfl_xor(ss, 1); ss += __shfl_xor(ss, 2); ss += __shfl_xor(ss, 4); ss += __shfl_xor(ss, 8);
        const float sc = (third < 2) ? rsqrtf(ss + 1e-6f) * qsc : 1.f;
#pragma unroll
        for (int e = 0; e < 8; ++e) acc[e] *= sc;
        *(uint4*)(QKV + (size_t)(t0 + t) * 3072 + ch0) = pack8(acc);
      }
    }
  }
  {
    const float* sw = p.ssm_conv_w + (size_t)l * 5 * 4096; const float* sb = p.ssm_conv_b + (size_t)l * 4096;
    constexpr int nLat = G * 64 * 8 * 2, nCtx = (MCTX / 16) * 2;
    float wt[5][8], bs[8];
    int cur_half = -1;
    for (int item = vb; item < nLat + nCtx; item += nb) {
      int half, base, stride, p0, seglen;
      if (item < nLat) { half = item & 1; const int piece = (item >> 1) & 7, cl = (item >> 4) & 63, b_l = item >> 10; base = b_l * 8192 + cl; stride = 64; p0 = piece * 16; seglen = 128; }
      else { const int i2 = item - nLat; half = i2 & 1; const int piece = i2 >> 1; base = MLAT + (piece >> 4) * 256; stride = 1; p0 = (piece & 15) * 16; seglen = 256; }
      const int ch0 = (half * 256 + tid) * 8;
      u32x4 raw[20];
#pragma unroll
      for (int i = 0; i < 20; ++i) { const int pq = p0 - 2 + i; raw[i] = (pq >= 0 && pq < seglen) ? *(const u32x4*)(P + (size_t)(base + pq * stride) * LDP + C_XBC + ch0) : (u32x4){0u, 0u, 0u, 0u}; }
      if (half != cur_half) {
        cur_half = half;
        const float4 b0 = *(const float4*)(sb + ch0), b1 = *(const float4*)(sb + ch0 + 4);
        bs[0] = b0.x; bs[1] = b0.y; bs[2] = b0.z; bs[3] = b0.w; bs[4] = b1.x; bs[5] = b1.y; bs[6] = b1.z; bs[7] = b1.w;
#pragma unroll
        for (int j = 0; j < 5; ++j) { const float4 w0 = *(const float4*)(sw + j * 4096 + ch0), w1 = *(const float4*)(sw + j * 4096 + ch0 + 4);
          wt[j][0] = w0.x; wt[j][1] = w0.y; wt[j][2] = w0.z; wt[j][3] = w0.w; wt[j][4] = w1.x; wt[j][5] = w1.y; wt[j][6] = w1.z; wt[j][7] = w1.w; }
      }
#pragma unroll
      for (int t = 0; t < 16; ++t) {
        float acc[8];
#pragma unroll
        for (int e = 0; e < 8; ++e) acc[e] = bs[e];
#pragma unroll
        for (int j = 0; j < 5; ++j) {
          const u32x4 rw = raw[t + j];
#pragma unroll
          for (int e = 0; e < 4; ++e) { acc[2 * e] += lo16(rw[e]) * wt[j][2 * e]; acc[2 * e + 1] += hi16(rw[e]) * wt[j][2 * e + 1]; }
        }
#pragma unroll
        for (int e = 0; e < 8; ++e) acc[e] = siluf_(acc[e]);
        *(uint4*)(XBC + (size_t)(base + (p0 + t) * stride) * 4096 + ch0) = pack8(acc);
      }
    }
  }
  for (int idx = gtid; idx < MG * 16; idx += gsz) {
    const int r = idx >> 4, dh = idx & 15;
    GBF[(size_t)r * 32 + 16 + dh] = sigmoidf_(bf2f(P[(size_t)r * LDP + C_B + dh]));
  }
  for (int idx = gtid; idx < G * 2 * 264 * 8; idx += gsz) {
    const int h = idx & 7; int t = idx >> 3; const int chunk = t % 264; t /= 264; const int dir = t & 1, b_l = t >> 1;
    const int dh = dir * 8 + h;
    const float bias = p.gdn_dt_bias[l * 16 + dh], aneg = -__expf(p.gdn_A_log[l * 16 + dh]);
    float cum = 0.f;
    for (int ub = 0; ub < 32; ub += 8) {
      float av[8];
#pragma unroll
      for (int u = 0; u < 8; ++u) av[u] = bf2f(P[(size_t)gdn_rowof(b_l, dir, chunk * 32 + ub + u) * LDP + C_A + dh]);
#pragma unroll
      for (int u = 0; u < 8; ++u) {
        cum += aneg * softplusf_(av[u] + bias);
        GBF[(size_t)gdn_rowof(b_l, dir, chunk * 32 + ub + u) * 32 + dh] = cum;
      }
    }
  }
  for (int idx = gtid; idx < G * 2 * 264 * 32; idx += gsz) {
    const int head = idx & 31; int t = idx >> 5; const int chunk = t % 264; t /= 264; const int dir = t & 1, b_l = t >> 1;
    const int dh = dir * 32 + head;
    const float bias = p.ssm_dt_bias[l * 64 + dh], aneg = -__expf(p.ssm_A_log[l * 64 + dh]);
    float cum = 0.f;
    for (int ub = 0; ub < 32; ub += 8) {
      float dtv[8];
#pragma unroll
      for (int u = 0; u < 8; ++u) dtv[u] = bf2f(P[(size_t)ssd_rowof(b_l, dir, chunk * 32 + ub + u) * LDP + C_DT + dh]);
#pragma unroll
      for (int u = 0; u < 8; ++u) {
        const size_t row = (size_t)ssd_rowof(b_l, dir, chunk * 32 + ub + u);
        const float dt = softplusf_(dtv[u] + bias);
        cum += dt * aneg;
        DTF[row * 128 + dh] = dt;
        DTF[row * 128 + 64 + dh] = cum;
      }
    }
  }
}

__device__ __forceinline__ void gdn_prep_phase(const Params& p, unsigned char* smraw) {
  const int tid = TIDX(), lane = tid & 63, w = tid >> 6, fr = lane & 15, fq = lane >> 4, ti = w >> 1, tj = w & 1;
  bf16_t* sK = (bf16_t*)smraw;
  bf16_t* sQ = sK + 32 * 136;
  bf16_t* sP = sQ + 32 * 136;
  bf16_t* sPT = sP + 2 * 1280;
  bf16_t* sR = sPT + 2 * 1280;
  float* sG = (float*)(sR + 2 * 1280);
  const bf16_t* QKV = (const bf16_t*)(p.ws + OFF_QKV);
  const float* GBF = (const float*)(p.ws + OFF_GBF);
  bf16_t* TMB = (bf16_t*)(p.ws + OFF_TMB);
  const int ltok = tid & 31, lp = tid >> 5;
  const int i = ti * 16 + fr, j0 = tj * 16 + fq * 4;
  for (int item = BIDX(); item < GDN_NITEM; item += GDIM()) {
    const int chunk = item % 264; const int t = item / 264; const int dir = t & 1, h = (t >> 1) & 7, b_l = t >> 4;
    const size_t row = (size_t)gdn_rowof(b_l, dir, chunk * 32 + ltok);
    const bf16_t* src = QKV + row * 3072 + h * 128;
    const u32x4 k0 = *(const u32x4*)(src + 1024 + lp * 8), k1 = *(const u32x4*)(src + 1024 + (lp + 8) * 8);
    const u32x4 q0 = *(const u32x4*)(src + lp * 8), q1 = *(const u32x4*)(src + (lp + 8) * 8);
    float g_ = 0.f, b_ = 0.f;
    if (tid < 32) { g_ = GBF[row * 32 + dir * 8 + h]; b_ = GBF[row * 32 + 16 + dir * 8 + h]; }
    __syncthreads();
    *(u32x4*)(sK + ltok * 136 + lp * 8) = k0; *(u32x4*)(sK + ltok * 136 + (lp + 8) * 8) = k1;
    *(u32x4*)(sQ + ltok * 136 + lp * 8) = q0; *(u32x4*)(sQ + ltok * 136 + (lp + 8) * 8) = q1;
    if (tid < 32) { sG[tid] = g_; sG[32 + tid] = b_; }
    __syncthreads();
    {
      f32x4 kk = (f32x4){0.f, 0.f, 0.f, 0.f}, qk = kk;
#pragma unroll
      for (int ks = 0; ks < 4; ++ks) {
        const bf16x8 kj = *(const bf16x8*)(sK + (tj * 16 + fr) * 136 + ks * 32 + fq * 8);
        const bf16x8 ki = *(const bf16x8*)(sK + (ti * 16 + fr) * 136 + ks * 32 + fq * 8);
        const bf16x8 qi = *(const bf16x8*)(sQ + (ti * 16 + fr) * 136 + ks * 32 + fq * 8);
        kk = __builtin_amdgcn_mfma_f32_16x16x32_bf16(kj, ki, kk, 0, 0, 0);
        qk = __builtin_amdgcn_mfma_f32_16x16x32_bf16(kj, qi, qk, 0, 0, 0);
      }
      const float gi = sG[i], bi = sG[32 + i];
      float n[4], nt[4], rr[4], m[4];
#pragma unroll
      for (int r = 0; r < 4; ++r) {
        const int j = j0 + r; const float gj = sG[j], bj = sG[32 + j];
        n[r] = (j < i) ? -bi * kk[r] * __expf(gi - gj) : 0.f;
        nt[r] = (i < j) ? -bj * kk[r] * __expf(gj - gi) : 0.f;
        m[r] = (j <= i) ? qk[r] * __expf(gi - gj) : 0.f;
        rr[r] = n[r] + ((i == j) ? 1.f : 0.f);
      }
      uint2 o;
      o.x = pack2(n[0], n[1]); o.y = pack2(n[2], n[3]); *(uint2*)(sP + i * 40 + j0) = o;
      o.x = pack2(nt[0], nt[1]); o.y = pack2(nt[2], nt[3]); *(uint2*)(sPT + i * 40 + j0) = o;
      o.x = pack2(rr[0], rr[1]); o.y = pack2(rr[2], rr[3]); *(uint2*)(sR + i * 40 + j0) = o;
      o.x = pack2(m[0], m[1]); o.y = pack2(m[2], m[3]); *(uint2*)(TMB + (size_t)item * 2048 + 1024 + i * 32 + j0) = o;
    }
    __syncthreads();
    int pc = 0, rc = 0;
#pragma unroll
    for (int st = 1; st <= 5; ++st) {
      const bf16_t* Pc = sP + pc * 1280; const bf16_t* PTc = sPT + pc * 1280; const bf16_t* Rc = sR + rc * 1280;
      const bf16x8 p_i = *(const bf16x8*)(Pc + (ti * 16 + fr) * 40 + fq * 8);
      const bf16x8 p_j = *(const bf16x8*)(Pc + (tj * 16 + fr) * 40 + fq * 8);
      const bf16x8 pt_i = *(const bf16x8*)(PTc + (ti * 16 + fr) * 40 + fq * 8);
      const bf16x8 pt_j = *(const bf16x8*)(PTc + (tj * 16 + fr) * 40 + fq * 8);
      const f32x4 z = (f32x4){0.f, 0.f, 0.f, 0.f};
      if (st >= 2) {
        const bf16x8 r_i = *(const bf16x8*)(Rc + (ti * 16 + fr) * 40 + fq * 8);
        const uint2 rin = *(const uint2*)(Rc + i * 40 + j0);
        f32x4 racc = (f32x4){lo16(rin.x), hi16(rin.x), lo16(rin.y), hi16(rin.y)};
        racc = __builtin_amdgcn_mfma_f32_16x16x32_bf16(pt_j, r_i, racc, 0, 0, 0);
        uint2 o; o.x = pack2(racc[0], racc[1]); o.y = pack2(racc[2], racc[3]);
        if (st < 5) *(uint2*)(sR + (rc ^ 1) * 1280 + i * 40 + j0) = o;
        else *(uint2*)(TMB + (size_t)item * 2048 + i * 32 + j0) = o;
      }
      if (st <= 4) {
        const f32x4 pn = __builtin_amdgcn_mfma_f32_16x16x32_bf16(pt_j, p_i, z, 0, 0, 0);
        const f32x4 ptn = __builtin_amdgcn_mfma_f32_16x16x32_bf16(p_j, pt_i, z, 0, 0, 0);
        uint2 o; o.x = pack2(pn[0], pn[1]); o.y = pack2(pn[2], pn[3]); *(uint2*)(sP + (pc ^ 1) * 1280 + i * 40 + j0) = o;
        o.x = pack2(ptn[0], ptn[1]); o.y = pack2(ptn[2], ptn[3]); *(uint2*)(sPT + (pc ^ 1) * 1280 + i * 40 + j0) = o;
      }
      if (st < 5) __syncthreads();
      pc ^= 1; if (st >= 2) rc ^= 1;
    }
  }
}

__device__ __forceinline__ void gdn_chunk_item(const Params& p, int id, unsigned char* smraw) {
  const int tid = TIDX(), lane = tid & 63, w = tid >> 6, fr = lane & 15, fq = lane >> 4, ta = w >> 1, tb = w & 1;
  const int b_l = id >> 6, h = (id >> 3) & 7, dir = (id >> 2) & 1, dvq = id & 3;
  bf16_t* sKb = (bf16_t*)smraw;
  bf16_t* sQ = sKb + 32 * 136;
  bf16_t* sKdT = sQ + 32 * 136;
  bf16_t* sVbT = sKdT + 128 * 40;
  bf16_t* sT = sVbT + 32 * 40;
  bf16_t* sM = sT + 32 * 40;
  bf16_t* sXT = sM + 32 * 40;
  bf16_t* sVnT = sXT + 32 * 40;
  bf16_t* sST = sVnT + 32 * 40;
  float* sG = (float*)(sST + 32 * 136);
  const bf16_t* QKV = (const bf16_t*)(p.ws + OFF_QKV);
  const float* GBF = (const float*)(p.ws + OFF_GBF);
  const bf16_t* TMB = (const bf16_t*)(p.ws + OFF_TMB);
  bf16_t* OUT = (bf16_t*)(p.ws + (dir ? OFF_OB : OFF_OF));
  const int ltok = tid & 31, lp = tid >> 5;
  const size_t item0 = (size_t)((b_l * 8 + h) * 2 + dir) * 264;
  struct Stage { u32x4 k0, k1, q0, q1, v, tm; float g, be, gl; };
  Stage st0, st1;
  constexpr int NCH = (256 + 8192) / 32;
  auto gload = [&](Stage& st, int c) __attribute__((always_inline)) {
    if (c >= NCH) return;
    const int s0 = c * 32;
    const size_t row = (size_t)gdn_rowof(b_l, dir, s0 + ltok);
    const bf16_t* src = QKV + row * 3072 + h * 128;
    st.k0 = *(const u32x4*)(src + 1024 + lp * 8); st.k1 = *(const u32x4*)(src + 1024 + (lp + 8) * 8);
    st.q0 = *(const u32x4*)(src + lp * 8); st.q1 = *(const u32x4*)(src + (lp + 8) * 8);
    st.v = *(const u32x4*)(src + 2048 + dvq * 32 + (lp & 3) * 8);
    st.tm = *(const u32x4*)(TMB + (item0 + c) * 2048 + (tid >> 7) * 1024 + ((tid & 127) >> 2) * 32 + (tid & 3) * 8);
    st.g = GBF[row * 32 + dir * 8 + h]; st.be = GBF[row * 32 + 16 + dir * 8 + h];
    st.gl = GBF[(size_t)gdn_rowof(b_l, dir, s0 + 31) * 32 + dir * 8 + h];
  };
  auto lstore = [&](const Stage& st) __attribute__((always_inline)) {
    const float skb = st.be * __expf(st.g), skd = __expf(st.gl - st.g);
    {
      float f[8]; uint4 o;
      f[0] = lo16(st.k0[0]); f[1] = hi16(st.k0[0]); f[2] = lo16(st.k0[1]); f[3] = hi16(st.k0[1]); f[4] = lo16(st.k0[2]); f[5] = hi16(st.k0[2]); f[6] = lo16(st.k0[3]); f[7] = hi16(st.k0[3]);
      bf16_t* t0 = sKdT + (lp * 8) * 40 + ltok;
#pragma unroll
      for (int e = 0; e < 8; ++e) t0[e * 40] = f2bf(f[e] * skd);
#pragma unroll
      for (int e = 0; e < 8; ++e) f[e] *= skb;
      o = pack8(f); *(uint4*)(sKb + ltok * 136 + lp * 8) = o;
      f[0] = lo16(st.k1[0]); f[1] = hi16(st.k1[0]); f[2] = lo16(st.k1[1]); f[3] = hi16(st.k1[1]); f[4] = lo16(st.k1[2]); f[5] = hi16(st.k1[2]); f[6] = lo16(st.k1[3]); f[7] = hi16(st.k1[3]);
      bf16_t* t1 = sKdT + ((lp + 8) * 8) * 40 + ltok;
#pragma unroll
      for (int e = 0; e < 8; ++e) t1[e * 40] = f2bf(f[e] * skd);
#pragma unroll
      for (int e = 0; e < 8; ++e) f[e] *= skb;
      o = pack8(f); *(uint4*)(sKb + ltok * 136 + (lp + 8) * 8) = o;
    }
    *(u32x4*)(sQ + ltok * 136 + lp * 8) = st.q0; *(u32x4*)(sQ + ltok * 136 + (lp + 8) * 8) = st.q1;
    if (tid < 128) {
      bf16_t* tv = sVbT + (lp * 8) * 40 + ltok;
#pragma unroll
      for (int e = 0; e < 4; ++e) { tv[(2 * e) * 40] = f2bf(lo16(st.v[e]) * st.be); tv[(2 * e + 1) * 40] = f2bf(hi16(st.v[e]) * st.be); }
      *(u32x4*)(sT + ((tid & 127) >> 2) * 40 + (tid & 3) * 8) = st.tm;
    } else {
      *(u32x4*)(sM + ((tid & 127) >> 2) * 40 + (tid & 3) * 8) = st.tm;
    }
    if (tid < 32) sG[tid] = st.g;
  };
  f32x4 S[4];
#pragma unroll
  for (int t = 0; t < 4; ++t) S[t] = (f32x4){0.f, 0.f, 0.f, 0.f};
  __syncthreads();
  for (int i = tid; i < 32 * 136 / 2; i += 256) ((unsigned*)sST)[i] = 0u;
  gload(st0, 0); lstore(st0);
  __syncthreads();
  gload(st0, 1); gload(st1, 2);
  for (int c = 0; c < NCH; ++c) {
    const int dv = ta * 16 + fr, i0 = tb * 16 + fq * 4;
    {
      f32x4 pr = (f32x4){0.f, 0.f, 0.f, 0.f};
#pragma unroll
      for (int ks = 0; ks < 4; ++ks) {
        const bf16x8 kb = *(const bf16x8*)(sKb + (tb * 16 + fr) * 136 + ks * 32 + fq * 8);
        const bf16x8 sf = *(const bf16x8*)(sST + (ta * 16 + fr) * 136 + ks * 32 + fq * 8);
        pr = __builtin_amdgcn_mfma_f32_16x16x32_bf16(kb, sf, pr, 0, 0, 0);
      }
      const uint2 vb = *(const uint2*)(sVbT + dv * 40 + i0);
      uint2 o; o.x = pack2(lo16(vb.x) - pr[0], hi16(vb.x) - pr[1]); o.y = pack2(lo16(vb.y) - pr[2], hi16(vb.y) - pr[3]);
      *(uint2*)(sXT + dv * 40 + i0) = o;
    }
    __syncthreads();
    {
      const bf16x8 tf = *(const bf16x8*)(sT + (tb * 16 + fr) * 40 + fq * 8);
      const bf16x8 xf = *(const bf16x8*)(sXT + (ta * 16 + fr) * 40 + fq * 8);
      const f32x4 vn = __builtin_amdgcn_mfma_f32_16x16x32_bf16(tf, xf, (f32x4){0.f, 0.f, 0.f, 0.f}, 0, 0, 0);
      uint2 o; o.x = pack2(vn[0], vn[1]); o.y = pack2(vn[2], vn[3]);
      *(uint2*)(sVnT + dv * 40 + i0) = o;
    }
    __syncthreads();
    const float eglast = __expf(sG[31]);
    {
      f32x4 oa = (f32x4){0.f, 0.f, 0.f, 0.f};
#pragma unroll
      for (int ks = 0; ks < 4; ++ks) {
        const bf16x8 qf = *(const bf16x8*)(sQ + (ta * 16 + fr) * 136 + ks * 32 + fq * 8);
        const bf16x8 sf = *(const bf16x8*)(sST + (tb * 16 + fr) * 136 + ks * 32 + fq * 8);
        oa = __builtin_amdgcn_mfma_f32_16x16x32_bf16(sf, qf, oa, 0, 0, 0);
      }
      const int i = ta * 16 + fr;
      oa *= __expf(sG[i]);
      const bf16x8 mf = *(const bf16x8*)(sM + i * 40 + fq * 8);
      const bf16x8 vf = *(const bf16x8*)(sVnT + (tb * 16 + fr) * 40 + fq * 8);
      oa = __builtin_amdgcn_mfma_f32_16x16x32_bf16(vf, mf, oa, 0, 0, 0);
      uint2 o; o.x = pack2(oa[0], oa[1]); o.y = pack2(oa[2], oa[3]);
      *(uint2*)(OUT + (size_t)gdn_rowof(b_l, dir, c * 32 + i) * 1024 + h * 128 + dvq * 32 + tb * 16 + fq * 4) = o;
    }
    {
      const bf16x8 vf = *(const bf16x8*)(sVnT + (ta * 16 + fr) * 40 + fq * 8);
#pragma unroll
      for (int t = 0; t < 4; ++t) {
        const bf16x8 kf = *(const bf16x8*)(sKdT + ((tb * 4 + t) * 16 + fr) * 40 + fq * 8);
        S[t] *= eglast;
        S[t] = __builtin_amdgcn_mfma_f32_16x16x32_bf16(kf, vf, S[t], 0, 0, 0);
      }
    }
    __syncthreads();
#pragma unroll
    for (int t = 0; t < 4; ++t) {
      uint2 o; o.x = pack2(S[t][0], S[t][1]); o.y = pack2(S[t][2], S[t][3]);
      *(uint2*)(sST + (ta * 16 + fr) * 136 + (tb * 4 + t) * 16 + fq * 4) = o;
    }
    if (c + 1 < NCH) { if (c & 1) lstore(st1); else lstore(st0); }
    if (c & 1) gload(st1, c + 3); else gload(st0, c + 3);
    __syncthreads();
  }
}

__device__ __forceinline__ void ssd_chunk_item(const Params& p, int id, unsigned char* smraw) {
  const int tid = TIDX(), lane = tid & 63, w = tid >> 6, fr = lane & 15, fq = lane >> 4;
  const int b_l = id >> 6, head = (id >> 1) & 31, dir = id & 1, grp = head >> 2;
  bf16_t* sC = (bf16_t*)smraw;
  bf16_t* sB = sC + 32 * 136;
  bf16_t* sBT = sB + 32 * 136;
  bf16_t* sXT = sBT + 128 * 40;
  bf16_t* sM = sXT + 64 * 40;
  bf16_t* sST = sM + 32 * 40;
  float* sG = (float*)(sST + 64 * 136);
  const bf16_t* XBC = (const bf16_t*)(p.ws + OFF_XBC);
  const float* DTF = (const float*)(p.ws + OFF_DTF);
  bf16_t* OUT = (bf16_t*)(p.ws + (dir ? OFF_YB : OFF_YF));
  const int ltok = tid & 31, lpart = tid >> 5;
  struct Stage { u32x4 b0, b1, c0, c1, x; float dt, g, gl; };
  Stage st0, st1;
  constexpr int NCH = (256 + 8192) / 32;
  auto gload = [&](Stage& st, int c) __attribute__((always_inline)) {
    if (c >= NCH) return;
    const int s0 = c * 32;
    const size_t row = (size_t)ssd_rowof(b_l, dir, s0 + ltok);
    const bf16_t* xr = XBC + row * 4096;
    st.b0 = *(const u32x4*)(xr + 2048 + grp * 128 + lpart * 8);
    st.b1 = *(const u32x4*)(xr + 2048 + grp * 128 + (lpart + 8) * 8);
    st.c0 = *(const u32x4*)(xr + 3072 + grp * 128 + lpart * 8);
    st.c1 = *(const u32x4*)(xr + 3072 + grp * 128 + (lpart + 8) * 8);
    st.x = *(const u32x4*)(xr + head * 64 + lpart * 8);
    st.dt = DTF[row * 128 + dir * 32 + head];
    st.g = DTF[row * 128 + 64 + dir * 32 + head];
    st.gl = DTF[(size_t)ssd_rowof(b_l, dir, s0 + 31) * 128 + 64 + dir * 32 + head];
  };
  auto lstore = [&](const Stage& st) __attribute__((always_inline)) {
    *(u32x4*)(sB + ltok * 136 + lpart * 8) = st.b0;
    *(u32x4*)(sB + ltok * 136 + (lpart + 8) * 8) = st.b1;
    *(u32x4*)(sC + ltok * 136 + lpart * 8) = st.c0;
    *(u32x4*)(sC + ltok * 136 + (lpart + 8) * 8) = st.c1;
    const float wj = __expf(st.gl - st.g);
    bf16_t* t0 = sBT + (lpart * 8) * 40 + ltok;
    bf16_t* t1 = sBT + ((lpart + 8) * 8) * 40 + ltok;
    bf16_t* tx = sXT + (lpart * 8) * 40 + ltok;
#pragma unroll
    for (int e = 0; e < 4; ++e) {
      t0[(2 * e) * 40] = f2bf(lo16(st.b0[e]) * wj); t0[(2 * e + 1) * 40] = f2bf(hi16(st.b0[e]) * wj);
      t1[(2 * e) * 40] = f2bf(lo16(st.b1[e]) * wj); t1[(2 * e + 1) * 40] = f2bf(hi16(st.b1[e]) * wj);
      tx[(2 * e) * 40] = f2bf(lo16(st.x[e]) * st.dt); tx[(2 * e + 1) * 40] = f2bf(hi16(st.x[e]) * st.dt);
    }
    if (tid < 32) sG[tid] = st.g;
  };
  f32x4 S[8];
#pragma unroll
  for (int i = 0; i < 8; ++i) S[i] = (f32x4){0.f, 0.f, 0.f, 0.f};
  __syncthreads();
  for (int i = lane; i < 16 * 136 / 2; i += 64) ((unsigned*)(sST + w * 16 * 136))[i] = 0u;
  gload(st0, 0); lstore(st0);
  __syncthreads();
  gload(st0, 1); gload(st1, 2);
  for (int c = 0; c < NCH; ++c) {
    {
      const int ti = w >> 1, tj = w & 1;
      f32x4 cb = (f32x4){0.f, 0.f, 0.f, 0.f};
      if (tj <= ti) {
#pragma unroll
        for (int ks = 0; ks < 4; ++ks) {
          const bf16x8 af = *(const bf16x8*)(sC + (ti * 16 + fr) * 136 + ks * 32 + fq * 8);
          const bf16x8 bf = *(const bf16x8*)(sB + (tj * 16 + fr) * 136 + ks * 32 + fq * 8);
          cb = __builtin_amdgcn_mfma_f32_16x16x32_bf16(bf, af, cb, 0, 0, 0);
        }
      }
      const int i = ti * 16 + fr, j0 = tj * 16 + fq * 4;
      const float gi = sG[i];
      float m[4];
#pragma unroll
      for (int r = 0; r < 4; ++r) { const int j = j0 + r; const float gj = sG[j]; m[r] = (j <= i) ? cb[r] * __expf(gi - gj) : 0.f; }
      uint2 o; o.x = pack2(m[0], m[1]); o.y = pack2(m[2], m[3]);
      *(uint2*)(sM + i * 40 + j0) = o;
    }
    __syncthreads();
    const bf16x8 xfrag = *(const bf16x8*)(sXT + (w * 16 + fr) * 40 + fq * 8);
    const float eglast = __expf(sG[31]);
#pragma unroll
    for (int ti = 0; ti < 2; ++ti) {
      f32x4 y = (f32x4){0.f, 0.f, 0.f, 0.f};
#pragma unroll
      for (int ks = 0; ks < 4; ++ks) {
        const bf16x8 af = *(const bf16x8*)(sC + (ti * 16 + fr) * 136 + ks * 32 + fq * 8);
        const bf16x8 bf = *(const bf16x8*)(sST + (w * 16 + fr) * 136 + ks * 32 + fq * 8);
        y = __builtin_amdgcn_mfma_f32_16x16x32_bf16(bf, af, y, 0, 0, 0);
      }
      const int i = ti * 16 + fr;
      const float eg = __expf(sG[i]);
      y *= eg;
      const bf16x8 mf = *(const bf16x8*)(sM + i * 40 + fq * 8);
      y = __builtin_amdgcn_mfma_f32_16x16x32_bf16(xfrag, mf, y, 0, 0, 0);
      uint2 o; o.x = pack2(y[0], y[1]); o.y = pack2(y[2], y[3]);
      *(uint2*)(OUT + (size_t)ssd_rowof(b_l, dir, c * 32 + i) * 2048 + head * 64 + w * 16 + fq * 4) = o;
    }
#pragma unroll
    for (int tn = 0; tn < 8; ++tn) {
      const bf16x8 bf = *(const bf16x8*)(sBT + (tn * 16 + fr) * 40 + fq * 8);
      S[tn] *= eglast;
      S[tn] = __builtin_amdgcn_mfma_f32_16x16x32_bf16(bf, xfrag, S[tn], 0, 0, 0);
    }
#pragma unroll
    for (int tn = 0; tn < 8; ++tn) {
      uint2 o; o.x = pack2(S[tn][0], S[tn][1]); o.y = pack2(S[tn][2], S[tn][3]);
      *(uint2*)(sST + (w * 16 + fr) * 136 + tn * 16 + fq * 4) = o;
    }
    __syncthreads();
    if (c + 1 < NCH) { if (c & 1) lstore(st1); else lstore(st0); }
    if (c & 1) gload(st1, c + 3); else gload(st0, c + 3);
    __syncthreads();
  }
}

__device__ __forceinline__ void scan_phase(const Params& p, unsigned char* sm) {
  for (int item = BIDX(); item < 256; item += GDIM()) {
    if (item < 128) gdn_chunk_item(p, item, sm); else ssd_chunk_item(p, item - 128, sm);
    __syncthreads();
  }
}

__device__ __forceinline__ void gnorm_phase(const Params& p, int l, int M) {
  const bf16_t* P = (const bf16_t*)(p.ws + OFF_P);
  const bf16_t* OF = (const bf16_t*)(p.ws + OFF_OF); const bf16_t* OB = (const bf16_t*)(p.ws + OFF_OB);
  const bf16_t* YF = (const bf16_t*)(p.ws + OFF_YF); const bf16_t* YB = (const bf16_t*)(p.ws + OFF_YB);
  const bf16_t* XBC = (const bf16_t*)(p.ws + OFF_XBC);
  bf16_t* YA = (bf16_t*)(p.ws + OFF_QKV); bf16_t* YBn = YA + (size_t)MG * 1024;
  const int gtid = BIDX() * 256 + TIDX(), gsz = GDIM() * 256;
  const float* nw = p.gdn_norm_w + l * 128;
  for (int idx = gtid; idx < M * 128; idx += gsz) {
    const int r = idx >> 7, c8 = (idx & 127) * 8;
    const uint4 a = *(const uint4*)(OF + (size_t)r * 1024 + c8), b = *(const uint4*)(OB + (size_t)r * 1024 + c8);
    const uint4 gt = *(const uint4*)(P + (size_t)r * LDP + C_GOUT + c8);
    float fa[8], fb[8], fg[8]; UNPACK8(a, fa); UNPACK8(b, fb); UNPACK8(gt, fg);
    float ss = 0.f;
#pragma unroll
    for (int e = 0; e < 8; ++e) { fa[e] += fb[e]; ss += fa[e] * fa[e]; }
    ss += __shfl_xor(ss, 1); ss += __shfl_xor(ss, 2); ss += __shfl_xor(ss, 4); ss += __shfl_xor(ss, 8);
    const float rs = rsqrtf(ss * (1.f / 128.f) + 1e-6f);
    const float4 w0 = *(const float4*)(nw + (c8 & 127)), w1 = *(const float4*)(nw + (c8 & 127) + 4);
    const float wv[8] = {w0.x, w0.y, w0.z, w0.w, w1.x, w1.y, w1.z, w1.w};
#pragma unroll
    for (int e = 0; e < 8; ++e) fa[e] = fa[e] * rs * wv[e] * siluf_(fg[e]);
    *(uint4*)(YA + (size_t)r * 1024 + c8) = pack8(fa);
  }
  const float* sw = p.ssm_norm_w + l * 2048; const float* Dk = p.ssm_D + l * 32;
  for (int idx = gtid; idx < M * 256; idx += gsz) {
    const int r = idx >> 8, c8 = (idx & 255) * 8;
    const uint4 a = *(const uint4*)(YF + (size_t)r * 2048 + c8), b = *(const uint4*)(YB + (size_t)r * 2048 + c8);
    const uint4 xx = *(const uint4*)(XBC + (size_t)r * 4096 + c8);
    const uint4 zz = *(const uint4*)(P + (size_t)r * LDP + C_Z + c8);
    float fa[8], fb[8], fx[8], fz[8]; UNPACK8(a, fa); UNPACK8(b, fb); UNPACK8(xx, fx); UNPACK8(zz, fz);
    const float dsk = Dk[c8 >> 6];
    float ss = 0.f;
#pragma unroll
    for (int e = 0; e < 8; ++e) { fa[e] = (fa[e] + fb[e] + dsk * fx[e]) * siluf_(fz[e]); ss += fa[e] * fa[e]; }
    ss += __shfl_xor(ss, 1); ss += __shfl_xor(ss, 2); ss += __shfl_xor(ss, 4); ss += __shfl_xor(ss, 8); ss += __shfl_xor(ss, 16);
    const float rs = rsqrtf(ss * (1.f / 256.f) + 1e-6f);
    const float4 w0 = *(const float4*)(sw + c8), w1 = *(const float4*)(sw + c8 + 4);
    const float wv[8] = {w0.x, w0.y, w0.z, w0.w, w1.x, w1.y, w1.z, w1.w};
#pragma unroll
    for (int e = 0; e < 8; ++e) fa[e] = fa[e] * rs * wv[e];
    *(uint4*)(YBn + (size_t)r * 2048 + c8) = pack8(fa);
  }
}

#ifndef STOP_AFTER
#define STOP_AFTER 0
#endif
#define SYNC() { grid.sync(); if (++nsync == STOP_AFTER) return; }
#define PH(CALL) { CALL; }
__global__ void __launch_bounds__(256, 2) mega(Params p) {
  cg::grid_group grid = cg::this_grid();
  int nsync = 0;
  __shared__ __attribute__((aligned(16))) unsigned char smem[SMEM_BYTES];
  float* smf = (float*)smem; bf16_t* smh = (bf16_t*)smem;
  for (int l = 0; l < 2; ++l) {
    PH(transpose_phase(p.w_in + (size_t)l * 1024 * IN_DIM, (bf16_t*)(p.ws + OFF_WIN), 1024, IN_DIM, LDP, smf))
    PH(transpose_phase(p.w_proj_gdn + (size_t)l * 1024 * 1024, (bf16_t*)(p.ws + OFF_WPG), 1024, 1024, 1024, smf))
    PH(transpose_phase(p.w_proj_ssm + (size_t)l * 2048 * 1024, (bf16_t*)(p.ws + OFF_WPS), 2048, 1024, 1024, smf))
    PH(transpose_phase(p.w_out + (size_t)l * 1024 * 1024, (bf16_t*)(p.ws + OFF_WOUT), 1024, 1024, 1024, smf))
    PH(transpose_phase(p.w_ff1 + (size_t)l * 1024 * 4096, (bf16_t*)(p.ws + OFF_WFF1), 1024, 4096, 4096, smf))
    PH(transpose_phase(p.w_ff2 + (size_t)l * 4096 * 1024, (bf16_t*)(p.ws + OFF_WFF2), 4096, 1024, 1024, smf))
    if (l == 0) { PH(modpart_phase(p, smf)) SYNC(); PH(modfinal_phase(p)) }
    SYNC();
    const bool last = (l == 1);
    const int Mpost = last ? MLAT : MG;
    for (int g = 0; g < NGRP; ++g) {
      PH(modulate_phase(p, l, g)) SYNC();
      PH(gemm_inproj_phase(p, smh)) SYNC();
      PH(conv_phase(p, l)) SYNC();
      PH(gdn_prep_phase(p, smem)) SYNC();
      PH(scan_phase(p, smem)) SYNC();
      PH(gnorm_phase(p, l, Mpost)) SYNC();
      PH(gemm_proj_phase(p, Mpost, smh)) SYNC();
      PH(gemm_wout_phase(p, l, g, Mpost, smh)) SYNC();
      PH(ln_phase(p, l, g, Mpost, p.ln1_g + l * D, p.ln1_b + l * D, true)) SYNC();
      PH(gemm_ff1_phase(p, l, Mpost, smh)) SYNC();
      PH(gemm_ff2_phase(p, l, g, Mpost, smh)) SYNC();
      PH(ln_phase(p, l, g, Mpost, p.ln2_g + l * D, p.ln2_b + l * D, false)) SYNC();
    }
  }
}

extern "C" void kernel_launch(void* const* d_in, const int* in_sizes, int n_in, void* d_out, int out_size, void* d_ws, size_t ws_size,
                              hipStream_t stream) {
  static int grid_blocks = 0;
  if (!grid_blocks) {
    int dev = 0, cus = 0, per_cu = 0;
    (void)hipGetDevice(&dev);
    (void)hipDeviceGetAttribute(&cus, hipDeviceAttributeMultiprocessorCount, dev);
    (void)hipOccupancyMaxActiveBlocksPerMultiprocessor(&per_cu, mega, 256, 0);
    if (per_cu > 2) per_cu = 2;
    grid_blocks = cus * per_cu;
    if (ws_size < WS_TOTAL) fprintf(stderr, "workspace too small: %zu < %zu\n", ws_size, WS_TOTAL);
  }
  Params p{};
  const float** pp = (const float**)&p;
  for (int i = 0; i < 28; ++i) pp[i] = (const float*)d_in[i];
  p.out = (float*)d_out;
  p.ws = (unsigned char*)d_ws;
  void* args[] = {&p};
  hipError_t e = hipLaunchCooperativeKernel((void*)mega, dim3(grid_blocks), dim3(256), args, 0, stream);
  if (e != hipSuccess) fprintf(stderr, "cooperative launch failed: %s (grid %d)\n", hipGetErrorString(e), grid_blocks);
}
```

```cpp
#include <hip/hip_runtime.h>
#include <hip/hip_cooperative_groups.h>
#include <cstdio>
namespace cg = cooperative_groups;

typedef unsigned short bf16_t;
typedef short bf16x8 __attribute__((ext_vector_type(8)));
typedef float f32x4 __attribute__((ext_vector_type(4)));
typedef float f32x2 __attribute__((ext_vector_type(2)));
typedef unsigned u32x4 __attribute__((ext_vector_type(4)));

constexpr int D = 1024, SEQ = 8192, LC = 256;
constexpr int G = 2, NGRP = 4;
constexpr int MLAT = G * SEQ, MCTX = G * LC, MG = MLAT + MCTX;
constexpr int IN_DIM = 12384, LDP = 12416;
constexpr int C_GOUT = 3072, C_A = 4096, C_B = 4112, C_Z = 4128, C_XBC = 6176, C_DT = 10272, C_GA = 10336, C_GB = 11360;
constexpr float DN_ALPHA = 1.4142135623730951f;

constexpr size_t SZ_WIN = (size_t)LDP * 1024 * 2;
constexpr size_t OFF_WIN = 0;
constexpr size_t OFF_WPG = OFF_WIN + SZ_WIN;
constexpr size_t OFF_WPS = OFF_WPG + 2097152;
constexpr size_t OFF_WOUT = OFF_WPS + 4194304;
constexpr size_t OFF_WFF1 = OFF_WOUT + 2097152;
constexpr size_t OFF_WFF2 = OFF_WFF1 + 8388608;
constexpr size_t OFF_MODP = OFF_WFF2 + 8388608;
constexpr size_t OFF_MOD = OFF_MODP + (size_t)2 * 16 * 9 * 6144 * 4;
constexpr size_t OFF_XSC = OFF_MOD + (size_t)2 * 9 * 6144 * 4;
constexpr size_t OFF_H = OFF_XSC + (size_t)2048 * 1024 * 4;
constexpr size_t OFF_P = OFF_H + (size_t)MG * 1024 * 2;
constexpr size_t OFF_QKV = OFF_P + (size_t)MG * LDP * 2;
constexpr size_t OFF_XBC = OFF_QKV + (size_t)MG * 3072 * 2;
constexpr size_t OFF_GBF = OFF_XBC + (size_t)MG * 4096 * 2;
constexpr size_t OFF_DTF = OFF_GBF + (size_t)MG * 32 * 4;
constexpr size_t OFF_OF = OFF_DTF + (size_t)MG * 128 * 4;
constexpr size_t OFF_OB = OFF_OF + (size_t)MG * 1024 * 2;
constexpr size_t OFF_YF = OFF_OB + (size_t)MG * 1024 * 2;
constexpr size_t OFF_YB = OFF_YF + (size_t)MG * 2048 * 2;
constexpr size_t OFF_TMB = OFF_YB + (size_t)MG * 2048 * 2;
constexpr int GDN_NITEM = G * 8 * 2 * 264;
constexpr size_t OFF_BAR = OFF_TMB + (size_t)GDN_NITEM * 2048 * 2;
constexpr size_t WS_TOTAL = OFF_BAR + 16384;
static_assert(WS_TOTAL <= ((size_t)1024 << 20), "workspace plan exceeds 1 GiB");

struct Params {
  const float *x, *c, *ctx, *c_ctx, *w_mod, *b_mod, *w_in, *gdn_conv_w, *gdn_A_log, *gdn_dt_bias, *gdn_norm_w;
  const float *ssm_conv_w, *ssm_conv_b, *ssm_A_log, *ssm_dt_bias, *ssm_D, *ssm_norm_w, *w_proj_gdn, *w_proj_ssm, *w_out;
  const float *ln1_g, *ln1_b, *w_ff1, *b_ff1, *w_ff2, *b_ff2, *ln2_g, *ln2_b;
  float* out;
  unsigned char* ws;
};

constexpr int SMEM_BYTES = 73728;


__device__ __forceinline__ int TIDX() { int t = threadIdx.x; asm volatile("" : "+v"(t)); return t; }
__device__ __forceinline__ int BIDX() { int t = blockIdx.x; asm volatile("" : "+s"(t)); return t; }
__device__ __forceinline__ int GDIM() { int t = gridDim.x; asm volatile("" : "+s"(t)); return t; }
__device__ __forceinline__ float bf2f(bf16_t b) { return __uint_as_float(((unsigned)b) << 16); }
__device__ __forceinline__ bf16_t f2bf(float f) { unsigned u = __float_as_uint(f); u += 0x7fffu + ((u >> 16) & 1u); return (bf16_t)(u >> 16); }
typedef __bf16 bf16v2 __attribute__((ext_vector_type(2)));
__device__ __forceinline__ unsigned pack2(float a, float b) { const f32x2 v = (f32x2){a, b}; const bf16v2 h = __builtin_convertvector(v, bf16v2); return __builtin_bit_cast(unsigned, h); }
__device__ __forceinline__ float lo16(unsigned v) { return __uint_as_float(v << 16); }
__device__ __forceinline__ float hi16(unsigned v) { return __uint_as_float(v & 0xffff0000u); }
#define UNPACK8(v, f) { f[0] = lo16(v.x); f[1] = hi16(v.x); f[2] = lo16(v.y); f[3] = hi16(v.y); f[4] = lo16(v.z); f[5] = hi16(v.z); f[6] = lo16(v.w); f[7] = hi16(v.w); }
__device__ __forceinline__ uint4 pack8(const float* f) { uint4 r; r.x = pack2(f[0], f[1]); r.y = pack2(f[2], f[3]); r.z = pack2(f[4], f[5]); r.w = pack2(f[6], f[7]); return r; }
__device__ __forceinline__ float sigmoidf_(float x) { return __builtin_amdgcn_rcpf(1.f + __expf(-x)); }
__device__ __forceinline__ float siluf_(float x) { return x * __builtin_amdgcn_rcpf(1.f + __expf(-x)); }
__device__ __forceinline__ float softplusf_(float x) { return x > 20.f ? x : log1pf(__expf(x)); }
template <int CTRL> __device__ __forceinline__ float dppf(float x) { return __builtin_bit_cast(float, __builtin_amdgcn_mov_dpp(__builtin_bit_cast(int, x), CTRL, 0xf, 0xf, true)); }
__device__ __forceinline__ float reduce16(float x) { x += dppf<0xB1>(x); x += dppf<0x4E>(x); x += dppf<0x141>(x); x += dppf<0x140>(x); return x; }

__device__ __forceinline__ float* xs_row(const Params& p, int g, int r) {
  return (r < MLAT) ? p.out + ((size_t)g * MLAT + r) * D : (float*)(p.ws + OFF_XSC) + ((size_t)g * MCTX + (r - MLAT)) * D;
}
__device__ __forceinline__ const float* xin_row(const Params& p, int l, int g, int r) {
  if (l == 0) return (r < MLAT) ? p.x + ((size_t)g * MLAT + r) * D : p.ctx + ((size_t)g * MCTX + (r - MLAT)) * D;
  return xs_row(p, g, r);
}
__device__ __forceinline__ int mod_row(int g, int r) { return r < MLAT ? g * G + r / SEQ : 8; }
__device__ __forceinline__ int gdn_rowof(int b_l, int dir, int s) {
  if (s < 256) { const int i = dir ? 255 - s : s; return MLAT + b_l * 256 + i; }
  const int i = s - 256; return b_l * 8192 + (dir ? 8191 - i : i);
}
__device__ __forceinline__ int ssd_rowof(int b_l, int dir, int s) {
  if (s < 256) { const int i = dir ? 255 - s : s; return MLAT + b_l * 256 + i; }
  const int j = s - 256; const int pos = dir ? 8191 - j : j; return b_l * 8192 + (pos & 127) * 64 + (pos >> 7);
}

__device__ __forceinline__ void transpose_phase(const float* __restrict__ src, bf16_t* __restrict__ dst, int K, int N, int Npad, float* tile) {
  const int tid = TIDX(), tk = K / 64, tn = Npad / 64;
  const int c = tid & 63, r4 = tid >> 6;
  for (int t = BIDX(); t < tk * tn; t += GDIM()) {
    const int kt = t % tk, nt = t / tk, k0 = kt * 64, n0 = nt * 64;
    __syncthreads();
#pragma unroll 4
    for (int i = 0; i < 16; ++i) { const int r = i * 4 + r4, n = n0 + c; tile[r * 65 + c] = (n < N) ? src[(size_t)(k0 + r) * N + n] : 0.f; }
    __syncthreads();
#pragma unroll 4
    for (int i = 0; i < 16; ++i) { const int nn = i * 4 + r4; dst[(size_t)(n0 + nn) * K + k0 + c] = f2bf(tile[c * 65 + nn]); }
  }
}

__device__ __forceinline__ void modpart_phase(const Params& p, float* sm) {
  const int tid = TIDX();
  float* MODP = (float*)(p.ws + OFF_MODP);
  for (int item = BIDX(); item < 2 * 24 * 16; item += GDIM()) {
    const int l = item / 384, rem = item % 384, cbk = rem / 16, ks = rem % 16;
    __syncthreads();
    for (int i = tid; i < 9 * 64; i += 256) { const int r = i / 64, k = ks * 64 + (i % 64); const float v = (r < 8) ? p.c[r * D + k] : p.c_ctx[k]; sm[i] = siluf_(v); }
    __syncthreads();
    const int col = cbk * 256 + tid;
    float acc[9];
#pragma unroll
    for (int r = 0; r < 9; ++r) acc[r] = 0.f;
    const float* wp = p.w_mod + ((size_t)l * D + ks * 64) * 6144 + col;
#pragma unroll 8
    for (int k = 0; k < 64; ++k) { const float w = wp[(size_t)k * 6144];
#pragma unroll
      for (int r = 0; r < 9; ++r) acc[r] += sm[r * 64 + k] * w; }
#pragma unroll
    for (int r = 0; r < 9; ++r) MODP[(((size_t)l * 16 + ks) * 9 + r) * 6144 + col] = acc[r];
  }
}
__device__ __forceinline__ void modfinal_phase(const Params& p) {
  const float* MODP = (const float*)(p.ws + OFF_MODP);
  float* MOD = (float*)(p.ws + OFF_MOD);
  for (int i = BIDX() * 256 + TIDX(); i < 2 * 9 * 6144; i += GDIM() * 256) {
    const int l = i / (9 * 6144), rem = i % (9 * 6144), col = rem % 6144;
    float s = p.b_mod[l * 6144 + col];
    for (int ks = 0; ks < 16; ++ks) s += MODP[((size_t)l * 16 + ks) * 9 * 6144 + rem];
    MOD[i] = s;
  }
}

__device__ __forceinline__ void modulate_phase(const Params& p, int l, int g) {
  const float* MOD = (const float*)(p.ws + OFF_MOD) + (size_t)l * 9 * 6144;
  bf16_t* H = (bf16_t*)(p.ws + OFF_H);
  for (int i = BIDX() * 256 + TIDX(); i < MG * 128; i += GDIM() * 256) {
    const int r = i >> 7, ch = (i & 127) * 8;
    const float* xr = xin_row(p, l, g, r) + ch;
    const float* m = MOD + (size_t)mod_row(g, r) * 6144;
    const float4 x0 = *(const float4*)xr, x1 = *(const float4*)(xr + 4);
    const float4 sh0 = *(const float4*)(m + ch), sh1 = *(const float4*)(m + ch + 4);
    const float4 sc0 = *(const float4*)(m + 1024 + ch), sc1 = *(const float4*)(m + 1024 + ch + 4);
    float f[8] = {x0.x * (1.f + sc0.x) + sh0.x, x0.y * (1.f + sc0.y) + sh0.y, x0.z * (1.f + sc0.z) + sh0.z, x0.w * (1.f + sc0.w) + sh0.w,
                  x1.x * (1.f + sc1.x) + sh1.x, x1.y * (1.f + sc1.y) + sh1.y, x1.z * (1.f + sc1.z) + sh1.z, x1.w * (1.f + sc1.w) + sh1.w};
    *(uint4*)(H + (size_t)r * D + ch) = pack8(f);
  }
}

struct Seg { const bf16_t* ap; const bf16_t* bp; int lda, ldb, nk; };

__device__ __forceinline__ bool tile_coord(int it, int nM, int nN, int& mt, int& nt) {
  const int nb = GDIM(), v = BIDX();
  long s;
  if ((nb & 7) == 0) { const int per = nb >> 3; s = (long)it * nb + (v & 7) * per + (v >> 3); } else s = (long)it * nb + v;
  if (s >= (long)nM * nN) return false;
  const int band = (int)(s / (8 * nN)), r = (int)(s - (long)band * 8 * nN);
  const int bsz = (nM - band * 8) < 8 ? (nM - band * 8) : 8;
  nt = r / bsz; mt = band * 8 + (r % bsz);
  return true;
}

#define ZERO_ACC(acc) { _Pragma("unroll") for (int i_ = 0; i_ < 4; ++i_) { _Pragma("unroll") for (int j_ = 0; j_ < 4; ++j_) acc[i_][j_] = (f32x4){0.f, 0.f, 0.f, 0.f}; } }
#define EPI_LOOP(...) { const int lane_ = TIDX() & 63, w_ = TIDX() >> 6; \
  _Pragma("unroll") for (int i_ = 0; i_ < 4; ++i_) { const int row = m0 + (w_ >> 1) * 64 + i_ * 16 + (lane_ & 15); \
  _Pragma("unroll") for (int j_ = 0; j_ < 4; ++j_) { const int col = n0 + (w_ & 1) * 64 + j_ * 16 + (lane_ >> 4) * 4; f32x4& v = acc[i_][j_]; __VA_ARGS__ } } }

template <class Prob>
__device__ __forceinline__ void gemm_stream(Prob& pr, bf16_t* sm) {
  const int tid = TIDX(), lane = tid & 63, w = tid >> 6, wr = w >> 1, wc = w & 1;
  const int lr = tid >> 3, lk = (tid & 7) * 8;
  const int fr = lane & 15, fq = lane >> 4;
  const int aoff = (wr * 64 + fr) * 72 + fq * 8, boff = 9216 + (wc * 64 + fr) * 72 + fq * 8;
  const int soff = lr * 72 + lk;
  Seg cur, nxt;
  if (!pr.seg(0, cur, lr, lk)) return;
  bool has_nxt = pr.seg(1, nxt, lr, lk);
  u32x4 r0a[4], r0b[4], r1a[4], r1b[4];
#pragma unroll
  for (int i = 0; i < 4; ++i) { r0a[i] = (u32x4){0u, 0u, 0u, 0u}; r0b[i] = r0a[i]; r1a[i] = r0a[i]; r1b[i] = r0a[i]; }
  f32x4 acc[4][4];
#define GS_LOAD(RA, RB, KT) { const int kt_ = (KT); const bf16_t* ap_ = nullptr; const bf16_t* bp_ = nullptr; int lda_ = 0, ldb_ = 0; bool ok_ = true; \
    if (kt_ < cur.nk) { ap_ = cur.ap + kt_ * 64; bp_ = cur.bp + kt_ * 64; lda_ = cur.lda; ldb_ = cur.ldb; } \
    else if (has_nxt) { ap_ = nxt.ap + (kt_ - cur.nk) * 64; bp_ = nxt.bp + (kt_ - cur.nk) * 64; lda_ = nxt.lda; ldb_ = nxt.ldb; } else ok_ = false; \
    if (ok_) { _Pragma("unroll") for (int i = 0; i < 4; ++i) { RA[i] = *(const u32x4*)(ap_ + (size_t)i * 32 * lda_); RB[i] = *(const u32x4*)(bp_ + (size_t)i * 32 * ldb_); } } }
#define GS_STORE(RA, RB, KT, STAGE) { if ((KT) < cur.nk || has_nxt) { bf16_t* st_ = (STAGE) + soff; \
    _Pragma("unroll") for (int i = 0; i < 4; ++i) { *(u32x4*)(st_ + i * 32 * 72) = RA[i]; *(u32x4*)(st_ + 9216 + i * 32 * 72) = RB[i]; } } }
#define GS_COMPUTE(STAGE) { const bf16_t* cs_ = (STAGE); _Pragma("unroll") for (int kk = 0; kk < 2; ++kk) { bf16x8 af[4], bfr[4]; \
    _Pragma("unroll") for (int i = 0; i < 4; ++i) { af[i] = *(const bf16x8*)(cs_ + aoff + i * 16 * 72 + kk * 32); bfr[i] = *(const bf16x8*)(cs_ + boff + i * 16 * 72 + kk * 32); } \
    _Pragma("unroll") for (int i = 0; i < 4; ++i) { _Pragma("unroll") for (int j = 0; j < 4; ++j) acc[i][j] = __builtin_amdgcn_mfma_f32_16x16x32_bf16(bfr[j], af[i], acc[i][j], 0, 0, 0); } } }
  GS_LOAD(r0a, r0b, 0)
  __syncthreads();
  GS_STORE(r0a, r0b, 0, sm)
  __syncthreads();
  GS_LOAD(r0a, r0b, 1)
  GS_LOAD(r1a, r1b, 2)
  for (int idx = 0;; ++idx) {
    pr.begin(idx, acc);
    for (int kt = 0; kt < cur.nk; kt += 2) {
      GS_COMPUTE(sm)
      GS_STORE(r0a, r0b, kt + 1, sm + 18432)
      GS_LOAD(r0a, r0b, kt + 3)
      __syncthreads();
      GS_COMPUTE(sm + 18432)
      GS_STORE(r1a, r1b, kt + 2, sm)
      GS_LOAD(r1a, r1b, kt + 4)
      __syncthreads();
    }
    pr.end(idx, acc);
    if (!has_nxt) break;
    cur = nxt; has_nxt = pr.seg(idx + 2, nxt, lr, lk);
  }
#undef GS_LOAD
#undef GS_STORE
#undef GS_COMPUTE
}

__device__ __forceinline__ void gemm_inproj_phase(const Params& p, bf16_t* sm) {
  struct Pr {
    const bf16_t* A; const bf16_t* W; bf16_t* P; int nM, nN;
    __device__ bool seg(int idx, Seg& s, int lr, int lk) const { int mt, nt; if (!tile_coord(idx, nM, nN, mt, nt)) return false;
      s.ap = A + (size_t)(mt * 128 + lr) * D + lk; s.bp = W + (size_t)(nt * 128 + lr) * D + lk; s.lda = D; s.ldb = D; s.nk = 16; return true; }
    __device__ void begin(int, f32x4 (&acc)[4][4]) const { ZERO_ACC(acc) }
    __device__ void end(int idx, f32x4 (&acc)[4][4]) const { int mt, nt; tile_coord(idx, nM, nN, mt, nt); const int m0 = mt * 128, n0 = nt * 128;
      EPI_LOOP({ uint2 o; o.x = pack2(v[0], v[1]); o.y = pack2(v[2], v[3]); *(uint2*)(P + (size_t)row * LDP + col) = o; }) }
  } pr{(const bf16_t*)(p.ws + OFF_H), (const bf16_t*)(p.ws + OFF_WIN), (bf16_t*)(p.ws + OFF_P), MG / 128, LDP / 128};
  gemm_stream(pr, sm);
}
__device__ __forceinline__ void gemm_proj_phase(const Params& p, int M, bf16_t* sm) {
  struct Pr {
    const bf16_t* YA; const bf16_t* YBn; const bf16_t* Wg; const bf16_t* Ws; const bf16_t* P; bf16_t* U; int nM, nN;
    __device__ bool seg(int idx, Seg& s, int lr, int lk) const { int mt, nt; if (!tile_coord(idx >> 1, nM, nN, mt, nt)) return false;
      if ((idx & 1) == 0) { s.ap = YA + (size_t)(mt * 128 + lr) * 1024 + lk; s.bp = Wg + (size_t)(nt * 128 + lr) * 1024 + lk; s.lda = 1024; s.ldb = 1024; s.nk = 16; }
      else { s.ap = YBn + (size_t)(mt * 128 + lr) * 2048 + lk; s.bp = Ws + (size_t)(nt * 128 + lr) * 2048 + lk; s.lda = 2048; s.ldb = 2048; s.nk = 32; }
      return true; }
    __device__ void begin(int idx, f32x4 (&acc)[4][4]) const { if ((idx & 1) == 0) ZERO_ACC(acc) }
    __device__ void end(int idx, f32x4 (&acc)[4][4]) const { int mt, nt; tile_coord(idx >> 1, nM, nN, mt, nt); const int m0 = mt * 128, n0 = nt * 128;
      if ((idx & 1) == 0) {
        EPI_LOOP({ const uint2 ga = *(const uint2*)(P + (size_t)row * LDP + C_GA + col); const uint2 gb = *(const uint2*)(P + (size_t)row * LDP + C_GB + col);
          v[0] *= (1.f + __expf(-lo16(gb.x))) / (1.f + __expf(-lo16(ga.x))); v[1] *= (1.f + __expf(-hi16(gb.x))) / (1.f + __expf(-hi16(ga.x)));
          v[2] *= (1.f + __expf(-lo16(gb.y))) / (1.f + __expf(-lo16(ga.y))); v[3] *= (1.f + __expf(-hi16(gb.y))) / (1.f + __expf(-hi16(ga.y))); })
      } else {
        EPI_LOOP({ const uint2 gb = *(const uint2*)(P + (size_t)row * LDP + C_GB + col);
          uint2 o; o.x = pack2(v[0] * sigmoidf_(lo16(gb.x)), v[1] * sigmoidf_(hi16(gb.x))); o.y = pack2(v[2] * sigmoidf_(lo16(gb.y)), v[3] * sigmoidf_(hi16(gb.y)));
          *(uint2*)(U + (size_t)row * D + col) = o; })
      } }
  } pr{(const bf16_t*)(p.ws + OFF_QKV), (const bf16_t*)(p.ws + OFF_QKV) + (size_t)MG * 1024, (const bf16_t*)(p.ws + OFF_WPG), (const bf16_t*)(p.ws + OFF_WPS),
       (const bf16_t*)(p.ws + OFF_P), (bf16_t*)(p.ws + OFF_H), M / 128, 8};
  gemm_stream(pr, sm);
}
__device__ __forceinline__ void gemm_wout_phase(const Params& p, int l, int g, int M, bf16_t* sm) {
  struct Pr {
    const Params& p; int l, g; const bf16_t* U; const bf16_t* W; const float* MOD; int nM, nN;
    __device__ bool seg(int idx, Seg& s, int lr, int lk) const { int mt, nt; if (!tile_coord(idx, nM, nN, mt, nt)) return false;
      s.ap = U + (size_t)(mt * 128 + lr) * D + lk; s.bp = W + (size_t)(nt * 128 + lr) * D + lk; s.lda = D; s.ldb = D; s.nk = 16; return true; }
    __device__ void begin(int, f32x4 (&acc)[4][4]) const { ZERO_ACC(acc) }
    __device__ void end(int idx, f32x4 (&acc)[4][4]) const { int mt, nt; tile_coord(idx, nM, nN, mt, nt); const int m0 = mt * 128, n0 = nt * 128;
      EPI_LOOP({ const float4 xr = *(const float4*)(xin_row(p, l, g, row) + col); const float4 g1 = *(const float4*)(MOD + (size_t)mod_row(g, row) * 6144 + 2048 + col);
        float4 o; o.x = DN_ALPHA * xr.x + g1.x * v[0]; o.y = DN_ALPHA * xr.y + g1.y * v[1]; o.z = DN_ALPHA * xr.z + g1.z * v[2]; o.w = DN_ALPHA * xr.w + g1.w * v[3];
        *(float4*)(xs_row(p, g, row) + col) = o; }) }
  } pr{p, l, g, (const bf16_t*)(p.ws + OFF_H), (const bf16_t*)(p.ws + OFF_WOUT), (const float*)(p.ws + OFF_MOD) + (size_t)l * 9 * 6144, M / 128, 8};
  gemm_stream(pr, sm);
}
__device__ __forceinline__ void gemm_ff1_phase(const Params& p, int l, int M, bf16_t* sm) {
  struct Pr {
    const bf16_t* H; const bf16_t* W; bf16_t* HID; const float* b1; int nM, nN;
    __device__ bool seg(int idx, Seg& s, int lr, int lk) const { int mt, nt; if (!tile_coord(idx, nM, nN, mt, nt)) return false;
      s.ap = H + (size_t)(mt * 128 + lr) * D + lk; s.bp = W + (size_t)(nt * 128 + lr) * D + lk; s.lda = D; s.ldb = D; s.nk = 16; return true; }
    __device__ void begin(int, f32x4 (&acc)[4][4]) const { ZERO_ACC(acc) }
    __device__ void end(int idx, f32x4 (&acc)[4][4]) const { int mt, nt; tile_coord(idx, nM, nN, mt, nt); const int m0 = mt * 128, n0 = nt * 128;
      EPI_LOOP({ const float4 b = *(const float4*)(b1 + col);
        float t0 = fmaxf(v[0] + b.x, 0.f), t1 = fmaxf(v[1] + b.y, 0.f), t2 = fmaxf(v[2] + b.z, 0.f), t3 = fmaxf(v[3] + b.w, 0.f);
        uint2 o; o.x = pack2(t0 * t0, t1 * t1); o.y = pack2(t2 * t2, t3 * t3); *(uint2*)(HID + (size_t)row * 4096 + col) = o; }) }
  } pr{(const bf16_t*)(p.ws + OFF_H), (const bf16_t*)(p.ws + OFF_WFF1), (bf16_t*)(p.ws + OFF_P), p.b_ff1 + (size_t)l * 4096, M / 128, 32};
  gemm_stream(pr, sm);
}
__device__ __forceinline__ void gemm_ff2_phase(const Params& p, int l, int g, int M, bf16_t* sm) {
  struct Pr {
    const Params& p; int g; const bf16_t* HID; const bf16_t* W; const float* MOD; const float* b2; int nM, nN;
    __device__ bool seg(int idx, Seg& s, int lr, int lk) const { int mt, nt; if (!tile_coord(idx, nM, nN, mt, nt)) return false;
      s.ap = HID + (size_t)(mt * 128 + lr) * 4096 + lk; s.bp = W + (size_t)(nt * 128 + lr) * 4096 + lk; s.lda = 4096; s.ldb = 4096; s.nk = 64; return true; }
    __device__ void begin(int, f32x4 (&acc)[4][4]) const { ZERO_ACC(acc) }
    __device__ void end(int idx, f32x4 (&acc)[4][4]) const { int mt, nt; tile_coord(idx, nM, nN, mt, nt); const int m0 = mt * 128, n0 = nt * 128;
      EPI_LOOP({ float* xp = xs_row(p, g, row) + col; const float4 xr = *(const float4*)xp; const float4 b = *(const float4*)(b2 + col);
        const float4 g2 = *(const float4*)(MOD + (size_t)mod_row(g, row) * 6144 + 5120 + col);
        float4 o; o.x = DN_ALPHA * xr.x + g2.x * (v[0] + b.x); o.y = DN_ALPHA * xr.y + g2.y * (v[1] + b.y); o.z = DN_ALPHA * xr.z + g2.z * (v[2] + b.z); o.w = DN_ALPHA * xr.w + g2.w * (v[3] + b.w);
        *(float4*)xp = o; }) }
  } pr{p, g, (const bf16_t*)(p.ws + OFF_P), (const bf16_t*)(p.ws + OFF_WFF2), (const float*)(p.ws + OFF_MOD) + (size_t)l * 9 * 6144, p.b_ff2 + (size_t)l * 1024, M / 128, 8};
  gemm_stream(pr, sm);
}

__device__ __forceinline__ void ln_phase(const Params& p, int l, int g, int M, const float* gam, const float* bet, bool write_h2) {
  const int lane = TIDX() & 63;
  const float* MOD = (const float*)(p.ws + OFF_MOD) + (size_t)l * 9 * 6144;
  bf16_t* H = (bf16_t*)(p.ws + OFF_H);
  for (int r = BIDX() * 4 + (TIDX() >> 6); r < M; r += GDIM() * 4) {
    float* xr = xs_row(p, g, r);
    float4 v[4];
    float s = 0.f;
#pragma unroll
    for (int i = 0; i < 4; ++i) { v[i] = *(const float4*)(xr + (i * 64 + lane) * 4); s += v[i].x + v[i].y + v[i].z + v[i].w; }
#pragma unroll
    for (int o = 32; o >= 1; o >>= 1) s += __shfl_xor(s, o);
    const float mu = s * (1.f / 1024.f);
    float q = 0.f;
#pragma unroll
    for (int i = 0; i < 4; ++i) { v[i].x -= mu; v[i].y -= mu; v[i].z -= mu; v[i].w -= mu; q += v[i].x * v[i].x + v[i].y * v[i].y + v[i].z * v[i].z + v[i].w * v[i].w; }
#pragma unroll
    for (int o = 32; o >= 1; o >>= 1) q += __shfl_xor(q, o);
    const float rs = rsqrtf(q * (1.f / 1024.f) + 1e-5f);
    const float* m = MOD + (size_t)mod_row(g, r) * 6144;
#pragma unroll
    for (int i = 0; i < 4; ++i) {
      const int ch = (i * 64 + lane) * 4;
      const float4 gg = *(const float4*)(gam + ch), bb = *(const float4*)(bet + ch);
      float4 o; o.x = v[i].x * rs * gg.x + bb.x; o.y = v[i].y * rs * gg.y + bb.y; o.z = v[i].z * rs * gg.z + bb.z; o.w = v[i].w * rs * gg.w + bb.w;
      *(float4*)(xr + ch) = o;
      if (write_h2) {
        const float4 sh = *(const float4*)(m + 3072 + ch), sc = *(const float4*)(m + 4096 + ch);
        uint2 h; h.x = pack2(o.x * (1.f + sc.x) + sh.x, o.y * (1.f + sc.y) + sh.y); h.y = pack2(o.z * (1.f + sc.z) + sh.z, o.w * (1.f + sc.w) + sh.w);
        *(uint2*)(H + (size_t)r * D + ch) = h;
      }
    }
  }
}

__device__ __forceinline__ void conv_phase(const Params& p, int l) {
  const bf16_t* P = (const bf16_t*)(p.ws + OFF_P);
  bf16_t* QKV = (bf16_t*)(p.ws + OFF_QKV); bf16_t* XBC = (bf16_t*)(p.ws + OFF_XBC);
  float* GBF = (float*)(p.ws + OFF_GBF); float* DTF = (float*)(p.ws + OFF_DTF);
  const int nb = GDIM(), bid = BIDX(), tid = TIDX();
  const int vb = ((nb & 7) == 0) ? (bid & 7) * (nb >> 3) + (bid >> 3) : bid;
  const int gtid = vb * 256 + tid, gsz = nb * 256;
  {
    const float* cw = p.gdn_conv_w + (size_t)l * 5 * 3072;
    const int c = tid & 127, hh = tid >> 7;
    for (int item = vb; item < (MG / 32) * 3; item += nb) {
      const int third = item % 3, pp = item / 3;
      const int ch0 = third * 1024 + c * 8;
      const int t0 = (pp * 2 + hh) * 16;
      int lo, hi;
      if (t0 < MLAT) { lo = t0 & ~63; hi = lo + 64; } else { lo = MLAT + ((t0 - MLAT) & ~255); hi = lo + 256; }
      u32x4 raw[20];
#pragma unroll
      for (int i = 0; i < 20; ++i) { const int row = t0 - 2 + i; raw[i] = (row >= lo && row < hi) ? *(const u32x4*)(P + (size_t)row * LDP + ch0) : (u32x4){0u, 0u, 0u, 0u}; }
      float wt[5][8];
#pragma unroll
      for (int j = 0; j < 5; ++j) { const float4 w0 = *(const float4*)(cw + j * 3072 + ch0), w1 = *(const float4*)(cw + j * 3072 + ch0 + 4);
        wt[j][0] = w0.x; wt[j][1] = w0.y; wt[j][2] = w0.z; wt[j][3] = w0.w; wt[j][4] = w1.x; wt[j][5] = w1.y; wt[j][6] = w1.z; wt[j][7] = w1.w; }
      const float qsc = (third == 0) ? 0.08838834764831845f : 1.f;
#pragma unroll
      for (int t = 0; t < 16; ++t) {
        float acc[8];
#pragma unroll
        for (int e = 0; e < 8; ++e) acc[e] = 0.f;
#pragma unroll
        for (int j = 0; j < 5; ++j) {
          const u32x4 rw = raw[t + j];
#pragma unroll
          for (int e = 0; e < 4; ++e) { acc[2 * e] += lo16(rw[e]) * wt[j][2 * e]; acc[2 * e + 1] += hi16(rw[e]) * wt[j][2 * e + 1]; }
        }
        float ss = 0.f;
#pragma unroll
        for (int e = 0; e < 8; ++e) { acc[e] = siluf_(acc[e]); ss += acc[e] * acc[e]; }
        ss += __shfl_xor(ss, 1); ss += __shfl_xor(ss, 2); ss += __shfl_xor(ss, 4); ss += __shfl_xor(ss, 8);
        const float sc = (third < 2) ? rsqrtf(ss + 1e-6f) * qsc : 1.f;
#pragma unroll
        for (int e = 0; e < 8; ++e) acc[e] *= sc;
        *(uint4*)(QKV + (size_t)(t0 + t) * 3072 + ch0) = pack8(acc);
      }
    }
  }
  {
    const float* sw = p.ssm_conv_w + (size_t)l * 5 * 4096; const float* sb = p.ssm_conv_b + (size_t)l * 4096;
    constexpr int nLat = G * 64 * 8 * 2, nCtx = (MCTX / 16) * 2;
    float wt[5][8], bs[8];
    int cur_half = -1;
    for (int item = vb; item < nLat + nCtx; item += nb) {
      int half, base, stride, p0, seglen;
      if (item < nLat) { half = item & 1; const int piece = (item >> 1) & 7, cl = (item >> 4) & 63, b_l = item >> 10; base = b_l * 8192 + cl; stride = 64; p0 = piece * 16; seglen = 128; }
      else { const int i2 = item - nLat; half = i2 & 1; const int piece = i2 >> 1; base = MLAT + (piece >> 4) * 256; stride = 1; p0 = (piece & 15) * 16; seglen = 256; }
      const int ch0 = (half * 256 + tid) * 8;
      u32x4 raw[20];
#pragma unroll
      for (int i = 0; i < 20; ++i) { const int pq = p0 - 2 + i; raw[i] = (pq >= 0 && pq < seglen) ? *(const u32x4*)(P + (size_t)(base + pq * stride) * LDP + C_XBC + ch0) : (u32x4){0u, 0u, 0u, 0u}; }
      if (half != cur_half) {
        cur_half = half;
        const float4 b0 = *(const float4*)(sb + ch0), b1 = *(const float4*)(sb + ch0 + 4);
        bs[0] = b0.x; bs[1] = b0.y; bs[2] = b0.z; bs[3] = b0.w; bs[4] = b1.x; bs[5] = b1.y; bs[6] = b1.z; bs[7] = b1.w;
#pragma unroll
        for (int j = 0; j < 5; ++j) { const float4 w0 = *(const float4*)(sw + j * 4096 + ch0), w1 = *(const float4*)(sw + j * 4096 + ch0 + 4);
          wt[j][0] = w0.x; wt[j][1] = w0.y; wt[j][2] = w0.z; wt[j][3] = w0.w; wt[j][4] = w1.x; wt[j][5] = w1.y; wt[j][6] = w1.z; wt[j][7] = w1.w; }
      }
#pragma unroll
      for (int t = 0; t < 16; ++t) {
        float acc[8];
#pragma unroll
        for (int e = 0; e < 8; ++e) acc[e] = bs[e];
#pragma unroll
        for (int j = 0; j < 5; ++j) {
          const u32x4 rw = raw[t + j];
#pragma unroll
          for (int e = 0; e < 4; ++e) { acc[2 * e] += lo16(rw[e]) * wt[j][2 * e]; acc[2 * e + 1] += hi16(rw[e]) * wt[j][2 * e + 1]; }
        }
#pragma unroll
        for (int e = 0; e < 8; ++e) acc[e] = siluf_(acc[e]);
        *(uint4*)(XBC + (size_t)(base + (p0 + t) * stride) * 4096 + ch0) = pack8(acc);
      }
    }
  }
  for (int idx = gtid; idx < MG * 16; idx += gsz) {
    const int r = idx >> 4, dh = idx & 15;
    GBF[(size_t)r * 32 + 16 + dh] = sigmoidf_(bf2f(P[(size_t)r * LDP + C_B + dh]));
  }
  for (int idx = gtid; idx < G * 2 * 264 * 8; idx += gsz) {
    const int h = idx & 7; int t = idx >> 3; const int chunk = t % 264; t /= 264; const int dir = t & 1, b_l = t >> 1;
    const int dh = dir * 8 + h;
    const float bias = p.gdn_dt_bias[l * 16 + dh], aneg = -__expf(p.gdn_A_log[l * 16 + dh]);
    float cum = 0.f;
    for (int ub = 0; ub < 32; ub += 8) {
      float av[8];
#pragma unroll
      for (int u = 0; u < 8; ++u) av[u] = bf2f(P[(size_t)gdn_rowof(b_l, dir, chunk * 32 + ub + u) * LDP + C_A + dh]);
#pragma unroll
      for (int u = 0; u < 8; ++u) {
        cum += aneg * softplusf_(av[u] + bias);
        GBF[(size_t)gdn_rowof(b_l, dir, chunk * 32 + ub + u) * 32 + dh] = cum;
      }
    }
  }
  for (int idx = gtid; idx < G * 2 * 264 * 32; idx += gsz) {
    const int head = idx & 31; int t = idx >> 5; const int chunk = t % 264; t /= 264; const int dir = t & 1, b_l = t >> 1;
    const int dh = dir * 32 + head;
    const float bias = p.ssm_dt_bias[l * 64 + dh], aneg = -__expf(p.ssm_A_log[l * 64 + dh]);
    float cum = 0.f;
    for (int ub = 0; ub < 32; ub += 8) {
      float dtv[8];
#pragma unroll
      for (int u = 0; u < 8; ++u) dtv[u] = bf2f(P[(size_t)ssd_rowof(b_l, dir, chunk * 32 + ub + u) * LDP + C_DT + dh]);
#pragma unroll
      for (int u = 0; u < 8; ++u) {
        const size_t row = (size_t)ssd_rowof(b_l, dir, chunk * 32 + ub + u);
        const float dt = softplusf_(dtv[u] + bias);
        cum += dt * aneg;
        DTF[row * 128 + dh] = dt;
        DTF[row * 128 + 64 + dh] = cum;
      }
    }
  }
}

__device__ __forceinline__ void gdn_prep_phase(const Params& p, unsigned char* smraw) {
  const int tid = TIDX(), lane = tid & 63, w = tid >> 6, fr = lane & 15, fq = lane >> 4, ti = w >> 1, tj = w & 1;
  bf16_t* sK = (bf16_t*)smraw;
  bf16_t* sQ = sK + 32 * 136;
  bf16_t* sP = sQ + 32 * 136;
  bf16_t* sPT = sP + 2 * 1280;
  bf16_t* sR = sPT + 2 * 1280;
  float* sG = (float*)(sR + 2 * 1280);
  const bf16_t* QKV = (const bf16_t*)(p.ws + OFF_QKV);
  const float* GBF = (const float*)(p.ws + OFF_GBF);
  bf16_t* TMB = (bf16_t*)(p.ws + OFF_TMB);
  const int ltok = tid & 31, lp = tid >> 5;
  const int i = ti * 16 + fr, j0 = tj * 16 + fq * 4;
  for (int item = BIDX(); item < GDN_NITEM; item += GDIM()) {
    const int chunk = item % 264; const int t = item / 264; const int dir = t & 1, h = (t >> 1) & 7, b_l = t >> 4;
    const size_t row = (size_t)gdn_rowof(b_l, dir, chunk * 32 + ltok);
    const bf16_t* src = QKV + row * 3072 + h * 128;
    const u32x4 k0 = *(const u32x4*)(src + 1024 + lp * 8), k1 = *(const u32x4*)(src + 1024 + (lp + 8) * 8);
    const u32x4 q0 = *(const u32x4*)(src + lp * 8), q1 = *(const u32x4*)(src + (lp + 8) * 8);
    float g_ = 0.f, b_ = 0.f;
    if (tid < 32) { g_ = GBF[row * 32 + dir * 8 + h]; b_ = GBF[row * 32 + 16 + dir * 8 + h]; }
    __syncthreads();
    *(u32x4*)(sK + ltok * 136 + lp * 8) = k0; *(u32x4*)(sK + ltok * 136 + (lp + 8) * 8) = k1;
    *(u32x4*)(sQ + ltok * 136 + lp * 8) = q0; *(u32x4*)(sQ + ltok * 136 + (lp + 8) * 8) = q1;
    if (tid < 32) { sG[tid] = g_; sG[32 + tid] = b_; }
    __syncthreads();
    {
      f32x4 kk = (f32x4){0.f, 0.f, 0.f, 0.f}, qk = kk;
#pragma unroll
      for (int ks = 0; ks < 4; ++ks) {
        const bf16x8 kj = *(const bf16x8*)(sK + (tj * 16 + fr) * 136 + ks * 32 + fq * 8);
        const bf16x8 ki = *(const bf16x8*)(sK + (ti * 16 + fr) * 136 + ks * 32 + fq * 8);
        const bf16x8 qi = *(const bf16x8*)(sQ + (ti * 16 + fr) * 136 + ks * 32 + fq * 8);
        kk = __builtin_amdgcn_mfma_f32_16x16x32_bf16(kj, ki, kk, 0, 0, 0);
        qk = __builtin_amdgcn_mfma_f32_16x16x32_bf16(kj, qi, qk, 0, 0, 0);
      }
      const float gi = sG[i], bi = sG[32 + i];
      float n[4], nt[4], rr[4], m[4];
#pragma unroll
      for (int r = 0; r < 4; ++r) {
        const int j = j0 + r; const float gj = sG[j], bj = sG[32 + j];
        n[r] = (j < i) ? -bi * kk[r] * __expf(gi - gj) : 0.f;
        nt[r] = (i < j) ? -bj * kk[r] * __expf(gj - gi) : 0.f;
        m[r] = (j <= i) ? qk[r] * __expf(gi - gj) : 0.f;
        rr[r] = n[r] + ((i == j) ? 1.f : 0.f);
      }
      uint2 o;
      o.x = pack2(n[0], n[1]); o.y = pack2(n[2], n[3]); *(uint2*)(sP + i * 40 + j0) = o;
      o.x = pack2(nt[0], nt[1]); o.y = pack2(nt[2], nt[3]); *(uint2*)(sPT + i * 40 + j0) = o;
      o.x = pack2(rr[0], rr[1]); o.y = pack2(rr[2], rr[3]); *(uint2*)(sR + i * 40 + j0) = o;
      o.x = pack2(m[0], m[1]); o.y = pack2(m[2], m[3]); *(uint2*)(TMB + (size_t)item * 2048 + 1024 + i * 32 + j0) = o;
    }
    __syncthreads();
    int pc = 0, rc = 0;
#pragma unroll
    for (int st = 1; st <= 5; ++st) {
      const bf16_t* Pc = sP + pc * 1280; const bf16_t* PTc = sPT + pc * 1280; const bf16_t* Rc = sR + rc * 1280;
      const bf16x8 p_i = *(const bf16x8*)(Pc + (ti * 16 + fr) * 40 + fq * 8);
      const bf16x8 p_j = *(const bf16x8*)(Pc + (tj * 16 + fr) * 40 + fq * 8);
      const bf16x8 pt_i = *(const bf16x8*)(PTc + (ti * 16 + fr) * 40 + fq * 8);
      const bf16x8 pt_j = *(const bf16x8*)(PTc + (tj * 16 + fr) * 40 + fq * 8);
      const f32x4 z = (f32x4){0.f, 0.f, 0.f, 0.f};
      if (st >= 2) {
        const bf16x8 r_i = *(const bf16x8*)(Rc + (ti * 16 + fr) * 40 + fq * 8);
        const uint2 rin = *(const uint2*)(Rc + i * 40 + j0);
        f32x4 racc = (f32x4){lo16(rin.x), hi16(rin.x), lo16(rin.y), hi16(rin.y)};
        racc = __builtin_amdgcn_mfma_f32_16x16x32_bf16(pt_j, r_i, racc, 0, 0, 0);
        uint2 o; o.x = pack2(racc[0], racc[1]); o.y = pack2(racc[2], racc[3]);
        if (st < 5) *(uint2*)(sR + (rc ^ 1) * 1280 + i * 40 + j0) = o;
        else *(uint2*)(TMB + (size_t)item * 2048 + i * 32 + j0) = o;
      }
      if (st <= 4) {
        const f32x4 pn = __builtin_amdgcn_mfma_f32_16x16x32_bf16(pt_j, p_i, z, 0, 0, 0);
        const f32x4 ptn = __builtin_amdgcn_mfma_f32_16x16x32_bf16(p_j, pt_i, z, 0, 0, 0);
        uint2 o; o.x = pack2(pn[0], pn[1]); o.y = pack2(pn[2], pn[3]); *(uint2*)(sP + (pc ^ 1) * 1280 + i * 40 + j0) = o;
        o.x = pack2(ptn[0], ptn[1]); o.y = pack2(ptn[2], ptn[3]); *(uint2*)(sPT + (pc ^ 1) * 1280 + i * 40 + j0) = o;
      }
      if (st < 5) __syncthreads();
      pc ^= 1; if (st >= 2) rc ^= 1;
    }
  }
}

__device__ __forceinline__ void gdn_chunk_item(const Params& p, int id, unsigned char* smraw) {
  const int tid = TIDX(), lane = tid & 63, w = tid >> 6, fr = lane & 15, fq = lane >> 4, ta = w >> 1, tb = w & 1;
  const int b_l = id >> 6, h = (id >> 3) & 7, dir = (id >> 2) & 1, dvq = id & 3;
  bf16_t* sKb = (bf16_t*)smraw;
  bf16_t* sQ = sKb + 32 * 136;
  bf16_t* sKdT = sQ + 32 * 136;
  bf16_t* sVbT = sKdT + 128 * 40;
  bf16_t* sT = sVbT + 32 * 40;
  bf16_t* sM = sT + 32 * 40;
  bf16_t* sXT = sM + 32 * 40;
  bf16_t* sVnT = sXT + 32 * 40;
  bf16_t* sST = sVnT + 32 * 40;
  float* sG = (float*)(sST + 32 * 136);
  const bf16_t* QKV = (const bf16_t*)(p.ws + OFF_QKV);
  const float* GBF = (const float*)(p.ws + OFF_GBF);
  const bf16_t* TMB = (const bf16_t*)(p.ws + OFF_TMB);
  bf16_t* OUT = (bf16_t*)(p.ws + (dir ? OFF_OB : OFF_OF));
  const int ltok = tid & 31, lp = tid >> 5;
  const size_t item0 = (size_t)((b_l * 8 + h) * 2 + dir) * 264;
  struct Stage { u32x4 k0, k1, q0, q1, v, tm; float g, be, gl; };
  Stage st0, st1;
  constexpr int NCH = (256 + 8192) / 32;
  auto gload = [&](Stage& st, int c) __attribute__((always_inline)) {
    const int s0 = (c < NCH ? c : NCH - 1) * 32;
    const size_t row = (size_t)gdn_rowof(b_l, dir, s0 + ltok);
    const bf16_t* src = QKV + row * 3072 + h * 128;
    st.k0 = *(const u32x4*)(src + 1024 + lp * 8); st.k1 = *(const u32x4*)(src + 1024 + (lp + 8) * 8);
    st.q0 = *(const u32x4*)(src + lp * 8); st.q1 = *(const u32x4*)(src + (lp + 8) * 8);
    st.v = *(const u32x4*)(src + 2048 + dvq * 32 + (lp & 3) * 8);
    st.tm = *(const u32x4*)(TMB + (item0 + (c < NCH ? c : NCH - 1)) * 2048 + (tid >> 7) * 1024 + ((tid & 127) >> 2) * 32 + (tid & 3) * 8);
    st.g = GBF[row * 32 + dir * 8 + h]; st.be = GBF[row * 32 + 16 + dir * 8 + h];
    st.gl = GBF[(size_t)gdn_rowof(b_l, dir, s0 + 31) * 32 + dir * 8 + h];
  };
  auto lstore = [&](const Stage& st) __attribute__((always_inline)) {
    const float skb = st.be * __expf(st.g), skd = __expf(st.gl - st.g);
    {
      float f[8]; uint4 o;
      f[0] = lo16(st.k0[0]); f[1] = hi16(st.k0[0]); f[2] = lo16(st.k0[1]); f[3] = hi16(st.k0[1]); f[4] = lo16(st.k0[2]); f[5] = hi16(st.k0[2]); f[6] = lo16(st.k0[3]); f[7] = hi16(st.k0[3]);
      bf16_t* t0 = sKdT + (lp * 8) * 40 + ltok;
#pragma unroll
      for (int e = 0; e < 8; ++e) t0[e * 40] = f2bf(f[e] * skd);
#pragma unroll
      for (int e = 0; e < 8; ++e) f[e] *= skb;
      o = pack8(f); *(uint4*)(sKb + ltok * 136 + lp * 8) = o;
      f[0] = lo16(st.k1[0]); f[1] = hi16(st.k1[0]); f[2] = lo16(st.k1[1]); f[3] = hi16(st.k1[1]); f[4] = lo16(st.k1[2]); f[5] = hi16(st.k1[2]); f[6] = lo16(st.k1[3]); f[7] = hi16(st.k1[3]);
      bf16_t* t1 = sKdT + ((lp + 8) * 8) * 40 + ltok;
#pragma unroll
      for (int e = 0; e < 8; ++e) t1[e * 40] = f2bf(f[e] * skd);
#pragma unroll
      for (int e = 0; e < 8; ++e) f[e] *= skb;
      o = pack8(f); *(uint4*)(sKb + ltok * 136 + (lp + 8) * 8) = o;
    }
    *(u32x4*)(sQ + ltok * 136 + lp * 8) = st.q0; *(u32x4*)(sQ + ltok * 136 + (lp + 8) * 8) = st.q1;
    if (tid < 128) {
      bf16_t* tv = sVbT + (lp * 8) * 40 + ltok;
#pragma unroll
      for (int e = 0; e < 4; ++e) { tv[(2 * e) * 40] = f2bf(lo16(st.v[e]) * st.be); tv[(2 * e + 1) * 40] = f2bf(hi16(st.v[e]) * st.be); }
      *(u32x4*)(sT + ((tid & 127) >> 2) * 40 + (tid & 3) * 8) = st.tm;
    } else {
      *(u32x4*)(sM + ((tid & 127) >> 2) * 40 + (tid & 3) * 8) = st.tm;
    }
    if (tid < 32) sG[tid] = st.g;
  };
  f32x4 S[4];
#pragma unroll
  for (int t = 0; t < 4; ++t) S[t] = (f32x4){0.f, 0.f, 0.f, 0.f};
  __syncthreads();
  for (int i = tid; i < 32 * 136 / 2; i += 256) ((unsigned*)sST)[i] = 0u;
  gload(st0, 0); lstore(st0);
  __syncthreads();
  gload(st0, 1); gload(st1, 2);
  auto body = [&](int c) __attribute__((always_inline)) {
    const int dv = ta * 16 + fr, i0 = tb * 16 + fq * 4;
    {
      f32x4 pr = (f32x4){0.f, 0.f, 0.f, 0.f};
#pragma unroll
      for (int ks = 0; ks < 4; ++ks) {
        const bf16x8 kb = *(const bf16x8*)(sKb + (tb * 16 + fr) * 136 + ks * 32 + fq * 8);
        const bf16x8 sf = *(const bf16x8*)(sST + (ta * 16 + fr) * 136 + ks * 32 + fq * 8);
        pr = __builtin_amdgcn_mfma_f32_16x16x32_bf16(kb, sf, pr, 0, 0, 0);
      }
      const uint2 vb = *(const uint2*)(sVbT + dv * 40 + i0);
      uint2 o; o.x = pack2(lo16(vb.x) - pr[0], hi16(vb.x) - pr[1]); o.y = pack2(lo16(vb.y) - pr[2], hi16(vb.y) - pr[3]);
      *(uint2*)(sXT + dv * 40 + i0) = o;
    }
    __syncthreads();
    {
      const bf16x8 tf = *(const bf16x8*)(sT + (tb * 16 + fr) * 40 + fq * 8);
      const bf16x8 xf = *(const bf16x8*)(sXT + (ta * 16 + fr) * 40 + fq * 8);
      const f32x4 vn = __builtin_amdgcn_mfma_f32_16x16x32_bf16(tf, xf, (f32x4){0.f, 0.f, 0.f, 0.f}, 0, 0, 0);
      uint2 o; o.x = pack2(vn[0], vn[1]); o.y = pack2(vn[2], vn[3]);
      *(uint2*)(sVnT + dv * 40 + i0) = o;
    }
    __syncthreads();
    const float eglast = __expf(sG[31]);
    {
      f32x4 oa = (f32x4){0.f, 0.f, 0.f, 0.f};
#pragma unroll
      for (int ks = 0; ks < 4; ++ks) {
        const bf16x8 qf = *(const bf16x8*)(sQ + (ta * 16 + fr) * 136 + ks * 32 + fq * 8);
        const bf16x8 sf = *(const bf16x8*)(sST + (tb * 16 + fr) * 136 + ks * 32 + fq * 8);
        oa = __builtin_amdgcn_mfma_f32_16x16x32_bf16(sf, qf, oa, 0, 0, 0);
      }
      const int i = ta * 16 + fr;
      oa *= __expf(sG[i]);
      const bf16x8 mf = *(const bf16x8*)(sM + i * 40 + fq * 8);
      const bf16x8 vf = *(const bf16x8*)(sVnT + (tb * 16 + fr) * 40 + fq * 8);
      oa = __builtin_amdgcn_mfma_f32_16x16x32_bf16(vf, mf, oa, 0, 0, 0);
      uint2 o; o.x = pack2(oa[0], oa[1]); o.y = pack2(oa[2], oa[3]);
      *(uint2*)(OUT + (size_t)gdn_rowof(b_l, dir, c * 32 + i) * 1024 + h * 128 + dvq * 32 + tb * 16 + fq * 4) = o;
    }
    {
      const bf16x8 vf = *(const bf16x8*)(sVnT + (ta * 16 + fr) * 40 + fq * 8);
#pragma unroll
      for (int t = 0; t < 4; ++t) {
        const bf16x8 kf = *(const bf16x8*)(sKdT + ((tb * 4 + t) * 16 + fr) * 40 + fq * 8);
        S[t] *= eglast;
        S[t] = __builtin_amdgcn_mfma_f32_16x16x32_bf16(kf, vf, S[t], 0, 0, 0);
      }
    }
    __syncthreads();
#pragma unroll
    for (int t = 0; t < 4; ++t) {
      uint2 o; o.x = pack2(S[t][0], S[t][1]); o.y = pack2(S[t][2], S[t][3]);
      *(uint2*)(sST + (ta * 16 + fr) * 136 + (tb * 4 + t) * 16 + fq * 4) = o;
    }
  };
  for (int c = 0; c < NCH; c += 2) {
    body(c);
    lstore(st0); gload(st0, c + 3);
    __syncthreads();
    body(c + 1);
    if (c + 2 < NCH) lstore(st1);
    gload(st1, c + 4);
    __syncthreads();
  }
}

__device__ __forceinline__ void ssd_chunk_item(const Params& p, int id, unsigned char* smraw) {
  const int tid = TIDX(), lane = tid & 63, w = tid >> 6, fr = lane & 15, fq = lane >> 4;
  const int b_l = id >> 6, head = (id >> 1) & 31, dir = id & 1, grp = head >> 2;
  bf16_t* sC = (bf16_t*)smraw;
  bf16_t* sB = sC + 32 * 136;
  bf16_t* sBT = sB + 32 * 136;
  bf16_t* sXT = sBT + 128 * 40;
  bf16_t* sM = sXT + 64 * 40;
  bf16_t* sST = sM + 32 * 40;
  float* sG = (float*)(sST + 64 * 136);
  const bf16_t* XBC = (const bf16_t*)(p.ws + OFF_XBC);
  const float* DTF = (const float*)(p.ws + OFF_DTF);
  bf16_t* OUT = (bf16_t*)(p.ws + (dir ? OFF_YB : OFF_YF));
  const int ltok = tid & 31, lpart = tid >> 5;
  struct Stage { u32x4 b0, b1, c0, c1, x; float dt, g, gl; };
  Stage st0, st1;
  constexpr int NCH = (256 + 8192) / 32;
  auto gload = [&](Stage& st, int c) __attribute__((always_inline)) {
    const int s0 = (c < NCH ? c : NCH - 1) * 32;
    const size_t row = (size_t)ssd_rowof(b_l, dir, s0 + ltok);
    const bf16_t* xr = XBC + row * 4096;
    st.b0 = *(const u32x4*)(xr + 2048 + grp * 128 + lpart * 8);
    st.b1 = *(const u32x4*)(xr + 2048 + grp * 128 + (lpart + 8) * 8);
    st.c0 = *(const u32x4*)(xr + 3072 + grp * 128 + lpart * 8);
    st.c1 = *(const u32x4*)(xr + 3072 + grp * 128 + (lpart + 8) * 8);
    st.x = *(const u32x4*)(xr + head * 64 + lpart * 8);
    st.dt = DTF[row * 128 + dir * 32 + head];
    st.g = DTF[row * 128 + 64 + dir * 32 + head];
    st.gl = DTF[(size_t)ssd_rowof(b_l, dir, s0 + 31) * 128 + 64 + dir * 32 + head];
  };
  auto lstore = [&](const Stage& st) __attribute__((always_inline)) {
    *(u32x4*)(sB + ltok * 136 + lpart * 8) = st.b0;
    *(u32x4*)(sB + ltok * 136 + (lpart + 8) * 8) = st.b1;
    *(u32x4*)(sC + ltok * 136 + lpart * 8) = st.c0;
    *(u32x4*)(sC + ltok * 136 + (lpart + 8) * 8) = st.c1;
    const float wj = __expf(st.gl - st.g);
    bf16_t* t0 = sBT + (lpart * 8) * 40 + ltok;
    bf16_t* t1 = sBT + ((lpart + 8) * 8) * 40 + ltok;
    bf16_t* tx = sXT + (lpart * 8) * 40 + ltok;
#pragma unroll
    for (int e = 0; e < 4; ++e) {
      t0[(2 * e) * 40] = f2bf(lo16(st.b0[e]) * wj); t0[(2 * e + 1) * 40] = f2bf(hi16(st.b0[e]) * wj);
      t1[(2 * e) * 40] = f2bf(lo16(st.b1[e]) * wj); t1[(2 * e + 1) * 40] = f2bf(hi16(st.b1[e]) * wj);
      tx[(2 * e) * 40] = f2bf(lo16(st.x[e]) * st.dt); tx[(2 * e + 1) * 40] = f2bf(hi16(st.x[e]) * st.dt);
    }
    if (tid < 32) sG[tid] = st.g;
  };
  f32x4 S[8];
#pragma unroll
  for (int i = 0; i < 8; ++i) S[i] = (f32x4){0.f, 0.f, 0.f, 0.f};
  __syncthreads();
  for (int i = lane; i < 16 * 136 / 2; i += 64) ((unsigned*)(sST + w * 16 * 136))[i] = 0u;
  gload(st0, 0); lstore(st0);
  __syncthreads();
  gload(st0, 1); gload(st1, 2);
  auto body = [&](int c) __attribute__((always_inline)) {
    {
      const int ti = w >> 1, tj = w & 1;
      f32x4 cb = (f32x4){0.f, 0.f, 0.f, 0.f};
      if (tj <= ti) {
#pragma unroll
        for (int ks = 0; ks < 4; ++ks) {
          const bf16x8 af = *(const bf16x8*)(sC + (ti * 16 + fr) * 136 + ks * 32 + fq * 8);
          const bf16x8 bf = *(const bf16x8*)(sB + (tj * 16 + fr) * 136 + ks * 32 + fq * 8);
          cb = __builtin_amdgcn_mfma_f32_16x16x32_bf16(bf, af, cb, 0, 0, 0);
        }
      }
      const int i = ti * 16 + fr, j0 = tj * 16 + fq * 4;
      const float gi = sG[i];
      float m[4];
#pragma unroll
      for (int r = 0; r < 4; ++r) { const int j = j0 + r; const float gj = sG[j]; m[r] = (j <= i) ? cb[r] * __expf(gi - gj) : 0.f; }
      uint2 o; o.x = pack2(m[0], m[1]); o.y = pack2(m[2], m[3]);
      *(uint2*)(sM + i * 40 + j0) = o;
    }
    __syncthreads();
    const bf16x8 xfrag = *(const bf16x8*)(sXT + (w * 16 + fr) * 40 + fq * 8);
    const float eglast = __expf(sG[31]);
#pragma unroll
    for (int ti = 0; ti < 2; ++ti) {
      f32x4 y = (f32x4){0.f, 0.f, 0.f, 0.f};
#pragma unroll
      for (int ks = 0; ks < 4; ++ks) {
        const bf16x8 af = *(const bf16x8*)(sC + (ti * 16 + fr) * 136 + ks * 32 + fq * 8);
        const bf16x8 bf = *(const bf16x8*)(sST + (w * 16 + fr) * 136 + ks * 32 + fq * 8);
        y = __builtin_amdgcn_mfma_f32_16x16x32_bf16(bf, af, y, 0, 0, 0);
      }
      const int i = ti * 16 + fr;
      const float eg = __expf(sG[i]);
      y *= eg;
      const bf16x8 mf = *(const bf16x8*)(sM + i * 40 + fq * 8);
      y = __builtin_amdgcn_mfma_f32_16x16x32_bf16(xfrag, mf, y, 0, 0, 0);
      uint2 o; o.x = pack2(y[0], y[1]); o.y = pack2(y[2], y[3]);
      *(uint2*)(OUT + (size_t)ssd_rowof(b_l, dir, c * 32 + i) * 2048 + head * 64 + w * 16 + fq * 4) = o;
    }
#pragma unroll
    for (int tn = 0; tn < 8; ++tn) {
      const bf16x8 bf = *(const bf16x8*)(sBT + (tn * 16 + fr) * 40 + fq * 8);
      S[tn] *= eglast;
      S[tn] = __builtin_amdgcn_mfma_f32_16x16x32_bf16(bf, xfrag, S[tn], 0, 0, 0);
    }
#pragma unroll
    for (int tn = 0; tn < 8; ++tn) {
      uint2 o; o.x = pack2(S[tn][0], S[tn][1]); o.y = pack2(S[tn][2], S[tn][3]);
      *(uint2*)(sST + (w * 16 + fr) * 136 + tn * 16 + fq * 4) = o;
    }
    __syncthreads();
  };
  for (int c = 0; c < NCH; c += 2) {
    body(c);
    lstore(st0); gload(st0, c + 3);
    __syncthreads();
    body(c + 1);
    if (c + 2 < NCH) lstore(st1);
    gload(st1, c + 4);
    __syncthreads();
  }
}

__device__ __forceinline__ void scan_phase(const Params& p, unsigned char* sm) {
  for (int item = BIDX(); item < 256; item += GDIM()) {
    if (item < 128) gdn_chunk_item(p, item, sm); else ssd_chunk_item(p, item - 128, sm);
    __syncthreads();
  }
}

__device__ __forceinline__ void gnorm_phase(const Params& p, int l, int M) {
  const bf16_t* P = (const bf16_t*)(p.ws + OFF_P);
  const bf16_t* OF = (const bf16_t*)(p.ws + OFF_OF); const bf16_t* OB = (const bf16_t*)(p.ws + OFF_OB);
  const bf16_t* YF = (const bf16_t*)(p.ws + OFF_YF); const bf16_t* YB = (const bf16_t*)(p.ws + OFF_YB);
  const bf16_t* XBC = (const bf16_t*)(p.ws + OFF_XBC);
  bf16_t* YA = (bf16_t*)(p.ws + OFF_QKV); bf16_t* YBn = YA + (size_t)MG * 1024;
  const int gtid = BIDX() * 256 + TIDX(), gsz = GDIM() * 256;
  const float* nw = p.gdn_norm_w + l * 128;
  for (int idx = gtid; idx < M * 128; idx += gsz) {
    const int r = idx >> 7, c8 = (idx & 127) * 8;
    const uint4 a = *(const uint4*)(OF + (size_t)r * 1024 + c8), b = *(const uint4*)(OB + (size_t)r * 1024 + c8);
    const uint4 gt = *(const uint4*)(P + (size_t)r * LDP + C_GOUT + c8);
    float fa[8], fb[8], fg[8]; UNPACK8(a, fa); UNPACK8(b, fb); UNPACK8(gt, fg);
    float ss = 0.f;
#pragma unroll
    for (int e = 0; e < 8; ++e) { fa[e] += fb[e]; ss += fa[e] * fa[e]; }
    ss += __shfl_xor(ss, 1); ss += __shfl_xor(ss, 2); ss += __shfl_xor(ss, 4); ss += __shfl_xor(ss, 8);
    const float rs = rsqrtf(ss * (1.f / 128.f) + 1e-6f);
    const float4 w0 = *(const float4*)(nw + (c8 & 127)), w1 = *(const float4*)(nw + (c8 & 127) + 4);
    const float wv[8] = {w0.x, w0.y, w0.z, w0.w, w1.x, w1.y, w1.z, w1.w};
#pragma unroll
    for (int e = 0; e < 8; ++e) fa[e] = fa[e] * rs * wv[e] * siluf_(fg[e]);
    *(uint4*)(YA + (size_t)r * 1024 + c8) = pack8(fa);
  }
  const float* sw = p.ssm_norm_w + l * 2048; const float* Dk = p.ssm_D + l * 32;
  for (int idx = gtid; idx < M * 256; idx += gsz) {
    const int r = idx >> 8, c8 = (idx & 255) * 8;
    const uint4 a = *(const uint4*)(YF + (size_t)r * 2048 + c8), b = *(const uint4*)(YB + (size_t)r * 2048 + c8);
    const uint4 xx = *(const uint4*)(XBC + (size_t)r * 4096 + c8);
    const uint4 zz = *(const uint4*)(P + (size_t)r * LDP + C_Z + c8);
    float fa[8], fb[8], fx[8], fz[8]; UNPACK8(a, fa); UNPACK8(b, fb); UNPACK8(xx, fx); UNPACK8(zz, fz);
    const float dsk = Dk[c8 >> 6];
    float ss = 0.f;
#pragma unroll
    for (int e = 0; e < 8; ++e) { fa[e] = (fa[e] + fb[e] + dsk * fx[e]) * siluf_(fz[e]); ss += fa[e] * fa[e]; }
    ss += __shfl_xor(ss, 1); ss += __shfl_xor(ss, 2); ss += __shfl_xor(ss, 4); ss += __shfl_xor(ss, 8); ss += __shfl_xor(ss, 16);
    const float rs = rsqrtf(ss * (1.f / 256.f) + 1e-6f);
    const float4 w0 = *(const float4*)(sw + c8), w1 = *(const float4*)(sw + c8 + 4);
    const float wv[8] = {w0.x, w0.y, w0.z, w0.w, w1.x, w1.y, w1.z, w1.w};
#pragma unroll
    for (int e = 0; e < 8; ++e) fa[e] = fa[e] * rs * wv[e];
    *(uint4*)(YBn + (size_t)r * 2048 + c8) = pack8(fa);
  }
}

#define XB_TMO      128
#define XB_XCNT(j)  (256  + 64 * (j))
#define XB_XSUB(j)  (1280 + 64 * (j))
#define XB_XGEN(j)  (2304 + 64 * (j))
#define XB_TOP      3328
#define XB_TOPGEN   3392
#define XCD_BAR_WORDS 3456
#define XB_SPIN_CAP (1u << 18)
#define LAS __attribute__((address_space(3)))

__device__ __forceinline__ unsigned xb_ld(unsigned* p)              { return __hip_atomic_load(p, __ATOMIC_RELAXED, __HIP_MEMORY_SCOPE_AGENT); }
__device__ __forceinline__ unsigned xb_add(unsigned* p, unsigned v) { return __hip_atomic_fetch_add(p, v, __ATOMIC_RELAXED, __HIP_MEMORY_SCOPE_AGENT); }
__device__ __forceinline__ unsigned xb_xcc_id() { return (unsigned)__builtin_amdgcn_s_getreg((3 << 11) | 20) & 0xFu; }
#define XB_SPIN(cond, bar) do { unsigned _sp = 0; while (cond) { __builtin_amdgcn_s_sleep(1); \
    if ((++_sp & 255u) == 0u) { if (xb_ld(&(bar)[XB_TMO])) break; if (_sp > XB_SPIN_CAP) { atomicAdd(&(bar)[XB_TMO], 1u); break; } } } } while (0)

struct XcdBarrier {
    unsigned* bar; unsigned x;
    volatile LAS unsigned* st;
};

__device__ __forceinline__ XcdBarrier xcd_barrier_post(unsigned* bar, volatile LAS unsigned* st) {
    XcdBarrier b; b.bar = bar; b.x = xb_xcc_id(); b.st = st;
    if (threadIdx.x == 0) (void)xb_add(&bar[XB_XCNT(b.x)], 1u);
    return b;
}
__device__ __forceinline__ void xcd_barrier_complete(unsigned* bar, unsigned x, unsigned& nloc, unsigned& nx) {
    const unsigned G = gridDim.x * gridDim.y * gridDim.z;
    unsigned sum, cnt, mine, sp = 0u;
    for (;;) {
        sum = 0u; cnt = 0u; mine = 0u;
#pragma unroll
        for (unsigned j = 0; j < 16; ++j) { const unsigned c = xb_ld(&bar[XB_XCNT(j)]); sum += c; cnt += (c > 0u) ? 1u : 0u; mine = (j == x) ? c : mine; }
        if (sum == G) break;
        __builtin_amdgcn_s_sleep(1);
        if ((++sp & 255u) == 0u) { if (xb_ld(&bar[XB_TMO])) break; if (sp > XB_SPIN_CAP) { atomicAdd(&bar[XB_TMO], 1u); break; } }
    }
    nloc = mine > 0u ? mine : 1u; nx = cnt > 0u ? cnt : 1u;
}

__device__ __forceinline__ void xcd_barrier(const XcdBarrier& b) {
    asm volatile("s_waitcnt vmcnt(0)" ::: "memory");
    __syncthreads();
    if (threadIdx.x == 0) {
        unsigned* bar = b.bar;
        __builtin_amdgcn_s_waitcnt(0);
        unsigned nloc = b.st[0], nx = b.st[1];
        if (nloc == 0u) { xcd_barrier_complete(bar, b.x, nloc, nx); b.st[0] = nloc; b.st[1] = nx; }
        const unsigned old = xb_add(&bar[XB_XSUB(b.x)], 1u);
        const unsigned gen = old / nloc;
        if (old + 1u == (gen + 1u) * nloc) {
            __builtin_amdgcn_fence(__ATOMIC_RELEASE, "agent");
            asm volatile("s_waitcnt vmcnt(0)" ::: "memory");
            const unsigned og = xb_add(&bar[XB_TOP], 1u);
            const unsigned tg = og / nx;
            if (og + 1u == (tg + 1u) * nx) xb_add(&bar[XB_TOPGEN], 1u);
            else XB_SPIN(xb_ld(&bar[XB_TOPGEN]) == tg, bar);
            __builtin_amdgcn_fence(__ATOMIC_ACQUIRE, "agent");
            xb_add(&bar[XB_XGEN(b.x)], 1u);
            asm volatile("s_waitcnt vmcnt(0)" ::: "memory");
        } else {
            XB_SPIN(xb_ld(&bar[XB_XGEN(b.x)]) == gen, bar);
            __builtin_amdgcn_fence(__ATOMIC_ACQUIRE, "agent");
            asm volatile("s_waitcnt vmcnt(0)" ::: "memory");
        }
    }
    __syncthreads();
}

#ifndef STOP_AFTER
#define STOP_AFTER 0
#endif
#define SYNC() { xcd_barrier(xb); if (++nsync == STOP_AFTER) return; }
#define PH(CALL) { CALL; }
__global__ void __launch_bounds__(256, 2) mega(Params p) {
  cg::grid_group grid = cg::this_grid();
  int nsync = 0;
  __shared__ __attribute__((aligned(16))) unsigned char smem[SMEM_BYTES];
  __shared__ uint4 xb_words;
  if (threadIdx.x == 0) xb_words = make_uint4(0u, 0u, 0u, 0u);
  __syncthreads();
  XcdBarrier xb = xcd_barrier_post((unsigned*)(p.ws + OFF_BAR), (volatile LAS unsigned*)&xb_words);
  float* smf = (float*)smem; bf16_t* smh = (bf16_t*)smem;
  for (int l = 0; l < 2; ++l) {
    PH(transpose_phase(p.w_in + (size_t)l * 1024 * IN_DIM, (bf16_t*)(p.ws + OFF_WIN), 1024, IN_DIM, LDP, smf))
    PH(transpose_phase(p.w_proj_gdn + (size_t)l * 1024 * 1024, (bf16_t*)(p.ws + OFF_WPG), 1024, 1024, 1024, smf))
    PH(transpose_phase(p.w_proj_ssm + (size_t)l * 2048 * 1024, (bf16_t*)(p.ws + OFF_WPS), 2048, 1024, 1024, smf))
    PH(transpose_phase(p.w_out + (size_t)l * 1024 * 1024, (bf16_t*)(p.ws + OFF_WOUT), 1024, 1024, 1024, smf))
    PH(transpose_phase(p.w_ff1 + (size_t)l * 1024 * 4096, (bf16_t*)(p.ws + OFF_WFF1), 1024, 4096, 4096, smf))
    PH(transpose_phase(p.w_ff2 + (size_t)l * 4096 * 1024, (bf16_t*)(p.ws + OFF_WFF2), 4096, 1024, 1024, smf))
    if (l == 0) { PH(modpart_phase(p, smf)) grid.sync(); PH(modfinal_phase(p)) }
    SYNC();
    const bool last = (l == 1);
    const int Mpost = last ? MLAT : MG;
    for (int g = 0; g < NGRP; ++g) {
      PH(modulate_phase(p, l, g)) SYNC();
      PH(gemm_inproj_phase(p, smh)) SYNC();
      PH(conv_phase(p, l)) SYNC();
      PH(gdn_prep_phase(p, smem)) SYNC();
      PH(scan_phase(p, smem)) SYNC();
      PH(gnorm_phase(p, l, Mpost)) SYNC();
      PH(gemm_proj_phase(p, Mpost, smh)) SYNC();
      PH(gemm_wout_phase(p, l, g, Mpost, smh)) SYNC();
      PH(ln_phase(p, l, g, Mpost, p.ln1_g + l * D, p.ln1_b + l * D, true)) SYNC();
      PH(gemm_ff1_phase(p, l, Mpost, smh)) SYNC();
      PH(gemm_ff2_phase(p, l, g, Mpost, smh)) SYNC();
      PH(ln_phase(p, l, g, Mpost, p.ln2_g + l * D, p.ln2_b + l * D, false)) SYNC();
    }
  }
}

extern "C" void kernel_launch(void* const* d_in, const int* in_sizes, int n_in, void* d_out, int out_size, void* d_ws, size_t ws_size,
                              hipStream_t stream) {
  static int grid_blocks = 0;
  if (!grid_blocks) {
    int dev = 0, cus = 0, per_cu = 0;
    (void)hipGetDevice(&dev);
    (void)hipDeviceGetAttribute(&cus, hipDeviceAttributeMultiprocessorCount, dev);
    (void)hipOccupancyMaxActiveBlocksPerMultiprocessor(&per_cu, mega, 256, 0);
    if (per_cu > 2) per_cu = 2;
    grid_blocks = cus * per_cu;
    if (ws_size < WS_TOTAL) fprintf(stderr, "workspace too small: %zu < %zu\n", ws_size, WS_TOTAL);
  }
  Params p{};
  const float** pp = (const float**)&p;
  for (int i = 0; i < 28; ++i) pp[i] = (const float*)d_in[i];
  p.out = (float*)d_out;
  p.ws = (unsigned char*)d_ws;
  (void)hipMemsetAsync((unsigned char*)d_ws + OFF_BAR, 0, 16384, stream);
  void* args[] = {&p};
  hipError_t e = hipLaunchCooperativeKernel((void*)mega, dim3(grid_blocks), dim3(256), args, 0, stream);
  if (e != hipSuccess) fprintf(stderr, "cooperative launch failed: %s (grid %d)\n", hipGetErrorString(e), grid_blocks);
}
```

```cpp
#include <hip/hip_runtime.h>
#include <hip/hip_cooperative_groups.h>
#include <cstdio>
namespace cg = cooperative_groups;

typedef unsigned short bf16_t;
typedef short bf16x8 __attribute__((ext_vector_type(8)));
typedef float f32x4 __attribute__((ext_vector_type(4)));
typedef float f32x2 __attribute__((ext_vector_type(2)));
typedef unsigned u32x4 __attribute__((ext_vector_type(4)));

constexpr int D = 1024, SEQ = 8192, LC = 256;
constexpr int G = 2, NGRP = 4;
constexpr int MLAT = G * SEQ, MCTX = G * LC, MG = MLAT + MCTX;
constexpr int IN_DIM = 12384, LDP = 12416;
constexpr int C_GOUT = 3072, C_A = 4096, C_B = 4112, C_Z = 4128, C_XBC = 6176, C_DT = 10272, C_GA = 10336, C_GB = 11360;
constexpr float DN_ALPHA = 1.4142135623730951f;

constexpr size_t SZ_WIN = (size_t)LDP * 1024 * 2;
constexpr size_t OFF_WIN = 0;
constexpr size_t OFF_WPG = OFF_WIN + SZ_WIN;
constexpr size_t OFF_WPS = OFF_WPG + 2097152;
constexpr size_t OFF_WOUT = OFF_WPS + 4194304;
constexpr size_t OFF_WFF1 = OFF_WOUT + 2097152;
constexpr size_t OFF_WFF2 = OFF_WFF1 + 8388608;
constexpr size_t OFF_MODP = OFF_WFF2 + 8388608;
constexpr size_t OFF_MOD = OFF_MODP + (size_t)2 * 16 * 9 * 6144 * 4;
constexpr size_t OFF_XSC = OFF_MOD + (size_t)2 * 9 * 6144 * 4;
constexpr size_t OFF_H = OFF_XSC + (size_t)2048 * 1024 * 4;
constexpr size_t OFF_P = OFF_H + (size_t)MG * 1024 * 2;
constexpr size_t OFF_QKV = OFF_P + (size_t)MG * LDP * 2;
constexpr size_t OFF_XBC = OFF_QKV + (size_t)MG * 3072 * 2;
constexpr size_t OFF_GBF = OFF_XBC + (size_t)MG * 4096 * 2;
constexpr size_t OFF_DTF = OFF_GBF + (size_t)MG * 32 * 4;
constexpr size_t OFF_OF = OFF_DTF + (size_t)MG * 128 * 4;
constexpr size_t OFF_OB = OFF_OF + (size_t)MG * 1024 * 2;
constexpr size_t OFF_YF = OFF_OB + (size_t)MG * 1024 * 2;
constexpr size_t OFF_YB = OFF_YF + (size_t)MG * 2048 * 2;
constexpr size_t OFF_TMB = OFF_YB + (size_t)MG * 2048 * 2;
constexpr int GDN_NITEM = G * 8 * 2 * 264;
constexpr size_t OFF_BAR = OFF_TMB + (size_t)GDN_NITEM * 2048 * 2;
constexpr size_t WS_TOTAL = OFF_BAR + 16384;
static_assert(WS_TOTAL <= ((size_t)1024 << 20), "workspace plan exceeds 1 GiB");

struct Params {
  const float *x, *c, *ctx, *c_ctx, *w_mod, *b_mod, *w_in, *gdn_conv_w, *gdn_A_log, *gdn_dt_bias, *gdn_norm_w;
  const float *ssm_conv_w, *ssm_conv_b, *ssm_A_log, *ssm_dt_bias, *ssm_D, *ssm_norm_w, *w_proj_gdn, *w_proj_ssm, *w_out;
  const float *ln1_g, *ln1_b, *w_ff1, *b_ff1, *w_ff2, *b_ff2, *ln2_g, *ln2_b;
  float* out;
  unsigned char* ws;
};

constexpr int SMEM_BYTES = 73728;


__device__ __forceinline__ int TIDX() { int t = threadIdx.x; asm volatile("" : "+v"(t)); return t; }
__device__ __forceinline__ int BIDX() { int t = blockIdx.x; asm volatile("" : "+s"(t)); return t; }
__device__ __forceinline__ int GDIM() { int t = gridDim.x; asm volatile("" : "+s"(t)); return t; }
__device__ __forceinline__ float bf2f(bf16_t b) { return __uint_as_float(((unsigned)b) << 16); }
__device__ __forceinline__ bf16_t f2bf(float f) { unsigned u = __float_as_uint(f); u += 0x7fffu + ((u >> 16) & 1u); return (bf16_t)(u >> 16); }
typedef __bf16 bf16v2 __attribute__((ext_vector_type(2)));
__device__ __forceinline__ unsigned pack2(float a, float b) { const f32x2 v = (f32x2){a, b}; const bf16v2 h = __builtin_convertvector(v, bf16v2); return __builtin_bit_cast(unsigned, h); }
__device__ __forceinline__ float lo16(unsigned v) { return __uint_as_float(v << 16); }
__device__ __forceinline__ float hi16(unsigned v) { return __uint_as_float(v & 0xffff0000u); }
#define UNPACK8(v, f) { f[0] = lo16(v.x); f[1] = hi16(v.x); f[2] = lo16(v.y); f[3] = hi16(v.y); f[4] = lo16(v.z); f[5] = hi16(v.z); f[6] = lo16(v.w); f[7] = hi16(v.w); }
__device__ __forceinline__ uint4 pack8(const float* f) { uint4 r; r.x = pack2(f[0], f[1]); r.y = pack2(f[2], f[3]); r.z = pack2(f[4], f[5]); r.w = pack2(f[6], f[7]); return r; }
__device__ __forceinline__ float sigmoidf_(float x) { return __builtin_amdgcn_rcpf(1.f + __expf(-x)); }
__device__ __forceinline__ float siluf_(float x) { return x * __builtin_amdgcn_rcpf(1.f + __expf(-x)); }
__device__ __forceinline__ float softplusf_(float x) { return x > 20.f ? x : log1pf(__expf(x)); }
template <int CTRL> __device__ __forceinline__ float dppf(float x) { return __builtin_bit_cast(float, __builtin_amdgcn_mov_dpp(__builtin_bit_cast(int, x), CTRL, 0xf, 0xf, true)); }
__device__ __forceinline__ float reduce16(float x) { x += dppf<0xB1>(x); x += dppf<0x4E>(x); x += dppf<0x141>(x); x += dppf<0x140>(x); return x; }

__device__ __forceinline__ float* xs_row(const Params& p, int g, int r) {
  return (r < MLAT) ? p.out + ((size_t)g * MLAT + r) * D : (float*)(p.ws + OFF_XSC) + ((size_t)g * MCTX + (r - MLAT)) * D;
}
__device__ __forceinline__ const float* xin_row(const Params& p, int l, int g, int r) {
  if (l == 0) return (r < MLAT) ? p.x + ((size_t)g * MLAT + r) * D : p.ctx + ((size_t)g * MCTX + (r - MLAT)) * D;
  return xs_row(p, g, r);
}
__device__ __forceinline__ int mod_row(int g, int r) { return r < MLAT ? g * G + r / SEQ : 8; }
__device__ __forceinline__ int gdn_rowof(int b_l, int dir, int s) {
  if (s < 256) { const int i = dir ? 255 - s : s; return MLAT + b_l * 256 + i; }
  const int i = s - 256; return b_l * 8192 + (dir ? 8191 - i : i);
}
__device__ __forceinline__ int ssd_rowof(int b_l, int dir, int s) {
  if (s < 256) { const int i = dir ? 255 - s : s; return MLAT + b_l * 256 + i; }
  const int j = s - 256; const int pos = dir ? 8191 - j : j; return b_l * 8192 + (pos & 127) * 64 + (pos >> 7);
}

__device__ __forceinline__ void transpose_phase(const float* __restrict__ src, bf16_t* __restrict__ dst, int K, int N, int Npad, float* tile) {
  const int tid = TIDX(), tk = K / 64, tn = Npad / 64;
  const int c = tid & 63, r4 = tid >> 6;
  for (int t = BIDX(); t < tk * tn; t += GDIM()) {
    const int kt = t % tk, nt = t / tk, k0 = kt * 64, n0 = nt * 64;
    __syncthreads();
#pragma unroll 4
    for (int i = 0; i < 16; ++i) { const int r = i * 4 + r4, n = n0 + c; tile[r * 65 + c] = (n < N) ? src[(size_t)(k0 + r) * N + n] : 0.f; }
    __syncthreads();
#pragma unroll 4
    for (int i = 0; i < 16; ++i) { const int nn = i * 4 + r4; dst[(size_t)(n0 + nn) * K + k0 + c] = f2bf(tile[c * 65 + nn]); }
  }
}

__device__ __forceinline__ void modpart_phase(const Params& p, float* sm) {
  const int tid = TIDX();
  float* MODP = (float*)(p.ws + OFF_MODP);
  for (int item = BIDX(); item < 2 * 24 * 16; item += GDIM()) {
    const int l = item / 384, rem = item % 384, cbk = rem / 16, ks = rem % 16;
    __syncthreads();
    for (int i = tid; i < 9 * 64; i += 256) { const int r = i / 64, k = ks * 64 + (i % 64); const float v = (r < 8) ? p.c[r * D + k] : p.c_ctx[k]; sm[i] = siluf_(v); }
    __syncthreads();
    const int col = cbk * 256 + tid;
    float acc[9];
#pragma unroll
    for (int r = 0; r < 9; ++r) acc[r] = 0.f;
    const float* wp = p.w_mod + ((size_t)l * D + ks * 64) * 6144 + col;
#pragma unroll 8
    for (int k = 0; k < 64; ++k) { const float w = wp[(size_t)k * 6144];
#pragma unroll
      for (int r = 0; r < 9; ++r) acc[r] += sm[r * 64 + k] * w; }
#pragma unroll
    for (int r = 0; r < 9; ++r) MODP[(((size_t)l * 16 + ks) * 9 + r) * 6144 + col] = acc[r];
  }
}
__device__ __forceinline__ void modfinal_phase(const Params& p) {
  const float* MODP = (const float*)(p.ws + OFF_MODP);
  float* MOD = (float*)(p.ws + OFF_MOD);
  for (int i = BIDX() * 256 + TIDX(); i < 2 * 9 * 6144; i += GDIM() * 256) {
    const int l = i / (9 * 6144), rem = i % (9 * 6144), col = rem % 6144;
    float s = p.b_mod[l * 6144 + col];
    for (int ks = 0; ks < 16; ++ks) s += MODP[((size_t)l * 16 + ks) * 9 * 6144 + rem];
    MOD[i] = s;
  }
}

__device__ __forceinline__ void modulate_phase(const Params& p, int l, int g) {
  const float* MOD = (const float*)(p.ws + OFF_MOD) + (size_t)l * 9 * 6144;
  bf16_t* H = (bf16_t*)(p.ws + OFF_H);
  for (int i = BIDX() * 256 + TIDX(); i < MG * 128; i += GDIM() * 256) {
    const int r = i >> 7, ch = (i & 127) * 8;
    const float* xr = xin_row(p, l, g, r) + ch;
    const float* m = MOD + (size_t)mod_row(g, r) * 6144;
    const float4 x0 = *(const float4*)xr, x1 = *(const float4*)(xr + 4);
    const float4 sh0 = *(const float4*)(m + ch), sh1 = *(const float4*)(m + ch + 4);
    const float4 sc0 = *(const float4*)(m + 1024 + ch), sc1 = *(const float4*)(m + 1024 + ch + 4);
    float f[8] = {x0.x * (1.f + sc0.x) + sh0.x, x0.y * (1.f + sc0.y) + sh0.y, x0.z * (1.f + sc0.z) + sh0.z, x0.w * (1.f + sc0.w) + sh0.w,
                  x1.x * (1.f + sc1.x) + sh1.x, x1.y * (1.f + sc1.y) + sh1.y, x1.z * (1.f + sc1.z) + sh1.z, x1.w * (1.f + sc1.w) + sh1.w};
    *(uint4*)(H + (size_t)r * D + ch) = pack8(f);
  }
}

struct Seg { const bf16_t* ap; const bf16_t* bp; int lda, ldb, nk; };

__device__ __forceinline__ bool tile_coord_sub(int it, int nM, int nN, int nb, int v, int& mt, int& nt) {
  long s;
  if ((nb & 7) == 0) { const int per = nb >> 3; s = (long)it * nb + (v & 7) * per + (v >> 3); } else s = (long)it * nb + v;
  if (s >= (long)nM * nN) return false;
  const int band = (int)(s / (8 * nN)), r = (int)(s - (long)band * 8 * nN);
  const int bsz = (nM - band * 8) < 8 ? (nM - band * 8) : 8;
  nt = r / bsz; mt = band * 8 + (r % bsz);
  return true;
}
__device__ __forceinline__ bool tile_coord(int it, int nM, int nN, int& mt, int& nt) { return tile_coord_sub(it, nM, nN, GDIM(), BIDX(), mt, nt); }
__device__ __forceinline__ int inproj_ntile(int part, int e) {
  if (part == 0) return e < 24 ? e : (e == 24 ? 32 : 23 + e);
  return e < 8 ? 24 + e : (e < 23 ? 25 + e : 58 + e);
}

#define ZERO_ACC(acc) { _Pragma("unroll") for (int i_ = 0; i_ < 4; ++i_) { _Pragma("unroll") for (int j_ = 0; j_ < 4; ++j_) acc[i_][j_] = (f32x4){0.f, 0.f, 0.f, 0.f}; } }
#define EPI_LOOP(...) { const int lane_ = TIDX() & 63, w_ = TIDX() >> 6; \
  _Pragma("unroll") for (int i_ = 0; i_ < 4; ++i_) { const int row = m0 + (w_ >> 1) * 64 + i_ * 16 + (lane_ & 15); \
  _Pragma("unroll") for (int j_ = 0; j_ < 4; ++j_) { const int col = n0 + (w_ & 1) * 64 + j_ * 16 + (lane_ >> 4) * 4; f32x4& v = acc[i_][j_]; __VA_ARGS__ } } }

template <class Prob>
__device__ __forceinline__ void gemm_stream(Prob& pr, bf16_t* sm) {
  const int tid = TIDX(), lane = tid & 63, w = tid >> 6, wr = w >> 1, wc = w & 1;
  const int lr = tid >> 3, lk = (tid & 7) * 8;
  const int fr = lane & 15, fq = lane >> 4;
  const int aoff = (wr * 64 + fr) * 72 + fq * 8, boff = 9216 + (wc * 64 + fr) * 72 + fq * 8;
  const int soff = lr * 72 + lk;
  Seg cur, nxt;
  if (!pr.seg(0, cur, lr, lk)) return;
  bool has_nxt = pr.seg(1, nxt, lr, lk);
  u32x4 r0a[4], r0b[4], r1a[4], r1b[4];
#pragma unroll
  for (int i = 0; i < 4; ++i) { r0a[i] = (u32x4){0u, 0u, 0u, 0u}; r0b[i] = r0a[i]; r1a[i] = r0a[i]; r1b[i] = r0a[i]; }
  f32x4 acc[4][4];
#define GS_LOAD(RA, RB, KT) { const int kt_ = (KT); const bf16_t* ap_ = cur.ap; const bf16_t* bp_ = cur.bp; int lda_ = cur.lda, ldb_ = cur.ldb; \
    if (kt_ < cur.nk) { ap_ += kt_ * 64; bp_ += kt_ * 64; } \
    else if (has_nxt) { ap_ = nxt.ap + (kt_ - cur.nk) * 64; bp_ = nxt.bp + (kt_ - cur.nk) * 64; lda_ = nxt.lda; ldb_ = nxt.ldb; } \
      \
    _Pragma("unroll") for (int i = 0; i < 4; ++i) { RA[i] = *(const u32x4*)(ap_ + (size_t)i * 32 * lda_); RB[i] = *(const u32x4*)(bp_ + (size_t)i * 32 * ldb_); } }
#define GS_STORE(RA, RB, KT, STAGE) { bf16_t* st_ = (STAGE) + soff; \
    _Pragma("unroll") for (int i = 0; i < 4; ++i) { *(u32x4*)(st_ + i * 32 * 72) = RA[i]; *(u32x4*)(st_ + 9216 + i * 32 * 72) = RB[i]; } }
#define GS_COMPUTE(STAGE) { const bf16_t* cs_ = (STAGE); _Pragma("unroll") for (int kk = 0; kk < 2; ++kk) { bf16x8 af[4], bfr[4]; \
    _Pragma("unroll") for (int i = 0; i < 4; ++i) { af[i] = *(const bf16x8*)(cs_ + aoff + i * 16 * 72 + kk * 32); bfr[i] = *(const bf16x8*)(cs_ + boff + i * 16 * 72 + kk * 32); } \
    _Pragma("unroll") for (int i = 0; i < 4; ++i) { _Pragma("unroll") for (int j = 0; j < 4; ++j) acc[i][j] = __builtin_amdgcn_mfma_f32_16x16x32_bf16(bfr[j], af[i], acc[i][j], 0, 0, 0); } } }
  GS_LOAD(r0a, r0b, 0)
  __syncthreads();
  GS_STORE(r0a, r0b, 0, sm)
  __syncthreads();
  GS_LOAD(r0a, r0b, 1)
  __builtin_amdgcn_sched_barrier(0);
  GS_LOAD(r1a, r1b, 2)
  __builtin_amdgcn_sched_barrier(0);
  for (int idx = 0;; ++idx) {
    pr.begin(idx, acc);
    for (int kt = 0; kt < cur.nk; kt += 2) {
      GS_COMPUTE(sm)
      GS_STORE(r0a, r0b, kt + 1, sm + 18432)
      GS_LOAD(r0a, r0b, kt + 3)
      __syncthreads();
      GS_COMPUTE(sm + 18432)
      GS_STORE(r1a, r1b, kt + 2, sm)
      GS_LOAD(r1a, r1b, kt + 4)
      __syncthreads();
    }
    pr.end(idx, acc);
    if (!has_nxt) break;
    cur = nxt; has_nxt = pr.seg(idx + 2, nxt, lr, lk);
  }
#undef GS_LOAD
#undef GS_STORE
#undef GS_COMPUTE
}

__device__ __forceinline__ void gemm_inproj_phase(const Params& p, bf16_t* sm, int part, int nb, int v) {
  struct Pr {
    const bf16_t* A; const bf16_t* W; bf16_t* P; int nM, nN, part, nb, v;
    __device__ bool seg(int idx, Seg& s, int lr, int lk) const { int mt, e; if (!tile_coord_sub(idx, nM, nN, nb, v, mt, e)) return false; const int nt = inproj_ntile(part, e);
      s.ap = A + (size_t)(mt * 128 + lr) * D + lk; s.bp = W + (size_t)(nt * 128 + lr) * D + lk; s.lda = D; s.ldb = D; s.nk = 16; return true; }
    __device__ void begin(int, f32x4 (&acc)[4][4]) const { ZERO_ACC(acc) }
    __device__ void end(int idx, f32x4 (&acc)[4][4]) const { int mt, e; tile_coord_sub(idx, nM, nN, nb, v, mt, e); const int m0 = mt * 128, n0 = inproj_ntile(part, e) * 128;
      EPI_LOOP({ uint2 o; o.x = pack2(v[0], v[1]); o.y = pack2(v[2], v[3]); *(uint2*)(P + (size_t)row * LDP + col) = o; }) }
  } pr{(const bf16_t*)(p.ws + OFF_H), (const bf16_t*)(p.ws + OFF_WIN), (bf16_t*)(p.ws + OFF_P), MG / 128, part == 0 ? 58 : 39, part, nb, v};
  gemm_stream(pr, sm);
}
__device__ __forceinline__ void gemm_proj_phase(const Params& p, int M, bf16_t* sm) {
  struct Pr {
    const bf16_t* YA; const bf16_t* YBn; const bf16_t* Wg; const bf16_t* Ws; const bf16_t* P; bf16_t* U; int nM, nN;
    __device__ bool seg(int idx, Seg& s, int lr, int lk) const { int mt, nt; if (!tile_coord(idx >> 1, nM, nN, mt, nt)) return false;
      if ((idx & 1) == 0) { s.ap = YA + (size_t)(mt * 128 + lr) * 1024 + lk; s.bp = Wg + (size_t)(nt * 128 + lr) * 1024 + lk; s.lda = 1024; s.ldb = 1024; s.nk = 16; }
      else { s.ap = YBn + (size_t)(mt * 128 + lr) * 2048 + lk; s.bp = Ws + (size_t)(nt * 128 + lr) * 2048 + lk; s.lda = 2048; s.ldb = 2048; s.nk = 32; }
      return true; }
    __device__ void begin(int idx, f32x4 (&acc)[4][4]) const { if ((idx & 1) == 0) ZERO_ACC(acc) }
    __device__ void end(int idx, f32x4 (&acc)[4][4]) const { int mt, nt; tile_coord(idx >> 1, nM, nN, mt, nt); const int m0 = mt * 128, n0 = nt * 128;
      if ((idx & 1) == 0) {
        EPI_LOOP({ const uint2 ga = *(const uint2*)(P + (size_t)row * LDP + C_GA + col); const uint2 gb = *(const uint2*)(P + (size_t)row * LDP + C_GB + col);
          v[0] *= (1.f + __expf(-lo16(gb.x))) / (1.f + __expf(-lo16(ga.x))); v[1] *= (1.f + __expf(-hi16(gb.x))) / (1.f + __expf(-hi16(ga.x)));
          v[2] *= (1.f + __expf(-lo16(gb.y))) / (1.f + __expf(-lo16(ga.y))); v[3] *= (1.f + __expf(-hi16(gb.y))) / (1.f + __expf(-hi16(ga.y))); })
      } else {
        EPI_LOOP({ const uint2 gb = *(const uint2*)(P + (size_t)row * LDP + C_GB + col);
          uint2 o; o.x = pack2(v[0] * sigmoidf_(lo16(gb.x)), v[1] * sigmoidf_(hi16(gb.x))); o.y = pack2(v[2] * sigmoidf_(lo16(gb.y)), v[3] * sigmoidf_(hi16(gb.y)));
          *(uint2*)(U + (size_t)row * D + col) = o; })
      } }
  } pr{(const bf16_t*)(p.ws + OFF_QKV), (const bf16_t*)(p.ws + OFF_QKV) + (size_t)MG * 1024, (const bf16_t*)(p.ws + OFF_WPG), (const bf16_t*)(p.ws + OFF_WPS),
       (const bf16_t*)(p.ws + OFF_P), (bf16_t*)(p.ws + OFF_H), M / 128, 8};
  gemm_stream(pr, sm);
}
__device__ __forceinline__ void gemm_wout_phase(const Params& p, int l, int g, int M, bf16_t* sm) {
  struct Pr {
    const Params& p; int l, g; const bf16_t* U; const bf16_t* W; const float* MOD; int nM, nN;
    __device__ bool seg(int idx, Seg& s, int lr, int lk) const { int mt, nt; if (!tile_coord(idx, nM, nN, mt, nt)) return false;
      s.ap = U + (size_t)(mt * 128 + lr) * D + lk; s.bp = W + (size_t)(nt * 128 + lr) * D + lk; s.lda = D; s.ldb = D; s.nk = 16; return true; }
    __device__ void begin(int, f32x4 (&acc)[4][4]) const { ZERO_ACC(acc) }
    __device__ void end(int idx, f32x4 (&acc)[4][4]) const { int mt, nt; tile_coord(idx, nM, nN, mt, nt); const int m0 = mt * 128, n0 = nt * 128;
      EPI_LOOP({ const float4 xr = *(const float4*)(xin_row(p, l, g, row) + col); const float4 g1 = *(const float4*)(MOD + (size_t)mod_row(g, row) * 6144 + 2048 + col);
        float4 o; o.x = DN_ALPHA * xr.x + g1.x * v[0]; o.y = DN_ALPHA * xr.y + g1.y * v[1]; o.z = DN_ALPHA * xr.z + g1.z * v[2]; o.w = DN_ALPHA * xr.w + g1.w * v[3];
        *(float4*)(xs_row(p, g, row) + col) = o; }) }
  } pr{p, l, g, (const bf16_t*)(p.ws + OFF_H), (const bf16_t*)(p.ws + OFF_WOUT), (const float*)(p.ws + OFF_MOD) + (size_t)l * 9 * 6144, M / 128, 8};
  gemm_stream(pr, sm);
}
__device__ __forceinline__ void gemm_ff1_phase(const Params& p, int l, int M, bf16_t* sm) {
  struct Pr {
    const bf16_t* H; const bf16_t* W; bf16_t* HID; const float* b1; int nM, nN;
    __device__ bool seg(int idx, Seg& s, int lr, int lk) const { int mt, nt; if (!tile_coord(idx, nM, nN, mt, nt)) return false;
      s.ap = H + (size_t)(mt * 128 + lr) * D + lk; s.bp = W + (size_t)(nt * 128 + lr) * D + lk; s.lda = D; s.ldb = D; s.nk = 16; return true; }
    __device__ void begin(int, f32x4 (&acc)[4][4]) const { ZERO_ACC(acc) }
    __device__ void end(int idx, f32x4 (&acc)[4][4]) const { int mt, nt; tile_coord(idx, nM, nN, mt, nt); const int m0 = mt * 128, n0 = nt * 128;
      EPI_LOOP({ const float4 b = *(const float4*)(b1 + col);
        float t0 = fmaxf(v[0] + b.x, 0.f), t1 = fmaxf(v[1] + b.y, 0.f), t2 = fmaxf(v[2] + b.z, 0.f), t3 = fmaxf(v[3] + b.w, 0.f);
        uint2 o; o.x = pack2(t0 * t0, t1 * t1); o.y = pack2(t2 * t2, t3 * t3); *(uint2*)(HID + (size_t)row * 4096 + col) = o; }) }
  } pr{(const bf16_t*)(p.ws + OFF_H), (const bf16_t*)(p.ws + OFF_WFF1), (bf16_t*)(p.ws + OFF_P), p.b_ff1 + (size_t)l * 4096, M / 128, 32};
  gemm_stream(pr, sm);
}
__device__ __forceinline__ void gemm_ff2_phase(const Params& p, int l, int g, int M, bf16_t* sm) {
  struct Pr {
    const Params& p; int g; const bf16_t* HID; const bf16_t* W; const float* MOD; const float* b2; int nM, nN;
    __device__ bool seg(int idx, Seg& s, int lr, int lk) const { int mt, nt; if (!tile_coord(idx, nM, nN, mt, nt)) return false;
      s.ap = HID + (size_t)(mt * 128 + lr) * 4096 + lk; s.bp = W + (size_t)(nt * 128 + lr) * 4096 + lk; s.lda = 4096; s.ldb = 4096; s.nk = 64; return true; }
    __device__ void begin(int, f32x4 (&acc)[4][4]) const { ZERO_ACC(acc) }
    __device__ void end(int idx, f32x4 (&acc)[4][4]) const { int mt, nt; tile_coord(idx, nM, nN, mt, nt); const int m0 = mt * 128, n0 = nt * 128;
      EPI_LOOP({ float* xp = xs_row(p, g, row) + col; const float4 xr = *(const float4*)xp; const float4 b = *(const float4*)(b2 + col);
        const float4 g2 = *(const float4*)(MOD + (size_t)mod_row(g, row) * 6144 + 5120 + col);
        float4 o; o.x = DN_ALPHA * xr.x + g2.x * (v[0] + b.x); o.y = DN_ALPHA * xr.y + g2.y * (v[1] + b.y); o.z = DN_ALPHA * xr.z + g2.z * (v[2] + b.z); o.w = DN_ALPHA * xr.w + g2.w * (v[3] + b.w);
        *(float4*)xp = o; }) }
  } pr{p, g, (const bf16_t*)(p.ws + OFF_P), (const bf16_t*)(p.ws + OFF_WFF2), (const float*)(p.ws + OFF_MOD) + (size_t)l * 9 * 6144, p.b_ff2 + (size_t)l * 1024, M / 128, 8};
  gemm_stream(pr, sm);
}

__device__ __forceinline__ void ln_phase(const Params& p, int l, int g, int M, const float* gam, const float* bet, bool write_h2) {
  const int lane = TIDX() & 63;
  const float* MOD = (const float*)(p.ws + OFF_MOD) + (size_t)l * 9 * 6144;
  bf16_t* H = (bf16_t*)(p.ws + OFF_H);
  for (int r = BIDX() * 4 + (TIDX() >> 6); r < M; r += GDIM() * 4) {
    float* xr = xs_row(p, g, r);
    float4 v[4];
    float s = 0.f;
#pragma unroll
    for (int i = 0; i < 4; ++i) { v[i] = *(const float4*)(xr + (i * 64 + lane) * 4); s += v[i].x + v[i].y + v[i].z + v[i].w; }
#pragma unroll
    for (int o = 32; o >= 1; o >>= 1) s += __shfl_xor(s, o);
    const float mu = s * (1.f / 1024.f);
    float q = 0.f;
#pragma unroll
    for (int i = 0; i < 4; ++i) { v[i].x -= mu; v[i].y -= mu; v[i].z -= mu; v[i].w -= mu; q += v[i].x * v[i].x + v[i].y * v[i].y + v[i].z * v[i].z + v[i].w * v[i].w; }
#pragma unroll
    for (int o = 32; o >= 1; o >>= 1) q += __shfl_xor(q, o);
    const float rs = rsqrtf(q * (1.f / 1024.f) + 1e-5f);
    const float* m = MOD + (size_t)mod_row(g, r) * 6144;
#pragma unroll
    for (int i = 0; i < 4; ++i) {
      const int ch = (i * 64 + lane) * 4;
      const float4 gg = *(const float4*)(gam + ch), bb = *(const float4*)(bet + ch);
      float4 o; o.x = v[i].x * rs * gg.x + bb.x; o.y = v[i].y * rs * gg.y + bb.y; o.z = v[i].z * rs * gg.z + bb.z; o.w = v[i].w * rs * gg.w + bb.w;
      *(float4*)(xr + ch) = o;
      if (write_h2) {
        const float4 sh = *(const float4*)(m + 3072 + ch), sc = *(const float4*)(m + 4096 + ch);
        uint2 h; h.x = pack2(o.x * (1.f + sc.x) + sh.x, o.y * (1.f + sc.y) + sh.y); h.y = pack2(o.z * (1.f + sc.z) + sh.z, o.w * (1.f + sc.w) + sh.w);
        *(uint2*)(H + (size_t)r * D + ch) = h;
      }
    }
  }
}

__device__ __forceinline__ void conv_phase(const Params& p, int l) {
  const bf16_t* P = (const bf16_t*)(p.ws + OFF_P);
  bf16_t* QKV = (bf16_t*)(p.ws + OFF_QKV); bf16_t* XBC = (bf16_t*)(p.ws + OFF_XBC);
  float* GBF = (float*)(p.ws + OFF_GBF); float* DTF = (float*)(p.ws + OFF_DTF);
  const int nb = GDIM(), bid = BIDX(), tid = TIDX();
  const int vb = ((nb & 7) == 0) ? (bid & 7) * (nb >> 3) + (bid >> 3) : bid;
  const int gtid = vb * 256 + tid, gsz = nb * 256;
  {
    const float* cw = p.gdn_conv_w + (size_t)l * 5 * 3072;
    const int c = tid & 127, hh = tid >> 7;
    for (int item = vb; item < (MG / 32) * 3; item += nb) {
      const int third = item % 3, pp = item / 3;
      const int ch0 = third * 1024 + c * 8;
      const int t0 = (pp * 2 + hh) * 16;
      int lo, hi;
      if (t0 < MLAT) { lo = t0 & ~63; hi = lo + 64; } else { lo = MLAT + ((t0 - MLAT) & ~255); hi = lo + 256; }
      u32x4 raw[20];
#pragma unroll
      for (int i = 0; i < 20; ++i) { const int row = t0 - 2 + i; raw[i] = (row >= lo && row < hi) ? *(const u32x4*)(P + (size_t)row * LDP + ch0) : (u32x4){0u, 0u, 0u, 0u}; }
      float wt[5][8];
#pragma unroll
      for (int j = 0; j < 5; ++j) { const float4 w0 = *(const float4*)(cw + j * 3072 + ch0), w1 = *(const float4*)(cw + j * 3072 + ch0 + 4);
        wt[j][0] = w0.x; wt[j][1] = w0.y; wt[j][2] = w0.z; wt[j][3] = w0.w; wt[j][4] = w1.x; wt[j][5] = w1.y; wt[j][6] = w1.z; wt[j][7] = w1.w; }
      const float qsc = (third == 0) ? 0.08838834764831845f : 1.f;
#pragma unroll
      for (int t = 0; t < 16; ++t) {
        float acc[8];
#pragma unroll
        for (int e = 0; e < 8; ++e) acc[e] = 0.f;
#pragma unroll
        for (int j = 0; j < 5; ++j) {
          const u32x4 rw = raw[t + j];
#pragma unroll
          for (int e = 0; e < 4; ++e) { acc[2 * e] += lo16(rw[e]) * wt[j][2 * e]; acc[2 * e + 1] += hi16(rw[e]) * wt[j][2 * e + 1]; }
        }
        float ss = 0.f;
#pragma unroll
        for (int e = 0; e < 8; ++e) { acc[e] = siluf_(acc[e]); ss += acc[e] * acc[e]; }
        ss += __shfl_xor(ss, 1); ss += __shfl_xor(ss, 2); ss += __shfl_xor(ss, 4); ss += __shfl_xor(ss, 8);
        const float sc = (third < 2) ? rsqrtf(ss + 1e-6f) * qsc : 1.f;
#pragma unroll
        for (int e = 0; e < 8; ++e) acc[e] *= sc;
        *(uint4*)(QKV + (size_t)(t0 + t) * 3072 + ch0) = pack8(acc);
      }
    }
  }
  {
    const float* sw = p.ssm_conv_w + (size_t)l * 5 * 4096; const float* sb = p.ssm_conv_b + (size_t)l * 4096;
    constexpr int nLat = G * 64 * 8 * 2, nCtx = (MCTX / 16) * 2;
    float wt[5][8], bs[8];
    int cur_half = -1;
    for (int item = vb; item < nLat + nCtx; item += nb) {
      int half, base, stride, p0, seglen;
      if (item < nLat) { half = item & 1; const int piece = (item >> 1) & 7, cl = (item >> 4) & 63, b_l = item >> 10; base = b_l * 8192 + cl; stride = 64; p0 = piece * 16; seglen = 128; }
      else { const int i2 = item - nLat; half = i2 & 1; const int piece = i2 >> 1; base = MLAT + (piece >> 4) * 256; stride = 1; p0 = (piece & 15) * 16; seglen = 256; }
      const int ch0 = (half * 256 + tid) * 8;
      u32x4 raw[20];
#pragma unroll
      for (int i = 0; i < 20; ++i) { const int pq = p0 - 2 + i; raw[i] = (pq >= 0 && pq < seglen) ? *(const u32x4*)(P + (size_t)(base + pq * stride) * LDP + C_XBC + ch0) : (u32x4){0u, 0u, 0u, 0u}; }
      if (half != cur_half) {
        cur_half = half;
        const float4 b0 = *(const float4*)(sb + ch0), b1 = *(const float4*)(sb + ch0 + 4);
        bs[0] = b0.x; bs[1] = b0.y; bs[2] = b0.z; bs[3] = b0.w; bs[4] = b1.x; bs[5] = b1.y; bs[6] = b1.z; bs[7] = b1.w;
#pragma unroll
        for (int j = 0; j < 5; ++j) { const float4 w0 = *(const float4*)(sw + j * 4096 + ch0), w1 = *(const float4*)(sw + j * 4096 + ch0 + 4);
          wt[j][0] = w0.x; wt[j][1] = w0.y; wt[j][2] = w0.z; wt[j][3] = w0.w; wt[j][4] = w1.x; wt[j][5] = w1.y; wt[j][6] = w1.z; wt[j][7] = w1.w; }
      }
#pragma unroll
      for (int t = 0; t < 16; ++t) {
        float acc[8];
#pragma unroll
        for (int e = 0; e < 8; ++e) acc[e] = bs[e];
#pragma unroll
        for (int j = 0; j < 5; ++j) {
          const u32x4 rw = raw[t + j];
#pragma unroll
          for (int e = 0; e < 4; ++e) { acc[2 * e] += lo16(rw[e]) * wt[j][2 * e]; acc[2 * e + 1] += hi16(rw[e]) * wt[j][2 * e + 1]; }
        }
#pragma unroll
        for (int e = 0; e < 8; ++e) acc[e] = siluf_(acc[e]);
        *(uint4*)(XBC + (size_t)(base + (p0 + t) * stride) * 4096 + ch0) = pack8(acc);
      }
    }
  }
  for (int idx = gtid; idx < MG * 16; idx += gsz) {
    const int r = idx >> 4, dh = idx & 15;
    GBF[(size_t)r * 32 + 16 + dh] = sigmoidf_(bf2f(P[(size_t)r * LDP + C_B + dh]));
  }
  for (int idx = gtid; idx < G * 2 * 264 * 8; idx += gsz) {
    const int h = idx & 7; int t = idx >> 3; const int chunk = t % 264; t /= 264; const int dir = t & 1, b_l = t >> 1;
    const int dh = dir * 8 + h;
    const float bias = p.gdn_dt_bias[l * 16 + dh], aneg = -__expf(p.gdn_A_log[l * 16 + dh]);
    float cum = 0.f;
    for (int ub = 0; ub < 32; ub += 8) {
      float av[8];
#pragma unroll
      for (int u = 0; u < 8; ++u) av[u] = bf2f(P[(size_t)gdn_rowof(b_l, dir, chunk * 32 + ub + u) * LDP + C_A + dh]);
#pragma unroll
      for (int u = 0; u < 8; ++u) {
        cum += aneg * softplusf_(av[u] + bias);
        GBF[(size_t)gdn_rowof(b_l, dir, chunk * 32 + ub + u) * 32 + dh] = cum;
      }
    }
  }
  for (int idx = gtid; idx < G * 2 * 264 * 32; idx += gsz) {
    const int head = idx & 31; int t = idx >> 5; const int chunk = t % 264; t /= 264; const int dir = t & 1, b_l = t >> 1;
    const int dh = dir * 32 + head;
    const float bias = p.ssm_dt_bias[l * 64 + dh], aneg = -__expf(p.ssm_A_log[l * 64 + dh]);
    float cum = 0.f;
    for (int ub = 0; ub < 32; ub += 8) {
      float dtv[8];
#pragma unroll
      for (int u = 0; u < 8; ++u) dtv[u] = bf2f(P[(size_t)ssd_rowof(b_l, dir, chunk * 32 + ub + u) * LDP + C_DT + dh]);
#pragma unroll
      for (int u = 0; u < 8; ++u) {
        const size_t row = (size_t)ssd_rowof(b_l, dir, chunk * 32 + ub + u);
        const float dt = softplusf_(dtv[u] + bias);
        cum += dt * aneg;
        DTF[row * 128 + dh] = dt;
        DTF[row * 128 + 64 + dh] = cum;
      }
    }
  }
}

__device__ __forceinline__ void gdn_prep_phase(const Params& p, unsigned char* smraw) {
  const int tid = TIDX(), lane = tid & 63, w = tid >> 6, fr = lane & 15, fq = lane >> 4, ti = w >> 1, tj = w & 1;
  bf16_t* sK = (bf16_t*)smraw;
  bf16_t* sQ = sK + 32 * 136;
  bf16_t* sP = sQ + 32 * 136;
  bf16_t* sPT = sP + 2 * 1280;
  bf16_t* sR = sPT + 2 * 1280;
  float* sG = (float*)(sR + 2 * 1280);
  const bf16_t* QKV = (const bf16_t*)(p.ws + OFF_QKV);
  const float* GBF = (const float*)(p.ws + OFF_GBF);
  bf16_t* TMB = (bf16_t*)(p.ws + OFF_TMB);
  const int ltok = tid & 31, lp = tid >> 5;
  const int i = ti * 16 + fr, j0 = tj * 16 + fq * 4;
  for (int item = BIDX(); item < GDN_NITEM; item += GDIM()) {
    const int chunk = item % 264; const int t = item / 264; const int dir = t & 1, h = (t >> 1) & 7, b_l = t >> 4;
    const size_t row = (size_t)gdn_rowof(b_l, dir, chunk * 32 + ltok);
    const bf16_t* src = QKV + row * 3072 + h * 128;
    const u32x4 k0 = *(const u32x4*)(src + 1024 + lp * 8), k1 = *(const u32x4*)(src + 1024 + (lp + 8) * 8);
    const u32x4 q0 = *(const u32x4*)(src + lp * 8), q1 = *(const u32x4*)(src + (lp + 8) * 8);
    float g_ = 0.f, b_ = 0.f;
    if (tid < 32) { g_ = GBF[row * 32 + dir * 8 + h]; b_ = GBF[row * 32 + 16 + dir * 8 + h]; }
    __syncthreads();
    *(u32x4*)(sK + ltok * 136 + lp * 8) = k0; *(u32x4*)(sK + ltok * 136 + (lp + 8) * 8) = k1;
    *(u32x4*)(sQ + ltok * 136 + lp * 8) = q0; *(u32x4*)(sQ + ltok * 136 + (lp + 8) * 8) = q1;
    if (tid < 32) { sG[tid] = g_; sG[32 + tid] = b_; }
    __syncthreads();
    {
      f32x4 kk = (f32x4){0.f, 0.f, 0.f, 0.f}, qk = kk;
#pragma unroll
      for (int ks = 0; ks < 4; ++ks) {
        const bf16x8 kj = *(const bf16x8*)(sK + (tj * 16 + fr) * 136 + ks * 32 + fq * 8);
        const bf16x8 ki = *(const bf16x8*)(sK + (ti * 16 + fr) * 136 + ks * 32 + fq * 8);
        const bf16x8 qi = *(const bf16x8*)(sQ + (ti * 16 + fr) * 136 + ks * 32 + fq * 8);
        kk = __builtin_amdgcn_mfma_f32_16x16x32_bf16(kj, ki, kk, 0, 0, 0);
        qk = __builtin_amdgcn_mfma_f32_16x16x32_bf16(kj, qi, qk, 0, 0, 0);
      }
      const float gi = sG[i], bi = sG[32 + i];
      float n[4], nt[4], rr[4], m[4];
#pragma unroll
      for (int r = 0; r < 4; ++r) {
        const int j = j0 + r; const float gj = sG[j], bj = sG[32 + j];
        n[r] = (j < i) ? -bi * kk[r] * __expf(gi - gj) : 0.f;
        nt[r] = (i < j) ? -bj * kk[r] * __expf(gj - gi) : 0.f;
        m[r] = (j <= i) ? qk[r] * __expf(gi - gj) : 0.f;
        rr[r] = n[r] + ((i == j) ? 1.f : 0.f);
      }
      uint2 o;
      o.x = pack2(n[0], n[1]); o.y = pack2(n[2], n[3]); *(uint2*)(sP + i * 40 + j0) = o;
      o.x = pack2(nt[0], nt[1]); o.y = pack2(nt[2], nt[3]); *(uint2*)(sPT + i * 40 + j0) = o;
      o.x = pack2(rr[0], rr[1]); o.y = pack2(rr[2], rr[3]); *(uint2*)(sR + i * 40 + j0) = o;
      o.x = pack2(m[0], m[1]); o.y = pack2(m[2], m[3]); *(uint2*)(TMB + (size_t)item * 2048 + 1024 + i * 32 + j0) = o;
    }
    __syncthreads();
    int pc = 0, rc = 0;
#pragma unroll
    for (int st = 1; st <= 5; ++st) {
      const bf16_t* Pc = sP + pc * 1280; const bf16_t* PTc = sPT + pc * 1280; const bf16_t* Rc = sR + rc * 1280;
      const bf16x8 p_i = *(const bf16x8*)(Pc + (ti * 16 + fr) * 40 + fq * 8);
      const bf16x8 p_j = *(const bf16x8*)(Pc + (tj * 16 + fr) * 40 + fq * 8);
      const bf16x8 pt_i = *(const bf16x8*)(PTc + (ti * 16 + fr) * 40 + fq * 8);
      const bf16x8 pt_j = *(const bf16x8*)(PTc + (tj * 16 + fr) * 40 + fq * 8);
      const f32x4 z = (f32x4){0.f, 0.f, 0.f, 0.f};
      if (st >= 2) {
        const bf16x8 r_i = *(const bf16x8*)(Rc + (ti * 16 + fr) * 40 + fq * 8);
        const uint2 rin = *(const uint2*)(Rc + i * 40 + j0);
        f32x4 racc = (f32x4){lo16(rin.x), hi16(rin.x), lo16(rin.y), hi16(rin.y)};
        racc = __builtin_amdgcn_mfma_f32_16x16x32_bf16(pt_j, r_i, racc, 0, 0, 0);
        uint2 o; o.x = pack2(racc[0], racc[1]); o.y = pack2(racc[2], racc[3]);
        if (st < 5) *(uint2*)(sR + (rc ^ 1) * 1280 + i * 40 + j0) = o;
        else *(uint2*)(TMB + (size_t)item * 2048 + i * 32 + j0) = o;
      }
      if (st <= 4) {
        const f32x4 pn = __builtin_amdgcn_mfma_f32_16x16x32_bf16(pt_j, p_i, z, 0, 0, 0);
        const f32x4 ptn = __builtin_amdgcn_mfma_f32_16x16x32_bf16(p_j, pt_i, z, 0, 0, 0);
        uint2 o; o.x = pack2(pn[0], pn[1]); o.y = pack2(pn[2], pn[3]); *(uint2*)(sP + (pc ^ 1) * 1280 + i * 40 + j0) = o;
        o.x = pack2(ptn[0], ptn[1]); o.y = pack2(ptn[2], ptn[3]); *(uint2*)(sPT + (pc ^ 1) * 1280 + i * 40 + j0) = o;
      }
      if (st < 5) __syncthreads();
      pc ^= 1; if (st >= 2) rc ^= 1;
    }
  }
}

__device__ __forceinline__ void gdn_chunk_item(const Params& p, int id, unsigned char* smraw) {
  const int tid = TIDX(), lane = tid & 63, w = tid >> 6, fr = lane & 15, fq = lane >> 4, ta = w >> 1, tb = w & 1;
  const int b_l = id >> 6, h = (id >> 3) & 7, dir = (id >> 2) & 1, dvq = id & 3;
  bf16_t* sKb = (bf16_t*)smraw;
  bf16_t* sQ = sKb + 32 * 136;
  bf16_t* sKdT = sQ + 32 * 136;
  bf16_t* sVbT = sKdT + 128 * 40;
  bf16_t* sT = sVbT + 32 * 40;
  bf16_t* sM = sT + 32 * 40;
  bf16_t* sXT = sM + 32 * 40;
  bf16_t* sVnT = sXT + 32 * 40;
  bf16_t* sST = sVnT + 32 * 40;
  float* sG = (float*)(sST + 32 * 136);
  const bf16_t* QKV = (const bf16_t*)(p.ws + OFF_QKV);
  const float* GBF = (const float*)(p.ws + OFF_GBF);
  const bf16_t* TMB = (const bf16_t*)(p.ws + OFF_TMB);
  bf16_t* OUT = (bf16_t*)(p.ws + (dir ? OFF_OB : OFF_OF));
  const int ltok = tid & 31, lp = tid >> 5;
  const size_t item0 = (size_t)((b_l * 8 + h) * 2 + dir) * 264;
  struct Stage { u32x4 k0, k1, q0, q1, v, tm; float g, be, gl; };
  Stage st0, st1;
  constexpr int NCH = (256 + 8192) / 32;
  auto gload = [&](Stage& st, int c) __attribute__((always_inline)) {
    const int s0 = (c < NCH ? c : NCH - 1) * 32;
    const size_t row = (size_t)gdn_rowof(b_l, dir, s0 + ltok);
    const bf16_t* src = QKV + row * 3072 + h * 128;
    st.k0 = *(const u32x4*)(src + 1024 + lp * 8); st.k1 = *(const u32x4*)(src + 1024 + (lp + 8) * 8);
    st.q0 = *(const u32x4*)(src + lp * 8); st.q1 = *(const u32x4*)(src + (lp + 8) * 8);
    st.v = *(const u32x4*)(src + 2048 + dvq * 32 + (lp & 3) * 8);
    st.tm = *(const u32x4*)(TMB + (item0 + (c < NCH ? c : NCH - 1)) * 2048 + (tid >> 7) * 1024 + ((tid & 127) >> 2) * 32 + (tid & 3) * 8);
    st.g = GBF[row * 32 + dir * 8 + h]; st.be = GBF[row * 32 + 16 + dir * 8 + h];
    st.gl = GBF[(size_t)gdn_rowof(b_l, dir, s0 + 31) * 32 + dir * 8 + h];
  };
  auto lstore = [&](const Stage& st) __attribute__((always_inline)) {
    const float skb = st.be * __expf(st.g), skd = __expf(st.gl - st.g);
    {
      float f[8]; uint4 o;
      f[0] = lo16(st.k0[0]); f[1] = hi16(st.k0[0]); f[2] = lo16(st.k0[1]); f[3] = hi16(st.k0[1]); f[4] = lo16(st.k0[2]); f[5] = hi16(st.k0[2]); f[6] = lo16(st.k0[3]); f[7] = hi16(st.k0[3]);
      bf16_t* t0 = sKdT + (lp * 8) * 40 + ltok;
#pragma unroll
      for (int e = 0; e < 4; ++e) { const unsigned pk = pack2(f[2 * e] * skd, f[2 * e + 1] * skd); t0[(2 * e) * 40] = (bf16_t)(pk & 0xffffu); t0[(2 * e + 1) * 40] = (bf16_t)(pk >> 16); }
#pragma unroll
      for (int e = 0; e < 8; ++e) f[e] *= skb;
      o = pack8(f); *(uint4*)(sKb + ltok * 136 + lp * 8) = o;
      f[0] = lo16(st.k1[0]); f[1] = hi16(st.k1[0]); f[2] = lo16(st.k1[1]); f[3] = hi16(st.k1[1]); f[4] = lo16(st.k1[2]); f[5] = hi16(st.k1[2]); f[6] = lo16(st.k1[3]); f[7] = hi16(st.k1[3]);
      bf16_t* t1 = sKdT + ((lp + 8) * 8) * 40 + ltok;
#pragma unroll
      for (int e = 0; e < 4; ++e) { const unsigned pk = pack2(f[2 * e] * skd, f[2 * e + 1] * skd); t1[(2 * e) * 40] = (bf16_t)(pk & 0xffffu); t1[(2 * e + 1) * 40] = (bf16_t)(pk >> 16); }
#pragma unroll
      for (int e = 0; e < 8; ++e) f[e] *= skb;
      o = pack8(f); *(uint4*)(sKb + ltok * 136 + (lp + 8) * 8) = o;
    }
    *(u32x4*)(sQ + ltok * 136 + lp * 8) = st.q0; *(u32x4*)(sQ + ltok * 136 + (lp + 8) * 8) = st.q1;
    if (tid < 128) {
      bf16_t* tv = sVbT + (lp * 8) * 40 + ltok;
#pragma unroll
      for (int e = 0; e < 4; ++e) { const unsigned pk = pack2(lo16(st.v[e]) * st.be, hi16(st.v[e]) * st.be); tv[(2 * e) * 40] = (bf16_t)(pk & 0xffffu); tv[(2 * e + 1) * 40] = (bf16_t)(pk >> 16); }
      *(u32x4*)(sT + ((tid & 127) >> 2) * 40 + (tid & 3) * 8) = st.tm;
    } else {
      *(u32x4*)(sM + ((tid & 127) >> 2) * 40 + (tid & 3) * 8) = st.tm;
    }
    if (tid < 32) sG[tid] = st.g;
  };
  f32x4 S[4];
#pragma unroll
  for (int t = 0; t < 4; ++t) S[t] = (f32x4){0.f, 0.f, 0.f, 0.f};
  __syncthreads();
  for (int i = tid; i < 32 * 136 / 2; i += 256) ((unsigned*)sST)[i] = 0u;
  gload(st0, 0); lstore(st0);
  __syncthreads();
  gload(st0, 1);
  __builtin_amdgcn_sched_barrier(0);
  gload(st1, 2);
  __builtin_amdgcn_sched_barrier(0);
  auto body = [&](int c) __attribute__((always_inline)) {
    const int dv = ta * 16 + fr, i0 = tb * 16 + fq * 4;
    {
      f32x4 pr = (f32x4){0.f, 0.f, 0.f, 0.f};
#pragma unroll
      for (int ks = 0; ks < 4; ++ks) {
        const bf16x8 kb = *(const bf16x8*)(sKb + (tb * 16 + fr) * 136 + ks * 32 + fq * 8);
        const bf16x8 sf = *(const bf16x8*)(sST + (ta * 16 + fr) * 136 + ks * 32 + fq * 8);
        pr = __builtin_amdgcn_mfma_f32_16x16x32_bf16(kb, sf, pr, 0, 0, 0);
      }
      const uint2 vb = *(const uint2*)(sVbT + dv * 40 + i0);
      uint2 o; o.x = pack2(lo16(vb.x) - pr[0], hi16(vb.x) - pr[1]); o.y = pack2(lo16(vb.y) - pr[2], hi16(vb.y) - pr[3]);
      *(uint2*)(sXT + dv * 40 + i0) = o;
    }
    __syncthreads();
    {
      const bf16x8 tf = *(const bf16x8*)(sT + (tb * 16 + fr) * 40 + fq * 8);
      const bf16x8 xf = *(const bf16x8*)(sXT + (ta * 16 + fr) * 40 + fq * 8);
      const f32x4 vn = __builtin_amdgcn_mfma_f32_16x16x32_bf16(tf, xf, (f32x4){0.f, 0.f, 0.f, 0.f}, 0, 0, 0);
      uint2 o; o.x = pack2(vn[0], vn[1]); o.y = pack2(vn[2], vn[3]);
      *(uint2*)(sVnT + dv * 40 + i0) = o;
    }
    __syncthreads();
    const float eglast = __expf(sG[31]);
    {
      f32x4 oa = (f32x4){0.f, 0.f, 0.f, 0.f};
#pragma unroll
      for (int ks = 0; ks < 4; ++ks) {
        const bf16x8 qf = *(const bf16x8*)(sQ + (ta * 16 + fr) * 136 + ks * 32 + fq * 8);
        const bf16x8 sf = *(const bf16x8*)(sST + (tb * 16 + fr) * 136 + ks * 32 + fq * 8);
        oa = __builtin_amdgcn_mfma_f32_16x16x32_bf16(sf, qf, oa, 0, 0, 0);
      }
      const int i = ta * 16 + fr;
      oa *= __expf(sG[i]);
      const bf16x8 mf = *(const bf16x8*)(sM + i * 40 + fq * 8);
      const bf16x8 vf = *(const bf16x8*)(sVnT + (tb * 16 + fr) * 40 + fq * 8);
      oa = __builtin_amdgcn_mfma_f32_16x16x32_bf16(vf, mf, oa, 0, 0, 0);
      uint2 o; o.x = pack2(oa[0], oa[1]); o.y = pack2(oa[2], oa[3]);
      *(uint2*)(OUT + (size_t)gdn_rowof(b_l, dir, c * 32 + i) * 1024 + h * 128 + dvq * 32 + tb * 16 + fq * 4) = o;
    }
    {
      const bf16x8 vf = *(const bf16x8*)(sVnT + (ta * 16 + fr) * 40 + fq * 8);
#pragma unroll
      for (int t = 0; t < 4; ++t) {
        const bf16x8 kf = *(const bf16x8*)(sKdT + ((tb * 4 + t) * 16 + fr) * 40 + fq * 8);
        S[t] *= eglast;
        S[t] = __builtin_amdgcn_mfma_f32_16x16x32_bf16(kf, vf, S[t], 0, 0, 0);
      }
    }
    __syncthreads();
#pragma unroll
    for (int t = 0; t < 4; ++t) {
      uint2 o; o.x = pack2(S[t][0], S[t][1]); o.y = pack2(S[t][2], S[t][3]);
      *(uint2*)(sST + (ta * 16 + fr) * 136 + (tb * 4 + t) * 16 + fq * 4) = o;
    }
  };
  for (int c = 0; c < NCH; c += 2) {
    body(c);
    lstore(st0); gload(st0, c + 3);
    __syncthreads();
    body(c + 1);
    if (c + 2 < NCH) lstore(st1);
    gload(st1, c + 4);
    __syncthreads();
  }
}

__device__ __forceinline__ void ssd_chunk_item(const Params& p, int id, unsigned char* smraw) {
  const int tid = TIDX(), lane = tid & 63, w = tid >> 6, fr = lane & 15, fq = lane >> 4;
  const int b_l = id >> 6, head = (id >> 1) & 31, dir = id & 1, grp = head >> 2;
  bf16_t* sC = (bf16_t*)smraw;
  bf16_t* sB = sC + 32 * 136;
  bf16_t* sBT = sB + 32 * 136;
  bf16_t* sXT = sBT + 128 * 40;
  bf16_t* sM = sXT + 64 * 40;
  bf16_t* sST = sM + 32 * 40;
  float* sG = (float*)(sST + 64 * 136);
  const bf16_t* XBC = (const bf16_t*)(p.ws + OFF_XBC);
  const float* DTF = (const float*)(p.ws + OFF_DTF);
  bf16_t* OUT = (bf16_t*)(p.ws + (dir ? OFF_YB : OFF_YF));
  const int ltok = tid & 31, lpart = tid >> 5;
  struct Stage { u32x4 b0, b1, c0, c1, x; float dt, g, gl; };
  Stage st0, st1;
  constexpr int NCH = (256 + 8192) / 32;
  auto gload = [&](Stage& st, int c) __attribute__((always_inline)) {
    const int s0 = (c < NCH ? c : NCH - 1) * 32;
    const size_t row = (size_t)ssd_rowof(b_l, dir, s0 + ltok);
    const bf16_t* xr = XBC + row * 4096;
    st.b0 = *(const u32x4*)(xr + 2048 + grp * 128 + lpart * 8);
    st.b1 = *(const u32x4*)(xr + 2048 + grp * 128 + (lpart + 8) * 8);
    st.c0 = *(const u32x4*)(xr + 3072 + grp * 128 + lpart * 8);
    st.c1 = *(const u32x4*)(xr + 3072 + grp * 128 + (lpart + 8) * 8);
    st.x = *(const u32x4*)(xr + head * 64 + lpart * 8);
    st.dt = DTF[row * 128 + dir * 32 + head];
    st.g = DTF[row * 128 + 64 + dir * 32 + head];
    st.gl = DTF[(size_t)ssd_rowof(b_l, dir, s0 + 31) * 128 + 64 + dir * 32 + head];
  };
  auto lstore = [&](const Stage& st) __attribute__((always_inline)) {
    *(u32x4*)(sB + ltok * 136 + lpart * 8) = st.b0;
    *(u32x4*)(sB + ltok * 136 + (lpart + 8) * 8) = st.b1;
    *(u32x4*)(sC + ltok * 136 + lpart * 8) = st.c0;
    *(u32x4*)(sC + ltok * 136 + (lpart + 8) * 8) = st.c1;
    const float wj = __expf(st.gl - st.g);
    bf16_t* t0 = sBT + (lpart * 8) * 40 + ltok;
    bf16_t* t1 = sBT + ((lpart + 8) * 8) * 40 + ltok;
    bf16_t* tx = sXT + (lpart * 8) * 40 + ltok;
#pragma unroll
    for (int e = 0; e < 4; ++e) {
      const unsigned pa = pack2(lo16(st.b0[e]) * wj, hi16(st.b0[e]) * wj), pb = pack2(lo16(st.b1[e]) * wj, hi16(st.b1[e]) * wj);
      const unsigned px = pack2(lo16(st.x[e]) * st.dt, hi16(st.x[e]) * st.dt);
      t0[(2 * e) * 40] = (bf16_t)(pa & 0xffffu); t0[(2 * e + 1) * 40] = (bf16_t)(pa >> 16);
      t1[(2 * e) * 40] = (bf16_t)(pb & 0xffffu); t1[(2 * e + 1) * 40] = (bf16_t)(pb >> 16);
      tx[(2 * e) * 40] = (bf16_t)(px & 0xffffu); tx[(2 * e + 1) * 40] = (bf16_t)(px >> 16);
    }
    if (tid < 32) sG[tid] = st.g;
  };
  f32x4 S[8];
#pragma unroll
  for (int i = 0; i < 8; ++i) S[i] = (f32x4){0.f, 0.f, 0.f, 0.f};
  __syncthreads();
  for (int i = lane; i < 16 * 136 / 2; i += 64) ((unsigned*)(sST + w * 16 * 136))[i] = 0u;
  gload(st0, 0); lstore(st0);
  __syncthreads();
  gload(st0, 1);
  __builtin_amdgcn_sched_barrier(0);
  gload(st1, 2);
  __builtin_amdgcn_sched_barrier(0);
  auto body = [&](int c) __attribute__((always_inline)) {
    {
      const int ti = w >> 1, tj = w & 1;
      f32x4 cb = (f32x4){0.f, 0.f, 0.f, 0.f};
      if (tj <= ti) {
#pragma unroll
        for (int ks = 0; ks < 4; ++ks) {
          const bf16x8 af = *(const bf16x8*)(sC + (ti * 16 + fr) * 136 + ks * 32 + fq * 8);
          const bf16x8 bf = *(const bf16x8*)(sB + (tj * 16 + fr) * 136 + ks * 32 + fq * 8);
          cb = __builtin_amdgcn_mfma_f32_16x16x32_bf16(bf, af, cb, 0, 0, 0);
        }
      }
      const int i = ti * 16 + fr, j0 = tj * 16 + fq * 4;
      const float gi = sG[i];
      const f32x4 gj = *(const f32x4*)(sG + j0);
      float m[4];
#pragma unroll
      for (int r = 0; r < 4; ++r) { const float e = __expf(fminf(gi - gj[r], 0.f)); m[r] = (j0 + r <= i) ? cb[r] * e : 0.f; }
      uint2 o; o.x = pack2(m[0], m[1]); o.y = pack2(m[2], m[3]);
      *(uint2*)(sM + i * 40 + j0) = o;
    }
    __syncthreads();
    const bf16x8 xfrag = *(const bf16x8*)(sXT + (w * 16 + fr) * 40 + fq * 8);
    const float eglast = __expf(sG[31]);
#pragma unroll
    for (int ti = 0; ti < 2; ++ti) {
      f32x4 y = (f32x4){0.f, 0.f, 0.f, 0.f};
#pragma unroll
      for (int ks = 0; ks < 4; ++ks) {
        const bf16x8 af = *(const bf16x8*)(sC + (ti * 16 + fr) * 136 + ks * 32 + fq * 8);
        const bf16x8 bf = *(const bf16x8*)(sST + (w * 16 + fr) * 136 + ks * 32 + fq * 8);
        y = __builtin_amdgcn_mfma_f32_16x16x32_bf16(bf, af, y, 0, 0, 0);
      }
      const int i = ti * 16 + fr;
      const float eg = __expf(sG[i]);
      y *= eg;
      const bf16x8 mf = *(const bf16x8*)(sM + i * 40 + fq * 8);
      y = __builtin_amdgcn_mfma_f32_16x16x32_bf16(xfrag, mf, y, 0, 0, 0);
      uint2 o; o.x = pack2(y[0], y[1]); o.y = pack2(y[2], y[3]);
      *(uint2*)(OUT + (size_t)ssd_rowof(b_l, dir, c * 32 + i) * 2048 + head * 64 + w * 16 + fq * 4) = o;
    }
#pragma unroll
    for (int tn = 0; tn < 8; ++tn) {
      const bf16x8 bf = *(const bf16x8*)(sBT + (tn * 16 + fr) * 40 + fq * 8);
      S[tn] *= eglast;
      S[tn] = __builtin_amdgcn_mfma_f32_16x16x32_bf16(bf, xfrag, S[tn], 0, 0, 0);
    }
#pragma unroll
    for (int tn = 0; tn < 8; ++tn) {
      uint2 o; o.x = pack2(S[tn][0], S[tn][1]); o.y = pack2(S[tn][2], S[tn][3]);
      *(uint2*)(sST + (w * 16 + fr) * 136 + tn * 16 + fq * 4) = o;
    }
    __syncthreads();
  };
  for (int c = 0; c < NCH; c += 2) {
    body(c);
    lstore(st0); gload(st0, c + 3);
    __syncthreads();
    body(c + 1);
    if (c + 2 < NCH) lstore(st1);
    gload(st1, c + 4);
    __syncthreads();
  }
}

__device__ __forceinline__ void scan_phase(const Params& p, unsigned char* sm, int nb, int v) {
  for (int item = v; item < 256; item += nb) {
    if (item < 128) gdn_chunk_item(p, item, sm); else ssd_chunk_item(p, item - 128, sm);
    __syncthreads();
  }
}

__device__ __forceinline__ void gnorm_phase(const Params& p, int l, int M) {
  const bf16_t* P = (const bf16_t*)(p.ws + OFF_P);
  const bf16_t* OF = (const bf16_t*)(p.ws + OFF_OF); const bf16_t* OB = (const bf16_t*)(p.ws + OFF_OB);
  const bf16_t* YF = (const bf16_t*)(p.ws + OFF_YF); const bf16_t* YB = (const bf16_t*)(p.ws + OFF_YB);
  const bf16_t* XBC = (const bf16_t*)(p.ws + OFF_XBC);
  bf16_t* YA = (bf16_t*)(p.ws + OFF_QKV); bf16_t* YBn = YA + (size_t)MG * 1024;
  const int gtid = BIDX() * 256 + TIDX(), gsz = GDIM() * 256;
  const float* nw = p.gdn_norm_w + l * 128;
  for (int idx = gtid; idx < M * 128; idx += gsz) {
    const int r = idx >> 7, c8 = (idx & 127) * 8;
    const uint4 a = *(const uint4*)(OF + (size_t)r * 1024 + c8), b = *(const uint4*)(OB + (size_t)r * 1024 + c8);
    const uint4 gt = *(const uint4*)(P + (size_t)r * LDP + C_GOUT + c8);
    float fa[8], fb[8], fg[8]; UNPACK8(a, fa); UNPACK8(b, fb); UNPACK8(gt, fg);
    float ss = 0.f;
#pragma unroll
    for (int e = 0; e < 8; ++e) { fa[e] += fb[e]; ss += fa[e] * fa[e]; }
    ss += __shfl_xor(ss, 1); ss += __shfl_xor(ss, 2); ss += __shfl_xor(ss, 4); ss += __shfl_xor(ss, 8);
    const float rs = rsqrtf(ss * (1.f / 128.f) + 1e-6f);
    const float4 w0 = *(const float4*)(nw + (c8 & 127)), w1 = *(const float4*)(nw + (c8 & 127) + 4);
    const float wv[8] = {w0.x, w0.y, w0.z, w0.w, w1.x, w1.y, w1.z, w1.w};
#pragma unroll
    for (int e = 0; e < 8; ++e) fa[e] = fa[e] * rs * wv[e] * siluf_(fg[e]);
    *(uint4*)(YA + (size_t)r * 1024 + c8) = pack8(fa);
  }
  const float* sw = p.ssm_norm_w + l * 2048; const float* Dk = p.ssm_D + l * 32;
  for (int idx = gtid; idx < M * 256; idx += gsz) {
    const int r = idx >> 8, c8 = (idx & 255) * 8;
    const uint4 a = *(const uint4*)(YF + (size_t)r * 2048 + c8), b = *(const uint4*)(YB + (size_t)r * 2048 + c8);
    const uint4 xx = *(const uint4*)(XBC + (size_t)r * 4096 + c8);
    const uint4 zz = *(const uint4*)(P + (size_t)r * LDP + C_Z + c8);
    float fa[8], fb[8], fx[8], fz[8]; UNPACK8(a, fa); UNPACK8(b, fb); UNPACK8(xx, fx); UNPACK8(zz, fz);
    const float dsk = Dk[c8 >> 6];
    float ss = 0.f;
#pragma unroll
    for (int e = 0; e < 8; ++e) { fa[e] = (fa[e] + fb[e] + dsk * fx[e]) * siluf_(fz[e]); ss += fa[e] * fa[e]; }
    ss += __shfl_xor(ss, 1); ss += __shfl_xor(ss, 2); ss += __shfl_xor(ss, 4); ss += __shfl_xor(ss, 8); ss += __shfl_xor(ss, 16);
    const float rs = rsqrtf(ss * (1.f / 256.f) + 1e-6f);
    const float4 w0 = *(const float4*)(sw + c8), w1 = *(const float4*)(sw + c8 + 4);
    const float wv[8] = {w0.x, w0.y, w0.z, w0.w, w1.x, w1.y, w1.z, w1.w};
#pragma unroll
    for (int e = 0; e < 8; ++e) fa[e] = fa[e] * rs * wv[e];
    *(uint4*)(YBn + (size_t)r * 2048 + c8) = pack8(fa);
  }
}

#define XB_TMO      128
#define XB_XCNT(j)  (256  + 64 * (j))
#define XB_XSUB(j)  (1280 + 64 * (j))
#define XB_XGEN(j)  (2304 + 64 * (j))
#define XB_TOP      3328
#define XB_TOPGEN   3392
#define XCD_BAR_WORDS 3456
#define XB_SPIN_CAP (1u << 18)
#define LAS __attribute__((address_space(3)))

__device__ __forceinline__ unsigned xb_ld(unsigned* p)              { return __hip_atomic_load(p, __ATOMIC_RELAXED, __HIP_MEMORY_SCOPE_AGENT); }
__device__ __forceinline__ unsigned xb_add(unsigned* p, unsigned v) { return __hip_atomic_fetch_add(p, v, __ATOMIC_RELAXED, __HIP_MEMORY_SCOPE_AGENT); }
__device__ __forceinline__ unsigned xb_xcc_id() { return (unsigned)__builtin_amdgcn_s_getreg((3 << 11) | 20) & 0xFu; }
#define XB_SPIN(cond, bar) do { unsigned _sp = 0; while (cond) { __builtin_amdgcn_s_sleep(1); \
    if ((++_sp & 255u) == 0u) { if (xb_ld(&(bar)[XB_TMO])) break; if (_sp > XB_SPIN_CAP) { atomicAdd(&(bar)[XB_TMO], 1u); break; } } } } while (0)

struct XcdBarrier {
    unsigned* bar; unsigned x;
    volatile LAS unsigned* st;
};

__device__ __forceinline__ XcdBarrier xcd_barrier_post(unsigned* bar, volatile LAS unsigned* st) {
    XcdBarrier b; b.bar = bar; b.x = xb_xcc_id(); b.st = st;
    if (threadIdx.x == 0) (void)xb_add(&bar[XB_XCNT(b.x)], 1u);
    return b;
}
__device__ __forceinline__ void xcd_barrier_complete(unsigned* bar, unsigned x, unsigned& nloc, unsigned& nx) {
    const unsigned G = gridDim.x * gridDim.y * gridDim.z;
    unsigned sum, cnt, mine, sp = 0u;
    for (;;) {
        sum = 0u; cnt = 0u; mine = 0u;
#pragma unroll
        for (unsigned j = 0; j < 16; ++j) { const unsigned c = xb_ld(&bar[XB_XCNT(j)]); sum += c; cnt += (c > 0u) ? 1u : 0u; mine = (j == x) ? c : mine; }
        if (sum == G) break;
        __builtin_amdgcn_s_sleep(1);
        if ((++sp & 255u) == 0u) { if (xb_ld(&bar[XB_TMO])) break; if (sp > XB_SPIN_CAP) { atomicAdd(&bar[XB_TMO], 1u); break; } }
    }
    nloc = mine > 0u ? mine : 1u; nx = cnt > 0u ? cnt : 1u;
}

__device__ __forceinline__ void xcd_barrier(const XcdBarrier& b) {
    asm volatile("s_waitcnt vmcnt(0)" ::: "memory");
    __syncthreads();
    if (threadIdx.x == 0) {
        unsigned* bar = b.bar;
        __builtin_amdgcn_s_waitcnt(0);
        unsigned nloc = b.st[0], nx = b.st[1];
        if (nloc == 0u) { xcd_barrier_complete(bar, b.x, nloc, nx); b.st[0] = nloc; b.st[1] = nx; }
        const unsigned old = xb_add(&bar[XB_XSUB(b.x)], 1u);
        const unsigned gen = old / nloc;
        if (old + 1u == (gen + 1u) * nloc) {
            __builtin_amdgcn_fence(__ATOMIC_RELEASE, "agent");
            asm volatile("s_waitcnt vmcnt(0)" ::: "memory");
            const unsigned og = xb_add(&bar[XB_TOP], 1u);
            const unsigned tg = og / nx;
            if (og + 1u == (tg + 1u) * nx) xb_add(&bar[XB_TOPGEN], 1u);
            else XB_SPIN(xb_ld(&bar[XB_TOPGEN]) == tg, bar);
            __builtin_amdgcn_fence(__ATOMIC_ACQUIRE, "agent");
            xb_add(&bar[XB_XGEN(b.x)], 1u);
            asm volatile("s_waitcnt vmcnt(0)" ::: "memory");
        } else {
            XB_SPIN(xb_ld(&bar[XB_XGEN(b.x)]) == gen, bar);
            __builtin_amdgcn_fence(__ATOMIC_ACQUIRE, "agent");
            asm volatile("s_waitcnt vmcnt(0)" ::: "memory");
        }
    }
    __syncthreads();
}

#ifndef STOP_AFTER
#define STOP_AFTER 0
#endif
#define SYNC() { xcd_barrier(xb); if (++nsync == STOP_AFTER) return; }
#define PH(CALL) { CALL; }
__global__ void __launch_bounds__(256, 2) mega(Params p) {
  cg::grid_group grid = cg::this_grid();
  int nsync = 0;
  __shared__ __attribute__((aligned(16))) unsigned char smem[SMEM_BYTES];
  __shared__ uint4 xb_words;
  if (threadIdx.x == 0) xb_words = make_uint4(0u, 0u, 0u, 0u);
  __syncthreads();
  XcdBarrier xb = xcd_barrier_post((unsigned*)(p.ws + OFF_BAR), (volatile LAS unsigned*)&xb_words);
  float* smf = (float*)smem; bf16_t* smh = (bf16_t*)smem;
  for (int l = 0; l < 2; ++l) {
    PH(transpose_phase(p.w_in + (size_t)l * 1024 * IN_DIM, (bf16_t*)(p.ws + OFF_WIN), 1024, IN_DIM, LDP, smf))
    PH(transpose_phase(p.w_proj_gdn + (size_t)l * 1024 * 1024, (bf16_t*)(p.ws + OFF_WPG), 1024, 1024, 1024, smf))
    PH(transpose_phase(p.w_proj_ssm + (size_t)l * 2048 * 1024, (bf16_t*)(p.ws + OFF_WPS), 2048, 1024, 1024, smf))
    PH(transpose_phase(p.w_out + (size_t)l * 1024 * 1024, (bf16_t*)(p.ws + OFF_WOUT), 1024, 1024, 1024, smf))
    PH(transpose_phase(p.w_ff1 + (size_t)l * 1024 * 4096, (bf16_t*)(p.ws + OFF_WFF1), 1024, 4096, 4096, smf))
    PH(transpose_phase(p.w_ff2 + (size_t)l * 4096 * 1024, (bf16_t*)(p.ws + OFF_WFF2), 4096, 1024, 1024, smf))
    if (l == 0) { PH(modpart_phase(p, smf)) grid.sync(); PH(modfinal_phase(p)) }
    SYNC();
    const bool last = (l == 1);
    const int Mpost = last ? MLAT : MG;
    for (int g = 0; g < NGRP; ++g) {
      PH(modulate_phase(p, l, g)) SYNC();
      PH(gemm_inproj_phase(p, smh, 0, GDIM(), BIDX())) SYNC();
      PH(conv_phase(p, l)) SYNC();
      PH(gdn_prep_phase(p, smem)) SYNC();
      {
        const int nb_ = GDIM(), v_ = BIDX();
        if (nb_ >= 512) { if (v_ < 256) { PH(scan_phase(p, smem, 256, v_)) } else { PH(gemm_inproj_phase(p, smh, 1, nb_ - 256, v_ - 256)) } }
        else { PH(scan_phase(p, smem, nb_, v_)) PH(gemm_inproj_phase(p, smh, 1, nb_, v_)) }
      }
      SYNC();
      PH(gnorm_phase(p, l, Mpost)) SYNC();
      PH(gemm_proj_phase(p, Mpost, smh)) SYNC();
      PH(gemm_wout_phase(p, l, g, Mpost, smh)) SYNC();
      PH(ln_phase(p, l, g, Mpost, p.ln1_g + l * D, p.ln1_b + l * D, true)) SYNC();
      PH(gemm_ff1_phase(p, l, Mpost, smh)) SYNC();
      PH(gemm_ff2_phase(p, l, g, Mpost, smh)) SYNC();
      PH(ln_phase(p, l, g, Mpost, p.ln2_g + l * D, p.ln2_b + l * D, false)) SYNC();
    }
  }
}

extern "C" void kernel_launch(void* const* d_in, const int* in_sizes, int n_in, void* d_out, int out_size, void* d_ws, size_t ws_size,
                              hipStream_t stream) {
  static int grid_blocks = 0;
  if (!grid_blocks) {
    int dev = 0, cus = 0, per_cu = 0;
    (void)hipGetDevice(&dev);
    (void)hipDeviceGetAttribute(&cus, hipDeviceAttributeMultiprocessorCount, dev);
    (void)hipOccupancyMaxActiveBlocksPerMultiprocessor(&per_cu, mega, 256, 0);
    if (per_cu > 2) per_cu = 2;
    grid_blocks = cus * per_cu;
    if (ws_size < WS_TOTAL) fprintf(stderr, "workspace too small: %zu < %zu\n", ws_size, WS_TOTAL);
  }
  Params p{};
  const float** pp = (const float**)&p;
  for (int i = 0; i < 28; ++i) pp[i] = (const float*)d_in[i];
  p.out = (float*)d_out;
  p.ws = (unsigned char*)d_ws;
  (void)hipMemsetAsync((unsigned char*)d_ws + OFF_BAR, 0, 16384, stream);
  void* args[] = {&p};
  hipError_t e = hipLaunchCooperativeKernel((void*)mega, dim3(grid_blocks), dim3(256), args, 0, stream);
  if (e != hipSuccess) fprintf(stderr, "cooperative launch failed: %s (grid %d)\n", hipGetErrorString(e), grid_blocks);
}
```

```cpp
#include <hip/hip_runtime.h>
#include <hip/hip_cooperative_groups.h>
#include <cstdio>
namespace cg = cooperative_groups;

typedef unsigned short bf16_t;
typedef short bf16x8 __attribute__((ext_vector_type(8)));
typedef float f32x4 __attribute__((ext_vector_type(4)));
typedef float f32x2 __attribute__((ext_vector_type(2)));
typedef unsigned u32x4 __attribute__((ext_vector_type(4)));

constexpr int D = 1024, SEQ = 8192, LC = 256;
constexpr int G = 2, NGRP = 4;
constexpr int MLAT = G * SEQ, MCTX = G * LC, MG = MLAT + MCTX;
constexpr int IN_DIM = 12384, LDP = 12416;
constexpr int C_GOUT = 3072, C_A = 4096, C_B = 4112, C_Z = 4128, C_XBC = 6176, C_DT = 10272, C_GA = 10336, C_GB = 11360;
constexpr float DN_ALPHA = 1.4142135623730951f;

constexpr size_t SZ_WIN = (size_t)LDP * 1024 * 2;
constexpr size_t OFF_WIN = 0;
constexpr size_t OFF_WPG = OFF_WIN + SZ_WIN;
constexpr size_t OFF_WPS = OFF_WPG + 2097152;
constexpr size_t OFF_WOUT = OFF_WPS + 4194304;
constexpr size_t OFF_WFF1 = OFF_WOUT + 2097152;
constexpr size_t OFF_WFF2 = OFF_WFF1 + 8388608;
constexpr size_t OFF_MODP = OFF_WFF2 + 8388608;
constexpr size_t OFF_MOD = OFF_MODP + (size_t)2 * 16 * 9 * 6144 * 4;
constexpr size_t OFF_XSC = OFF_MOD + (size_t)2 * 9 * 6144 * 4;
constexpr size_t OFF_H = OFF_XSC + (size_t)2048 * 1024 * 4;
constexpr size_t OFF_P = OFF_H + (size_t)MG * 1024 * 2;
constexpr size_t OFF_QKV = OFF_P + (size_t)MG * LDP * 2;
constexpr size_t OFF_XBC = OFF_QKV + (size_t)MG * 3072 * 2;
constexpr size_t OFF_GBF = OFF_XBC + (size_t)MG * 4096 * 2;
constexpr size_t OFF_DTF = OFF_GBF + (size_t)MG * 32 * 4;
constexpr size_t OFF_OF = OFF_DTF + (size_t)MG * 128 * 4;
constexpr size_t OFF_OB = OFF_OF + (size_t)MG * 1024 * 2;
constexpr size_t OFF_YF = OFF_OB + (size_t)MG * 1024 * 2;
constexpr size_t OFF_YB = OFF_YF + (size_t)MG * 2048 * 2;
constexpr size_t OFF_TMB = OFF_YB + (size_t)MG * 2048 * 2;
constexpr int GDN_NITEM = G * 8 * 2 * 264;
constexpr size_t OFF_BAR = OFF_TMB + (size_t)GDN_NITEM * 2048 * 2;
constexpr size_t WS_TOTAL = OFF_BAR + 16384;
static_assert(WS_TOTAL <= ((size_t)1024 << 20), "workspace plan exceeds 1 GiB");

struct Params {
  const float *x, *c, *ctx, *c_ctx, *w_mod, *b_mod, *w_in, *gdn_conv_w, *gdn_A_log, *gdn_dt_bias, *gdn_norm_w;
  const float *ssm_conv_w, *ssm_conv_b, *ssm_A_log, *ssm_dt_bias, *ssm_D, *ssm_norm_w, *w_proj_gdn, *w_proj_ssm, *w_out;
  const float *ln1_g, *ln1_b, *w_ff1, *b_ff1, *w_ff2, *b_ff2, *ln2_g, *ln2_b;
  float* out;
  unsigned char* ws;
};

constexpr int SMEM_BYTES = 73728;


__device__ __forceinline__ int TIDX() { int t = threadIdx.x; asm volatile("" : "+v"(t)); return t; }
__device__ __forceinline__ int BIDX() { int t = blockIdx.x; asm volatile("" : "+s"(t)); return t; }
__device__ __forceinline__ int GDIM() { int t = gridDim.x; asm volatile("" : "+s"(t)); return t; }
__device__ __forceinline__ float bf2f(bf16_t b) { return __uint_as_float(((unsigned)b) << 16); }
__device__ __forceinline__ bf16_t f2bf(float f) { unsigned u = __float_as_uint(f); u += 0x7fffu + ((u >> 16) & 1u); return (bf16_t)(u >> 16); }
typedef __bf16 bf16v2 __attribute__((ext_vector_type(2)));
__device__ __forceinline__ unsigned pack2(float a, float b) { const f32x2 v = (f32x2){a, b}; const bf16v2 h = __builtin_convertvector(v, bf16v2); return __builtin_bit_cast(unsigned, h); }
__device__ __forceinline__ float lo16(unsigned v) { return __uint_as_float(v << 16); }
__device__ __forceinline__ float hi16(unsigned v) { return __uint_as_float(v & 0xffff0000u); }
#define UNPACK8(v, f) { f[0] = lo16(v.x); f[1] = hi16(v.x); f[2] = lo16(v.y); f[3] = hi16(v.y); f[4] = lo16(v.z); f[5] = hi16(v.z); f[6] = lo16(v.w); f[7] = hi16(v.w); }
__device__ __forceinline__ uint4 pack8(const float* f) { uint4 r; r.x = pack2(f[0], f[1]); r.y = pack2(f[2], f[3]); r.z = pack2(f[4], f[5]); r.w = pack2(f[6], f[7]); return r; }
__device__ __forceinline__ float sigmoidf_(float x) { return __builtin_amdgcn_rcpf(1.f + __expf(-x)); }
__device__ __forceinline__ float siluf_(float x) { return x * __builtin_amdgcn_rcpf(1.f + __expf(-x)); }
__device__ __forceinline__ float softplusf_(float x) { return x > 20.f ? x : log1pf(__expf(x)); }
template <int CTRL> __device__ __forceinline__ float dppf(float x) { return __builtin_bit_cast(float, __builtin_amdgcn_mov_dpp(__builtin_bit_cast(int, x), CTRL, 0xf, 0xf, true)); }
__device__ __forceinline__ float reduce16(float x) { x += dppf<0xB1>(x); x += dppf<0x4E>(x); x += dppf<0x141>(x); x += dppf<0x140>(x); return x; }

__device__ __forceinline__ float* xs_row(const Params& p, int g, int r) {
  return (r < MLAT) ? p.out + ((size_t)g * MLAT + r) * D : (float*)(p.ws + OFF_XSC) + ((size_t)g * MCTX + (r - MLAT)) * D;
}
__device__ __forceinline__ const float* xin_row(const Params& p, int l, int g, int r) {
  if (l == 0) return (r < MLAT) ? p.x + ((size_t)g * MLAT + r) * D : p.ctx + ((size_t)g * MCTX + (r - MLAT)) * D;
  return xs_row(p, g, r);
}
__device__ __forceinline__ int mod_row(int g, int r) { return r < MLAT ? g * G + r / SEQ : 8; }
__device__ __forceinline__ int gdn_rowof(int b_l, int dir, int s) {
  if (s < 256) { const int i = dir ? 255 - s : s; return MLAT + b_l * 256 + i; }
  const int i = s - 256; return b_l * 8192 + (dir ? 8191 - i : i);
}
__device__ __forceinline__ int ssd_rowof(int b_l, int dir, int s) {
  if (s < 256) { const int i = dir ? 255 - s : s; return MLAT + b_l * 256 + i; }
  const int j = s - 256; const int pos = dir ? 8191 - j : j; return b_l * 8192 + (pos & 127) * 64 + (pos >> 7);
}

__device__ __forceinline__ void transpose_phase(const float* __restrict__ src, bf16_t* __restrict__ dst, int K, int N, int Npad, float* tile) {
  const int tid = TIDX(), tk = K / 64, tn = Npad / 64;
  const int c = tid & 63, r4 = tid >> 6;
  for (int t = BIDX(); t < tk * tn; t += GDIM()) {
    const int kt = t % tk, nt = t / tk, k0 = kt * 64, n0 = nt * 64;
    __syncthreads();
#pragma unroll 4
    for (int i = 0; i < 16; ++i) { const int r = i * 4 + r4, n = n0 + c; tile[r * 65 + c] = (n < N) ? src[(size_t)(k0 + r) * N + n] : 0.f; }
    __syncthreads();
#pragma unroll 4
    for (int i = 0; i < 16; ++i) { const int nn = i * 4 + r4; dst[(size_t)(n0 + nn) * K + k0 + c] = f2bf(tile[c * 65 + nn]); }
  }
}

__device__ __forceinline__ void modpart_phase(const Params& p, float* sm) {
  const int tid = TIDX();
  float* MODP = (float*)(p.ws + OFF_MODP);
  for (int item = BIDX(); item < 2 * 24 * 16; item += GDIM()) {
    const int l = item / 384, rem = item % 384, cbk = rem / 16, ks = rem % 16;
    __syncthreads();
    for (int i = tid; i < 9 * 64; i += 256) { const int r = i / 64, k = ks * 64 + (i % 64); const float v = (r < 8) ? p.c[r * D + k] : p.c_ctx[k]; sm[i] = siluf_(v); }
    __syncthreads();
    const int col = cbk * 256 + tid;
    float acc[9];
#pragma unroll
    for (int r = 0; r < 9; ++r) acc[r] = 0.f;
    const float* wp = p.w_mod + ((size_t)l * D + ks * 64) * 6144 + col;
#pragma unroll 8
    for (int k = 0; k < 64; ++k) { const float w = wp[(size_t)k * 6144];
#pragma unroll
      for (int r = 0; r < 9; ++r) acc[r] += sm[r * 64 + k] * w; }
#pragma unroll
    for (int r = 0; r < 9; ++r) MODP[(((size_t)l * 16 + ks) * 9 + r) * 6144 + col] = acc[r];
  }
}
__device__ __forceinline__ void modfinal_phase(const Params& p) {
  const float* MODP = (const float*)(p.ws + OFF_MODP);
  float* MOD = (float*)(p.ws + OFF_MOD);
  for (int i = BIDX() * 256 + TIDX(); i < 2 * 9 * 6144; i += GDIM() * 256) {
    const int l = i / (9 * 6144), rem = i % (9 * 6144), col = rem % 6144;
    float s = p.b_mod[l * 6144 + col];
    for (int ks = 0; ks < 16; ++ks) s += MODP[((size_t)l * 16 + ks) * 9 * 6144 + rem];
    MOD[i] = s;
  }
}

__device__ __forceinline__ void modulate_phase(const Params& p, int l, int g) {
  const float* MOD = (const float*)(p.ws + OFF_MOD) + (size_t)l * 9 * 6144;
  bf16_t* H = (bf16_t*)(p.ws + OFF_H);
  for (int i = BIDX() * 256 + TIDX(); i < MG * 128; i += GDIM() * 256) {
    const int r = i >> 7, ch = (i & 127) * 8;
    const float* xr = xin_row(p, l, g, r) + ch;
    const float* m = MOD + (size_t)mod_row(g, r) * 6144;
    const float4 x0 = *(const float4*)xr, x1 = *(const float4*)(xr + 4);
    const float4 sh0 = *(const float4*)(m + ch), sh1 = *(const float4*)(m + ch + 4);
    const float4 sc0 = *(const float4*)(m + 1024 + ch), sc1 = *(const float4*)(m + 1024 + ch + 4);
    float f[8] = {x0.x * (1.f + sc0.x) + sh0.x, x0.y * (1.f + sc0.y) + sh0.y, x0.z * (1.f + sc0.z) + sh0.z, x0.w * (1.f + sc0.w) + sh0.w,
                  x1.x * (1.f + sc1.x) + sh1.x, x1.y * (1.f + sc1.y) + sh1.y, x1.z * (1.f + sc1.z) + sh1.z, x1.w * (1.f + sc1.w) + sh1.w};
    *(uint4*)(H + (size_t)r * D + ch) = pack8(f);
  }
}

struct Seg { const bf16_t* ap; const bf16_t* bp; int lda, ldb, nk; };

__device__ __forceinline__ bool tile_coord_sub(int it, int nM, int nN, int nb, int v, int& mt, int& nt) {
  long s;
  if ((nb & 7) == 0) { const int per = nb >> 3; s = (long)it * nb + (v & 7) * per + (v >> 3); } else s = (long)it * nb + v;
  if (s >= (long)nM * nN) return false;
  const int band = (int)(s / (8 * nN)), r = (int)(s - (long)band * 8 * nN);
  const int bsz = (nM - band * 8) < 8 ? (nM - band * 8) : 8;
  nt = r / bsz; mt = band * 8 + (r % bsz);
  return true;
}
__device__ __forceinline__ bool tile_coord(int it, int nM, int nN, int& mt, int& nt) { return tile_coord_sub(it, nM, nN, GDIM(), BIDX(), mt, nt); }
__device__ __forceinline__ int inproj_ntile(int part, int e) {
  if (part == 0) return e < 24 ? e : (e == 24 ? 32 : 23 + e);
  return e < 8 ? 24 + e : (e < 23 ? 25 + e : 58 + e);
}

#define ZERO_ACC(acc) { _Pragma("unroll") for (int i_ = 0; i_ < 4; ++i_) { _Pragma("unroll") for (int j_ = 0; j_ < 4; ++j_) acc[i_][j_] = (f32x4){0.f, 0.f, 0.f, 0.f}; } }
#define EPI_LOOP(...) { const int lane_ = TIDX() & 63, w_ = TIDX() >> 6; \
  _Pragma("unroll") for (int i_ = 0; i_ < 4; ++i_) { const int row = m0 + (w_ >> 1) * 64 + i_ * 16 + (lane_ & 15); \
  _Pragma("unroll") for (int j_ = 0; j_ < 4; ++j_) { const int col = n0 + (w_ & 1) * 64 + j_ * 16 + (lane_ >> 4) * 4; f32x4& v = acc[i_][j_]; __VA_ARGS__ } } }

template <class Prob>
__device__ __forceinline__ void gemm_stream(Prob& pr, bf16_t* sm) {
  const int tid = TIDX(), lane = tid & 63, w = tid >> 6, wr = w >> 1, wc = w & 1;
  const int lr = tid >> 3, lk = (tid & 7) * 8;
  const int fr = lane & 15, fq = lane >> 4;
  const int aoff = (wr * 64 + fr) * 72 + fq * 8, boff = 9216 + (wc * 64 + fr) * 72 + fq * 8;
  const int soff = lr * 72 + lk;
  Seg cur, nxt;
  if (!pr.seg(0, cur, lr, lk)) return;
  bool has_nxt = pr.seg(1, nxt, lr, lk);
  u32x4 r0a[4], r0b[4], r1a[4], r1b[4];
#pragma unroll
  for (int i = 0; i < 4; ++i) { r0a[i] = (u32x4){0u, 0u, 0u, 0u}; r0b[i] = r0a[i]; r1a[i] = r0a[i]; r1b[i] = r0a[i]; }
  f32x4 acc[4][4];
#define GS_LOAD(RA, RB, KT) { const int kt_ = (KT); const bf16_t* ap_ = cur.ap; const bf16_t* bp_ = cur.bp; int lda_ = cur.lda, ldb_ = cur.ldb; \
    if (kt_ < cur.nk) { ap_ += kt_ * 64; bp_ += kt_ * 64; } \
    else if (has_nxt) { ap_ = nxt.ap + (kt_ - cur.nk) * 64; bp_ = nxt.bp + (kt_ - cur.nk) * 64; lda_ = nxt.lda; ldb_ = nxt.ldb; } \
      \
    _Pragma("unroll") for (int i = 0; i < 4; ++i) { RA[i] = *(const u32x4*)(ap_ + (size_t)i * 32 * lda_); RB[i] = *(const u32x4*)(bp_ + (size_t)i * 32 * ldb_); } }
#define GS_STORE(RA, RB, KT, STAGE) { bf16_t* st_ = (STAGE) + soff; \
    _Pragma("unroll") for (int i = 0; i < 4; ++i) { *(u32x4*)(st_ + i * 32 * 72) = RA[i]; *(u32x4*)(st_ + 9216 + i * 32 * 72) = RB[i]; } }
#define GS_COMPUTE(STAGE) { const bf16_t* cs_ = (STAGE); _Pragma("unroll") for (int kk = 0; kk < 2; ++kk) { bf16x8 af[4], bfr[4]; \
    _Pragma("unroll") for (int i = 0; i < 4; ++i) { af[i] = *(const bf16x8*)(cs_ + aoff + i * 16 * 72 + kk * 32); bfr[i] = *(const bf16x8*)(cs_ + boff + i * 16 * 72 + kk * 32); } \
    _Pragma("unroll") for (int i = 0; i < 4; ++i) { _Pragma("unroll") for (int j = 0; j < 4; ++j) acc[i][j] = __builtin_amdgcn_mfma_f32_16x16x32_bf16(bfr[j], af[i], acc[i][j], 0, 0, 0); } } }
  GS_LOAD(r0a, r0b, 0)
  __syncthreads();
  GS_STORE(r0a, r0b, 0, sm)
  __syncthreads();
  GS_LOAD(r0a, r0b, 1)
  __builtin_amdgcn_sched_barrier(0);
  GS_LOAD(r1a, r1b, 2)
  __builtin_amdgcn_sched_barrier(0);
  for (int idx = 0;; ++idx) {
    pr.begin(idx, acc);
    for (int kt = 0; kt < cur.nk; kt += 2) {
      GS_COMPUTE(sm)
      GS_STORE(r0a, r0b, kt + 1, sm + 18432)
      GS_LOAD(r0a, r0b, kt + 3)
      __syncthreads();
      GS_COMPUTE(sm + 18432)
      GS_STORE(r1a, r1b, kt + 2, sm)
      GS_LOAD(r1a, r1b, kt + 4)
      __syncthreads();
    }
    pr.end(idx, acc);
    if (!has_nxt) break;
    cur = nxt; has_nxt = pr.seg(idx + 2, nxt, lr, lk);
  }
#undef GS_LOAD
#undef GS_STORE
#undef GS_COMPUTE
}

__device__ __forceinline__ void gemm_inproj_phase(const Params& p, bf16_t* sm, int part, int nb, int v) {
  struct Pr {
    const bf16_t* A; const bf16_t* W; bf16_t* P; int nM, nN, part, nb, v;
    __device__ bool seg(int idx, Seg& s, int lr, int lk) const { int mt, e; if (!tile_coord_sub(idx, nM, nN, nb, v, mt, e)) return false; const int nt = inproj_ntile(part, e);
      s.ap = A + (size_t)(mt * 128 + lr) * D + lk; s.bp = W + (size_t)(nt * 128 + lr) * D + lk; s.lda = D; s.ldb = D; s.nk = 16; return true; }
    __device__ void begin(int, f32x4 (&acc)[4][4]) const { ZERO_ACC(acc) }
    __device__ void end(int idx, f32x4 (&acc)[4][4]) const { int mt, e; tile_coord_sub(idx, nM, nN, nb, v, mt, e); const int m0 = mt * 128, n0 = inproj_ntile(part, e) * 128;
      EPI_LOOP({ uint2 o; o.x = pack2(v[0], v[1]); o.y = pack2(v[2], v[3]); *(uint2*)(P + (size_t)row * LDP + col) = o; }) }
  } pr{(const bf16_t*)(p.ws + OFF_H), (const bf16_t*)(p.ws + OFF_WIN), (bf16_t*)(p.ws + OFF_P), MG / 128, part == 0 ? 58 : 39, part, nb, v};
  gemm_stream(pr, sm);
}
__device__ __forceinline__ void gemm_proj_phase(const Params& p, int M, bf16_t* sm) {
  struct Pr {
    const bf16_t* YA; const bf16_t* YBn; const bf16_t* Wg; const bf16_t* Ws; const bf16_t* P; bf16_t* U; int nM, nN;
    __device__ bool seg(int idx, Seg& s, int lr, int lk) const { int mt, nt; if (!tile_coord(idx >> 1, nM, nN, mt, nt)) return false;
      if ((idx & 1) == 0) { s.ap = YA + (size_t)(mt * 128 + lr) * 1024 + lk; s.bp = Wg + (size_t)(nt * 128 + lr) * 1024 + lk; s.lda = 1024; s.ldb = 1024; s.nk = 16; }
      else { s.ap = YBn + (size_t)(mt * 128 + lr) * 2048 + lk; s.bp = Ws + (size_t)(nt * 128 + lr) * 2048 + lk; s.lda = 2048; s.ldb = 2048; s.nk = 32; }
      return true; }
    __device__ void begin(int idx, f32x4 (&acc)[4][4]) const { if ((idx & 1) == 0) ZERO_ACC(acc) }
    __device__ void end(int idx, f32x4 (&acc)[4][4]) const { int mt, nt; tile_coord(idx >> 1, nM, nN, mt, nt); const int m0 = mt * 128, n0 = nt * 128;
      if ((idx & 1) == 0) {
        EPI_LOOP({ const uint2 ga = *(const uint2*)(P + (size_t)row * LDP + C_GA + col); const uint2 gb = *(const uint2*)(P + (size_t)row * LDP + C_GB + col);
          v[0] *= (1.f + __expf(-lo16(gb.x))) / (1.f + __expf(-lo16(ga.x))); v[1] *= (1.f + __expf(-hi16(gb.x))) / (1.f + __expf(-hi16(ga.x)));
          v[2] *= (1.f + __expf(-lo16(gb.y))) / (1.f + __expf(-lo16(ga.y))); v[3] *= (1.f + __expf(-hi16(gb.y))) / (1.f + __expf(-hi16(ga.y))); })
      } else {
        EPI_LOOP({ const uint2 gb = *(const uint2*)(P + (size_t)row * LDP + C_GB + col);
          uint2 o; o.x = pack2(v[0] * sigmoidf_(lo16(gb.x)), v[1] * sigmoidf_(hi16(gb.x))); o.y = pack2(v[2] * sigmoidf_(lo16(gb.y)), v[3] * sigmoidf_(hi16(gb.y)));
          *(uint2*)(U + (size_t)row * D + col) = o; })
      } }
  } pr{(const bf16_t*)(p.ws + OFF_QKV), (const bf16_t*)(p.ws + OFF_QKV) + (size_t)MG * 1024, (const bf16_t*)(p.ws + OFF_WPG), (const bf16_t*)(p.ws + OFF_WPS),
       (const bf16_t*)(p.ws + OFF_P), (bf16_t*)(p.ws + OFF_H), M / 128, 8};
  gemm_stream(pr, sm);
}
__device__ __forceinline__ void gemm_wout_phase(const Params& p, int l, int g, int M, bf16_t* sm) {
  struct Pr {
    const Params& p; int l, g; const bf16_t* U; const bf16_t* W; const float* MOD; int nM, nN;
    __device__ bool seg(int idx, Seg& s, int lr, int lk) const { int mt, nt; if (!tile_coord(idx, nM, nN, mt, nt)) return false;
      s.ap = U + (size_t)(mt * 128 + lr) * D + lk; s.bp = W + (size_t)(nt * 128 + lr) * D + lk; s.lda = D; s.ldb = D; s.nk = 16; return true; }
    __device__ void begin(int, f32x4 (&acc)[4][4]) const { ZERO_ACC(acc) }
    __device__ void end(int idx, f32x4 (&acc)[4][4]) const { int mt, nt; tile_coord(idx, nM, nN, mt, nt); const int m0 = mt * 128, n0 = nt * 128;
      EPI_LOOP({ const float4 xr = *(const float4*)(xin_row(p, l, g, row) + col); const float4 g1 = *(const float4*)(MOD + (size_t)mod_row(g, row) * 6144 + 2048 + col);
        float4 o; o.x = DN_ALPHA * xr.x + g1.x * v[0]; o.y = DN_ALPHA * xr.y + g1.y * v[1]; o.z = DN_ALPHA * xr.z + g1.z * v[2]; o.w = DN_ALPHA * xr.w + g1.w * v[3];
        *(float4*)(xs_row(p, g, row) + col) = o; }) }
  } pr{p, l, g, (const bf16_t*)(p.ws + OFF_H), (const bf16_t*)(p.ws + OFF_WOUT), (const float*)(p.ws + OFF_MOD) + (size_t)l * 9 * 6144, M / 128, 8};
  gemm_stream(pr, sm);
}
__device__ __forceinline__ void gemm_ff1_phase(const Params& p, int l, int M, bf16_t* sm) {
  struct Pr {
    const bf16_t* H; const bf16_t* W; bf16_t* HID; const float* b1; int nM, nN;
    __device__ bool seg(int idx, Seg& s, int lr, int lk) const { int mt, nt; if (!tile_coord(idx, nM, nN, mt, nt)) return false;
      s.ap = H + (size_t)(mt * 128 + lr) * D + lk; s.bp = W + (size_t)(nt * 128 + lr) * D + lk; s.lda = D; s.ldb = D; s.nk = 16; return true; }
    __device__ void begin(int, f32x4 (&acc)[4][4]) const { ZERO_ACC(acc) }
    __device__ void end(int idx, f32x4 (&acc)[4][4]) const { int mt, nt; tile_coord(idx, nM, nN, mt, nt); const int m0 = mt * 128, n0 = nt * 128;
      EPI_LOOP({ const float4 b = *(const float4*)(b1 + col);
        float t0 = fmaxf(v[0] + b.x, 0.f), t1 = fmaxf(v[1] + b.y, 0.f), t2 = fmaxf(v[2] + b.z, 0.f), t3 = fmaxf(v[3] + b.w, 0.f);
        uint2 o; o.x = pack2(t0 * t0, t1 * t1); o.y = pack2(t2 * t2, t3 * t3); *(uint2*)(HID + (size_t)row * 4096 + col) = o; }) }
  } pr{(const bf16_t*)(p.ws + OFF_H), (const bf16_t*)(p.ws + OFF_WFF1), (bf16_t*)(p.ws + OFF_P), p.b_ff1 + (size_t)l * 4096, M / 128, 32};
  gemm_stream(pr, sm);
}
__device__ __forceinline__ void gemm_ff2_phase(const Params& p, int l, int g, int M, bf16_t* sm) {
  struct Pr {
    const Params& p; int g; const bf16_t* HID; const bf16_t* W; const float* MOD; const float* b2; int nM, nN;
    __device__ bool seg(int idx, Seg& s, int lr, int lk) const { int mt, nt; if (!tile_coord(idx, nM, nN, mt, nt)) return false;
      s.ap = HID + (size_t)(mt * 128 + lr) * 4096 + lk; s.bp = W + (size_t)(nt * 128 + lr) * 4096 + lk; s.lda = 4096; s.ldb = 4096; s.nk = 64; return true; }
    __device__ void begin(int, f32x4 (&acc)[4][4]) const { ZERO_ACC(acc) }
    __device__ void end(int idx, f32x4 (&acc)[4][4]) const { int mt, nt; tile_coord(idx, nM, nN, mt, nt); const int m0 = mt * 128, n0 = nt * 128;
      EPI_LOOP({ float* xp = xs_row(p, g, row) + col; const float4 xr = *(const float4*)xp; const float4 b = *(const float4*)(b2 + col);
        const float4 g2 = *(const float4*)(MOD + (size_t)mod_row(g, row) * 6144 + 5120 + col);
        float4 o; o.x = DN_ALPHA * xr.x + g2.x * (v[0] + b.x); o.y = DN_ALPHA * xr.y + g2.y * (v[1] + b.y); o.z = DN_ALPHA * xr.z + g2.z * (v[2] + b.z); o.w = DN_ALPHA * xr.w + g2.w * (v[3] + b.w);
        *(float4*)xp = o; }) }
  } pr{p, g, (const bf16_t*)(p.ws + OFF_P), (const bf16_t*)(p.ws + OFF_WFF2), (const float*)(p.ws + OFF_MOD) + (size_t)l * 9 * 6144, p.b_ff2 + (size_t)l * 1024, M / 128, 8};
  gemm_stream(pr, sm);
}

__device__ __forceinline__ void ln_phase(const Params& p, int l, int g, int M, const float* gam, const float* bet, bool write_h2) {
  const int lane = TIDX() & 63;
  const float* MOD = (const float*)(p.ws + OFF_MOD) + (size_t)l * 9 * 6144;
  bf16_t* H = (bf16_t*)(p.ws + OFF_H);
  const int stride = GDIM() * 4;
  for (int r0 = BIDX() * 4 + (TIDX() >> 6); r0 < M; r0 += 2 * stride) {
    const int r1 = r0 + stride; const bool has1 = r1 < M;
    float* xr0 = xs_row(p, g, r0); float* xr1 = xs_row(p, g, has1 ? r1 : r0);
    float4 v0[4], v1[4];
#pragma unroll
    for (int i = 0; i < 4; ++i) { v0[i] = *(const float4*)(xr0 + (i * 64 + lane) * 4); v1[i] = *(const float4*)(xr1 + (i * 64 + lane) * 4); }
    float s0 = 0.f, s1 = 0.f;
#pragma unroll
    for (int i = 0; i < 4; ++i) { s0 += v0[i].x + v0[i].y + v0[i].z + v0[i].w; s1 += v1[i].x + v1[i].y + v1[i].z + v1[i].w; }
#pragma unroll
    for (int o = 32; o >= 1; o >>= 1) { s0 += __shfl_xor(s0, o); s1 += __shfl_xor(s1, o); }
    const float mu0 = s0 * (1.f / 1024.f), mu1 = s1 * (1.f / 1024.f);
    float q0 = 0.f, q1 = 0.f;
#pragma unroll
    for (int i = 0; i < 4; ++i) {
      v0[i].x -= mu0; v0[i].y -= mu0; v0[i].z -= mu0; v0[i].w -= mu0; q0 += v0[i].x * v0[i].x + v0[i].y * v0[i].y + v0[i].z * v0[i].z + v0[i].w * v0[i].w;
      v1[i].x -= mu1; v1[i].y -= mu1; v1[i].z -= mu1; v1[i].w -= mu1; q1 += v1[i].x * v1[i].x + v1[i].y * v1[i].y + v1[i].z * v1[i].z + v1[i].w * v1[i].w;
    }
#pragma unroll
    for (int o = 32; o >= 1; o >>= 1) { q0 += __shfl_xor(q0, o); q1 += __shfl_xor(q1, o); }
    const float rs0 = rsqrtf(q0 * (1.f / 1024.f) + 1e-5f), rs1 = rsqrtf(q1 * (1.f / 1024.f) + 1e-5f);
    const float* m0 = MOD + (size_t)mod_row(g, r0) * 6144;
    const float* m1 = MOD + (size_t)mod_row(g, has1 ? r1 : r0) * 6144;
#pragma unroll
    for (int i = 0; i < 4; ++i) {
      const int ch = (i * 64 + lane) * 4;
      const float4 gg = *(const float4*)(gam + ch), bb = *(const float4*)(bet + ch);
      float4 o0, o1;
      o0.x = v0[i].x * rs0 * gg.x + bb.x; o0.y = v0[i].y * rs0 * gg.y + bb.y; o0.z = v0[i].z * rs0 * gg.z + bb.z; o0.w = v0[i].w * rs0 * gg.w + bb.w;
      o1.x = v1[i].x * rs1 * gg.x + bb.x; o1.y = v1[i].y * rs1 * gg.y + bb.y; o1.z = v1[i].z * rs1 * gg.z + bb.z; o1.w = v1[i].w * rs1 * gg.w + bb.w;
      *(float4*)(xr0 + ch) = o0;
      if (has1) *(float4*)(xr1 + ch) = o1;
      if (write_h2) {
        const float4 sh0 = *(const float4*)(m0 + 3072 + ch), sc0 = *(const float4*)(m0 + 4096 + ch);
        uint2 h; h.x = pack2(o0.x * (1.f + sc0.x) + sh0.x, o0.y * (1.f + sc0.y) + sh0.y); h.y = pack2(o0.z * (1.f + sc0.z) + sh0.z, o0.w * (1.f + sc0.w) + sh0.w);
        *(uint2*)(H + (size_t)r0 * D + ch) = h;
        if (has1) {
          const float4 sh1 = *(const float4*)(m1 + 3072 + ch), sc1 = *(const float4*)(m1 + 4096 + ch);
          h.x = pack2(o1.x * (1.f + sc1.x) + sh1.x, o1.y * (1.f + sc1.y) + sh1.y); h.y = pack2(o1.z * (1.f + sc1.z) + sh1.z, o1.w * (1.f + sc1.w) + sh1.w);
          *(uint2*)(H + (size_t)r1 * D + ch) = h;
        }
      }
    }
  }
}

__device__ __forceinline__ void conv_phase(const Params& p, int l) {
  const bf16_t* P = (const bf16_t*)(p.ws + OFF_P);
  bf16_t* QKV = (bf16_t*)(p.ws + OFF_QKV); bf16_t* XBC = (bf16_t*)(p.ws + OFF_XBC);
  float* GBF = (float*)(p.ws + OFF_GBF); float* DTF = (float*)(p.ws + OFF_DTF);
  const int nb = GDIM(), bid = BIDX(), tid = TIDX();
  const int vb = ((nb & 7) == 0) ? (bid & 7) * (nb >> 3) + (bid >> 3) : bid;
  const int gtid = vb * 256 + tid, gsz = nb * 256;
  {
    const float* cw = p.gdn_conv_w + (size_t)l * 5 * 3072;
    const int c = tid & 127, hh = tid >> 7;
    for (int item = vb; item < (MG / 32) * 3; item += nb) {
      const int third = item % 3, pp = item / 3;
      const int ch0 = third * 1024 + c * 8;
      const int t0 = (pp * 2 + hh) * 16;
      int lo, hi;
      if (t0 < MLAT) { lo = t0 & ~63; hi = lo + 64; } else { lo = MLAT + ((t0 - MLAT) & ~255); hi = lo + 256; }
      u32x4 raw[20];
#pragma unroll
      for (int i = 0; i < 20; ++i) { const int row = t0 - 2 + i; raw[i] = (row >= lo && row < hi) ? *(const u32x4*)(P + (size_t)row * LDP + ch0) : (u32x4){0u, 0u, 0u, 0u}; }
      float wt[5][8];
#pragma unroll
      for (int j = 0; j < 5; ++j) { const float4 w0 = *(const float4*)(cw + j * 3072 + ch0), w1 = *(const float4*)(cw + j * 3072 + ch0 + 4);
        wt[j][0] = w0.x; wt[j][1] = w0.y; wt[j][2] = w0.z; wt[j][3] = w0.w; wt[j][4] = w1.x; wt[j][5] = w1.y; wt[j][6] = w1.z; wt[j][7] = w1.w; }
      const float qsc = (third == 0) ? 0.08838834764831845f : 1.f;
#pragma unroll
      for (int t = 0; t < 16; ++t) {
        float acc[8];
#pragma unroll
        for (int e = 0; e < 8; ++e) acc[e] = 0.f;
#pragma unroll
        for (int j = 0; j < 5; ++j) {
          const u32x4 rw = raw[t + j];
#pragma unroll
          for (int e = 0; e < 4; ++e) { acc[2 * e] += lo16(rw[e]) * wt[j][2 * e]; acc[2 * e + 1] += hi16(rw[e]) * wt[j][2 * e + 1]; }
        }
        float ss = 0.f;
#pragma unroll
        for (int e = 0; e < 8; ++e) { acc[e] = siluf_(acc[e]); ss += acc[e] * acc[e]; }
        ss += __shfl_xor(ss, 1); ss += __shfl_xor(ss, 2); ss += __shfl_xor(ss, 4); ss += __shfl_xor(ss, 8);
        const float sc = (third < 2) ? rsqrtf(ss + 1e-6f) * qsc : 1.f;
#pragma unroll
        for (int e = 0; e < 8; ++e) acc[e] *= sc;
        *(uint4*)(QKV + (size_t)(t0 + t) * 3072 + ch0) = pack8(acc);
      }
    }
  }
  {
    const float* sw = p.ssm_conv_w + (size_t)l * 5 * 4096; const float* sb = p.ssm_conv_b + (size_t)l * 4096;
    constexpr int nLat = G * 64 * 8 * 2, nCtx = (MCTX / 16) * 2;
    float wt[5][8], bs[8];
    int cur_half = -1;
    for (int item = vb; item < nLat + nCtx; item += nb) {
      int half, base, stride, p0, seglen;
      if (item < nLat) { half = item & 1; const int piece = (item >> 1) & 7, cl = (item >> 4) & 63, b_l = item >> 10; base = b_l * 8192 + cl; stride = 64; p0 = piece * 16; seglen = 128; }
      else { const int i2 = item - nLat; half = i2 & 1; const int piece = i2 >> 1; base = MLAT + (piece >> 4) * 256; stride = 1; p0 = (piece & 15) * 16; seglen = 256; }
      const int ch0 = (half * 256 + tid) * 8;
      u32x4 raw[20];
#pragma unroll
      for (int i = 0; i < 20; ++i) { const int pq = p0 - 2 + i; raw[i] = (pq >= 0 && pq < seglen) ? *(const u32x4*)(P + (size_t)(base + pq * stride) * LDP + C_XBC + ch0) : (u32x4){0u, 0u, 0u, 0u}; }
      if (half != cur_half) {
        cur_half = half;
        const float4 b0 = *(const float4*)(sb + ch0), b1 = *(const float4*)(sb + ch0 + 4);
        bs[0] = b0.x; bs[1] = b0.y; bs[2] = b0.z; bs[3] = b0.w; bs[4] = b1.x; bs[5] = b1.y; bs[6] = b1.z; bs[7] = b1.w;
#pragma unroll
        for (int j = 0; j < 5; ++j) { const float4 w0 = *(const float4*)(sw + j * 4096 + ch0), w1 = *(const float4*)(sw + j * 4096 + ch0 + 4);
          wt[j][0] = w0.x; wt[j][1] = w0.y; wt[j][2] = w0.z; wt[j][3] = w0.w; wt[j][4] = w1.x; wt[j][5] = w1.y; wt[j][6] = w1.z; wt[j][7] = w1.w; }
      }
#pragma unroll
      for (int t = 0; t < 16; ++t) {
        float acc[8];
#pragma unroll
        for (int e = 0; e < 8; ++e) acc[e] = bs[e];
#pragma unroll
        for (int j = 0; j < 5; ++j) {
          const u32x4 rw = raw[t + j];
#pragma unroll
          for (int e = 0; e < 4; ++e) { acc[2 * e] += lo16(rw[e]) * wt[j][2 * e]; acc[2 * e + 1] += hi16(rw[e]) * wt[j][2 * e + 1]; }
        }
#pragma unroll
        for (int e = 0; e < 8; ++e) acc[e] = siluf_(acc[e]);
        *(uint4*)(XBC + (size_t)(base + (p0 + t) * stride) * 4096 + ch0) = pack8(acc);
      }
    }
  }
  for (int idx = gtid; idx < MG * 16; idx += gsz) {
    const int r = idx >> 4, dh = idx & 15;
    GBF[(size_t)r * 32 + 16 + dh] = sigmoidf_(bf2f(P[(size_t)r * LDP + C_B + dh]));
  }
  for (int idx = gtid; idx < G * 2 * 264 * 8; idx += gsz) {
    const int h = idx & 7; int t = idx >> 3; const int chunk = t % 264; t /= 264; const int dir = t & 1, b_l = t >> 1;
    const int dh = dir * 8 + h;
    const float bias = p.gdn_dt_bias[l * 16 + dh], aneg = -__expf(p.gdn_A_log[l * 16 + dh]);
    float cum = 0.f;
    for (int ub = 0; ub < 32; ub += 8) {
      float av[8];
#pragma unroll
      for (int u = 0; u < 8; ++u) av[u] = bf2f(P[(size_t)gdn_rowof(b_l, dir, chunk * 32 + ub + u) * LDP + C_A + dh]);
#pragma unroll
      for (int u = 0; u < 8; ++u) {
        cum += aneg * softplusf_(av[u] + bias);
        GBF[(size_t)gdn_rowof(b_l, dir, chunk * 32 + ub + u) * 32 + dh] = cum;
      }
    }
  }
  for (int idx = gtid; idx < G * 2 * 264 * 32; idx += gsz) {
    const int head = idx & 31; int t = idx >> 5; const int chunk = t % 264; t /= 264; const int dir = t & 1, b_l = t >> 1;
    const int dh = dir * 32 + head;
    const float bias = p.ssm_dt_bias[l * 64 + dh], aneg = -__expf(p.ssm_A_log[l * 64 + dh]);
    float cum = 0.f;
    for (int ub = 0; ub < 32; ub += 8) {
      float dtv[8];
#pragma unroll
      for (int u = 0; u < 8; ++u) dtv[u] = bf2f(P[(size_t)ssd_rowof(b_l, dir, chunk * 32 + ub + u) * LDP + C_DT + dh]);
#pragma unroll
      for (int u = 0; u < 8; ++u) {
        const size_t row = (size_t)ssd_rowof(b_l, dir, chunk * 32 + ub + u);
        const float dt = softplusf_(dtv[u] + bias);
        cum += dt * aneg;
        DTF[row * 128 + dh] = dt;
        DTF[row * 128 + 64 + dh] = cum;
      }
    }
  }
}

__device__ __forceinline__ void gdn_prep_phase(const Params& p, unsigned char* smraw) {
  const int tid = TIDX(), lane = tid & 63, w = tid >> 6, fr = lane & 15, fq = lane >> 4, ti = w >> 1, tj = w & 1;
  bf16_t* sK = (bf16_t*)smraw;
  bf16_t* sQ = sK + 32 * 136;
  bf16_t* sP = sQ + 32 * 136;
  bf16_t* sPT = sP + 2 * 1280;
  bf16_t* sR = sPT + 2 * 1280;
  float* sG = (float*)(sR + 2 * 1280);
  const bf16_t* QKV = (const bf16_t*)(p.ws + OFF_QKV);
  const float* GBF = (const float*)(p.ws + OFF_GBF);
  bf16_t* TMB = (bf16_t*)(p.ws + OFF_TMB);
  const int ltok = tid & 31, lp = tid >> 5;
  const int i = ti * 16 + fr, j0 = tj * 16 + fq * 4;
  for (int item = BIDX(); item < GDN_NITEM; item += GDIM()) {
    const int chunk = item % 264; const int t = item / 264; const int dir = t & 1, h = (t >> 1) & 7, b_l = t >> 4;
    const size_t row = (size_t)gdn_rowof(b_l, dir, chunk * 32 + ltok);
    const bf16_t* src = QKV + row * 3072 + h * 128;
    const u32x4 k0 = *(const u32x4*)(src + 1024 + lp * 8), k1 = *(const u32x4*)(src + 1024 + (lp + 8) * 8);
    const u32x4 q0 = *(const u32x4*)(src + lp * 8), q1 = *(const u32x4*)(src + (lp + 8) * 8);
    float g_ = 0.f, b_ = 0.f;
    if (tid < 32) { g_ = GBF[row * 32 + dir * 8 + h]; b_ = GBF[row * 32 + 16 + dir * 8 + h]; }
    __syncthreads();
    *(u32x4*)(sK + ltok * 136 + lp * 8) = k0; *(u32x4*)(sK + ltok * 136 + (lp + 8) * 8) = k1;
    *(u32x4*)(sQ + ltok * 136 + lp * 8) = q0; *(u32x4*)(sQ + ltok * 136 + (lp + 8) * 8) = q1;
    if (tid < 32) { sG[tid] = g_; sG[32 + tid] = b_; }
    __syncthreads();
    {
      f32x4 kk = (f32x4){0.f, 0.f, 0.f, 0.f}, qk = kk;
#pragma unroll
      for (int ks = 0; ks < 4; ++ks) {
        const bf16x8 kj = *(const bf16x8*)(sK + (tj * 16 + fr) * 136 + ks * 32 + fq * 8);
        const bf16x8 ki = *(const bf16x8*)(sK + (ti * 16 + fr) * 136 + ks * 32 + fq * 8);
        const bf16x8 qi = *(const bf16x8*)(sQ + (ti * 16 + fr) * 136 + ks * 32 + fq * 8);
        kk = __builtin_amdgcn_mfma_f32_16x16x32_bf16(kj, ki, kk, 0, 0, 0);
        qk = __builtin_amdgcn_mfma_f32_16x16x32_bf16(kj, qi, qk, 0, 0, 0);
      }
      const float gi = sG[i], bi = sG[32 + i];
      float n[4], nt[4], rr[4], m[4];
#pragma unroll
      for (int r = 0; r < 4; ++r) {
        const int j = j0 + r; const float gj = sG[j], bj = sG[32 + j];
        n[r] = (j < i) ? -bi * kk[r] * __expf(gi - gj) : 0.f;
        nt[r] = (i < j) ? -bj * kk[r] * __expf(gj - gi) : 0.f;
        m[r] = (j <= i) ? qk[r] * __expf(gi - gj) : 0.f;
        rr[r] = n[r] + ((i == j) ? 1.f : 0.f);
      }
      uint2 o;
      o.x = pack2(n[0], n[1]); o.y = pack2(n[2], n[3]); *(uint2*)(sP + i * 40 + j0) = o;
      o.x = pack2(nt[0], nt[1]); o.y = pack2(nt[2], nt[3]); *(uint2*)(sPT + i * 40 + j0) = o;
      o.x = pack2(rr[0], rr[1]); o.y = pack2(rr[2], rr[3]); *(uint2*)(sR + i * 40 + j0) = o;
      o.x = pack2(m[0], m[1]); o.y = pack2(m[2], m[3]); *(uint2*)(TMB + (size_t)item * 2048 + 1024 + i * 32 + j0) = o;
    }
    __syncthreads();
    int pc = 0, rc = 0;
#pragma unroll
    for (int st = 1; st <= 5; ++st) {
      const bf16_t* Pc = sP + pc * 1280; const bf16_t* PTc = sPT + pc * 1280; const bf16_t* Rc = sR + rc * 1280;
      const bf16x8 p_i = *(const bf16x8*)(Pc + (ti * 16 + fr) * 40 + fq * 8);
      const bf16x8 p_j = *(const bf16x8*)(Pc + (tj * 16 + fr) * 40 + fq * 8);
      const bf16x8 pt_i = *(const bf16x8*)(PTc + (ti * 16 + fr) * 40 + fq * 8);
      const bf16x8 pt_j = *(const bf16x8*)(PTc + (tj * 16 + fr) * 40 + fq * 8);
      const f32x4 z = (f32x4){0.f, 0.f, 0.f, 0.f};
      if (st >= 2) {
        const bf16x8 r_i = *(const bf16x8*)(Rc + (ti * 16 + fr) * 40 + fq * 8);
        const uint2 rin = *(const uint2*)(Rc + i * 40 + j0);
        f32x4 racc = (f32x4){lo16(rin.x), hi16(rin.x), lo16(rin.y), hi16(rin.y)};
        racc = __builtin_amdgcn_mfma_f32_16x16x32_bf16(pt_j, r_i, racc, 0, 0, 0);
        uint2 o; o.x = pack2(racc[0], racc[1]); o.y = pack2(racc[2], racc[3]);
        if (st < 5) *(uint2*)(sR + (rc ^ 1) * 1280 + i * 40 + j0) = o;
        else *(uint2*)(TMB + (size_t)item * 2048 + i * 32 + j0) = o;
      }
      if (st <= 4) {
        const f32x4 pn = __builtin_amdgcn_mfma_f32_16x16x32_bf16(pt_j, p_i, z, 0, 0, 0);
        const f32x4 ptn = __builtin_amdgcn_mfma_f32_16x16x32_bf16(p_j, pt_i, z, 0, 0, 0);
        uint2 o; o.x = pack2(pn[0], pn[1]); o.y = pack2(pn[2], pn[3]); *(uint2*)(sP + (pc ^ 1) * 1280 + i * 40 + j0) = o;
        o.x = pack2(ptn[0], ptn[1]); o.y = pack2(ptn[2], ptn[3]); *(uint2*)(sPT + (pc ^ 1) * 1280 + i * 40 + j0) = o;
      }
      if (st < 5) __syncthreads();
      pc ^= 1; if (st >= 2) rc ^= 1;
    }
  }
}

__device__ __forceinline__ void gdn_chunk_item(const Params& p, int id, unsigned char* smraw) {
  const int tid = TIDX(), lane = tid & 63, w = tid >> 6, fr = lane & 15, fq = lane >> 4, ta = w >> 1, tb = w & 1;
  const int b_l = id >> 6, h = (id >> 3) & 7, dir = (id >> 2) & 1, dvq = id & 3;
  bf16_t* sKb = (bf16_t*)smraw;
  bf16_t* sQ = sKb + 32 * 136;
  bf16_t* sKdT = sQ + 32 * 136;
  bf16_t* sVbT = sKdT + 128 * 40;
  bf16_t* sT = sVbT + 32 * 40;
  bf16_t* sM = sT + 32 * 40;
  bf16_t* sXT = sM + 32 * 40;
  bf16_t* sVnT = sXT + 32 * 40;
  bf16_t* sST = sVnT + 32 * 40;
  float* sG = (float*)(sST + 32 * 136);
  const bf16_t* QKV = (const bf16_t*)(p.ws + OFF_QKV);
  const float* GBF = (const float*)(p.ws + OFF_GBF);
  const bf16_t* TMB = (const bf16_t*)(p.ws + OFF_TMB);
  bf16_t* OUT = (bf16_t*)(p.ws + (dir ? OFF_OB : OFF_OF));
  const int ltok = tid & 31, lp = tid >> 5;
  const size_t item0 = (size_t)((b_l * 8 + h) * 2 + dir) * 264;
  struct Stage { u32x4 k0, k1, q0, q1, v, tm; float g, be, gl; };
  Stage st0, st1;
  constexpr int NCH = (256 + 8192) / 32;
  auto gload = [&](Stage& st, int c) __attribute__((always_inline)) {
    const int s0 = (c < NCH ? c : NCH - 1) * 32;
    const size_t row = (size_t)gdn_rowof(b_l, dir, s0 + ltok);
    const bf16_t* src = QKV + row * 3072 + h * 128;
    st.k0 = *(const u32x4*)(src + 1024 + lp * 8); st.k1 = *(const u32x4*)(src + 1024 + (lp + 8) * 8);
    st.q0 = *(const u32x4*)(src + lp * 8); st.q1 = *(const u32x4*)(src + (lp + 8) * 8);
    st.v = *(const u32x4*)(src + 2048 + dvq * 32 + (lp & 3) * 8);
    st.tm = *(const u32x4*)(TMB + (item0 + (c < NCH ? c : NCH - 1)) * 2048 + (tid >> 7) * 1024 + ((tid & 127) >> 2) * 32 + (tid & 3) * 8);
    st.g = GBF[row * 32 + dir * 8 + h]; st.be = GBF[row * 32 + 16 + dir * 8 + h];
    st.gl = GBF[(size_t)gdn_rowof(b_l, dir, s0 + 31) * 32 + dir * 8 + h];
  };
  auto lstore = [&](const Stage& st) __attribute__((always_inline)) {
    const float skb = st.be * __expf(st.g), skd = __expf(st.gl - st.g);
    {
      float f[8]; uint4 o;
      f[0] = lo16(st.k0[0]); f[1] = hi16(st.k0[0]); f[2] = lo16(st.k0[1]); f[3] = hi16(st.k0[1]); f[4] = lo16(st.k0[2]); f[5] = hi16(st.k0[2]); f[6] = lo16(st.k0[3]); f[7] = hi16(st.k0[3]);
      bf16_t* t0 = sKdT + (lp * 8) * 40 + ltok;
#pragma unroll
      for (int e = 0; e < 4; ++e) { const unsigned pk = pack2(f[2 * e] * skd, f[2 * e + 1] * skd); t0[(2 * e) * 40] = (bf16_t)(pk & 0xffffu); t0[(2 * e + 1) * 40] = (bf16_t)(pk >> 16); }
#pragma unroll
      for (int e = 0; e < 8; ++e) f[e] *= skb;
      o = pack8(f); *(uint4*)(sKb + ltok * 136 + lp * 8) = o;
      f[0] = lo16(st.k1[0]); f[1] = hi16(st.k1[0]); f[2] = lo16(st.k1[1]); f[3] = hi16(st.k1[1]); f[4] = lo16(st.k1[2]); f[5] = hi16(st.k1[2]); f[6] = lo16(st.k1[3]); f[7] = hi16(st.k1[3]);
      bf16_t* t1 = sKdT + ((lp + 8) * 8) * 40 + ltok;
#pragma unroll
      for (int e = 0; e < 4; ++e) { const unsigned pk = pack2(f[2 * e] * skd, f[2 * e + 1] * skd); t1[(2 * e) * 40] = (bf16_t)(pk & 0xffffu); t1[(2 * e + 1) * 40] = (bf16_t)(pk >> 16); }
#pragma unroll
      for (int e = 0; e < 8; ++e) f[e] *= skb;
      o = pack8(f); *(uint4*)(sKb + ltok * 136 + (lp + 8) * 8) = o;
    }
    *(u32x4*)(sQ + ltok * 136 + lp * 8) = st.q0; *(u32x4*)(sQ + ltok * 136 + (lp + 8) * 8) = st.q1;
    if (tid < 128) {
      bf16_t* tv = sVbT + (lp * 8) * 40 + ltok;
#pragma unroll
      for (int e = 0; e < 4; ++e) { const unsigned pk = pack2(lo16(st.v[e]) * st.be, hi16(st.v[e]) * st.be); tv[(2 * e) * 40] = (bf16_t)(pk & 0xffffu); tv[(2 * e + 1) * 40] = (bf16_t)(pk >> 16); }
      *(u32x4*)(sT + ((tid & 127) >> 2) * 40 + (tid & 3) * 8) = st.tm;
    } else {
      *(u32x4*)(sM + ((tid & 127) >> 2) * 40 + (tid & 3) * 8) = st.tm;
    }
    if (tid < 32) sG[tid] = st.g;
  };
  f32x4 S[4];
#pragma unroll
  for (int t = 0; t < 4; ++t) S[t] = (f32x4){0.f, 0.f, 0.f, 0.f};
  __syncthreads();
  for (int i = tid; i < 32 * 136 / 2; i += 256) ((unsigned*)sST)[i] = 0u;
  gload(st0, 0); lstore(st0);
  __syncthreads();
  gload(st0, 1);
  __builtin_amdgcn_sched_barrier(0);
  gload(st1, 2);
  __builtin_amdgcn_sched_barrier(0);
  auto body = [&](int c) __attribute__((always_inline)) {
    const int dv = ta * 16 + fr, i0 = tb * 16 + fq * 4;
    {
      f32x4 pr = (f32x4){0.f, 0.f, 0.f, 0.f};
#pragma unroll
      for (int ks = 0; ks < 4; ++ks) {
        const bf16x8 kb = *(const bf16x8*)(sKb + (tb * 16 + fr) * 136 + ks * 32 + fq * 8);
        const bf16x8 sf = *(const bf16x8*)(sST + (ta * 16 + fr) * 136 + ks * 32 + fq * 8);
        pr = __builtin_amdgcn_mfma_f32_16x16x32_bf16(kb, sf, pr, 0, 0, 0);
      }
      const uint2 vb = *(const uint2*)(sVbT + dv * 40 + i0);
      uint2 o; o.x = pack2(lo16(vb.x) - pr[0], hi16(vb.x) - pr[1]); o.y = pack2(lo16(vb.y) - pr[2], hi16(vb.y) - pr[3]);
      *(uint2*)(sXT + dv * 40 + i0) = o;
    }
    __syncthreads();
    {
      const bf16x8 tf = *(const bf16x8*)(sT + (tb * 16 + fr) * 40 + fq * 8);
      const bf16x8 xf = *(const bf16x8*)(sXT + (ta * 16 + fr) * 40 + fq * 8);
      const f32x4 vn = __builtin_amdgcn_mfma_f32_16x16x32_bf16(tf, xf, (f32x4){0.f, 0.f, 0.f, 0.f}, 0, 0, 0);
      uint2 o; o.x = pack2(vn[0], vn[1]); o.y = pack2(vn[2], vn[3]);
      *(uint2*)(sVnT + dv * 40 + i0) = o;
    }
    __syncthreads();
    const float eglast = __expf(sG[31]);
    {
      f32x4 oa = (f32x4){0.f, 0.f, 0.f, 0.f};
#pragma unroll
      for (int ks = 0; ks < 4; ++ks) {
        const bf16x8 qf = *(const bf16x8*)(sQ + (ta * 16 + fr) * 136 + ks * 32 + fq * 8);
        const bf16x8 sf = *(const bf16x8*)(sST + (tb * 16 + fr) * 136 + ks * 32 + fq * 8);
        oa = __builtin_amdgcn_mfma_f32_16x16x32_bf16(sf, qf, oa, 0, 0, 0);
      }
      const int i = ta * 16 + fr;
      oa *= __expf(sG[i]);
      const bf16x8 mf = *(const bf16x8*)(sM + i * 40 + fq * 8);
      const bf16x8 vf = *(const bf16x8*)(sVnT + (tb * 16 + fr) * 40 + fq * 8);
      oa = __builtin_amdgcn_mfma_f32_16x16x32_bf16(vf, mf, oa, 0, 0, 0);
      uint2 o; o.x = pack2(oa[0], oa[1]); o.y = pack2(oa[2], oa[3]);
      *(uint2*)(OUT + (size_t)gdn_rowof(b_l, dir, c * 32 + i) * 1024 + h * 128 + dvq * 32 + tb * 16 + fq * 4) = o;
    }
    {
      const bf16x8 vf = *(const bf16x8*)(sVnT + (ta * 16 + fr) * 40 + fq * 8);
#pragma unroll
      for (int t = 0; t < 4; ++t) {
        const bf16x8 kf = *(const bf16x8*)(sKdT + ((tb * 4 + t) * 16 + fr) * 40 + fq * 8);
        S[t] *= eglast;
        S[t] = __builtin_amdgcn_mfma_f32_16x16x32_bf16(kf, vf, S[t], 0, 0, 0);
      }
    }
    __syncthreads();
#pragma unroll
    for (int t = 0; t < 4; ++t) {
      uint2 o; o.x = pack2(S[t][0], S[t][1]); o.y = pack2(S[t][2], S[t][3]);
      *(uint2*)(sST + (ta * 16 + fr) * 136 + (tb * 4 + t) * 16 + fq * 4) = o;
    }
  };
  for (int c = 0; c < NCH; c += 2) {
    body(c);
    lstore(st0); gload(st0, c + 3);
    __syncthreads();
    body(c + 1);
    if (c + 2 < NCH) lstore(st1);
    gload(st1, c + 4);
    __syncthreads();
  }
}

__device__ __forceinline__ void ssd_chunk_item(const Params& p, int id, unsigned char* smraw) {
  const int tid = TIDX(), lane = tid & 63, w = tid >> 6, fr = lane & 15, fq = lane >> 4;
  const int b_l = id >> 6, head = (id >> 1) & 31, dir = id & 1, grp = head >> 2;
  bf16_t* sC = (bf16_t*)smraw;
  bf16_t* sB = sC + 32 * 136;
  bf16_t* sBT = sB + 32 * 136;
  bf16_t* sXT = sBT + 128 * 40;
  bf16_t* sM = sXT + 64 * 40;
  bf16_t* sST = sM + 32 * 40;
  float* sG = (float*)(sST + 64 * 136);
  const bf16_t* XBC = (const bf16_t*)(p.ws + OFF_XBC);
  const float* DTF = (const float*)(p.ws + OFF_DTF);
  bf16_t* OUT = (bf16_t*)(p.ws + (dir ? OFF_YB : OFF_YF));
  const int ltok = tid & 31, lpart = tid >> 5;
  struct Stage { u32x4 b0, b1, c0, c1, x; float dt, g, gl; };
  Stage st0, st1;
  constexpr int NCH = (256 + 8192) / 32;
  auto gload = [&](Stage& st, int c) __attribute__((always_inline)) {
    const int s0 = (c < NCH ? c : NCH - 1) * 32;
    const size_t row = (size_t)ssd_rowof(b_l, dir, s0 + ltok);
    const bf16_t* xr = XBC + row * 4096;
    st.b0 = *(const u32x4*)(xr + 2048 + grp * 128 + lpart * 8);
    st.b1 = *(const u32x4*)(xr + 2048 + grp * 128 + (lpart + 8) * 8);
    st.c0 = *(const u32x4*)(xr + 3072 + grp * 128 + lpart * 8);
    st.c1 = *(const u32x4*)(xr + 3072 + grp * 128 + (lpart + 8) * 8);
    st.x = *(const u32x4*)(xr + head * 64 + lpart * 8);
    st.dt = DTF[row * 128 + dir * 32 + head];
    st.g = DTF[row * 128 + 64 + dir * 32 + head];
    st.gl = DTF[(size_t)ssd_rowof(b_l, dir, s0 + 31) * 128 + 64 + dir * 32 + head];
  };
  auto lstore = [&](const Stage& st) __attribute__((always_inline)) {
    *(u32x4*)(sB + ltok * 136 + lpart * 8) = st.b0;
    *(u32x4*)(sB + ltok * 136 + (lpart + 8) * 8) = st.b1;
    *(u32x4*)(sC + ltok * 136 + lpart * 8) = st.c0;
    *(u32x4*)(sC + ltok * 136 + (lpart + 8) * 8) = st.c1;
    const float wj = __expf(st.gl - st.g);
    bf16_t* t0 = sBT + (lpart * 8) * 40 + ltok;
    bf16_t* t1 = sBT + ((lpart + 8) * 8) * 40 + ltok;
    bf16_t* tx = sXT + (lpart * 8) * 40 + ltok;
#pragma unroll
    for (int e = 0; e < 4; ++e) {
      const unsigned pa = pack2(lo16(st.b0[e]) * wj, hi16(st.b0[e]) * wj), pb = pack2(lo16(st.b1[e]) * wj, hi16(st.b1[e]) * wj);
      const unsigned px = pack2(lo16(st.x[e]) * st.dt, hi16(st.x[e]) * st.dt);
      t0[(2 * e) * 40] = (bf16_t)(pa & 0xffffu); t0[(2 * e + 1) * 40] = (bf16_t)(pa >> 16);
      t1[(2 * e) * 40] = (bf16_t)(pb & 0xffffu); t1[(2 * e + 1) * 40] = (bf16_t)(pb >> 16);
      tx[(2 * e) * 40] = (bf16_t)(px & 0xffffu); tx[(2 * e + 1) * 40] = (bf16_t)(px >> 16);
    }
    if (tid < 32) sG[tid] = st.g;
  };
  f32x4 S[8];
#pragma unroll
  for (int i = 0; i < 8; ++i) S[i] = (f32x4){0.f, 0.f, 0.f, 0.f};
  __syncthreads();
  for (int i = lane; i < 16 * 136 / 2; i += 64) ((unsigned*)(sST + w * 16 * 136))[i] = 0u;
  gload(st0, 0); lstore(st0);
  __syncthreads();
  gload(st0, 1);
  __builtin_amdgcn_sched_barrier(0);
  gload(st1, 2);
  __builtin_amdgcn_sched_barrier(0);
  auto body = [&](int c) __attribute__((always_inline)) {
    {
      const int ti = w >> 1, tj = w & 1;
      f32x4 cb = (f32x4){0.f, 0.f, 0.f, 0.f};
      if (tj <= ti) {
#pragma unroll
        for (int ks = 0; ks < 4; ++ks) {
          const bf16x8 af = *(const bf16x8*)(sC + (ti * 16 + fr) * 136 + ks * 32 + fq * 8);
          const bf16x8 bf = *(const bf16x8*)(sB + (tj * 16 + fr) * 136 + ks * 32 + fq * 8);
          cb = __builtin_amdgcn_mfma_f32_16x16x32_bf16(bf, af, cb, 0, 0, 0);
        }
      }
      const int i = ti * 16 + fr, j0 = tj * 16 + fq * 4;
      const float gi = sG[i];
      const f32x4 gj = *(const f32x4*)(sG + j0);
      float m[4];
#pragma unroll
      for (int r = 0; r < 4; ++r) { const float e = __expf(fminf(gi - gj[r], 0.f)); m[r] = (j0 + r <= i) ? cb[r] * e : 0.f; }
      uint2 o; o.x = pack2(m[0], m[1]); o.y = pack2(m[2], m[3]);
      *(uint2*)(sM + i * 40 + j0) = o;
    }
    __syncthreads();
    const bf16x8 xfrag = *(const bf16x8*)(sXT + (w * 16 + fr) * 40 + fq * 8);
    const float eglast = __expf(sG[31]);
#pragma unroll
    for (int ti = 0; ti < 2; ++ti) {
      f32x4 y = (f32x4){0.f, 0.f, 0.f, 0.f};
#pragma unroll
      for (int ks = 0; ks < 4; ++ks) {
        const bf16x8 af = *(const bf16x8*)(sC + (ti * 16 + fr) * 136 + ks * 32 + fq * 8);
        const bf16x8 bf = *(const bf16x8*)(sST + (w * 16 + fr) * 136 + ks * 32 + fq * 8);
        y = __builtin_amdgcn_mfma_f32_16x16x32_bf16(bf, af, y, 0, 0, 0);
      }
      const int i = ti * 16 + fr;
      const float eg = __expf(sG[i]);
      y *= eg;
      const bf16x8 mf = *(const bf16x8*)(sM + i * 40 + fq * 8);
      y = __builtin_amdgcn_mfma_f32_16x16x32_bf16(xfrag, mf, y, 0, 0, 0);
      uint2 o; o.x = pack2(y[0], y[1]); o.y = pack2(y[2], y[3]);
      *(uint2*)(OUT + (size_t)ssd_rowof(b_l, dir, c * 32 + i) * 2048 + head * 64 + w * 16 + fq * 4) = o;
    }
#pragma unroll
    for (int tn = 0; tn < 8; ++tn) {
      const bf16x8 bf = *(const bf16x8*)(sBT + (tn * 16 + fr) * 40 + fq * 8);
      S[tn] *= eglast;
      S[tn] = __builtin_amdgcn_mfma_f32_16x16x32_bf16(bf, xfrag, S[tn], 0, 0, 0);
    }
#pragma unroll
    for (int tn = 0; tn < 8; ++tn) {
      uint2 o; o.x = pack2(S[tn][0], S[tn][1]); o.y = pack2(S[tn][2], S[tn][3]);
      *(uint2*)(sST + (w * 16 + fr) * 136 + tn * 16 + fq * 4) = o;
    }
    __syncthreads();
  };
  for (int c = 0; c < NCH; c += 2) {
    body(c);
    lstore(st0); gload(st0, c + 3);
    __syncthreads();
    body(c + 1);
    if (c + 2 < NCH) lstore(st1);
    gload(st1, c + 4);
    __syncthreads();
  }
}

__device__ __forceinline__ void scan_phase(const Params& p, unsigned char* sm, int nb, int v) {
  for (int item = v; item < 256; item += nb) {
    if (item < 128) gdn_chunk_item(p, item, sm); else ssd_chunk_item(p, item - 128, sm);
    __syncthreads();
  }
}

__device__ __forceinline__ void gnorm_phase(const Params& p, int l, int M) {
  const bf16_t* P = (const bf16_t*)(p.ws + OFF_P);
  const bf16_t* OF = (const bf16_t*)(p.ws + OFF_OF); const bf16_t* OB = (const bf16_t*)(p.ws + OFF_OB);
  const bf16_t* YF = (const bf16_t*)(p.ws + OFF_YF); const bf16_t* YB = (const bf16_t*)(p.ws + OFF_YB);
  const bf16_t* XBC = (const bf16_t*)(p.ws + OFF_XBC);
  bf16_t* YA = (bf16_t*)(p.ws + OFF_QKV); bf16_t* YBn = YA + (size_t)MG * 1024;
  const int gtid = BIDX() * 256 + TIDX(), gsz = GDIM() * 256;
  const float* nw = p.gdn_norm_w + l * 128;
  for (int idx0 = gtid; idx0 < M * 128; idx0 += 2 * gsz) {
    const int idx1 = idx0 + gsz; const bool has1 = idx1 < M * 128;
    const int ia[2] = {idx0, has1 ? idx1 : idx0};
    uint4 a[2], b[2], gt[2];
#pragma unroll
    for (int u = 0; u < 2; ++u) { const int r = ia[u] >> 7, c8 = (ia[u] & 127) * 8;
      a[u] = *(const uint4*)(OF + (size_t)r * 1024 + c8); b[u] = *(const uint4*)(OB + (size_t)r * 1024 + c8); gt[u] = *(const uint4*)(P + (size_t)r * LDP + C_GOUT + c8); }
#pragma unroll
    for (int u = 0; u < 2; ++u) {
      const int r = ia[u] >> 7, c8 = (ia[u] & 127) * 8;
      float fa[8], fb[8], fg[8]; UNPACK8(a[u], fa); UNPACK8(b[u], fb); UNPACK8(gt[u], fg);
      float ss = 0.f;
#pragma unroll
      for (int e = 0; e < 8; ++e) { fa[e] += fb[e]; ss += fa[e] * fa[e]; }
      ss += __shfl_xor(ss, 1); ss += __shfl_xor(ss, 2); ss += __shfl_xor(ss, 4); ss += __shfl_xor(ss, 8);
      const float rs = rsqrtf(ss * (1.f / 128.f) + 1e-6f);
      const float4 w0 = *(const float4*)(nw + (c8 & 127)), w1 = *(const float4*)(nw + (c8 & 127) + 4);
      const float wv[8] = {w0.x, w0.y, w0.z, w0.w, w1.x, w1.y, w1.z, w1.w};
#pragma unroll
      for (int e = 0; e < 8; ++e) fa[e] = fa[e] * rs * wv[e] * siluf_(fg[e]);
      if (u == 0 || has1) *(uint4*)(YA + (size_t)r * 1024 + c8) = pack8(fa);
    }
  }
  const float* sw = p.ssm_norm_w + l * 2048; const float* Dk = p.ssm_D + l * 32;
  for (int idx0 = gtid; idx0 < M * 256; idx0 += 2 * gsz) {
    const int idx1 = idx0 + gsz; const bool has1 = idx1 < M * 256;
    const int ia[2] = {idx0, has1 ? idx1 : idx0};
    uint4 a[2], b[2], xx[2], zz[2];
#pragma unroll
    for (int u = 0; u < 2; ++u) { const int r = ia[u] >> 8, c8 = (ia[u] & 255) * 8;
      a[u] = *(const uint4*)(YF + (size_t)r * 2048 + c8); b[u] = *(const uint4*)(YB + (size_t)r * 2048 + c8);
      xx[u] = *(const uint4*)(XBC + (size_t)r * 4096 + c8); zz[u] = *(const uint4*)(P + (size_t)r * LDP + C_Z + c8); }
#pragma unroll
    for (int u = 0; u < 2; ++u) {
      const int r = ia[u] >> 8, c8 = (ia[u] & 255) * 8;
      float fa[8], fb[8], fx[8], fz[8]; UNPACK8(a[u], fa); UNPACK8(b[u], fb); UNPACK8(xx[u], fx); UNPACK8(zz[u], fz);
      const float dsk = Dk[c8 >> 6];
      float ss = 0.f;
#pragma unroll
      for (int e = 0; e < 8; ++e) { fa[e] = (fa[e] + fb[e] + dsk * fx[e]) * siluf_(fz[e]); ss += fa[e] * fa[e]; }
      ss += __shfl_xor(ss, 1); ss += __shfl_xor(ss, 2); ss += __shfl_xor(ss, 4); ss += __shfl_xor(ss, 8); ss += __shfl_xor(ss, 16);
      const float rs = rsqrtf(ss * (1.f / 256.f) + 1e-6f);
      const float4 w0 = *(const float4*)(sw + c8), w1 = *(const float4*)(sw + c8 + 4);
      const float wv[8] = {w0.x, w0.y, w0.z, w0.w, w1.x, w1.y, w1.z, w1.w};
#pragma unroll
      for (int e = 0; e < 8; ++e) fa[e] = fa[e] * rs * wv[e];
      if (u == 0 || has1) *(uint4*)(YBn + (size_t)r * 2048 + c8) = pack8(fa);
    }
  }
}

#define XB_TMO      128
#define XB_XCNT(j)  (256  + 64 * (j))
#define XB_XSUB(j)  (1280 + 64 * (j))
#define XB_XGEN(j)  (2304 + 64 * (j))
#define XB_TOP      3328
#define XB_TOPGEN   3392
#define XCD_BAR_WORDS 3456
#define XB_SPIN_CAP (1u << 18)
#define LAS __attribute__((address_space(3)))

__device__ __forceinline__ unsigned xb_ld(unsigned* p)              { return __hip_atomic_load(p, __ATOMIC_RELAXED, __HIP_MEMORY_SCOPE_AGENT); }
__device__ __forceinline__ unsigned xb_add(unsigned* p, unsigned v) { return __hip_atomic_fetch_add(p, v, __ATOMIC_RELAXED, __HIP_MEMORY_SCOPE_AGENT); }
__device__ __forceinline__ unsigned xb_xcc_id() { return (unsigned)__builtin_amdgcn_s_getreg((3 << 11) | 20) & 0xFu; }
#define XB_SPIN(cond, bar) do { unsigned _sp = 0; while (cond) { __builtin_amdgcn_s_sleep(1); \
    if ((++_sp & 255u) == 0u) { if (xb_ld(&(bar)[XB_TMO])) break; if (_sp > XB_SPIN_CAP) { atomicAdd(&(bar)[XB_TMO], 1u); break; } } } } while (0)

struct XcdBarrier {
    unsigned* bar; unsigned x;
    volatile LAS unsigned* st;
};

__device__ __forceinline__ XcdBarrier xcd_barrier_post(unsigned* bar, volatile LAS unsigned* st) {
    XcdBarrier b; b.bar = bar; b.x = xb_xcc_id(); b.st = st;
    if (threadIdx.x == 0) (void)xb_add(&bar[XB_XCNT(b.x)], 1u);
    return b;
}
__device__ __forceinline__ void xcd_barrier_complete(unsigned* bar, unsigned x, unsigned& nloc, unsigned& nx) {
    const unsigned G = gridDim.x * gridDim.y * gridDim.z;
    unsigned sum, cnt, mine, sp = 0u;
    for (;;) {
        sum = 0u; cnt = 0u; mine = 0u;
#pragma unroll
        for (unsigned j = 0; j < 16; ++j) { const unsigned c = xb_ld(&bar[XB_XCNT(j)]); sum += c; cnt += (c > 0u) ? 1u : 0u; mine = (j == x) ? c : mine; }
        if (sum == G) break;
        __builtin_amdgcn_s_sleep(1);
        if ((++sp & 255u) == 0u) { if (xb_ld(&bar[XB_TMO])) break; if (sp > XB_SPIN_CAP) { atomicAdd(&bar[XB_TMO], 1u); break; } }
    }
    nloc = mine > 0u ? mine : 1u; nx = cnt > 0u ? cnt : 1u;
}

__device__ __forceinline__ void xcd_barrier(const XcdBarrier& b) {
    asm volatile("s_waitcnt vmcnt(0)" ::: "memory");
    __syncthreads();
    if (threadIdx.x == 0) {
        unsigned* bar = b.bar;
        __builtin_amdgcn_s_waitcnt(0);
        unsigned nloc = b.st[0], nx = b.st[1];
        if (nloc == 0u) { xcd_barrier_complete(bar, b.x, nloc, nx); b.st[0] = nloc; b.st[1] = nx; }
        const unsigned old = xb_add(&bar[XB_XSUB(b.x)], 1u);
        const unsigned gen = old / nloc;
        if (old + 1u == (gen + 1u) * nloc) {
            __builtin_amdgcn_fence(__ATOMIC_RELEASE, "agent");
            asm volatile("s_waitcnt vmcnt(0)" ::: "memory");
            const unsigned og = xb_add(&bar[XB_TOP], 1u);
            const unsigned tg = og / nx;
            if (og + 1u == (tg + 1u) * nx) xb_add(&bar[XB_TOPGEN], 1u);
            else XB_SPIN(xb_ld(&bar[XB_TOPGEN]) == tg, bar);
            __builtin_amdgcn_fence(__ATOMIC_ACQUIRE, "agent");
            xb_add(&bar[XB_XGEN(b.x)], 1u);
            asm volatile("s_waitcnt vmcnt(0)" ::: "memory");
        } else {
            XB_SPIN(xb_ld(&bar[XB_XGEN(b.x)]) == gen, bar);
            __builtin_amdgcn_fence(__ATOMIC_ACQUIRE, "agent");
            asm volatile("s_waitcnt vmcnt(0)" ::: "memory");
        }
    }
    __syncthreads();
}

#ifndef STOP_AFTER
#define STOP_AFTER 0
#endif
#define SYNC() { xcd_barrier(xb); if (++nsync == STOP_AFTER) return; }
#define PH(CALL) { CALL; }
__global__ void __launch_bounds__(256, 2) mega(Params p) {
  cg::grid_group grid = cg::this_grid();
  int nsync = 0;
  __shared__ __attribute__((aligned(16))) unsigned char smem[SMEM_BYTES];
  __shared__ uint4 xb_words;
  if (threadIdx.x == 0) xb_words = make_uint4(0u, 0u, 0u, 0u);
  __syncthreads();
  XcdBarrier xb = xcd_barrier_post((unsigned*)(p.ws + OFF_BAR), (volatile LAS unsigned*)&xb_words);
  float* smf = (float*)smem; bf16_t* smh = (bf16_t*)smem;
  for (int l = 0; l < 2; ++l) {
    PH(transpose_phase(p.w_in + (size_t)l * 1024 * IN_DIM, (bf16_t*)(p.ws + OFF_WIN), 1024, IN_DIM, LDP, smf))
    PH(transpose_phase(p.w_proj_gdn + (size_t)l * 1024 * 1024, (bf16_t*)(p.ws + OFF_WPG), 1024, 1024, 1024, smf))
    PH(transpose_phase(p.w_proj_ssm + (size_t)l * 2048 * 1024, (bf16_t*)(p.ws + OFF_WPS), 2048, 1024, 1024, smf))
    PH(transpose_phase(p.w_out + (size_t)l * 1024 * 1024, (bf16_t*)(p.ws + OFF_WOUT), 1024, 1024, 1024, smf))
    PH(transpose_phase(p.w_ff1 + (size_t)l * 1024 * 4096, (bf16_t*)(p.ws + OFF_WFF1), 1024, 4096, 4096, smf))
    PH(transpose_phase(p.w_ff2 + (size_t)l * 4096 * 1024, (bf16_t*)(p.ws + OFF_WFF2), 4096, 1024, 1024, smf))
    if (l == 0) { PH(modpart_phase(p, smf)) grid.sync(); PH(modfinal_phase(p)) }
    SYNC();
    const bool last = (l == 1);
    const int Mpost = last ? MLAT : MG;
    for (int g = 0; g < NGRP; ++g) {
      PH(modulate_phase(p, l, g)) SYNC();
      PH(gemm_inproj_phase(p, smh, 0, GDIM(), BIDX())) SYNC();
      PH(conv_phase(p, l)) SYNC();
      PH(gdn_prep_phase(p, smem)) SYNC();
      {
        const int nb_ = GDIM(), v_ = BIDX();
        if (nb_ >= 512) { if (v_ < 256) { PH(scan_phase(p, smem, 256, v_)) } else { PH(gemm_inproj_phase(p, smh, 1, nb_ - 256, v_ - 256)) } }
        else { PH(scan_phase(p, smem, nb_, v_)) PH(gemm_inproj_phase(p, smh, 1, nb_, v_)) }
      }
      SYNC();
      PH(gnorm_phase(p, l, Mpost)) SYNC();
      PH(gemm_proj_phase(p, Mpost, smh)) SYNC();
      PH(gemm_wout_phase(p, l, g, Mpost, smh)) SYNC();
      PH(ln_phase(p, l, g, Mpost, p.ln1_g + l * D, p.ln1_b + l * D, true)) SYNC();
      PH(gemm_ff1_phase(p, l, Mpost, smh)) SYNC();
      PH(gemm_ff2_phase(p, l, g, Mpost, smh)) SYNC();
      PH(ln_phase(p, l, g, Mpost, p.ln2_g + l * D, p.ln2_b + l * D, false)) SYNC();
    }
  }
}

extern "C" void kernel_launch(void* const* d_in, const int* in_sizes, int n_in, void* d_out, int out_size, void* d_ws, size_t ws_size,
                              hipStream_t stream) {
  static int grid_blocks = 0;
  if (!grid_blocks) {
    int dev = 0, cus = 0, per_cu = 0;
    (void)hipGetDevice(&dev);
    (void)hipDeviceGetAttribute(&cus, hipDeviceAttributeMultiprocessorCount, dev);
    (void)hipOccupancyMaxActiveBlocksPerMultiprocessor(&per_cu, mega, 256, 0);
    if (per_cu > 2) per_cu = 2;
    grid_blocks = cus * per_cu;
    if (ws_size < WS_TOTAL) fprintf(stderr, "workspace too small: %zu < %zu\n", ws_size, WS_TOTAL);
  }
  Params p{};
  const float** pp = (const float**)&p;
  for (int i = 0; i < 28; ++i) pp[i] = (const float*)d_in[i];
  p.out = (float*)d_out;
  p.ws = (unsigned char*)d_ws;
  (void)hipMemsetAsync((unsigned char*)d_ws + OFF_BAR, 0, 16384, stream);
  void* args[] = {&p};
  hipError_t e = hipLaunchCooperativeKernel((void*)mega, dim3(grid_blocks), dim3(256), args, 0, stream);
  if (e != hipSuccess) fprintf(stderr, "cooperative launch failed: %s (grid %d)\n", hipGetErrorString(e), grid_blocks);
}
```

```cpp
#include <hip/hip_runtime.h>
#include <hip/hip_cooperative_groups.h>
#include <cstdio>
namespace cg = cooperative_groups;

typedef unsigned short bf16_t;
typedef short bf16x8 __attribute__((ext_vector_type(8)));
typedef float f32x4 __attribute__((ext_vector_type(4)));
typedef float f32x2 __attribute__((ext_vector_type(2)));
typedef unsigned u32x4 __attribute__((ext_vector_type(4)));

constexpr int D = 1024, SEQ = 8192, LC = 256;
constexpr int G = 2, NGRP = 4;
constexpr int MLAT = G * SEQ, MCTX = G * LC, MG = MLAT + MCTX;
constexpr int IN_DIM = 12384, LDP = 12416;
constexpr int C_GOUT = 3072, C_A = 4096, C_B = 4112, C_Z = 4128, C_XBC = 6176, C_DT = 10272, C_GA = 10336, C_GB = 11360;
constexpr float DN_ALPHA = 1.4142135623730951f;

constexpr size_t SZ_WIN = (size_t)LDP * 1024 * 2;
constexpr size_t OFF_WIN = 0;
constexpr size_t OFF_WPG = OFF_WIN + SZ_WIN;
constexpr size_t OFF_WPS = OFF_WPG + 2097152;
constexpr size_t OFF_WOUT = OFF_WPS + 4194304;
constexpr size_t OFF_WFF1 = OFF_WOUT + 2097152;
constexpr size_t OFF_WFF2 = OFF_WFF1 + 8388608;
constexpr size_t OFF_MODP = OFF_WFF2 + 8388608;
constexpr size_t OFF_MOD = OFF_MODP + (size_t)2 * 16 * 9 * 6144 * 4;
constexpr size_t OFF_XSC = OFF_MOD + (size_t)2 * 9 * 6144 * 4;
constexpr size_t OFF_H = OFF_XSC + (size_t)2048 * 1024 * 4;
constexpr size_t OFF_P = OFF_H + (size_t)MG * 1024 * 2;
constexpr size_t OFF_QKV = OFF_P + (size_t)MG * LDP * 2;
constexpr size_t OFF_XBC = OFF_QKV + (size_t)MG * 3072 * 2;
constexpr size_t OFF_GBF = OFF_XBC + (size_t)MG * 4096 * 2;
constexpr size_t OFF_DTF = OFF_GBF + (size_t)MG * 32 * 4;
constexpr size_t OFF_OF = OFF_DTF + (size_t)MG * 128 * 4;
constexpr size_t OFF_OB = OFF_OF + (size_t)MG * 1024 * 2;
constexpr size_t OFF_YF = OFF_OB + (size_t)MG * 1024 * 2;
constexpr size_t OFF_YB = OFF_YF + (size_t)MG * 2048 * 2;
constexpr size_t OFF_TMB = OFF_YB + (size_t)MG * 2048 * 2;
constexpr int GDN_NITEM = G * 8 * 2 * 264;
constexpr size_t OFF_BAR = OFF_TMB + (size_t)GDN_NITEM * 2048 * 2;
constexpr size_t WS_TOTAL = OFF_BAR + 16384;
static_assert(WS_TOTAL <= ((size_t)1024 << 20), "workspace plan exceeds 1 GiB");

struct Params {
  const float *x, *c, *ctx, *c_ctx, *w_mod, *b_mod, *w_in, *gdn_conv_w, *gdn_A_log, *gdn_dt_bias, *gdn_norm_w;
  const float *ssm_conv_w, *ssm_conv_b, *ssm_A_log, *ssm_dt_bias, *ssm_D, *ssm_norm_w, *w_proj_gdn, *w_proj_ssm, *w_out;
  const float *ln1_g, *ln1_b, *w_ff1, *b_ff1, *w_ff2, *b_ff2, *ln2_g, *ln2_b;
  float* out;
  unsigned char* ws;
};

constexpr int SMEM_BYTES = 73728;


__device__ __forceinline__ int TIDX() { int t = threadIdx.x; asm volatile("" : "+v"(t)); return t; }
__device__ __forceinline__ int BIDX() { int t = blockIdx.x; asm volatile("" : "+s"(t)); return t; }
__device__ __forceinline__ int GDIM() { int t = gridDim.x; asm volatile("" : "+s"(t)); return t; }
__device__ __forceinline__ float bf2f(bf16_t b) { return __uint_as_float(((unsigned)b) << 16); }
__device__ __forceinline__ bf16_t f2bf(float f) { unsigned u = __float_as_uint(f); u += 0x7fffu + ((u >> 16) & 1u); return (bf16_t)(u >> 16); }
typedef __bf16 bf16v2 __attribute__((ext_vector_type(2)));
__device__ __forceinline__ unsigned pack2(float a, float b) { const f32x2 v = (f32x2){a, b}; const bf16v2 h = __builtin_convertvector(v, bf16v2); return __builtin_bit_cast(unsigned, h); }
__device__ __forceinline__ float lo16(unsigned v) { return __uint_as_float(v << 16); }
__device__ __forceinline__ float hi16(unsigned v) { return __uint_as_float(v & 0xffff0000u); }
#define UNPACK8(v, f) { f[0] = lo16(v.x); f[1] = hi16(v.x); f[2] = lo16(v.y); f[3] = hi16(v.y); f[4] = lo16(v.z); f[5] = hi16(v.z); f[6] = lo16(v.w); f[7] = hi16(v.w); }
__device__ __forceinline__ uint4 pack8(const float* f) { uint4 r; r.x = pack2(f[0], f[1]); r.y = pack2(f[2], f[3]); r.z = pack2(f[4], f[5]); r.w = pack2(f[6], f[7]); return r; }
__device__ __forceinline__ float sigmoidf_(float x) { return __builtin_amdgcn_rcpf(1.f + __expf(-x)); }
__device__ __forceinline__ float siluf_(float x) { return x * __builtin_amdgcn_rcpf(1.f + __expf(-x)); }
__device__ __forceinline__ float softplusf_(float x) { return x > 20.f ? x : log1pf(__expf(x)); }
template <int CTRL> __device__ __forceinline__ float dppf(float x) { return __builtin_bit_cast(float, __builtin_amdgcn_mov_dpp(__builtin_bit_cast(int, x), CTRL, 0xf, 0xf, true)); }
__device__ __forceinline__ float reduce16(float x) { x += dppf<0xB1>(x); x += dppf<0x4E>(x); x += dppf<0x141>(x); x += dppf<0x140>(x); return x; }

__device__ __forceinline__ float* xs_row(const Params& p, int g, int r) {
  return (r < MLAT) ? p.out + ((size_t)g * MLAT + r) * D : (float*)(p.ws + OFF_XSC) + ((size_t)g * MCTX + (r - MLAT)) * D;
}
__device__ __forceinline__ const float* xin_row(const Params& p, int l, int g, int r) {
  if (l == 0) return (r < MLAT) ? p.x + ((size_t)g * MLAT + r) * D : p.ctx + ((size_t)g * MCTX + (r - MLAT)) * D;
  return xs_row(p, g, r);
}
__device__ __forceinline__ int mod_row(int g, int r) { return r < MLAT ? g * G + r / SEQ : 8; }
__device__ __forceinline__ int gdn_rowof(int b_l, int dir, int s) {
  if (s < 256) { const int i = dir ? 255 - s : s; return MLAT + b_l * 256 + i; }
  const int i = s - 256; return b_l * 8192 + (dir ? 8191 - i : i);
}
__device__ __forceinline__ int ssd_rowof(int b_l, int dir, int s) {
  if (s < 256) { const int i = dir ? 255 - s : s; return MLAT + b_l * 256 + i; }
  const int j = s - 256; const int pos = dir ? 8191 - j : j; return b_l * 8192 + (pos & 127) * 64 + (pos >> 7);
}

__device__ __forceinline__ void transpose_phase(const float* __restrict__ src, bf16_t* __restrict__ dst, int K, int N, int Npad, float* tile) {
  const int tid = TIDX(), tk = K / 64, tn = Npad / 64;
  const int c = tid & 63, r4 = tid >> 6;
  for (int t = BIDX(); t < tk * tn; t += GDIM()) {
    const int kt = t % tk, nt = t / tk, k0 = kt * 64, n0 = nt * 64;
    __syncthreads();
#pragma unroll 4
    for (int i = 0; i < 16; ++i) { const int r = i * 4 + r4, n = n0 + c; tile[r * 65 + c] = (n < N) ? src[(size_t)(k0 + r) * N + n] : 0.f; }
    __syncthreads();
#pragma unroll 4
    for (int i = 0; i < 16; ++i) { const int nn = i * 4 + r4; dst[(size_t)(n0 + nn) * K + k0 + c] = f2bf(tile[c * 65 + nn]); }
  }
}

__device__ __forceinline__ void modpart_phase(const Params& p, float* sm) {
  const int tid = TIDX();
  float* MODP = (float*)(p.ws + OFF_MODP);
  for (int item = BIDX(); item < 2 * 24 * 16; item += GDIM()) {
    const int l = item / 384, rem = item % 384, cbk = rem / 16, ks = rem % 16;
    __syncthreads();
    for (int i = tid; i < 9 * 64; i += 256) { const int r = i / 64, k = ks * 64 + (i % 64); const float v = (r < 8) ? p.c[r * D + k] : p.c_ctx[k]; sm[i] = siluf_(v); }
    __syncthreads();
    const int col = cbk * 256 + tid;
    float acc[9];
#pragma unroll
    for (int r = 0; r < 9; ++r) acc[r] = 0.f;
    const float* wp = p.w_mod + ((size_t)l * D + ks * 64) * 6144 + col;
#pragma unroll 8
    for (int k = 0; k < 64; ++k) { const float w = wp[(size_t)k * 6144];
#pragma unroll
      for (int r = 0; r < 9; ++r) acc[r] += sm[r * 64 + k] * w; }
#pragma unroll
    for (int r = 0; r < 9; ++r) MODP[(((size_t)l * 16 + ks) * 9 + r) * 6144 + col] = acc[r];
  }
}
__device__ __forceinline__ void modfinal_phase(const Params& p) {
  const float* MODP = (const float*)(p.ws + OFF_MODP);
  float* MOD = (float*)(p.ws + OFF_MOD);
  for (int i = BIDX() * 256 + TIDX(); i < 2 * 9 * 6144; i += GDIM() * 256) {
    const int l = i / (9 * 6144), rem = i % (9 * 6144), col = rem % 6144;
    float s = p.b_mod[l * 6144 + col];
    for (int ks = 0; ks < 16; ++ks) s += MODP[((size_t)l * 16 + ks) * 9 * 6144 + rem];
    MOD[i] = s;
  }
}

__device__ __forceinline__ void modulate_phase(const Params& p, int l, int g) {
  const float* MOD = (const float*)(p.ws + OFF_MOD) + (size_t)l * 9 * 6144;
  bf16_t* H = (bf16_t*)(p.ws + OFF_H);
  for (int i = BIDX() * 256 + TIDX(); i < MG * 128; i += GDIM() * 256) {
    const int r = i >> 7, ch = (i & 127) * 8;
    const float* xr = xin_row(p, l, g, r) + ch;
    const float* m = MOD + (size_t)mod_row(g, r) * 6144;
    const float4 x0 = *(const float4*)xr, x1 = *(const float4*)(xr + 4);
    const float4 sh0 = *(const float4*)(m + ch), sh1 = *(const float4*)(m + ch + 4);
    const float4 sc0 = *(const float4*)(m + 1024 + ch), sc1 = *(const float4*)(m + 1024 + ch + 4);
    float f[8] = {x0.x * (1.f + sc0.x) + sh0.x, x0.y * (1.f + sc0.y) + sh0.y, x0.z * (1.f + sc0.z) + sh0.z, x0.w * (1.f + sc0.w) + sh0.w,
                  x1.x * (1.f + sc1.x) + sh1.x, x1.y * (1.f + sc1.y) + sh1.y, x1.z * (1.f + sc1.z) + sh1.z, x1.w * (1.f + sc1.w) + sh1.w};
    *(uint4*)(H + (size_t)r * D + ch) = pack8(f);
  }
}

struct Seg { const bf16_t* ap; const bf16_t* bp; int lda, ldb, nk; };

__device__ __forceinline__ bool tile_coord_sub(int it, int nM, int nN, int nb, int v, int& mt, int& nt) {
  long s;
  if ((nb & 7) == 0) { const int per = nb >> 3; s = (long)it * nb + (v & 7) * per + (v >> 3); } else s = (long)it * nb + v;
  if (s >= (long)nM * nN) return false;
  const int band = (int)(s / (8 * nN)), r = (int)(s - (long)band * 8 * nN);
  const int bsz = (nM - band * 8) < 8 ? (nM - band * 8) : 8;
  nt = r / bsz; mt = band * 8 + (r % bsz);
  return true;
}
__device__ __forceinline__ bool tile_coord(int it, int nM, int nN, int& mt, int& nt) { return tile_coord_sub(it, nM, nN, GDIM(), BIDX(), mt, nt); }
__device__ __forceinline__ int inproj_ntile(int part, int e) {
  if (part == 0) return e < 24 ? e : (e == 24 ? 32 : 23 + e);
  return e < 8 ? 24 + e : (e < 23 ? 25 + e : 58 + e);
}

#define ZERO_ACC(acc) { _Pragma("unroll") for (int i_ = 0; i_ < 4; ++i_) { _Pragma("unroll") for (int j_ = 0; j_ < 4; ++j_) acc[i_][j_] = (f32x4){0.f, 0.f, 0.f, 0.f}; } }
#define EPI_LOOP(...) { const int lane_ = TIDX() & 63, w_ = TIDX() >> 6; \
  _Pragma("unroll") for (int i_ = 0; i_ < 4; ++i_) { const int row = m0 + (w_ >> 1) * 64 + i_ * 16 + (lane_ & 15); \
  _Pragma("unroll") for (int j_ = 0; j_ < 4; ++j_) { const int col = n0 + (w_ & 1) * 64 + j_ * 16 + (lane_ >> 4) * 4; f32x4& v = acc[i_][j_]; __VA_ARGS__ } } }

__device__ __forceinline__ int perm_brow(int lr) { return 8 * ((lr & 15) >> 2) + 4 * ((lr >> 4) & 1) + (lr & 3); }
#define EPI8_LOOP(...) { const int lane_ = TIDX() & 63, w_ = TIDX() >> 6; \
  _Pragma("unroll") for (int i_ = 0; i_ < 4; ++i_) { const int row = m0 + (w_ >> 1) * 64 + i_ * 16 + (lane_ & 15); \
  _Pragma("unroll") for (int a_ = 0; a_ < 2; ++a_) { const int col = n0 + (w_ & 1) * 64 + a_ * 32 + (lane_ >> 4) * 8; f32x4& v0 = acc[i_][2 * a_]; f32x4& v1 = acc[i_][2 * a_ + 1]; __VA_ARGS__ } } }

template <class Prob>
__device__ __forceinline__ void gemm_stream(Prob& pr, bf16_t* sm) {
  const int tid = TIDX(), lane = tid & 63, w = tid >> 6, wr = w >> 1, wc = w & 1;
  const int lr = tid >> 3, lk = (tid & 7) * 8;
  const int fr = lane & 15, fq = lane >> 4;
  const int aoff = (wr * 64 + fr) * 72 + fq * 8, boff = 9216 + (wc * 64 + fr) * 72 + fq * 8;
  const int soff = lr * 72 + lk;
  Seg cur, nxt;
  if (!pr.seg(0, cur, lr, lk)) return;
  bool has_nxt = pr.seg(1, nxt, lr, lk);
  u32x4 r0a[4], r0b[4], r1a[4], r1b[4];
#pragma unroll
  for (int i = 0; i < 4; ++i) { r0a[i] = (u32x4){0u, 0u, 0u, 0u}; r0b[i] = r0a[i]; r1a[i] = r0a[i]; r1b[i] = r0a[i]; }
  f32x4 acc[4][4];
#define GS_LOAD(RA, RB, KT) { const int kt_ = (KT); const bf16_t* ap_ = cur.ap; const bf16_t* bp_ = cur.bp; int lda_ = cur.lda, ldb_ = cur.ldb; \
    if (kt_ < cur.nk) { ap_ += kt_ * 64; bp_ += kt_ * 64; } \
    else if (has_nxt) { ap_ = nxt.ap + (kt_ - cur.nk) * 64; bp_ = nxt.bp + (kt_ - cur.nk) * 64; lda_ = nxt.lda; ldb_ = nxt.ldb; } \
      \
    _Pragma("unroll") for (int i = 0; i < 4; ++i) { RA[i] = *(const u32x4*)(ap_ + (size_t)i * 32 * lda_); RB[i] = *(const u32x4*)(bp_ + (size_t)i * 32 * ldb_); } }
#define GS_STORE(RA, RB, KT, STAGE) { bf16_t* st_ = (STAGE) + soff; \
    _Pragma("unroll") for (int i = 0; i < 4; ++i) { *(u32x4*)(st_ + i * 32 * 72) = RA[i]; *(u32x4*)(st_ + 9216 + i * 32 * 72) = RB[i]; } }
#define GS_COMPUTE(STAGE) { const bf16_t* cs_ = (STAGE); _Pragma("unroll") for (int kk = 0; kk < 2; ++kk) { bf16x8 af[4], bfr[4]; \
    _Pragma("unroll") for (int i = 0; i < 4; ++i) { af[i] = *(const bf16x8*)(cs_ + aoff + i * 16 * 72 + kk * 32); bfr[i] = *(const bf16x8*)(cs_ + boff + i * 16 * 72 + kk * 32); } \
    _Pragma("unroll") for (int i = 0; i < 4; ++i) { _Pragma("unroll") for (int j = 0; j < 4; ++j) acc[i][j] = __builtin_amdgcn_mfma_f32_16x16x32_bf16(bfr[j], af[i], acc[i][j], 0, 0, 0); } } }
  GS_LOAD(r0a, r0b, 0)
  __syncthreads();
  GS_STORE(r0a, r0b, 0, sm)
  __syncthreads();
  GS_LOAD(r0a, r0b, 1)
  __builtin_amdgcn_sched_barrier(0);
  GS_LOAD(r1a, r1b, 2)
  __builtin_amdgcn_sched_barrier(0);
  for (int idx = 0;; ++idx) {
    pr.begin(idx, acc);
    for (int kt = 0; kt < cur.nk; kt += 2) {
      GS_COMPUTE(sm)
      GS_STORE(r0a, r0b, kt + 1, sm + 18432)
      GS_LOAD(r0a, r0b, kt + 3)
      __syncthreads();
      GS_COMPUTE(sm + 18432)
      GS_STORE(r1a, r1b, kt + 2, sm)
      GS_LOAD(r1a, r1b, kt + 4)
      __syncthreads();
    }
    pr.end(idx, acc);
    if (!has_nxt) break;
    cur = nxt; has_nxt = pr.seg(idx + 2, nxt, lr, lk);
  }
#undef GS_LOAD
#undef GS_STORE
#undef GS_COMPUTE
}

__device__ __forceinline__ void gemm_inproj_phase(const Params& p, bf16_t* sm, int part, int nb, int v) {
  struct Pr {
    const bf16_t* A; const bf16_t* W; bf16_t* P; int nM, nN, part, nb, v;
    __device__ bool seg(int idx, Seg& s, int lr, int lk) const { int mt, e; if (!tile_coord_sub(idx, nM, nN, nb, v, mt, e)) return false; const int nt = inproj_ntile(part, e);
      s.ap = A + (size_t)(mt * 128 + lr) * D + lk; s.bp = W + (size_t)(nt * 128 + perm_brow(lr)) * D + lk; s.lda = D; s.ldb = D; s.nk = 16; return true; }
    __device__ void begin(int, f32x4 (&acc)[4][4]) const { ZERO_ACC(acc) }
    __device__ void end(int idx, f32x4 (&acc)[4][4]) const { int mt, e; tile_coord_sub(idx, nM, nN, nb, v, mt, e); const int m0 = mt * 128, n0 = inproj_ntile(part, e) * 128;
      EPI8_LOOP({ uint4 o; o.x = pack2(v0[0], v0[1]); o.y = pack2(v0[2], v0[3]); o.z = pack2(v1[0], v1[1]); o.w = pack2(v1[2], v1[3]); *(uint4*)(P + (size_t)row * LDP + col) = o; }) }
  } pr{(const bf16_t*)(p.ws + OFF_H), (const bf16_t*)(p.ws + OFF_WIN), (bf16_t*)(p.ws + OFF_P), MG / 128, part == 0 ? 58 : 39, part, nb, v};
  gemm_stream(pr, sm);
}
__device__ __forceinline__ void gemm_proj_phase(const Params& p, int M, bf16_t* sm) {
  struct Pr {
    const bf16_t* YA; const bf16_t* YBn; const bf16_t* Wg; const bf16_t* Ws; const bf16_t* P; bf16_t* U; int nM, nN;
    __device__ bool seg(int idx, Seg& s, int lr, int lk) const { int mt, nt; if (!tile_coord(idx >> 1, nM, nN, mt, nt)) return false;
      if ((idx & 1) == 0) { s.ap = YA + (size_t)(mt * 128 + lr) * 1024 + lk; s.bp = Wg + (size_t)(nt * 128 + perm_brow(lr)) * 1024 + lk; s.lda = 1024; s.ldb = 1024; s.nk = 16; }
      else { s.ap = YBn + (size_t)(mt * 128 + lr) * 2048 + lk; s.bp = Ws + (size_t)(nt * 128 + perm_brow(lr)) * 2048 + lk; s.lda = 2048; s.ldb = 2048; s.nk = 32; }
      return true; }
    __device__ void begin(int idx, f32x4 (&acc)[4][4]) const { if ((idx & 1) == 0) ZERO_ACC(acc) }
    __device__ void end(int idx, f32x4 (&acc)[4][4]) const { int mt, nt; tile_coord(idx >> 1, nM, nN, mt, nt); const int m0 = mt * 128, n0 = nt * 128;
      if ((idx & 1) == 0) {
        EPI8_LOOP({ const uint4 ga = *(const uint4*)(P + (size_t)row * LDP + C_GA + col); const uint4 gb = *(const uint4*)(P + (size_t)row * LDP + C_GB + col);
          v0[0] *= (1.f + __expf(-lo16(gb.x))) / (1.f + __expf(-lo16(ga.x))); v0[1] *= (1.f + __expf(-hi16(gb.x))) / (1.f + __expf(-hi16(ga.x)));
          v0[2] *= (1.f + __expf(-lo16(gb.y))) / (1.f + __expf(-lo16(ga.y))); v0[3] *= (1.f + __expf(-hi16(gb.y))) / (1.f + __expf(-hi16(ga.y)));
          v1[0] *= (1.f + __expf(-lo16(gb.z))) / (1.f + __expf(-lo16(ga.z))); v1[1] *= (1.f + __expf(-hi16(gb.z))) / (1.f + __expf(-hi16(ga.z)));
          v1[2] *= (1.f + __expf(-lo16(gb.w))) / (1.f + __expf(-lo16(ga.w))); v1[3] *= (1.f + __expf(-hi16(gb.w))) / (1.f + __expf(-hi16(ga.w))); })
      } else {
        EPI8_LOOP({ const uint4 gb = *(const uint4*)(P + (size_t)row * LDP + C_GB + col);
          uint4 o; o.x = pack2(v0[0] * sigmoidf_(lo16(gb.x)), v0[1] * sigmoidf_(hi16(gb.x))); o.y = pack2(v0[2] * sigmoidf_(lo16(gb.y)), v0[3] * sigmoidf_(hi16(gb.y)));
          o.z = pack2(v1[0] * sigmoidf_(lo16(gb.z)), v1[1] * sigmoidf_(hi16(gb.z))); o.w = pack2(v1[2] * sigmoidf_(lo16(gb.w)), v1[3] * sigmoidf_(hi16(gb.w)));
          *(uint4*)(U + (size_t)row * D + col) = o; })
      } }
  } pr{(const bf16_t*)(p.ws + OFF_QKV), (const bf16_t*)(p.ws + OFF_QKV) + (size_t)MG * 1024, (const bf16_t*)(p.ws + OFF_WPG), (const bf16_t*)(p.ws + OFF_WPS),
       (const bf16_t*)(p.ws + OFF_P), (bf16_t*)(p.ws + OFF_H), M / 128, 8};
  gemm_stream(pr, sm);
}
__device__ __forceinline__ void gemm_wout_phase(const Params& p, int l, int g, int M, bf16_t* sm) {
  struct Pr {
    const Params& p; int l, g; const bf16_t* U; const bf16_t* W; const float* MOD; int nM, nN;
    __device__ bool seg(int idx, Seg& s, int lr, int lk) const { int mt, nt; if (!tile_coord(idx, nM, nN, mt, nt)) return false;
      s.ap = U + (size_t)(mt * 128 + lr) * D + lk; s.bp = W + (size_t)(nt * 128 + perm_brow(lr)) * D + lk; s.lda = D; s.ldb = D; s.nk = 16; return true; }
    __device__ void begin(int, f32x4 (&acc)[4][4]) const { ZERO_ACC(acc) }
    __device__ void end(int idx, f32x4 (&acc)[4][4]) const { int mt, nt; tile_coord(idx, nM, nN, mt, nt); const int m0 = mt * 128, n0 = nt * 128;
      EPI8_LOOP({ const float* xp = xin_row(p, l, g, row) + col; const float* gp = MOD + (size_t)mod_row(g, row) * 6144 + 2048 + col; float* op = xs_row(p, g, row) + col;
        const float4 xa = *(const float4*)xp, xb = *(const float4*)(xp + 4), ga = *(const float4*)gp, gb = *(const float4*)(gp + 4);
        float4 oa, ob; oa.x = DN_ALPHA * xa.x + ga.x * v0[0]; oa.y = DN_ALPHA * xa.y + ga.y * v0[1]; oa.z = DN_ALPHA * xa.z + ga.z * v0[2]; oa.w = DN_ALPHA * xa.w + ga.w * v0[3];
        ob.x = DN_ALPHA * xb.x + gb.x * v1[0]; ob.y = DN_ALPHA * xb.y + gb.y * v1[1]; ob.z = DN_ALPHA * xb.z + gb.z * v1[2]; ob.w = DN_ALPHA * xb.w + gb.w * v1[3];
        *(float4*)op = oa; *(float4*)(op + 4) = ob; }) }
  } pr{p, l, g, (const bf16_t*)(p.ws + OFF_H), (const bf16_t*)(p.ws + OFF_WOUT), (const float*)(p.ws + OFF_MOD) + (size_t)l * 9 * 6144, M / 128, 8};
  gemm_stream(pr, sm);
}
__device__ __forceinline__ void gemm_ff1_phase(const Params& p, int l, int M, bf16_t* sm) {
  struct Pr {
    const bf16_t* H; const bf16_t* W; bf16_t* HID; const float* b1; int nM, nN;
    __device__ bool seg(int idx, Seg& s, int lr, int lk) const { int mt, nt; if (!tile_coord(idx, nM, nN, mt, nt)) return false;
      s.ap = H + (size_t)(mt * 128 + lr) * D + lk; s.bp = W + (size_t)(nt * 128 + perm_brow(lr)) * D + lk; s.lda = D; s.ldb = D; s.nk = 16; return true; }
    __device__ void begin(int, f32x4 (&acc)[4][4]) const { ZERO_ACC(acc) }
    __device__ void end(int idx, f32x4 (&acc)[4][4]) const { int mt, nt; tile_coord(idx, nM, nN, mt, nt); const int m0 = mt * 128, n0 = nt * 128;
      EPI8_LOOP({ const float4 ba = *(const float4*)(b1 + col), bb = *(const float4*)(b1 + col + 4);
        const float t0 = fmaxf(v0[0] + ba.x, 0.f), t1 = fmaxf(v0[1] + ba.y, 0.f), t2 = fmaxf(v0[2] + ba.z, 0.f), t3 = fmaxf(v0[3] + ba.w, 0.f);
        const float t4 = fmaxf(v1[0] + bb.x, 0.f), t5 = fmaxf(v1[1] + bb.y, 0.f), t6 = fmaxf(v1[2] + bb.z, 0.f), t7 = fmaxf(v1[3] + bb.w, 0.f);
        uint4 o; o.x = pack2(t0 * t0, t1 * t1); o.y = pack2(t2 * t2, t3 * t3); o.z = pack2(t4 * t4, t5 * t5); o.w = pack2(t6 * t6, t7 * t7);
        *(uint4*)(HID + (size_t)row * 4096 + col) = o; }) }
  } pr{(const bf16_t*)(p.ws + OFF_H), (const bf16_t*)(p.ws + OFF_WFF1), (bf16_t*)(p.ws + OFF_P), p.b_ff1 + (size_t)l * 4096, M / 128, 32};
  gemm_stream(pr, sm);
}
__device__ __forceinline__ void gemm_ff2_phase(const Params& p, int l, int g, int M, bf16_t* sm) {
  struct Pr {
    const Params& p; int g; const bf16_t* HID; const bf16_t* W; const float* MOD; const float* b2; int nM, nN;
    __device__ bool seg(int idx, Seg& s, int lr, int lk) const { int mt, nt; if (!tile_coord(idx, nM, nN, mt, nt)) return false;
      s.ap = HID + (size_t)(mt * 128 + lr) * 4096 + lk; s.bp = W + (size_t)(nt * 128 + perm_brow(lr)) * 4096 + lk; s.lda = 4096; s.ldb = 4096; s.nk = 64; return true; }
    __device__ void begin(int, f32x4 (&acc)[4][4]) const { ZERO_ACC(acc) }
    __device__ void end(int idx, f32x4 (&acc)[4][4]) const { int mt, nt; tile_coord(idx, nM, nN, mt, nt); const int m0 = mt * 128, n0 = nt * 128;
      EPI8_LOOP({ float* xp = xs_row(p, g, row) + col; const float* gp = MOD + (size_t)mod_row(g, row) * 6144 + 5120 + col;
        const float4 xa = *(const float4*)xp, xb = *(const float4*)(xp + 4), ba = *(const float4*)(b2 + col), bb = *(const float4*)(b2 + col + 4), ga = *(const float4*)gp, gb = *(const float4*)(gp + 4);
        float4 oa, ob; oa.x = DN_ALPHA * xa.x + ga.x * (v0[0] + ba.x); oa.y = DN_ALPHA * xa.y + ga.y * (v0[1] + ba.y); oa.z = DN_ALPHA * xa.z + ga.z * (v0[2] + ba.z); oa.w = DN_ALPHA * xa.w + ga.w * (v0[3] + ba.w);
        ob.x = DN_ALPHA * xb.x + gb.x * (v1[0] + bb.x); ob.y = DN_ALPHA * xb.y + gb.y * (v1[1] + bb.y); ob.z = DN_ALPHA * xb.z + gb.z * (v1[2] + bb.z); ob.w = DN_ALPHA * xb.w + gb.w * (v1[3] + bb.w);
        *(float4*)xp = oa; *(float4*)(xp + 4) = ob; }) }
  } pr{p, g, (const bf16_t*)(p.ws + OFF_P), (const bf16_t*)(p.ws + OFF_WFF2), (const float*)(p.ws + OFF_MOD) + (size_t)l * 9 * 6144, p.b_ff2 + (size_t)l * 1024, M / 128, 8};
  gemm_stream(pr, sm);
}

__device__ __forceinline__ void ln_phase(const Params& p, int l, int g, int M, const float* gam, const float* bet, bool write_h2) {
  const int lane = TIDX() & 63;
  const float* MOD = (const float*)(p.ws + OFF_MOD) + (size_t)l * 9 * 6144;
  bf16_t* H = (bf16_t*)(p.ws + OFF_H);
  const int stride = GDIM() * 4;
  for (int r0 = BIDX() * 4 + (TIDX() >> 6); r0 < M; r0 += 2 * stride) {
    const int r1 = r0 + stride; const bool has1 = r1 < M;
    float* xr0 = xs_row(p, g, r0); float* xr1 = xs_row(p, g, has1 ? r1 : r0);
    float4 v0[4], v1[4];
#pragma unroll
    for (int i = 0; i < 4; ++i) { v0[i] = *(const float4*)(xr0 + (i * 64 + lane) * 4); v1[i] = *(const float4*)(xr1 + (i * 64 + lane) * 4); }
    float s0 = 0.f, s1 = 0.f;
#pragma unroll
    for (int i = 0; i < 4; ++i) { s0 += v0[i].x + v0[i].y + v0[i].z + v0[i].w; s1 += v1[i].x + v1[i].y + v1[i].z + v1[i].w; }
#pragma unroll
    for (int o = 32; o >= 1; o >>= 1) { s0 += __shfl_xor(s0, o); s1 += __shfl_xor(s1, o); }
    const float mu0 = s0 * (1.f / 1024.f), mu1 = s1 * (1.f / 1024.f);
    float q0 = 0.f, q1 = 0.f;
#pragma unroll
    for (int i = 0; i < 4; ++i) {
      v0[i].x -= mu0; v0[i].y -= mu0; v0[i].z -= mu0; v0[i].w -= mu0; q0 += v0[i].x * v0[i].x + v0[i].y * v0[i].y + v0[i].z * v0[i].z + v0[i].w * v0[i].w;
      v1[i].x -= mu1; v1[i].y -= mu1; v1[i].z -= mu1; v1[i].w -= mu1; q1 += v1[i].x * v1[i].x + v1[i].y * v1[i].y + v1[i].z * v1[i].z + v1[i].w * v1[i].w;
    }
#pragma unroll
    for (int o = 32; o >= 1; o >>= 1) { q0 += __shfl_xor(q0, o); q1 += __shfl_xor(q1, o); }
    const float rs0 = rsqrtf(q0 * (1.f / 1024.f) + 1e-5f), rs1 = rsqrtf(q1 * (1.f / 1024.f) + 1e-5f);
    const float* m0 = MOD + (size_t)mod_row(g, r0) * 6144;
    const float* m1 = MOD + (size_t)mod_row(g, has1 ? r1 : r0) * 6144;
#pragma unroll
    for (int i = 0; i < 4; ++i) {
      const int ch = (i * 64 + lane) * 4;
      const float4 gg = *(const float4*)(gam + ch), bb = *(const float4*)(bet + ch);
      float4 o0, o1;
      o0.x = v0[i].x * rs0 * gg.x + bb.x; o0.y = v0[i].y * rs0 * gg.y + bb.y; o0.z = v0[i].z * rs0 * gg.z + bb.z; o0.w = v0[i].w * rs0 * gg.w + bb.w;
      o1.x = v1[i].x * rs1 * gg.x + bb.x; o1.y = v1[i].y * rs1 * gg.y + bb.y; o1.z = v1[i].z * rs1 * gg.z + bb.z; o1.w = v1[i].w * rs1 * gg.w + bb.w;
      *(float4*)(xr0 + ch) = o0;
      if (has1) *(float4*)(xr1 + ch) = o1;
      if (write_h2) {
        const float4 sh0 = *(const float4*)(m0 + 3072 + ch), sc0 = *(const float4*)(m0 + 4096 + ch);
        uint2 h; h.x = pack2(o0.x * (1.f + sc0.x) + sh0.x, o0.y * (1.f + sc0.y) + sh0.y); h.y = pack2(o0.z * (1.f + sc0.z) + sh0.z, o0.w * (1.f + sc0.w) + sh0.w);
        *(uint2*)(H + (size_t)r0 * D + ch) = h;
        if (has1) {
          const float4 sh1 = *(const float4*)(m1 + 3072 + ch), sc1 = *(const float4*)(m1 + 4096 + ch);
          h.x = pack2(o1.x * (1.f + sc1.x) + sh1.x, o1.y * (1.f + sc1.y) + sh1.y); h.y = pack2(o1.z * (1.f + sc1.z) + sh1.z, o1.w * (1.f + sc1.w) + sh1.w);
          *(uint2*)(H + (size_t)r1 * D + ch) = h;
        }
      }
    }
  }
}

__device__ __forceinline__ void conv_phase(const Params& p, int l) {
  const bf16_t* P = (const bf16_t*)(p.ws + OFF_P);
  bf16_t* QKV = (bf16_t*)(p.ws + OFF_QKV); bf16_t* XBC = (bf16_t*)(p.ws + OFF_XBC);
  float* GBF = (float*)(p.ws + OFF_GBF); float* DTF = (float*)(p.ws + OFF_DTF);
  const int nb = GDIM(), bid = BIDX(), tid = TIDX();
  const int vb = ((nb & 7) == 0) ? (bid & 7) * (nb >> 3) + (bid >> 3) : bid;
  const int gtid = vb * 256 + tid, gsz = nb * 256;
  {
    const float* cw = p.gdn_conv_w + (size_t)l * 5 * 3072;
    const int c = tid & 127, hh = tid >> 7;
    for (int item = vb; item < (MG / 32) * 3; item += nb) {
      const int third = item % 3, pp = item / 3;
      const int ch0 = third * 1024 + c * 8;
      const int t0 = (pp * 2 + hh) * 16;
      int lo, hi;
      if (t0 < MLAT) { lo = t0 & ~63; hi = lo + 64; } else { lo = MLAT + ((t0 - MLAT) & ~255); hi = lo + 256; }
      u32x4 raw[20];
#pragma unroll
      for (int i = 0; i < 20; ++i) { const int row = t0 - 2 + i; raw[i] = (row >= lo && row < hi) ? *(const u32x4*)(P + (size_t)row * LDP + ch0) : (u32x4){0u, 0u, 0u, 0u}; }
      float wt[5][8];
#pragma unroll
      for (int j = 0; j < 5; ++j) { const float4 w0 = *(const float4*)(cw + j * 3072 + ch0), w1 = *(const float4*)(cw + j * 3072 + ch0 + 4);
        wt[j][0] = w0.x; wt[j][1] = w0.y; wt[j][2] = w0.z; wt[j][3] = w0.w; wt[j][4] = w1.x; wt[j][5] = w1.y; wt[j][6] = w1.z; wt[j][7] = w1.w; }
      const float qsc = (third == 0) ? 0.08838834764831845f : 1.f;
#pragma unroll
      for (int t = 0; t < 16; ++t) {
        float acc[8];
#pragma unroll
        for (int e = 0; e < 8; ++e) acc[e] = 0.f;
#pragma unroll
        for (int j = 0; j < 5; ++j) {
          const u32x4 rw = raw[t + j];
#pragma unroll
          for (int e = 0; e < 4; ++e) { acc[2 * e] += lo16(rw[e]) * wt[j][2 * e]; acc[2 * e + 1] += hi16(rw[e]) * wt[j][2 * e + 1]; }
        }
        float ss = 0.f;
#pragma unroll
        for (int e = 0; e < 8; ++e) { acc[e] = siluf_(acc[e]); ss += acc[e] * acc[e]; }
        ss += __shfl_xor(ss, 1); ss += __shfl_xor(ss, 2); ss += __shfl_xor(ss, 4); ss += __shfl_xor(ss, 8);
        const float sc = (third < 2) ? rsqrtf(ss + 1e-6f) * qsc : 1.f;
#pragma unroll
        for (int e = 0; e < 8; ++e) acc[e] *= sc;
        *(uint4*)(QKV + (size_t)(t0 + t) * 3072 + ch0) = pack8(acc);
      }
    }
  }
  {
    const float* sw = p.ssm_conv_w + (size_t)l * 5 * 4096; const float* sb = p.ssm_conv_b + (size_t)l * 4096;
    constexpr int nLat = G * 64 * 8 * 2, nCtx = (MCTX / 16) * 2;
    float wt[5][8], bs[8];
    int cur_half = -1;
    for (int item = vb; item < nLat + nCtx; item += nb) {
      int half, base, stride, p0, seglen;
      if (item < nLat) { half = item & 1; const int piece = (item >> 1) & 7, cl = (item >> 4) & 63, b_l = item >> 10; base = b_l * 8192 + cl; stride = 64; p0 = piece * 16; seglen = 128; }
      else { const int i2 = item - nLat; half = i2 & 1; const int piece = i2 >> 1; base = MLAT + (piece >> 4) * 256; stride = 1; p0 = (piece & 15) * 16; seglen = 256; }
      const int ch0 = (half * 256 + tid) * 8;
      u32x4 raw[20];
#pragma unroll
      for (int i = 0; i < 20; ++i) { const int pq = p0 - 2 + i; raw[i] = (pq >= 0 && pq < seglen) ? *(const u32x4*)(P + (size_t)(base + pq * stride) * LDP + C_XBC + ch0) : (u32x4){0u, 0u, 0u, 0u}; }
      if (half != cur_half) {
        cur_half = half;
        const float4 b0 = *(const float4*)(sb + ch0), b1 = *(const float4*)(sb + ch0 + 4);
        bs[0] = b0.x; bs[1] = b0.y; bs[2] = b0.z; bs[3] = b0.w; bs[4] = b1.x; bs[5] = b1.y; bs[6] = b1.z; bs[7] = b1.w;
#pragma unroll
        for (int j = 0; j < 5; ++j) { const float4 w0 = *(const float4*)(sw + j * 4096 + ch0), w1 = *(const float4*)(sw + j * 4096 + ch0 + 4);
          wt[j][0] = w0.x; wt[j][1] = w0.y; wt[j][2] = w0.z; wt[j][3] = w0.w; wt[j][4] = w1.x; wt[j][5] = w1.y; wt[j][6] = w1.z; wt[j][7] = w1.w; }
      }
#pragma unroll
      for (int t = 0; t < 16; ++t) {
        float acc[8];
#pragma unroll
        for (int e = 0; e < 8; ++e) acc[e] = bs[e];
#pragma unroll
        for (int j = 0; j < 5; ++j) {
          const u32x4 rw = raw[t + j];
#pragma unroll
          for (int e = 0; e < 4; ++e) { acc[2 * e] += lo16(rw[e]) * wt[j][2 * e]; acc[2 * e + 1] += hi16(rw[e]) * wt[j][2 * e + 1]; }
        }
#pragma unroll
        for (int e = 0; e < 8; ++e) acc[e] = siluf_(acc[e]);
        *(uint4*)(XBC + (size_t)(base + (p0 + t) * stride) * 4096 + ch0) = pack8(acc);
      }
    }
  }
  for (int idx = gtid; idx < MG * 16; idx += gsz) {
    const int r = idx >> 4, dh = idx & 15;
    GBF[(size_t)r * 32 + 16 + dh] = sigmoidf_(bf2f(P[(size_t)r * LDP + C_B + dh]));
  }
  for (int idx = gtid; idx < G * 2 * 264 * 8; idx += gsz) {
    const int h = idx & 7; int t = idx >> 3; const int chunk = t % 264; t /= 264; const int dir = t & 1, b_l = t >> 1;
    const int dh = dir * 8 + h;
    const float bias = p.gdn_dt_bias[l * 16 + dh], aneg = -__expf(p.gdn_A_log[l * 16 + dh]);
    float cum = 0.f;
    for (int ub = 0; ub < 32; ub += 8) {
      float av[8];
#pragma unroll
      for (int u = 0; u < 8; ++u) av[u] = bf2f(P[(size_t)gdn_rowof(b_l, dir, chunk * 32 + ub + u) * LDP + C_A + dh]);
#pragma unroll
      for (int u = 0; u < 8; ++u) {
        cum += aneg * softplusf_(av[u] + bias);
        GBF[(size_t)gdn_rowof(b_l, dir, chunk * 32 + ub + u) * 32 + dh] = cum;
      }
    }
  }
  for (int idx = gtid; idx < G * 2 * 264 * 32; idx += gsz) {
    const int head = idx & 31; int t = idx >> 5; const int chunk = t % 264; t /= 264; const int dir = t & 1, b_l = t >> 1;
    const int dh = dir * 32 + head;
    const float bias = p.ssm_dt_bias[l * 64 + dh], aneg = -__expf(p.ssm_A_log[l * 64 + dh]);
    float cum = 0.f;
    for (int ub = 0; ub < 32; ub += 8) {
      float dtv[8];
#pragma unroll
      for (int u = 0; u < 8; ++u) dtv[u] = bf2f(P[(size_t)ssd_rowof(b_l, dir, chunk * 32 + ub + u) * LDP + C_DT + dh]);
#pragma unroll
      for (int u = 0; u < 8; ++u) {
        const size_t row = (size_t)ssd_rowof(b_l, dir, chunk * 32 + ub + u);
        const float dt = softplusf_(dtv[u] + bias);
        cum += dt * aneg;
        DTF[row * 128 + dh] = dt;
        DTF[row * 128 + 64 + dh] = cum;
      }
    }
  }
}

__device__ __forceinline__ void gdn_prep_phase(const Params& p, unsigned char* smraw) {
  const int tid = TIDX(), lane = tid & 63, w = tid >> 6, fr = lane & 15, fq = lane >> 4, ti = w >> 1, tj = w & 1;
  bf16_t* sK = (bf16_t*)smraw;
  bf16_t* sQ = sK + 32 * 136;
  bf16_t* sP = sQ + 32 * 136;
  bf16_t* sPT = sP + 2 * 1280;
  bf16_t* sR = sPT + 2 * 1280;
  float* sG = (float*)(sR + 2 * 1280);
  const bf16_t* QKV = (const bf16_t*)(p.ws + OFF_QKV);
  const float* GBF = (const float*)(p.ws + OFF_GBF);
  bf16_t* TMB = (bf16_t*)(p.ws + OFF_TMB);
  const int ltok = tid & 31, lp = tid >> 5;
  const int i = ti * 16 + fr, j0 = tj * 16 + fq * 4;
  for (int item = BIDX(); item < GDN_NITEM; item += GDIM()) {
    const int chunk = item % 264; const int t = item / 264; const int dir = t & 1, h = (t >> 1) & 7, b_l = t >> 4;
    const size_t row = (size_t)gdn_rowof(b_l, dir, chunk * 32 + ltok);
    const bf16_t* src = QKV + row * 3072 + h * 128;
    const u32x4 k0 = *(const u32x4*)(src + 1024 + lp * 8), k1 = *(const u32x4*)(src + 1024 + (lp + 8) * 8);
    const u32x4 q0 = *(const u32x4*)(src + lp * 8), q1 = *(const u32x4*)(src + (lp + 8) * 8);
    float g_ = 0.f, b_ = 0.f;
    if (tid < 32) { g_ = GBF[row * 32 + dir * 8 + h]; b_ = GBF[row * 32 + 16 + dir * 8 + h]; }
    __syncthreads();
    *(u32x4*)(sK + ltok * 136 + lp * 8) = k0; *(u32x4*)(sK + ltok * 136 + (lp + 8) * 8) = k1;
    *(u32x4*)(sQ + ltok * 136 + lp * 8) = q0; *(u32x4*)(sQ + ltok * 136 + (lp + 8) * 8) = q1;
    if (tid < 32) { sG[tid] = g_; sG[32 + tid] = b_; }
    __syncthreads();
    {
      f32x4 kk = (f32x4){0.f, 0.f, 0.f, 0.f}, qk = kk;
#pragma unroll
      for (int ks = 0; ks < 4; ++ks) {
        const bf16x8 kj = *(const bf16x8*)(sK + (tj * 16 + fr) * 136 + ks * 32 + fq * 8);
        const bf16x8 ki = *(const bf16x8*)(sK + (ti * 16 + fr) * 136 + ks * 32 + fq * 8);
        const bf16x8 qi = *(const bf16x8*)(sQ + (ti * 16 + fr) * 136 + ks * 32 + fq * 8);
        kk = __builtin_amdgcn_mfma_f32_16x16x32_bf16(kj, ki, kk, 0, 0, 0);
        qk = __builtin_amdgcn_mfma_f32_16x16x32_bf16(kj, qi, qk, 0, 0, 0);
      }
      const float gi = sG[i], bi = sG[32 + i];
      float n[4], nt[4], rr[4], m[4];
#pragma unroll
      for (int r = 0; r < 4; ++r) {
        const int j = j0 + r; const float gj = sG[j], bj = sG[32 + j];
        n[r] = (j < i) ? -bi * kk[r] * __expf(gi - gj) : 0.f;
        nt[r] = (i < j) ? -bj * kk[r] * __expf(gj - gi) : 0.f;
        m[r] = (j <= i) ? qk[r] * __expf(gi - gj) : 0.f;
        rr[r] = n[r] + ((i == j) ? 1.f : 0.f);
      }
      uint2 o;
      o.x = pack2(n[0], n[1]); o.y = pack2(n[2], n[3]); *(uint2*)(sP + i * 40 + j0) = o;
      o.x = pack2(nt[0], nt[1]); o.y = pack2(nt[2], nt[3]); *(uint2*)(sPT + i * 40 + j0) = o;
      o.x = pack2(rr[0], rr[1]); o.y = pack2(rr[2], rr[3]); *(uint2*)(sR + i * 40 + j0) = o;
      o.x = pack2(m[0], m[1]); o.y = pack2(m[2], m[3]); *(uint2*)(TMB + (size_t)item * 2048 + 1024 + i * 32 + j0) = o;
    }
    __syncthreads();
    int pc = 0, rc = 0;
#pragma unroll
    for (int st = 1; st <= 5; ++st) {
      const bf16_t* Pc = sP + pc * 1280; const bf16_t* PTc = sPT + pc * 1280; const bf16_t* Rc = sR + rc * 1280;
      const bf16x8 p_i = *(const bf16x8*)(Pc + (ti * 16 + fr) * 40 + fq * 8);
      const bf16x8 p_j = *(const bf16x8*)(Pc + (tj * 16 + fr) * 40 + fq * 8);
      const bf16x8 pt_i = *(const bf16x8*)(PTc + (ti * 16 + fr) * 40 + fq * 8);
      const bf16x8 pt_j = *(const bf16x8*)(PTc + (tj * 16 + fr) * 40 + fq * 8);
      const f32x4 z = (f32x4){0.f, 0.f, 0.f, 0.f};
      if (st >= 2) {
        const bf16x8 r_i = *(const bf16x8*)(Rc + (ti * 16 + fr) * 40 + fq * 8);
        const uint2 rin = *(const uint2*)(Rc + i * 40 + j0);
        f32x4 racc = (f32x4){lo16(rin.x), hi16(rin.x), lo16(rin.y), hi16(rin.y)};
        racc = __builtin_amdgcn_mfma_f32_16x16x32_bf16(pt_j, r_i, racc, 0, 0, 0);
        uint2 o; o.x = pack2(racc[0], racc[1]); o.y = pack2(racc[2], racc[3]);
        if (st < 5) *(uint2*)(sR + (rc ^ 1) * 1280 + i * 40 + j0) = o;
        else *(uint2*)(TMB + (size_t)item * 2048 + i * 32 + j0) = o;
      }
      if (st <= 4) {
        const f32x4 pn = __builtin_amdgcn_mfma_f32_16x16x32_bf16(pt_j, p_i, z, 0, 0, 0);
        const f32x4 ptn = __builtin_amdgcn_mfma_f32_16x16x32_bf16(p_j, pt_i, z, 0, 0, 0);
        uint2 o; o.x = pack2(pn[0], pn[1]); o.y = pack2(pn[2], pn[3]); *(uint2*)(sP + (pc ^ 1) * 1280 + i * 40 + j0) = o;
        o.x = pack2(ptn[0], ptn[1]); o.y = pack2(ptn[2], ptn[3]); *(uint2*)(sPT + (pc ^ 1) * 1280 + i * 40 + j0) = o;
      }
      if (st < 5) __syncthreads();
      pc ^= 1; if (st >= 2) rc ^= 1;
    }
  }
}

__device__ __forceinline__ void gdn_chunk_item(const Params& p, int id, unsigned char* smraw) {
  const int tid = TIDX(), lane = tid & 63, w = tid >> 6, fr = lane & 15, fq = lane >> 4, ta = w >> 1, tb = w & 1;
  const int b_l = id >> 6, h = (id >> 3) & 7, dir = (id >> 2) & 1, dvq = id & 3;
  bf16_t* sKb = (bf16_t*)smraw;
  bf16_t* sQ = sKb + 32 * 136;
  bf16_t* sKdT = sQ + 32 * 136;
  bf16_t* sVbT = sKdT + 128 * 40;
  bf16_t* sT = sVbT + 32 * 40;
  bf16_t* sM = sT + 32 * 40;
  bf16_t* sXT = sM + 32 * 40;
  bf16_t* sVnT = sXT + 32 * 40;
  bf16_t* sST = sVnT + 32 * 40;
  float* sG = (float*)(sST + 32 * 136);
  const bf16_t* QKV = (const bf16_t*)(p.ws + OFF_QKV);
  const float* GBF = (const float*)(p.ws + OFF_GBF);
  const bf16_t* TMB = (const bf16_t*)(p.ws + OFF_TMB);
  bf16_t* OUT = (bf16_t*)(p.ws + (dir ? OFF_OB : OFF_OF));
  const int ltok = tid & 31, lp = tid >> 5;
  const size_t item0 = (size_t)((b_l * 8 + h) * 2 + dir) * 264;
  struct Stage { u32x4 k0, k1, q0, q1, v, tm; float g, be, gl; };
  Stage st0, st1;
  constexpr int NCH = (256 + 8192) / 32;
  auto gload = [&](Stage& st, int c) __attribute__((always_inline)) {
    const int s0 = (c < NCH ? c : NCH - 1) * 32;
    const size_t row = (size_t)gdn_rowof(b_l, dir, s0 + ltok);
    const bf16_t* src = QKV + row * 3072 + h * 128;
    st.k0 = *(const u32x4*)(src + 1024 + lp * 8); st.k1 = *(const u32x4*)(src + 1024 + (lp + 8) * 8);
    st.q0 = *(const u32x4*)(src + lp * 8); st.q1 = *(const u32x4*)(src + (lp + 8) * 8);
    st.v = *(const u32x4*)(src + 2048 + dvq * 32 + (lp & 3) * 8);
    st.tm = *(const u32x4*)(TMB + (item0 + (c < NCH ? c : NCH - 1)) * 2048 + (tid >> 7) * 1024 + ((tid & 127) >> 2) * 32 + (tid & 3) * 8);
    st.g = GBF[row * 32 + dir * 8 + h]; st.be = GBF[row * 32 + 16 + dir * 8 + h];
    st.gl = GBF[(size_t)gdn_rowof(b_l, dir, s0 + 31) * 32 + dir * 8 + h];
  };
  auto lstore = [&](const Stage& st) __attribute__((always_inline)) {
    const float skb = st.be * __expf(st.g), skd = __expf(st.gl - st.g);
    {
      float f[8]; uint4 o;
      f[0] = lo16(st.k0[0]); f[1] = hi16(st.k0[0]); f[2] = lo16(st.k0[1]); f[3] = hi16(st.k0[1]); f[4] = lo16(st.k0[2]); f[5] = hi16(st.k0[2]); f[6] = lo16(st.k0[3]); f[7] = hi16(st.k0[3]);
      bf16_t* t0 = sKdT + (lp * 8) * 40 + ltok;
#pragma unroll
      for (int e = 0; e < 4; ++e) { const unsigned pk = pack2(f[2 * e] * skd, f[2 * e + 1] * skd); t0[(2 * e) * 40] = (bf16_t)(pk & 0xffffu); t0[(2 * e + 1) * 40] = (bf16_t)(pk >> 16); }
#pragma unroll
      for (int e = 0; e < 8; ++e) f[e] *= skb;
      o = pack8(f); *(uint4*)(sKb + ltok * 136 + lp * 8) = o;
      f[0] = lo16(st.k1[0]); f[1] = hi16(st.k1[0]); f[2] = lo16(st.k1[1]); f[3] = hi16(st.k1[1]); f[4] = lo16(st.k1[2]); f[5] = hi16(st.k1[2]); f[6] = lo16(st.k1[3]); f[7] = hi16(st.k1[3]);
      bf16_t* t1 = sKdT + ((lp + 8) * 8) * 40 + ltok;
#pragma unroll
      for (int e = 0; e < 4; ++e) { const unsigned pk = pack2(f[2 * e] * skd, f[2 * e + 1] * skd); t1[(2 * e) * 40] = (bf16_t)(pk & 0xffffu); t1[(2 * e + 1) * 40] = (bf16_t)(pk >> 16); }
#pragma unroll
      for (int e = 0; e < 8; ++e) f[e] *= skb;
      o = pack8(f); *(uint4*)(sKb + ltok * 136 + (lp + 8) * 8) = o;
    }
    *(u32x4*)(sQ + ltok * 136 + lp * 8) = st.q0; *(u32x4*)(sQ + ltok * 136 + (lp + 8) * 8) = st.q1;
    if (tid < 128) {
      bf16_t* tv = sVbT + (lp * 8) * 40 + ltok;
#pragma unroll
      for (int e = 0; e < 4; ++e) { const unsigned pk = pack2(lo16(st.v[e]) * st.be, hi16(st.v[e]) * st.be); tv[(2 * e) * 40] = (bf16_t)(pk & 0xffffu); tv[(2 * e + 1) * 40] = (bf16_t)(pk >> 16); }
      *(u32x4*)(sT + ((tid & 127) >> 2) * 40 + (tid & 3) * 8) = st.tm;
    } else {
      *(u32x4*)(sM + ((tid & 127) >> 2) * 40 + (tid & 3) * 8) = st.tm;
    }
    if (tid < 32) sG[tid] = st.g;
  };
  f32x4 S[4];
#pragma unroll
  for (int t = 0; t < 4; ++t) S[t] = (f32x4){0.f, 0.f, 0.f, 0.f};
  __syncthreads();
  for (int i = tid; i < 32 * 136 / 2; i += 256) ((unsigned*)sST)[i] = 0u;
  gload(st0, 0); lstore(st0);
  __syncthreads();
  gload(st0, 1);
  __builtin_amdgcn_sched_barrier(0);
  gload(st1, 2);
  __builtin_amdgcn_sched_barrier(0);
  auto body = [&](int c) __attribute__((always_inline)) {
    const int dv = ta * 16 + fr, i0 = tb * 16 + fq * 4;
    {
      f32x4 pr = (f32x4){0.f, 0.f, 0.f, 0.f};
#pragma unroll
      for (int ks = 0; ks < 4; ++ks) {
        const bf16x8 kb = *(const bf16x8*)(sKb + (tb * 16 + fr) * 136 + ks * 32 + fq * 8);
        const bf16x8 sf = *(const bf16x8*)(sST + (ta * 16 + fr) * 136 + ks * 32 + fq * 8);
        pr = __builtin_amdgcn_mfma_f32_16x16x32_bf16(kb, sf, pr, 0, 0, 0);
      }
      const uint2 vb = *(const uint2*)(sVbT + dv * 40 + i0);
      uint2 o; o.x = pack2(lo16(vb.x) - pr[0], hi16(vb.x) - pr[1]); o.y = pack2(lo16(vb.y) - pr[2], hi16(vb.y) - pr[3]);
      *(uint2*)(sXT + dv * 40 + i0) = o;
    }
    __syncthreads();
    {
      const bf16x8 tf = *(const bf16x8*)(sT + (tb * 16 + fr) * 40 + fq * 8);
      const bf16x8 xf = *(const bf16x8*)(sXT + (ta * 16 + fr) * 40 + fq * 8);
      const f32x4 vn = __builtin_amdgcn_mfma_f32_16x16x32_bf16(tf, xf, (f32x4){0.f, 0.f, 0.f, 0.f}, 0, 0, 0);
      uint2 o; o.x = pack2(vn[0], vn[1]); o.y = pack2(vn[2], vn[3]);
      *(uint2*)(sVnT + dv * 40 + i0) = o;
    }
    __syncthreads();
    const float eglast = __expf(sG[31]);
    {
      f32x4 oa = (f32x4){0.f, 0.f, 0.f, 0.f};
#pragma unroll
      for (int ks = 0; ks < 4; ++ks) {
        const bf16x8 qf = *(const bf16x8*)(sQ + (ta * 16 + fr) * 136 + ks * 32 + fq * 8);
        const bf16x8 sf = *(const bf16x8*)(sST + (tb * 16 + fr) * 136 + ks * 32 + fq * 8);
        oa = __builtin_amdgcn_mfma_f32_16x16x32_bf16(sf, qf, oa, 0, 0, 0);
      }
      const int i = ta * 16 + fr;
      oa *= __expf(sG[i]);
      const bf16x8 mf = *(const bf16x8*)(sM + i * 40 + fq * 8);
      const bf16x8 vf = *(const bf16x8*)(sVnT + (tb * 16 + fr) * 40 + fq * 8);
      oa = __builtin_amdgcn_mfma_f32_16x16x32_bf16(vf, mf, oa, 0, 0, 0);
      uint2 o; o.x = pack2(oa[0], oa[1]); o.y = pack2(oa[2], oa[3]);
      *(uint2*)(OUT + (size_t)gdn_rowof(b_l, dir, c * 32 + i) * 1024 + h * 128 + dvq * 32 + tb * 16 + fq * 4) = o;
    }
    {
      const bf16x8 vf = *(const bf16x8*)(sVnT + (ta * 16 + fr) * 40 + fq * 8);
#pragma unroll
      for (int t = 0; t < 4; ++t) {
        const bf16x8 kf = *(const bf16x8*)(sKdT + ((tb * 4 + t) * 16 + fr) * 40 + fq * 8);
        S[t] *= eglast;
        S[t] = __builtin_amdgcn_mfma_f32_16x16x32_bf16(kf, vf, S[t], 0, 0, 0);
      }
    }
    __syncthreads();
#pragma unroll
    for (int t = 0; t < 4; ++t) {
      uint2 o; o.x = pack2(S[t][0], S[t][1]); o.y = pack2(S[t][2], S[t][3]);
      *(uint2*)(sST + (ta * 16 + fr) * 136 + (tb * 4 + t) * 16 + fq * 4) = o;
    }
  };
  for (int c = 0; c < NCH; c += 2) {
    body(c);
    lstore(st0); gload(st0, c + 3);
    __syncthreads();
    body(c + 1);
    if (c + 2 < NCH) lstore(st1);
    gload(st1, c + 4);
    __syncthreads();
  }
}

__device__ __forceinline__ void ssd_chunk_item(const Params& p, int id, unsigned char* smraw) {
  const int tid = TIDX(), lane = tid & 63, w = tid >> 6, fr = lane & 15, fq = lane >> 4;
  const int b_l = id >> 6, head = (id >> 1) & 31, dir = id & 1, grp = head >> 2;
  bf16_t* sC = (bf16_t*)smraw;
  bf16_t* sB = sC + 32 * 136;
  bf16_t* sBT = sB + 32 * 136;
  bf16_t* sXT = sBT + 128 * 40;
  bf16_t* sM = sXT + 64 * 40;
  bf16_t* sST = sM + 32 * 40;
  float* sG = (float*)(sST + 64 * 136);
  const bf16_t* XBC = (const bf16_t*)(p.ws + OFF_XBC);
  const float* DTF = (const float*)(p.ws + OFF_DTF);
  bf16_t* OUT = (bf16_t*)(p.ws + (dir ? OFF_YB : OFF_YF));
  const int ltok = tid & 31, lpart = tid >> 5;
  struct Stage { u32x4 b0, b1, c0, c1, x; float dt, g, gl; };
  Stage st0, st1;
  constexpr int NCH = (256 + 8192) / 32;
  auto gload = [&](Stage& st, int c) __attribute__((always_inline)) {
    const int s0 = (c < NCH ? c : NCH - 1) * 32;
    const size_t row = (size_t)ssd_rowof(b_l, dir, s0 + ltok);
    const bf16_t* xr = XBC + row * 4096;
    st.b0 = *(const u32x4*)(xr + 2048 + grp * 128 + lpart * 8);
    st.b1 = *(const u32x4*)(xr + 2048 + grp * 128 + (lpart + 8) * 8);
    st.c0 = *(const u32x4*)(xr + 3072 + grp * 128 + lpart * 8);
    st.c1 = *(const u32x4*)(xr + 3072 + grp * 128 + (lpart + 8) * 8);
    st.x = *(const u32x4*)(xr + head * 64 + lpart * 8);
    st.dt = DTF[row * 128 + dir * 32 + head];
    st.g = DTF[row * 128 + 64 + dir * 32 + head];
    st.gl = DTF[(size_t)ssd_rowof(b_l, dir, s0 + 31) * 128 + 64 + dir * 32 + head];
  };
  auto lstore = [&](const Stage& st) __attribute__((always_inline)) {
    *(u32x4*)(sB + ltok * 136 + lpart * 8) = st.b0;
    *(u32x4*)(sB + ltok * 136 + (lpart + 8) * 8) = st.b1;
    *(u32x4*)(sC + ltok * 136 + lpart * 8) = st.c0;
    *(u32x4*)(sC + ltok * 136 + (lpart + 8) * 8) = st.c1;
    const float wj = __expf(st.gl - st.g);
    bf16_t* t0 = sBT + (lpart * 8) * 40 + ltok;
    bf16_t* t1 = sBT + ((lpart + 8) * 8) * 40 + ltok;
    bf16_t* tx = sXT + (lpart * 8) * 40 + ltok;
#pragma unroll
    for (int e = 0; e < 4; ++e) {
      const unsigned pa = pack2(lo16(st.b0[e]) * wj, hi16(st.b0[e]) * wj), pb = pack2(lo16(st.b1[e]) * wj, hi16(st.b1[e]) * wj);
      const unsigned px = pack2(lo16(st.x[e]) * st.dt, hi16(st.x[e]) * st.dt);
      t0[(2 * e) * 40] = (bf16_t)(pa & 0xffffu); t0[(2 * e + 1) * 40] = (bf16_t)(pa >> 16);
      t1[(2 * e) * 40] = (bf16_t)(pb & 0xffffu); t1[(2 * e + 1) * 40] = (bf16_t)(pb >> 16);
      tx[(2 * e) * 40] = (bf16_t)(px & 0xffffu); tx[(2 * e + 1) * 40] = (bf16_t)(px >> 16);
    }
    if (tid < 32) sG[tid] = st.g;
  };
  f32x4 S[8];
#pragma unroll
  for (int i = 0; i < 8; ++i) S[i] = (f32x4){0.f, 0.f, 0.f, 0.f};
  __syncthreads();
  for (int i = lane; i < 16 * 136 / 2; i += 64) ((unsigned*)(sST + w * 16 * 136))[i] = 0u;
  gload(st0, 0); lstore(st0);
  __syncthreads();
  gload(st0, 1);
  __builtin_amdgcn_sched_barrier(0);
  gload(st1, 2);
  __builtin_amdgcn_sched_barrier(0);
  auto body = [&](int c) __attribute__((always_inline)) {
    {
      const int ti = w >> 1, tj = w & 1;
      f32x4 cb = (f32x4){0.f, 0.f, 0.f, 0.f};
      if (tj <= ti) {
#pragma unroll
        for (int ks = 0; ks < 4; ++ks) {
          const bf16x8 af = *(const bf16x8*)(sC + (ti * 16 + fr) * 136 + ks * 32 + fq * 8);
          const bf16x8 bf = *(const bf16x8*)(sB + (tj * 16 + fr) * 136 + ks * 32 + fq * 8);
          cb = __builtin_amdgcn_mfma_f32_16x16x32_bf16(bf, af, cb, 0, 0, 0);
        }
      }
      const int i = ti * 16 + fr, j0 = tj * 16 + fq * 4;
      const float gi = sG[i];
      const f32x4 gj = *(const f32x4*)(sG + j0);
      float m[4];
#pragma unroll
      for (int r = 0; r < 4; ++r) { const float e = __expf(fminf(gi - gj[r], 0.f)); m[r] = (j0 + r <= i) ? cb[r] * e : 0.f; }
      uint2 o; o.x = pack2(m[0], m[1]); o.y = pack2(m[2], m[3]);
      *(uint2*)(sM + i * 40 + j0) = o;
    }
    __syncthreads();
    const bf16x8 xfrag = *(const bf16x8*)(sXT + (w * 16 + fr) * 40 + fq * 8);
    const float eglast = __expf(sG[31]);
#pragma unroll
    for (int ti = 0; ti < 2; ++ti) {
      f32x4 y = (f32x4){0.f, 0.f, 0.f, 0.f};
#pragma unroll
      for (int ks = 0; ks < 4; ++ks) {
        const bf16x8 af = *(const bf16x8*)(sC + (ti * 16 + fr) * 136 + ks * 32 + fq * 8);
        const bf16x8 bf = *(const bf16x8*)(sST + (w * 16 + fr) * 136 + ks * 32 + fq * 8);
        y = __builtin_amdgcn_mfma_f32_16x16x32_bf16(bf, af, y, 0, 0, 0);
      }
      const int i = ti * 16 + fr;
      const float eg = __expf(sG[i]);
      y *= eg;
      const bf16x8 mf = *(const bf16x8*)(sM + i * 40 + fq * 8);
      y = __builtin_amdgcn_mfma_f32_16x16x32_bf16(xfrag, mf, y, 0, 0, 0);
      uint2 o; o.x = pack2(y[0], y[1]); o.y = pack2(y[2], y[3]);
      *(uint2*)(OUT + (size_t)ssd_rowof(b_l, dir, c * 32 + i) * 2048 + head * 64 + w * 16 + fq * 4) = o;
    }
#pragma unroll
    for (int tn = 0; tn < 8; ++tn) {
      const bf16x8 bf = *(const bf16x8*)(sBT + (tn * 16 + fr) * 40 + fq * 8);
      S[tn] *= eglast;
      S[tn] = __builtin_amdgcn_mfma_f32_16x16x32_bf16(bf, xfrag, S[tn], 0, 0, 0);
    }
#pragma unroll
    for (int tn = 0; tn < 8; ++tn) {
      uint2 o; o.x = pack2(S[tn][0], S[tn][1]); o.y = pack2(S[tn][2], S[tn][3]);
      *(uint2*)(sST + (w * 16 + fr) * 136 + tn * 16 + fq * 4) = o;
    }
    __syncthreads();
  };
  for (int c = 0; c < NCH; c += 2) {
    body(c);
    lstore(st0); gload(st0, c + 3);
    __syncthreads();
    body(c + 1);
    if (c + 2 < NCH) lstore(st1);
    gload(st1, c + 4);
    __syncthreads();
  }
}

__device__ __forceinline__ void scan_phase(const Params& p, unsigned char* sm, int nb, int v) {
  for (int item = v; item < 256; item += nb) {
    if (item < 128) gdn_chunk_item(p, item, sm); else ssd_chunk_item(p, item - 128, sm);
    __syncthreads();
  }
}

__device__ __forceinline__ void gnorm_phase(const Params& p, int l, int M) {
  const bf16_t* P = (const bf16_t*)(p.ws + OFF_P);
  const bf16_t* OF = (const bf16_t*)(p.ws + OFF_OF); const bf16_t* OB = (const bf16_t*)(p.ws + OFF_OB);
  const bf16_t* YF = (const bf16_t*)(p.ws + OFF_YF); const bf16_t* YB = (const bf16_t*)(p.ws + OFF_YB);
  const bf16_t* XBC = (const bf16_t*)(p.ws + OFF_XBC);
  bf16_t* YA = (bf16_t*)(p.ws + OFF_QKV); bf16_t* YBn = YA + (size_t)MG * 1024;
  const int gtid = BIDX() * 256 + TIDX(), gsz = GDIM() * 256;
  const float* nw = p.gdn_norm_w + l * 128;
  for (int idx0 = gtid; idx0 < M * 128; idx0 += 2 * gsz) {
    const int idx1 = idx0 + gsz; const bool has1 = idx1 < M * 128;
    const int ia[2] = {idx0, has1 ? idx1 : idx0};
    uint4 a[2], b[2], gt[2];
#pragma unroll
    for (int u = 0; u < 2; ++u) { const int r = ia[u] >> 7, c8 = (ia[u] & 127) * 8;
      a[u] = *(const uint4*)(OF + (size_t)r * 1024 + c8); b[u] = *(const uint4*)(OB + (size_t)r * 1024 + c8); gt[u] = *(const uint4*)(P + (size_t)r * LDP + C_GOUT + c8); }
#pragma unroll
    for (int u = 0; u < 2; ++u) {
      const int r = ia[u] >> 7, c8 = (ia[u] & 127) * 8;
      float fa[8], fb[8], fg[8]; UNPACK8(a[u], fa); UNPACK8(b[u], fb); UNPACK8(gt[u], fg);
      float ss = 0.f;
#pragma unroll
      for (int e = 0; e < 8; ++e) { fa[e] += fb[e]; ss += fa[e] * fa[e]; }
      ss += __shfl_xor(ss, 1); ss += __shfl_xor(ss, 2); ss += __shfl_xor(ss, 4); ss += __shfl_xor(ss, 8);
      const float rs = rsqrtf(ss * (1.f / 128.f) + 1e-6f);
      const float4 w0 = *(const float4*)(nw + (c8 & 127)), w1 = *(const float4*)(nw + (c8 & 127) + 4);
      const float wv[8] = {w0.x, w0.y, w0.z, w0.w, w1.x, w1.y, w1.z, w1.w};
#pragma unroll
      for (int e = 0; e < 8; ++e) fa[e] = fa[e] * rs * wv[e] * siluf_(fg[e]);
      if (u == 0 || has1) *(uint4*)(YA + (size_t)r * 1024 + c8) = pack8(fa);
    }
  }
  const float* sw = p.ssm_norm_w + l * 2048; const float* Dk = p.ssm_D + l * 32;
  for (int idx0 = gtid; idx0 < M * 256; idx0 += 2 * gsz) {
    const int idx1 = idx0 + gsz; const bool has1 = idx1 < M * 256;
    const int ia[2] = {idx0, has1 ? idx1 : idx0};
    uint4 a[2], b[2], xx[2], zz[2];
#pragma unroll
    for (int u = 0; u < 2; ++u) { const int r = ia[u] >> 8, c8 = (ia[u] & 255) * 8;
      a[u] = *(const uint4*)(YF + (size_t)r * 2048 + c8); b[u] = *(const uint4*)(YB + (size_t)r * 2048 + c8);
      xx[u] = *(const uint4*)(XBC + (size_t)r * 4096 + c8); zz[u] = *(const uint4*)(P + (size_t)r * LDP + C_Z + c8); }
#pragma unroll
    for (int u = 0; u < 2; ++u) {
      const int r = ia[u] >> 8, c8 = (ia[u] & 255) * 8;
      float fa[8], fb[8], fx[8], fz[8]; UNPACK8(a[u], fa); UNPACK8(b[u], fb); UNPACK8(xx[u], fx); UNPACK8(zz[u], fz);
      const float dsk = Dk[c8 >> 6];
      float ss = 0.f;
#pragma unroll
      for (int e = 0; e < 8; ++e) { fa[e] = (fa[e] + fb[e] + dsk * fx[e]) * siluf_(fz[e]); ss += fa[e] * fa[e]; }
      ss += __shfl_xor(ss, 1); ss += __shfl_xor(ss, 2); ss += __shfl_xor(ss, 4); ss += __shfl_xor(ss, 8); ss += __shfl_xor(ss, 16);
      const float rs = rsqrtf(ss * (1.f / 256.f) + 1e-6f);
      const float4 w0 = *(const float4*)(sw + c8), w1 = *(const float4*)(sw + c8 + 4);
      const float wv[8] = {w0.x, w0.y, w0.z, w0.w, w1.x, w1.y, w1.z, w1.w};
#pragma unroll
      for (int e = 0; e < 8; ++e) fa[e] = fa[e] * rs * wv[e];
      if (u == 0 || has1) *(uint4*)(YBn + (size_t)r * 2048 + c8) = pack8(fa);
    }
  }
}

#define XB_TMO      128
#define XB_XCNT(j)  (256  + 64 * (j))
#define XB_XSUB(j)  (1280 + 64 * (j))
#define XB_XGEN(j)  (2304 + 64 * (j))
#define XB_TOP      3328
#define XB_TOPGEN   3392
#define XCD_BAR_WORDS 3456
#define XB_SPIN_CAP (1u << 18)
#define LAS __attribute__((address_space(3)))

__device__ __forceinline__ unsigned xb_ld(unsigned* p)              { return __hip_atomic_load(p, __ATOMIC_RELAXED, __HIP_MEMORY_SCOPE_AGENT); }
__device__ __forceinline__ unsigned xb_add(unsigned* p, unsigned v) { return __hip_atomic_fetch_add(p, v, __ATOMIC_RELAXED, __HIP_MEMORY_SCOPE_AGENT); }
__device__ __forceinline__ unsigned xb_xcc_id() { return (unsigned)__builtin_amdgcn_s_getreg((3 << 11) | 20) & 0xFu; }
#define XB_SPIN(cond, bar) do { unsigned _sp = 0; while (cond) { __builtin_amdgcn_s_sleep(1); \
    if ((++_sp & 255u) == 0u) { if (xb_ld(&(bar)[XB_TMO])) break; if (_sp > XB_SPIN_CAP) { atomicAdd(&(bar)[XB_TMO], 1u); break; } } } } while (0)

struct XcdBarrier {
    unsigned* bar; unsigned x;
    volatile LAS unsigned* st;
};

__device__ __forceinline__ XcdBarrier xcd_barrier_post(unsigned* bar, volatile LAS unsigned* st) {
    XcdBarrier b; b.bar = bar; b.x = xb_xcc_id(); b.st = st;
    if (threadIdx.x == 0) (void)xb_add(&bar[XB_XCNT(b.x)], 1u);
    return b;
}
__device__ __forceinline__ void xcd_barrier_complete(unsigned* bar, unsigned x, unsigned& nloc, unsigned& nx) {
    const unsigned G = gridDim.x * gridDim.y * gridDim.z;
    unsigned sum, cnt, mine, sp = 0u;
    for (;;) {
        sum = 0u; cnt = 0u; mine = 0u;
#pragma unroll
        for (unsigned j = 0; j < 16; ++j) { const unsigned c = xb_ld(&bar[XB_XCNT(j)]); sum += c; cnt += (c > 0u) ? 1u : 0u; mine = (j == x) ? c : mine; }
        if (sum == G) break;
        __builtin_amdgcn_s_sleep(1);
        if ((++sp & 255u) == 0u) { if (xb_ld(&bar[XB_TMO])) break; if (sp > XB_SPIN_CAP) { atomicAdd(&bar[XB_TMO], 1u); break; } }
    }
    nloc = mine > 0u ? mine : 1u; nx = cnt > 0u ? cnt : 1u;
}

__device__ __forceinline__ void xcd_barrier(const XcdBarrier& b) {
    asm volatile("s_waitcnt vmcnt(0)" ::: "memory");
    __syncthreads();
    if (threadIdx.x == 0) {
        unsigned* bar = b.bar;
        __builtin_amdgcn_s_waitcnt(0);
        unsigned nloc = b.st[0], nx = b.st[1];
        if (nloc == 0u) { xcd_barrier_complete(bar, b.x, nloc, nx); b.st[0] = nloc; b.st[1] = nx; }
        const unsigned old = xb_add(&bar[XB_XSUB(b.x)], 1u);
        const unsigned gen = old / nloc;
        if (old + 1u == (gen + 1u) * nloc) {
            __builtin_amdgcn_fence(__ATOMIC_RELEASE, "agent");
            asm volatile("s_waitcnt vmcnt(0)" ::: "memory");
            const unsigned og = xb_add(&bar[XB_TOP], 1u);
            const unsigned tg = og / nx;
            if (og + 1u == (tg + 1u) * nx) xb_add(&bar[XB_TOPGEN], 1u);
            else XB_SPIN(xb_ld(&bar[XB_TOPGEN]) == tg, bar);
            __builtin_amdgcn_fence(__ATOMIC_ACQUIRE, "agent");
            xb_add(&bar[XB_XGEN(b.x)], 1u);
            asm volatile("s_waitcnt vmcnt(0)" ::: "memory");
        } else {
            XB_SPIN(xb_ld(&bar[XB_XGEN(b.x)]) == gen, bar);
            __builtin_amdgcn_fence(__ATOMIC_ACQUIRE, "agent");
            asm volatile("s_waitcnt vmcnt(0)" ::: "memory");
        }
    }
    __syncthreads();
}

#ifndef STOP_AFTER
#define STOP_AFTER 0
#endif
#define SYNC() { xcd_barrier(xb); if (++nsync == STOP_AFTER) return; }
#define PH(CALL) { CALL; }
__global__ void __launch_bounds__(256, 2) mega(Params p) {
  cg::grid_group grid = cg::this_grid();
  int nsync = 0;
  __shared__ __attribute__((aligned(16))) unsigned char smem[SMEM_BYTES];
  __shared__ uint4 xb_words;
  if (threadIdx.x == 0) xb_words = make_uint4(0u, 0u, 0u, 0u);
  __syncthreads();
  XcdBarrier xb = xcd_barrier_post((unsigned*)(p.ws + OFF_BAR), (volatile LAS unsigned*)&xb_words);
  float* smf = (float*)smem; bf16_t* smh = (bf16_t*)smem;
  for (int l = 0; l < 2; ++l) {
    PH(transpose_phase(p.w_in + (size_t)l * 1024 * IN_DIM, (bf16_t*)(p.ws + OFF_WIN), 1024, IN_DIM, LDP, smf))
    PH(transpose_phase(p.w_proj_gdn + (size_t)l * 1024 * 1024, (bf16_t*)(p.ws + OFF_WPG), 1024, 1024, 1024, smf))
    PH(transpose_phase(p.w_proj_ssm + (size_t)l * 2048 * 1024, (bf16_t*)(p.ws + OFF_WPS), 2048, 1024, 1024, smf))
    PH(transpose_phase(p.w_out + (size_t)l * 1024 * 1024, (bf16_t*)(p.ws + OFF_WOUT), 1024, 1024, 1024, smf))
    PH(transpose_phase(p.w_ff1 + (size_t)l * 1024 * 4096, (bf16_t*)(p.ws + OFF_WFF1), 1024, 4096, 4096, smf))
    PH(transpose_phase(p.w_ff2 + (size_t)l * 4096 * 1024, (bf16_t*)(p.ws + OFF_WFF2), 4096, 1024, 1024, smf))
    if (l == 0) { PH(modpart_phase(p, smf)) grid.sync(); PH(modfinal_phase(p)) }
    SYNC();
    const bool last = (l == 1);
    const int Mpost = last ? MLAT : MG;
    for (int g = 0; g < NGRP; ++g) {
      PH(modulate_phase(p, l, g)) SYNC();
      PH(gemm_inproj_phase(p, smh, 0, GDIM(), BIDX())) SYNC();
      PH(conv_phase(p, l)) SYNC();
      PH(gdn_prep_phase(p, smem)) SYNC();
      {
        const int nb_ = GDIM(), v_ = BIDX();
        if (nb_ >= 512) { if (v_ < 256) { PH(scan_phase(p, smem, 256, v_)) } else { PH(gemm_inproj_phase(p, smh, 1, nb_ - 256, v_ - 256)) } }
        else { PH(scan_phase(p, smem, nb_, v_)) PH(gemm_inproj_phase(p, smh, 1, nb_, v_)) }
      }
      SYNC();
      PH(gnorm_phase(p, l, Mpost)) SYNC();
      PH(gemm_proj_phase(p, Mpost, smh)) SYNC();
      PH(gemm_wout_phase(p, l, g, Mpost, smh)) SYNC();
      PH(ln_phase(p, l, g, Mpost, p.ln1_g + l * D, p.ln1_b + l * D, true)) SYNC();
      PH(gemm_ff1_phase(p, l, Mpost, smh)) SYNC();
      PH(gemm_ff2_phase(p, l, g, Mpost, smh)) SYNC();
      PH(ln_phase(p, l, g, Mpost, p.ln2_g + l * D, p.ln2_b + l * D, false)) SYNC();
    }
  }
}

extern "C" void kernel_launch(void* const* d_in, const int* in_sizes, int n_in, void* d_out, int out_size, void* d_ws, size_t ws_size,
                              hipStream_t stream) {
  static int grid_blocks = 0;
  if (!grid_blocks) {
    int dev = 0, cus = 0, per_cu = 0;
    (void)hipGetDevice(&dev);
    (void)hipDeviceGetAttribute(&cus, hipDeviceAttributeMultiprocessorCount, dev);
    (void)hipOccupancyMaxActiveBlocksPerMultiprocessor(&per_cu, mega, 256, 0);
    if (per_cu > 2) per_cu = 2;
    grid_blocks = cus * per_cu;
    if (ws_size < WS_TOTAL) fprintf(stderr, "workspace too small: %zu < %zu\n", ws_size, WS_TOTAL);
  }
  Params p{};
  const float** pp = (const float**)&p;
  for (int i = 0; i < 28; ++i) pp[i] = (const float*)d_in[i];
  p.out = (float*)d_out;
  p.ws = (unsigned char*)d_ws;
  (void)hipMemsetAsync((unsigned char*)d_ws + OFF_BAR, 0, 16384, stream);
  void* args[] = {&p};
  hipError_t e = hipLaunchCooperativeKernel((void*)mega, dim3(grid_blocks), dim3(256), args, 0, stream);
  if (e != hipSuccess) fprintf(stderr, "cooperative launch failed: %s (grid %d)\n", hipGetErrorString(e), grid_blocks);
}
```

```cpp
#include <hip/hip_runtime.h>
#include <hip/hip_cooperative_groups.h>
#include <cstdio>
namespace cg = cooperative_groups;

typedef unsigned short bf16_t;
typedef short bf16x8 __attribute__((ext_vector_type(8)));
typedef float f32x4 __attribute__((ext_vector_type(4)));
typedef float f32x2 __attribute__((ext_vector_type(2)));
typedef unsigned u32x4 __attribute__((ext_vector_type(4)));

constexpr int D = 1024, SEQ = 8192, LC = 256;
constexpr int G = 2, NGRP = 4;
constexpr int MLAT = G * SEQ, MCTX = G * LC, MG = MLAT + MCTX;
constexpr int IN_DIM = 12384, LDP = 12416;
constexpr int C_GOUT = 3072, C_A = 4096, C_B = 4112, C_Z = 4128, C_XBC = 6176, C_DT = 10272, C_GA = 10336, C_GB = 11360;
constexpr float DN_ALPHA = 1.4142135623730951f;

constexpr size_t SZ_WIN = (size_t)LDP * 1024 * 2;
constexpr size_t OFF_WIN = 0;
constexpr size_t OFF_WPG = OFF_WIN + SZ_WIN;
constexpr size_t OFF_WPS = OFF_WPG + 2097152;
constexpr size_t OFF_WOUT = OFF_WPS + 4194304;
constexpr size_t OFF_WFF1 = OFF_WOUT + 2097152;
constexpr size_t OFF_WFF2 = OFF_WFF1 + 8388608;
constexpr size_t OFF_MODP = OFF_WFF2 + 8388608;
constexpr size_t OFF_MOD = OFF_MODP + (size_t)2 * 16 * 9 * 6144 * 4;
constexpr size_t OFF_XSC = OFF_MOD + (size_t)2 * 9 * 6144 * 4;
constexpr size_t OFF_H = OFF_XSC + (size_t)2048 * 1024 * 4;
constexpr size_t OFF_P = OFF_H + (size_t)MG * 1024 * 2;
constexpr size_t OFF_QKV = OFF_P + (size_t)MG * LDP * 2;
constexpr size_t OFF_XBC = OFF_QKV + (size_t)MG * 3072 * 2;
constexpr size_t OFF_GBF = OFF_XBC + (size_t)MG * 4096 * 2;
constexpr size_t OFF_DTF = OFF_GBF + (size_t)MG * 32 * 4;
constexpr size_t OFF_OF = OFF_DTF + (size_t)MG * 128 * 4;
constexpr size_t OFF_OB = OFF_OF + (size_t)MG * 1024 * 2;
constexpr size_t OFF_YF = OFF_OB + (size_t)MG * 1024 * 2;
constexpr size_t OFF_YB = OFF_YF + (size_t)MG * 2048 * 2;
constexpr size_t OFF_TMB = OFF_YB + (size_t)MG * 2048 * 2;
constexpr int GDN_NITEM = G * 8 * 2 * 264;
constexpr size_t OFF_BAR = OFF_TMB + (size_t)GDN_NITEM * 2048 * 2;
constexpr size_t WS_TOTAL = OFF_BAR + 16384;
static_assert(WS_TOTAL <= ((size_t)1024 << 20), "workspace plan exceeds 1 GiB");

struct Params {
  const float *x, *c, *ctx, *c_ctx, *w_mod, *b_mod, *w_in, *gdn_conv_w, *gdn_A_log, *gdn_dt_bias, *gdn_norm_w;
  const float *ssm_conv_w, *ssm_conv_b, *ssm_A_log, *ssm_dt_bias, *ssm_D, *ssm_norm_w, *w_proj_gdn, *w_proj_ssm, *w_out;
  const float *ln1_g, *ln1_b, *w_ff1, *b_ff1, *w_ff2, *b_ff2, *ln2_g, *ln2_b;
  float* out;
  unsigned char* ws;
};

constexpr int SMEM_BYTES = 73728;


__device__ __forceinline__ int TIDX() { int t = threadIdx.x; asm volatile("" : "+v"(t)); return t; }
__device__ __forceinline__ int BIDX() { int t = blockIdx.x; asm volatile("" : "+s"(t)); return t; }
__device__ __forceinline__ int GDIM() { int t = gridDim.x; asm volatile("" : "+s"(t)); return t; }
__device__ __forceinline__ float bf2f(bf16_t b) { return __uint_as_float(((unsigned)b) << 16); }
__device__ __forceinline__ bf16_t f2bf(float f) { unsigned u = __float_as_uint(f); u += 0x7fffu + ((u >> 16) & 1u); return (bf16_t)(u >> 16); }
typedef __bf16 bf16v2 __attribute__((ext_vector_type(2)));
__device__ __forceinline__ unsigned pack2(float a, float b) { const f32x2 v = (f32x2){a, b}; const bf16v2 h = __builtin_convertvector(v, bf16v2); return __builtin_bit_cast(unsigned, h); }
__device__ __forceinline__ float lo16(unsigned v) { return __uint_as_float(v << 16); }
__device__ __forceinline__ float hi16(unsigned v) { return __uint_as_float(v & 0xffff0000u); }
#define UNPACK8(v, f) { f[0] = lo16(v.x); f[1] = hi16(v.x); f[2] = lo16(v.y); f[3] = hi16(v.y); f[4] = lo16(v.z); f[5] = hi16(v.z); f[6] = lo16(v.w); f[7] = hi16(v.w); }
__device__ __forceinline__ uint4 pack8(const float* f) { uint4 r; r.x = pack2(f[0], f[1]); r.y = pack2(f[2], f[3]); r.z = pack2(f[4], f[5]); r.w = pack2(f[6], f[7]); return r; }
__device__ __forceinline__ float sigmoidf_(float x) { return __builtin_amdgcn_rcpf(1.f + __expf(-x)); }
__device__ __forceinline__ float siluf_(float x) { return x * __builtin_amdgcn_rcpf(1.f + __expf(-x)); }
__device__ __forceinline__ float softplusf_(float x) { return x > 20.f ? x : log1pf(__expf(x)); }
template <int CTRL> __device__ __forceinline__ float dppf(float x) { return __builtin_bit_cast(float, __builtin_amdgcn_mov_dpp(__builtin_bit_cast(int, x), CTRL, 0xf, 0xf, true)); }
__device__ __forceinline__ float reduce16(float x) { x += dppf<0xB1>(x); x += dppf<0x4E>(x); x += dppf<0x141>(x); x += dppf<0x140>(x); return x; }

__device__ __forceinline__ float* xs_row(const Params& p, int g, int r) {
  return (r < MLAT) ? p.out + ((size_t)g * MLAT + r) * D : (float*)(p.ws + OFF_XSC) + ((size_t)g * MCTX + (r - MLAT)) * D;
}
__device__ __forceinline__ const float* xin_row(const Params& p, int l, int g, int r) {
  if (l == 0) return (r < MLAT) ? p.x + ((size_t)g * MLAT + r) * D : p.ctx + ((size_t)g * MCTX + (r - MLAT)) * D;
  return xs_row(p, g, r);
}
__device__ __forceinline__ int mod_row(int g, int r) { return r < MLAT ? g * G + r / SEQ : 8; }
__device__ __forceinline__ int gdn_rowof(int b_l, int dir, int s) {
  if (s < 256) { const int i = dir ? 255 - s : s; return MLAT + b_l * 256 + i; }
  const int i = s - 256; return b_l * 8192 + (dir ? 8191 - i : i);
}
__device__ __forceinline__ int ssd_rowof(int b_l, int dir, int s) {
  if (s < 256) { const int i = dir ? 255 - s : s; return MLAT + b_l * 256 + i; }
  const int j = s - 256; const int pos = dir ? 8191 - j : j; return b_l * 8192 + (pos & 127) * 64 + (pos >> 7);
}

__device__ __forceinline__ void transpose_phase(const float* __restrict__ src, bf16_t* __restrict__ dst, int K, int N, int Npad, float* tile) {
  const int tid = TIDX(), tk = K / 64, tn = Npad / 64;
  const int c = tid & 63, r4 = tid >> 6;
  for (int t = BIDX(); t < tk * tn; t += GDIM()) {
    const int kt = t % tk, nt = t / tk, k0 = kt * 64, n0 = nt * 64;
    __syncthreads();
#pragma unroll 4
    for (int i = 0; i < 16; ++i) { const int r = i * 4 + r4, n = n0 + c; tile[r * 65 + c] = (n < N) ? src[(size_t)(k0 + r) * N + n] : 0.f; }
    __syncthreads();
#pragma unroll 4
    for (int i = 0; i < 16; ++i) { const int nn = i * 4 + r4; dst[(size_t)(n0 + nn) * K + k0 + c] = f2bf(tile[c * 65 + nn]); }
  }
}

__device__ __forceinline__ void modpart_phase(const Params& p, float* sm) {
  const int tid = TIDX();
  float* MODP = (float*)(p.ws + OFF_MODP);
  for (int item = BIDX(); item < 2 * 24 * 16; item += GDIM()) {
    const int l = item / 384, rem = item % 384, cbk = rem / 16, ks = rem % 16;
    __syncthreads();
    for (int i = tid; i < 9 * 64; i += 256) { const int r = i / 64, k = ks * 64 + (i % 64); const float v = (r < 8) ? p.c[r * D + k] : p.c_ctx[k]; sm[i] = siluf_(v); }
    __syncthreads();
    const int col = cbk * 256 + tid;
    float acc[9];
#pragma unroll
    for (int r = 0; r < 9; ++r) acc[r] = 0.f;
    const float* wp = p.w_mod + ((size_t)l * D + ks * 64) * 6144 + col;
#pragma unroll 8
    for (int k = 0; k < 64; ++k) { const float w = wp[(size_t)k * 6144];
#pragma unroll
      for (int r = 0; r < 9; ++r) acc[r] += sm[r * 64 + k] * w; }
#pragma unroll
    for (int r = 0; r < 9; ++r) MODP[(((size_t)l * 16 + ks) * 9 + r) * 6144 + col] = acc[r];
  }
}
__device__ __forceinline__ void modfinal_phase(const Params& p) {
  const float* MODP = (const float*)(p.ws + OFF_MODP);
  float* MOD = (float*)(p.ws + OFF_MOD);
  for (int i = BIDX() * 256 + TIDX(); i < 2 * 9 * 6144; i += GDIM() * 256) {
    const int l = i / (9 * 6144), rem = i % (9 * 6144), col = rem % 6144;
    float s = p.b_mod[l * 6144 + col];
    for (int ks = 0; ks < 16; ++ks) s += MODP[((size_t)l * 16 + ks) * 9 * 6144 + rem];
    MOD[i] = s;
  }
}

__device__ __forceinline__ void modulate_phase(const Params& p, int l, int g) {
  const float* MOD = (const float*)(p.ws + OFF_MOD) + (size_t)l * 9 * 6144;
  bf16_t* H = (bf16_t*)(p.ws + OFF_H);
  for (int i = BIDX() * 256 + TIDX(); i < MG * 128; i += GDIM() * 256) {
    const int r = i >> 7, ch = (i & 127) * 8;
    const float* xr = xin_row(p, l, g, r) + ch;
    const float* m = MOD + (size_t)mod_row(g, r) * 6144;
    const float4 x0 = *(const float4*)xr, x1 = *(const float4*)(xr + 4);
    const float4 sh0 = *(const float4*)(m + ch), sh1 = *(const float4*)(m + ch + 4);
    const float4 sc0 = *(const float4*)(m + 1024 + ch), sc1 = *(const float4*)(m + 1024 + ch + 4);
    float f[8] = {x0.x * (1.f + sc0.x) + sh0.x, x0.y * (1.f + sc0.y) + sh0.y, x0.z * (1.f + sc0.z) + sh0.z, x0.w * (1.f + sc0.w) + sh0.w,
                  x1.x * (1.f + sc1.x) + sh1.x, x1.y * (1.f + sc1.y) + sh1.y, x1.z * (1.f + sc1.z) + sh1.z, x1.w * (1.f + sc1.w) + sh1.w};
    *(uint4*)(H + (size_t)r * D + ch) = pack8(f);
  }
}

struct Seg { const bf16_t* ap; const bf16_t* bp; int lda, ldb, nk; };

__device__ __forceinline__ bool tile_coord_sub(int it, int nM, int nN, int nb, int v, int& mt, int& nt) {
  long s;
  if ((nb & 7) == 0) { const int per = nb >> 3; s = (long)it * nb + (v & 7) * per + (v >> 3); } else s = (long)it * nb + v;
  if (s >= (long)nM * nN) return false;
  const int band = (int)(s / (8 * nN)), r = (int)(s - (long)band * 8 * nN);
  const int bsz = (nM - band * 8) < 8 ? (nM - band * 8) : 8;
  nt = r / bsz; mt = band * 8 + (r % bsz);
  return true;
}
__device__ __forceinline__ bool tile_coord(int it, int nM, int nN, int& mt, int& nt) { return tile_coord_sub(it, nM, nN, GDIM(), BIDX(), mt, nt); }
__device__ __forceinline__ int inproj_ntile(int part, int e) {
  if (part == 0) return e < 24 ? e : (e == 24 ? 32 : 23 + e);
  return e < 8 ? 24 + e : (e < 23 ? 25 + e : 58 + e);
}

#define ZERO_ACC(acc) { _Pragma("unroll") for (int i_ = 0; i_ < 4; ++i_) { _Pragma("unroll") for (int j_ = 0; j_ < 4; ++j_) acc[i_][j_] = (f32x4){0.f, 0.f, 0.f, 0.f}; } }
#define EPI_LOOP(...) { const int lane_ = TIDX() & 63, w_ = TIDX() >> 6; \
  _Pragma("unroll") for (int i_ = 0; i_ < 4; ++i_) { const int row = m0 + (w_ >> 1) * 64 + i_ * 16 + (lane_ & 15); \
  _Pragma("unroll") for (int j_ = 0; j_ < 4; ++j_) { const int col = n0 + (w_ & 1) * 64 + j_ * 16 + (lane_ >> 4) * 4; f32x4& v = acc[i_][j_]; __VA_ARGS__ } } }

__device__ __forceinline__ int perm_brow(int lr) { return 8 * ((lr & 15) >> 2) + 4 * ((lr >> 4) & 1) + (lr & 3); }
#define EPI8_LOOP(...) { const int lane_ = TIDX() & 63, w_ = TIDX() >> 6; \
  _Pragma("unroll") for (int i_ = 0; i_ < 4; ++i_) { const int row = m0 + (w_ >> 1) * 64 + i_ * 16 + (lane_ & 15); \
  _Pragma("unroll") for (int a_ = 0; a_ < 2; ++a_) { const int col = n0 + (w_ & 1) * 64 + a_ * 32 + (lane_ >> 4) * 8; f32x4& v0 = acc[i_][2 * a_]; f32x4& v1 = acc[i_][2 * a_ + 1]; __VA_ARGS__ } } }

template <class Prob>
__device__ __forceinline__ void gemm_stream(Prob& pr, bf16_t* sm) {
  const int tid = TIDX(), lane = tid & 63, w = tid >> 6, wr = w >> 1, wc = w & 1;
  const int lr = tid >> 3, lk = (tid & 7) * 8;
  const int fr = lane & 15, fq = lane >> 4;
  const int aoff = (wr * 64 + fr) * 72 + fq * 8, boff = 9216 + (wc * 64 + fr) * 72 + fq * 8;
  const int soff = lr * 72 + lk;
  Seg cur, nxt;
  if (!pr.seg(0, cur, lr, lk)) return;
  bool has_nxt = pr.seg(1, nxt, lr, lk);
  u32x4 r0a[4], r0b[4], r1a[4], r1b[4];
#pragma unroll
  for (int i = 0; i < 4; ++i) { r0a[i] = (u32x4){0u, 0u, 0u, 0u}; r0b[i] = r0a[i]; r1a[i] = r0a[i]; r1b[i] = r0a[i]; }
  f32x4 acc[4][4];
#define GS_LOAD(RA, RB, KT) { const int kt_ = (KT); const bf16_t* ap_ = cur.ap; const bf16_t* bp_ = cur.bp; int lda_ = cur.lda, ldb_ = cur.ldb; \
    if (kt_ < cur.nk) { ap_ += kt_ * 64; bp_ += kt_ * 64; } \
    else if (has_nxt) { ap_ = nxt.ap + (kt_ - cur.nk) * 64; bp_ = nxt.bp + (kt_ - cur.nk) * 64; lda_ = nxt.lda; ldb_ = nxt.ldb; } \
      \
    _Pragma("unroll") for (int i = 0; i < 4; ++i) { RA[i] = *(const u32x4*)(ap_ + (size_t)i * 32 * lda_); RB[i] = *(const u32x4*)(bp_ + (size_t)i * 32 * ldb_); } }
#define GS_STORE(RA, RB, KT, STAGE) { bf16_t* st_ = (STAGE) + soff; \
    _Pragma("unroll") for (int i = 0; i < 4; ++i) { *(u32x4*)(st_ + i * 32 * 72) = RA[i]; *(u32x4*)(st_ + 9216 + i * 32 * 72) = RB[i]; } }
#define GS_COMPUTE(STAGE) { const bf16_t* cs_ = (STAGE); bf16x8 af0[4], bf0[4], af1[4], bf1[4]; \
    _Pragma("unroll") for (int i = 0; i < 4; ++i) { af0[i] = *(const bf16x8*)(cs_ + aoff + i * 16 * 72); bf0[i] = *(const bf16x8*)(cs_ + boff + i * 16 * 72); } \
    _Pragma("unroll") for (int i = 0; i < 4; ++i) { af1[i] = *(const bf16x8*)(cs_ + aoff + i * 16 * 72 + 32); bf1[i] = *(const bf16x8*)(cs_ + boff + i * 16 * 72 + 32); } \
    _Pragma("unroll") for (int i = 0; i < 4; ++i) { _Pragma("unroll") for (int j = 0; j < 4; ++j) acc[i][j] = __builtin_amdgcn_mfma_f32_16x16x32_bf16(bf0[j], af0[i], acc[i][j], 0, 0, 0); } \
    _Pragma("unroll") for (int i = 0; i < 4; ++i) { _Pragma("unroll") for (int j = 0; j < 4; ++j) acc[i][j] = __builtin_amdgcn_mfma_f32_16x16x32_bf16(bf1[j], af1[i], acc[i][j], 0, 0, 0); } }
#define GS_SCHED() { __builtin_amdgcn_sched_group_barrier(0x100, 8, 0); \
    _Pragma("unroll") for (int q_ = 0; q_ < 8; ++q_) { __builtin_amdgcn_sched_group_barrier(0x008, 2, 0); __builtin_amdgcn_sched_group_barrier(0x100, 1, 0); __builtin_amdgcn_sched_group_barrier(0x020, 1, 0); } \
    _Pragma("unroll") for (int q_ = 0; q_ < 8; ++q_) { __builtin_amdgcn_sched_group_barrier(0x008, 2, 0); __builtin_amdgcn_sched_group_barrier(0x200, 1, 0); } }
  GS_LOAD(r0a, r0b, 0)
  __syncthreads();
  GS_STORE(r0a, r0b, 0, sm)
  __syncthreads();
  GS_LOAD(r0a, r0b, 1)
  __builtin_amdgcn_sched_barrier(0);
  for (int idx = 0;; ++idx) {
    pr.begin(idx, acc);
    for (int kt = 0; kt < cur.nk; kt += 2) {
      GS_LOAD(r1a, r1b, kt + 2)
      GS_COMPUTE(sm)
      GS_STORE(r0a, r0b, kt + 1, sm + 18432)
      GS_SCHED()
      __syncthreads();
      GS_LOAD(r0a, r0b, kt + 3)
      GS_COMPUTE(sm + 18432)
      GS_STORE(r1a, r1b, kt + 2, sm)
      GS_SCHED()
      __syncthreads();
    }
    pr.end(idx, acc);
    if (!has_nxt) break;
    cur = nxt; has_nxt = pr.seg(idx + 2, nxt, lr, lk);
  }
#undef GS_LOAD
#undef GS_STORE
#undef GS_COMPUTE
#undef GS_SCHED
}

__device__ __forceinline__ void gemm_inproj_phase(const Params& p, bf16_t* sm, int part, int nb, int v) {
  struct Pr {
    const bf16_t* A; const bf16_t* W; bf16_t* P; int nM, nN, part, nb, v;
    __device__ bool seg(int idx, Seg& s, int lr, int lk) const { int mt, e; if (!tile_coord_sub(idx, nM, nN, nb, v, mt, e)) return false; const int nt = inproj_ntile(part, e);
      s.ap = A + (size_t)(mt * 128 + lr) * D + lk; s.bp = W + (size_t)(nt * 128 + perm_brow(lr)) * D + lk; s.lda = D; s.ldb = D; s.nk = 16; return true; }
    __device__ void begin(int, f32x4 (&acc)[4][4]) const { ZERO_ACC(acc) }
    __device__ void end(int idx, f32x4 (&acc)[4][4]) const { int mt, e; tile_coord_sub(idx, nM, nN, nb, v, mt, e); const int m0 = mt * 128, n0 = inproj_ntile(part, e) * 128;
      EPI8_LOOP({ uint4 o; o.x = pack2(v0[0], v0[1]); o.y = pack2(v0[2], v0[3]); o.z = pack2(v1[0], v1[1]); o.w = pack2(v1[2], v1[3]); *(uint4*)(P + (size_t)row * LDP + col) = o; }) }
  } pr{(const bf16_t*)(p.ws + OFF_H), (const bf16_t*)(p.ws + OFF_WIN), (bf16_t*)(p.ws + OFF_P), MG / 128, part == 0 ? 58 : 39, part, nb, v};
  gemm_stream(pr, sm);
}
__device__ __forceinline__ void gemm_proj_phase(const Params& p, int M, bf16_t* sm) {
  struct Pr {
    const bf16_t* YA; const bf16_t* YBn; const bf16_t* Wg; const bf16_t* Ws; const bf16_t* P; bf16_t* U; int nM, nN;
    __device__ bool seg(int idx, Seg& s, int lr, int lk) const { int mt, nt; if (!tile_coord(idx >> 1, nM, nN, mt, nt)) return false;
      if ((idx & 1) == 0) { s.ap = YA + (size_t)(mt * 128 + lr) * 1024 + lk; s.bp = Wg + (size_t)(nt * 128 + perm_brow(lr)) * 1024 + lk; s.lda = 1024; s.ldb = 1024; s.nk = 16; }
      else { s.ap = YBn + (size_t)(mt * 128 + lr) * 2048 + lk; s.bp = Ws + (size_t)(nt * 128 + perm_brow(lr)) * 2048 + lk; s.lda = 2048; s.ldb = 2048; s.nk = 32; }
      return true; }
    __device__ void begin(int idx, f32x4 (&acc)[4][4]) const { if ((idx & 1) == 0) ZERO_ACC(acc) }
    __device__ void end(int idx, f32x4 (&acc)[4][4]) const { int mt, nt; tile_coord(idx >> 1, nM, nN, mt, nt); const int m0 = mt * 128, n0 = nt * 128;
      if ((idx & 1) == 0) {
        EPI8_LOOP({ const uint4 ga = *(const uint4*)(P + (size_t)row * LDP + C_GA + col); const uint4 gb = *(const uint4*)(P + (size_t)row * LDP + C_GB + col);
          v0[0] *= (1.f + __expf(-lo16(gb.x))) / (1.f + __expf(-lo16(ga.x))); v0[1] *= (1.f + __expf(-hi16(gb.x))) / (1.f + __expf(-hi16(ga.x)));
          v0[2] *= (1.f + __expf(-lo16(gb.y))) / (1.f + __expf(-lo16(ga.y))); v0[3] *= (1.f + __expf(-hi16(gb.y))) / (1.f + __expf(-hi16(ga.y)));
          v1[0] *= (1.f + __expf(-lo16(gb.z))) / (1.f + __expf(-lo16(ga.z))); v1[1] *= (1.f + __expf(-hi16(gb.z))) / (1.f + __expf(-hi16(ga.z)));
          v1[2] *= (1.f + __expf(-lo16(gb.w))) / (1.f + __expf(-lo16(ga.w))); v1[3] *= (1.f + __expf(-hi16(gb.w))) / (1.f + __expf(-hi16(ga.w))); })
      } else {
        EPI8_LOOP({ const uint4 gb = *(const uint4*)(P + (size_t)row * LDP + C_GB + col);
          uint4 o; o.x = pack2(v0[0] * sigmoidf_(lo16(gb.x)), v0[1] * sigmoidf_(hi16(gb.x))); o.y = pack2(v0[2] * sigmoidf_(lo16(gb.y)), v0[3] * sigmoidf_(hi16(gb.y)));
          o.z = pack2(v1[0] * sigmoidf_(lo16(gb.z)), v1[1] * sigmoidf_(hi16(gb.z))); o.w = pack2(v1[2] * sigmoidf_(lo16(gb.w)), v1[3] * sigmoidf_(hi16(gb.w)));
          *(uint4*)(U + (size_t)row * D + col) = o; })
      } }
  } pr{(const bf16_t*)(p.ws + OFF_QKV), (const bf16_t*)(p.ws + OFF_QKV) + (size_t)MG * 1024, (const bf16_t*)(p.ws + OFF_WPG), (const bf16_t*)(p.ws + OFF_WPS),
       (const bf16_t*)(p.ws + OFF_P), (bf16_t*)(p.ws + OFF_H), M / 128, 8};
  gemm_stream(pr, sm);
}
__device__ __forceinline__ void gemm_wout_phase(const Params& p, int l, int g, int M, bf16_t* sm) {
  struct Pr {
    const Params& p; int l, g; const bf16_t* U; const bf16_t* W; const float* MOD; int nM, nN;
    __device__ bool seg(int idx, Seg& s, int lr, int lk) const { int mt, nt; if (!tile_coord(idx, nM, nN, mt, nt)) return false;
      s.ap = U + (size_t)(mt * 128 + lr) * D + lk; s.bp = W + (size_t)(nt * 128 + perm_brow(lr)) * D + lk; s.lda = D; s.ldb = D; s.nk = 16; return true; }
    __device__ void begin(int, f32x4 (&acc)[4][4]) const { ZERO_ACC(acc) }
    __device__ void end(int idx, f32x4 (&acc)[4][4]) const { int mt, nt; tile_coord(idx, nM, nN, mt, nt); const int m0 = mt * 128, n0 = nt * 128;
      EPI8_LOOP({ const float* xp = xin_row(p, l, g, row) + col; const float* gp = MOD + (size_t)mod_row(g, row) * 6144 + 2048 + col; float* op = xs_row(p, g, row) + col;
        const float4 xa = *(const float4*)xp, xb = *(const float4*)(xp + 4), ga = *(const float4*)gp, gb = *(const float4*)(gp + 4);
        float4 oa, ob; oa.x = DN_ALPHA * xa.x + ga.x * v0[0]; oa.y = DN_ALPHA * xa.y + ga.y * v0[1]; oa.z = DN_ALPHA * xa.z + ga.z * v0[2]; oa.w = DN_ALPHA * xa.w + ga.w * v0[3];
        ob.x = DN_ALPHA * xb.x + gb.x * v1[0]; ob.y = DN_ALPHA * xb.y + gb.y * v1[1]; ob.z = DN_ALPHA * xb.z + gb.z * v1[2]; ob.w = DN_ALPHA * xb.w + gb.w * v1[3];
        *(float4*)op = oa; *(float4*)(op + 4) = ob; }) }
  } pr{p, l, g, (const bf16_t*)(p.ws + OFF_H), (const bf16_t*)(p.ws + OFF_WOUT), (const float*)(p.ws + OFF_MOD) + (size_t)l * 9 * 6144, M / 128, 8};
  gemm_stream(pr, sm);
}
__device__ __forceinline__ void gemm_ff1_phase(const Params& p, int l, int M, bf16_t* sm) {
  struct Pr {
    const bf16_t* H; const bf16_t* W; bf16_t* HID; const float* b1; int nM, nN;
    __device__ bool seg(int idx, Seg& s, int lr, int lk) const { int mt, nt; if (!tile_coord(idx, nM, nN, mt, nt)) return false;
      s.ap = H + (size_t)(mt * 128 + lr) * D + lk; s.bp = W + (size_t)(nt * 128 + perm_brow(lr)) * D + lk; s.lda = D; s.ldb = D; s.nk = 16; return true; }
    __device__ void begin(int, f32x4 (&acc)[4][4]) const { ZERO_ACC(acc) }
    __device__ void end(int idx, f32x4 (&acc)[4][4]) const { int mt, nt; tile_coord(idx, nM, nN, mt, nt); const int m0 = mt * 128, n0 = nt * 128;
      EPI8_LOOP({ const float4 ba = *(const float4*)(b1 + col), bb = *(const float4*)(b1 + col + 4);
        const float t0 = fmaxf(v0[0] + ba.x, 0.f), t1 = fmaxf(v0[1] + ba.y, 0.f), t2 = fmaxf(v0[2] + ba.z, 0.f), t3 = fmaxf(v0[3] + ba.w, 0.f);
        const float t4 = fmaxf(v1[0] + bb.x, 0.f), t5 = fmaxf(v1[1] + bb.y, 0.f), t6 = fmaxf(v1[2] + bb.z, 0.f), t7 = fmaxf(v1[3] + bb.w, 0.f);
        uint4 o; o.x = pack2(t0 * t0, t1 * t1); o.y = pack2(t2 * t2, t3 * t3); o.z = pack2(t4 * t4, t5 * t5); o.w = pack2(t6 * t6, t7 * t7);
        *(uint4*)(HID + (size_t)row * 4096 + col) = o; }) }
  } pr{(const bf16_t*)(p.ws + OFF_H), (const bf16_t*)(p.ws + OFF_WFF1), (bf16_t*)(p.ws + OFF_P), p.b_ff1 + (size_t)l * 4096, M / 128, 32};
  gemm_stream(pr, sm);
}
__device__ __forceinline__ void gemm_ff2_phase(const Params& p, int l, int g, int M, bf16_t* sm) {
  struct Pr {
    const Params& p; int g; const bf16_t* HID; const bf16_t* W; const float* MOD; const float* b2; int nM, nN;
    __device__ bool seg(int idx, Seg& s, int lr, int lk) const { int mt, nt; if (!tile_coord(idx, nM, nN, mt, nt)) return false;
      s.ap = HID + (size_t)(mt * 128 + lr) * 4096 + lk; s.bp = W + (size_t)(nt * 128 + perm_brow(lr)) * 4096 + lk; s.lda = 4096; s.ldb = 4096; s.nk = 64; return true; }
    __device__ void begin(int, f32x4 (&acc)[4][4]) const { ZERO_ACC(acc) }
    __device__ void end(int idx, f32x4 (&acc)[4][4]) const { int mt, nt; tile_coord(idx, nM, nN, mt, nt); const int m0 = mt * 128, n0 = nt * 128;
      EPI8_LOOP({ float* xp = xs_row(p, g, row) + col; const float* gp = MOD + (size_t)mod_row(g, row) * 6144 + 5120 + col;
        const float4 xa = *(const float4*)xp, xb = *(const float4*)(xp + 4), ba = *(const float4*)(b2 + col), bb = *(const float4*)(b2 + col + 4), ga = *(const float4*)gp, gb = *(const float4*)(gp + 4);
        float4 oa, ob; oa.x = DN_ALPHA * xa.x + ga.x * (v0[0] + ba.x); oa.y = DN_ALPHA * xa.y + ga.y * (v0[1] + ba.y); oa.z = DN_ALPHA * xa.z + ga.z * (v0[2] + ba.z); oa.w = DN_ALPHA * xa.w + ga.w * (v0[3] + ba.w);
        ob.x = DN_ALPHA * xb.x + gb.x * (v1[0] + bb.x); ob.y = DN_ALPHA * xb.y + gb.y * (v1[1] + bb.y); ob.z = DN_ALPHA * xb.z + gb.z * (v1[2] + bb.z); ob.w = DN_ALPHA * xb.w + gb.w * (v1[3] + bb.w);
        *(float4*)xp = oa; *(float4*)(xp + 4) = ob; }) }
  } pr{p, g, (const bf16_t*)(p.ws + OFF_P), (const bf16_t*)(p.ws + OFF_WFF2), (const float*)(p.ws + OFF_MOD) + (size_t)l * 9 * 6144, p.b_ff2 + (size_t)l * 1024, M / 128, 8};
  gemm_stream(pr, sm);
}

__device__ __forceinline__ void ln_phase(const Params& p, int l, int g, int M, const float* gam, const float* bet, bool write_h2) {
  const int lane = TIDX() & 63;
  const float* MOD = (const float*)(p.ws + OFF_MOD) + (size_t)l * 9 * 6144;
  bf16_t* H = (bf16_t*)(p.ws + OFF_H);
  const int stride = GDIM() * 4;
  for (int r0 = BIDX() * 4 + (TIDX() >> 6); r0 < M; r0 += 2 * stride) {
    const int r1 = r0 + stride; const bool has1 = r1 < M;
    float* xr0 = xs_row(p, g, r0); float* xr1 = xs_row(p, g, has1 ? r1 : r0);
    float4 v0[4], v1[4];
#pragma unroll
    for (int i = 0; i < 4; ++i) { v0[i] = *(const float4*)(xr0 + (i * 64 + lane) * 4); v1[i] = *(const float4*)(xr1 + (i * 64 + lane) * 4); }
    float s0 = 0.f, s1 = 0.f;
#pragma unroll
    for (int i = 0; i < 4; ++i) { s0 += v0[i].x + v0[i].y + v0[i].z + v0[i].w; s1 += v1[i].x + v1[i].y + v1[i].z + v1[i].w; }
#pragma unroll
    for (int o = 32; o >= 1; o >>= 1) { s0 += __shfl_xor(s0, o); s1 += __shfl_xor(s1, o); }
    const float mu0 = s0 * (1.f / 1024.f), mu1 = s1 * (1.f / 1024.f);
    float q0 = 0.f, q1 = 0.f;
#pragma unroll
    for (int i = 0; i < 4; ++i) {
      v0[i].x -= mu0; v0[i].y -= mu0; v0[i].z -= mu0; v0[i].w -= mu0; q0 += v0[i].x * v0[i].x + v0[i].y * v0[i].y + v0[i].z * v0[i].z + v0[i].w * v0[i].w;
      v1[i].x -= mu1; v1[i].y -= mu1; v1[i].z -= mu1; v1[i].w -= mu1; q1 += v1[i].x * v1[i].x + v1[i].y * v1[i].y + v1[i].z * v1[i].z + v1[i].w * v1[i].w;
    }
#pragma unroll
    for (int o = 32; o >= 1; o >>= 1) { q0 += __shfl_xor(q0, o); q1 += __shfl_xor(q1, o); }
    const float rs0 = rsqrtf(q0 * (1.f / 1024.f) + 1e-5f), rs1 = rsqrtf(q1 * (1.f / 1024.f) + 1e-5f);
    const float* m0 = MOD + (size_t)mod_row(g, r0) * 6144;
    const float* m1 = MOD + (size_t)mod_row(g, has1 ? r1 : r0) * 6144;
#pragma unroll
    for (int i = 0; i < 4; ++i) {
      const int ch = (i * 64 + lane) * 4;
      const float4 gg = *(const float4*)(gam + ch), bb = *(const float4*)(bet + ch);
      float4 o0, o1;
      o0.x = v0[i].x * rs0 * gg.x + bb.x; o0.y = v0[i].y * rs0 * gg.y + bb.y; o0.z = v0[i].z * rs0 * gg.z + bb.z; o0.w = v0[i].w * rs0 * gg.w + bb.w;
      o1.x = v1[i].x * rs1 * gg.x + bb.x; o1.y = v1[i].y * rs1 * gg.y + bb.y; o1.z = v1[i].z * rs1 * gg.z + bb.z; o1.w = v1[i].w * rs1 * gg.w + bb.w;
      *(float4*)(xr0 + ch) = o0;
      if (has1) *(float4*)(xr1 + ch) = o1;
      if (write_h2) {
        const float4 sh0 = *(const float4*)(m0 + 3072 + ch), sc0 = *(const float4*)(m0 + 4096 + ch);
        uint2 h; h.x = pack2(o0.x * (1.f + sc0.x) + sh0.x, o0.y * (1.f + sc0.y) + sh0.y); h.y = pack2(o0.z * (1.f + sc0.z) + sh0.z, o0.w * (1.f + sc0.w) + sh0.w);
        *(uint2*)(H + (size_t)r0 * D + ch) = h;
        if (has1) {
          const float4 sh1 = *(const float4*)(m1 + 3072 + ch), sc1 = *(const float4*)(m1 + 4096 + ch);
          h.x = pack2(o1.x * (1.f + sc1.x) + sh1.x, o1.y * (1.f + sc1.y) + sh1.y); h.y = pack2(o1.z * (1.f + sc1.z) + sh1.z, o1.w * (1.f + sc1.w) + sh1.w);
          *(uint2*)(H + (size_t)r1 * D + ch) = h;
        }
      }
    }
  }
}

__device__ __forceinline__ void conv_phase(const Params& p, int l) {
  const bf16_t* P = (const bf16_t*)(p.ws + OFF_P);
  bf16_t* QKV = (bf16_t*)(p.ws + OFF_QKV); bf16_t* XBC = (bf16_t*)(p.ws + OFF_XBC);
  float* GBF = (float*)(p.ws + OFF_GBF); float* DTF = (float*)(p.ws + OFF_DTF);
  const int nb = GDIM(), bid = BIDX(), tid = TIDX();
  const int vb = ((nb & 7) == 0) ? (bid & 7) * (nb >> 3) + (bid >> 3) : bid;
  const int gtid = vb * 256 + tid, gsz = nb * 256;
  {
    const float* cw = p.gdn_conv_w + (size_t)l * 5 * 3072;
    const int c = tid & 127, hh = tid >> 7;
    for (int item = vb; item < (MG / 32) * 3; item += nb) {
      const int third = item % 3, pp = item / 3;
      const int ch0 = third * 1024 + c * 8;
      const int t0 = (pp * 2 + hh) * 16;
      int lo, hi;
      if (t0 < MLAT) { lo = t0 & ~63; hi = lo + 64; } else { lo = MLAT + ((t0 - MLAT) & ~255); hi = lo + 256; }
      u32x4 raw[20];
#pragma unroll
      for (int i = 0; i < 20; ++i) { const int row = t0 - 2 + i; raw[i] = (row >= lo && row < hi) ? *(const u32x4*)(P + (size_t)row * LDP + ch0) : (u32x4){0u, 0u, 0u, 0u}; }
      float wt[5][8];
#pragma unroll
      for (int j = 0; j < 5; ++j) { const float4 w0 = *(const float4*)(cw + j * 3072 + ch0), w1 = *(const float4*)(cw + j * 3072 + ch0 + 4);
        wt[j][0] = w0.x; wt[j][1] = w0.y; wt[j][2] = w0.z; wt[j][3] = w0.w; wt[j][4] = w1.x; wt[j][5] = w1.y; wt[j][6] = w1.z; wt[j][7] = w1.w; }
      const float qsc = (third == 0) ? 0.08838834764831845f : 1.f;
#pragma unroll
      for (int t = 0; t < 16; ++t) {
        float acc[8];
#pragma unroll
        for (int e = 0; e < 8; ++e) acc[e] = 0.f;
#pragma unroll
        for (int j = 0; j < 5; ++j) {
          const u32x4 rw = raw[t + j];
#pragma unroll
          for (int e = 0; e < 4; ++e) { acc[2 * e] += lo16(rw[e]) * wt[j][2 * e]; acc[2 * e + 1] += hi16(rw[e]) * wt[j][2 * e + 1]; }
        }
        float ss = 0.f;
#pragma unroll
        for (int e = 0; e < 8; ++e) { acc[e] = siluf_(acc[e]); ss += acc[e] * acc[e]; }
        ss += __shfl_xor(ss, 1); ss += __shfl_xor(ss, 2); ss += __shfl_xor(ss, 4); ss += __shfl_xor(ss, 8);
        const float sc = (third < 2) ? rsqrtf(ss + 1e-6f) * qsc : 1.f;
#pragma unroll
        for (int e = 0; e < 8; ++e) acc[e] *= sc;
        *(uint4*)(QKV + (size_t)(t0 + t) * 3072 + ch0) = pack8(acc);
      }
    }
  }
  {
    const float* sw = p.ssm_conv_w + (size_t)l * 5 * 4096; const float* sb = p.ssm_conv_b + (size_t)l * 4096;
    constexpr int nLat = G * 64 * 8 * 2, nCtx = (MCTX / 16) * 2;
    float wt[5][8], bs[8];
    int cur_half = -1;
    for (int item = vb; item < nLat + nCtx; item += nb) {
      int half, base, stride, p0, seglen;
      if (item < nLat) { half = item & 1; const int piece = (item >> 1) & 7, cl = (item >> 4) & 63, b_l = item >> 10; base = b_l * 8192 + cl; stride = 64; p0 = piece * 16; seglen = 128; }
      else { const int i2 = item - nLat; half = i2 & 1; const int piece = i2 >> 1; base = MLAT + (piece >> 4) * 256; stride = 1; p0 = (piece & 15) * 16; seglen = 256; }
      const int ch0 = (half * 256 + tid) * 8;
      u32x4 raw[20];
#pragma unroll
      for (int i = 0; i < 20; ++i) { const int pq = p0 - 2 + i; raw[i] = (pq >= 0 && pq < seglen) ? *(const u32x4*)(P + (size_t)(base + pq * stride) * LDP + C_XBC + ch0) : (u32x4){0u, 0u, 0u, 0u}; }
      if (half != cur_half) {
        cur_half = half;
        const float4 b0 = *(const float4*)(sb + ch0), b1 = *(const float4*)(sb + ch0 + 4);
        bs[0] = b0.x; bs[1] = b0.y; bs[2] = b0.z; bs[3] = b0.w; bs[4] = b1.x; bs[5] = b1.y; bs[6] = b1.z; bs[7] = b1.w;
#pragma unroll
        for (int j = 0; j < 5; ++j) { const float4 w0 = *(const float4*)(sw + j * 4096 + ch0), w1 = *(const float4*)(sw + j * 4096 + ch0 + 4);
          wt[j][0] = w0.x; wt[j][1] = w0.y; wt[j][2] = w0.z; wt[j][3] = w0.w; wt[j][4] = w1.x; wt[j][5] = w1.y; wt[j][6] = w1.z; wt[j][7] = w1.w; }
      }
#pragma unroll
      for (int t = 0; t < 16; ++t) {
        float acc[8];
#pragma unroll
        for (int e = 0; e < 8; ++e) acc[e] = bs[e];
#pragma unroll
        for (int j = 0; j < 5; ++j) {
          const u32x4 rw = raw[t + j];
#pragma unroll
          for (int e = 0; e < 4; ++e) { acc[2 * e] += lo16(rw[e]) * wt[j][2 * e]; acc[2 * e + 1] += hi16(rw[e]) * wt[j][2 * e + 1]; }
        }
#pragma unroll
        for (int e = 0; e < 8; ++e) acc[e] = siluf_(acc[e]);
        *(uint4*)(XBC + (size_t)(base + (p0 + t) * stride) * 4096 + ch0) = pack8(acc);
      }
    }
  }
  for (int idx = gtid; idx < MG * 16; idx += gsz) {
    const int r = idx >> 4, dh = idx & 15;
    GBF[(size_t)r * 32 + 16 + dh] = sigmoidf_(bf2f(P[(size_t)r * LDP + C_B + dh]));
  }
  for (int idx = gtid; idx < G * 2 * 264 * 8; idx += gsz) {
    const int h = idx & 7; int t = idx >> 3; const int chunk = t % 264; t /= 264; const int dir = t & 1, b_l = t >> 1;
    const int dh = dir * 8 + h;
    const float bias = p.gdn_dt_bias[l * 16 + dh], aneg = -__expf(p.gdn_A_log[l * 16 + dh]);
    float cum = 0.f;
    for (int ub = 0; ub < 32; ub += 8) {
      float av[8];
#pragma unroll
      for (int u = 0; u < 8; ++u) av[u] = bf2f(P[(size_t)gdn_rowof(b_l, dir, chunk * 32 + ub + u) * LDP + C_A + dh]);
#pragma unroll
      for (int u = 0; u < 8; ++u) {
        cum += aneg * softplusf_(av[u] + bias);
        GBF[(size_t)gdn_rowof(b_l, dir, chunk * 32 + ub + u) * 32 + dh] = cum;
      }
    }
  }
  for (int idx = gtid; idx < G * 2 * 264 * 32; idx += gsz) {
    const int head = idx & 31; int t = idx >> 5; const int chunk = t % 264; t /= 264; const int dir = t & 1, b_l = t >> 1;
    const int dh = dir * 32 + head;
    const float bias = p.ssm_dt_bias[l * 64 + dh], aneg = -__expf(p.ssm_A_log[l * 64 + dh]);
    float cum = 0.f;
    for (int ub = 0; ub < 32; ub += 8) {
      float dtv[8];
#pragma unroll
      for (int u = 0; u < 8; ++u) dtv[u] = bf2f(P[(size_t)ssd_rowof(b_l, dir, chunk * 32 + ub + u) * LDP + C_DT + dh]);
#pragma unroll
      for (int u = 0; u < 8; ++u) {
        const size_t row = (size_t)ssd_rowof(b_l, dir, chunk * 32 + ub + u);
        const float dt = softplusf_(dtv[u] + bias);
        cum += dt * aneg;
        DTF[row * 128 + dh] = dt;
        DTF[row * 128 + 64 + dh] = cum;
      }
    }
  }
}

__device__ __forceinline__ void gdn_prep_phase(const Params& p, unsigned char* smraw) {
  const int tid = TIDX(), lane = tid & 63, w = tid >> 6, fr = lane & 15, fq = lane >> 4, ti = w >> 1, tj = w & 1;
  bf16_t* sK = (bf16_t*)smraw;
  bf16_t* sQ = sK + 32 * 136;
  bf16_t* sP = sQ + 32 * 136;
  bf16_t* sPT = sP + 2 * 1280;
  bf16_t* sR = sPT + 2 * 1280;
  float* sG = (float*)(sR + 2 * 1280);
  const bf16_t* QKV = (const bf16_t*)(p.ws + OFF_QKV);
  const float* GBF = (const float*)(p.ws + OFF_GBF);
  bf16_t* TMB = (bf16_t*)(p.ws + OFF_TMB);
  const int ltok = tid & 31, lp = tid >> 5;
  const int i = ti * 16 + fr, j0 = tj * 16 + fq * 4;
  for (int item = BIDX(); item < GDN_NITEM; item += GDIM()) {
    const int chunk = item % 264; const int t = item / 264; const int dir = t & 1, h = (t >> 1) & 7, b_l = t >> 4;
    const size_t row = (size_t)gdn_rowof(b_l, dir, chunk * 32 + ltok);
    const bf16_t* src = QKV + row * 3072 + h * 128;
    const u32x4 k0 = *(const u32x4*)(src + 1024 + lp * 8), k1 = *(const u32x4*)(src + 1024 + (lp + 8) * 8);
    const u32x4 q0 = *(const u32x4*)(src + lp * 8), q1 = *(const u32x4*)(src + (lp + 8) * 8);
    float g_ = 0.f, b_ = 0.f;
    if (tid < 32) { g_ = GBF[row * 32 + dir * 8 + h]; b_ = GBF[row * 32 + 16 + dir * 8 + h]; }
    __syncthreads();
    *(u32x4*)(sK + ltok * 136 + lp * 8) = k0; *(u32x4*)(sK + ltok * 136 + (lp + 8) * 8) = k1;
    *(u32x4*)(sQ + ltok * 136 + lp * 8) = q0; *(u32x4*)(sQ + ltok * 136 + (lp + 8) * 8) = q1;
    if (tid < 32) { sG[tid] = g_; sG[32 + tid] = b_; }
    __syncthreads();
    {
      f32x4 kk = (f32x4){0.f, 0.f, 0.f, 0.f}, qk = kk;
#pragma unroll
      for (int ks = 0; ks < 4; ++ks) {
        const bf16x8 kj = *(const bf16x8*)(sK + (tj * 16 + fr) * 136 + ks * 32 + fq * 8);
        const bf16x8 ki = *(const bf16x8*)(sK + (ti * 16 + fr) * 136 + ks * 32 + fq * 8);
        const bf16x8 qi = *(const bf16x8*)(sQ + (ti * 16 + fr) * 136 + ks * 32 + fq * 8);
        kk = __builtin_amdgcn_mfma_f32_16x16x32_bf16(kj, ki, kk, 0, 0, 0);
        qk = __builtin_amdgcn_mfma_f32_16x16x32_bf16(kj, qi, qk, 0, 0, 0);
      }
      const float gi = sG[i], bi = sG[32 + i];
      float n[4], nt[4], rr[4], m[4];
#pragma unroll
      for (int r = 0; r < 4; ++r) {
        const int j = j0 + r; const float gj = sG[j], bj = sG[32 + j];
        n[r] = (j < i) ? -bi * kk[r] * __expf(gi - gj) : 0.f;
        nt[r] = (i < j) ? -bj * kk[r] * __expf(gj - gi) : 0.f;
        m[r] = (j <= i) ? qk[r] * __expf(gi - gj) : 0.f;
        rr[r] = n[r] + ((i == j) ? 1.f : 0.f);
      }
      uint2 o;
      o.x = pack2(n[0], n[1]); o.y = pack2(n[2], n[3]); *(uint2*)(sP + i * 40 + j0) = o;
      o.x = pack2(nt[0], nt[1]); o.y = pack2(nt[2], nt[3]); *(uint2*)(sPT + i * 40 + j0) = o;
      o.x = pack2(rr[0], rr[1]); o.y = pack2(rr[2], rr[3]); *(uint2*)(sR + i * 40 + j0) = o;
      o.x = pack2(m[0], m[1]); o.y = pack2(m[2], m[3]); *(uint2*)(TMB + (size_t)item * 2048 + 1024 + i * 32 + j0) = o;
    }
    __syncthreads();
    int pc = 0, rc = 0;
#pragma unroll
    for (int st = 1; st <= 5; ++st) {
      const bf16_t* Pc = sP + pc * 1280; const bf16_t* PTc = sPT + pc * 1280; const bf16_t* Rc = sR + rc * 1280;
      const bf16x8 p_i = *(const bf16x8*)(Pc + (ti * 16 + fr) * 40 + fq * 8);
      const bf16x8 p_j = *(const bf16x8*)(Pc + (tj * 16 + fr) * 40 + fq * 8);
      const bf16x8 pt_i = *(const bf16x8*)(PTc + (ti * 16 + fr) * 40 + fq * 8);
      const bf16x8 pt_j = *(const bf16x8*)(PTc + (tj * 16 + fr) * 40 + fq * 8);
      const f32x4 z = (f32x4){0.f, 0.f, 0.f, 0.f};
      if (st >= 2) {
        const bf16x8 r_i = *(const bf16x8*)(Rc + (ti * 16 + fr) * 40 + fq * 8);
        const uint2 rin = *(const uint2*)(Rc + i * 40 + j0);
        f32x4 racc = (f32x4){lo16(rin.x), hi16(rin.x), lo16(rin.y), hi16(rin.y)};
        racc = __builtin_amdgcn_mfma_f32_16x16x32_bf16(pt_j, r_i, racc, 0, 0, 0);
        uint2 o; o.x = pack2(racc[0], racc[1]); o.y = pack2(racc[2], racc[3]);
        if (st < 5) *(uint2*)(sR + (rc ^ 1) * 1280 + i * 40 + j0) = o;
        else *(uint2*)(TMB + (size_t)item * 2048 + i * 32 + j0) = o;
      }
      if (st <= 4) {
        const f32x4 pn = __builtin_amdgcn_mfma_f32_16x16x32_bf16(pt_j, p_i, z, 0, 0, 0);
        const f32x4 ptn = __builtin_amdgcn_mfma_f32_16x16x32_bf16(p_j, pt_i, z, 0, 0, 0);
        uint2 o; o.x = pack2(pn[0], pn[1]); o.y = pack2(pn[2], pn[3]); *(uint2*)(sP + (pc ^ 1) * 1280 + i * 40 + j0) = o;
        o.x = pack2(ptn[0], ptn[1]); o.y = pack2(ptn[2], ptn[3]); *(uint2*)(sPT + (pc ^ 1) * 1280 + i * 40 + j0) = o;
      }
      if (st < 5) __syncthreads();
      pc ^= 1; if (st >= 2) rc ^= 1;
    }
  }
}

__device__ __forceinline__ void gdn_chunk_item(const Params& p, int id, unsigned char* smraw) {
  const int tid = TIDX(), lane = tid & 63, w = tid >> 6, fr = lane & 15, fq = lane >> 4, ta = w >> 1, tb = w & 1;
  const int b_l = id >> 6, h = (id >> 3) & 7, dir = (id >> 2) & 1, dvq = id & 3;
  bf16_t* sKb = (bf16_t*)smraw;
  bf16_t* sQ = sKb + 32 * 136;
  bf16_t* sKdT = sQ + 32 * 136;
  bf16_t* sVbT = sKdT + 128 * 40;
  bf16_t* sT = sVbT + 32 * 40;
  bf16_t* sM = sT + 32 * 40;
  bf16_t* sXT = sM + 32 * 40;
  bf16_t* sVnT = sXT + 32 * 40;
  bf16_t* sST = sVnT + 32 * 40;
  float* sG = (float*)(sST + 32 * 136);
  const bf16_t* QKV = (const bf16_t*)(p.ws + OFF_QKV);
  const float* GBF = (const float*)(p.ws + OFF_GBF);
  const bf16_t* TMB = (const bf16_t*)(p.ws + OFF_TMB);
  bf16_t* OUT = (bf16_t*)(p.ws + (dir ? OFF_OB : OFF_OF));
  const int ltok = tid & 31, lp = tid >> 5;
  const size_t item0 = (size_t)((b_l * 8 + h) * 2 + dir) * 264;
  struct Stage { u32x4 k0, k1, q0, q1, v, tm; float g, be, gl; };
  Stage st0, st1;
  constexpr int NCH = (256 + 8192) / 32;
  auto gload = [&](Stage& st, int c) __attribute__((always_inline)) {
    const int s0 = (c < NCH ? c : NCH - 1) * 32;
    const size_t row = (size_t)gdn_rowof(b_l, dir, s0 + ltok);
    const bf16_t* src = QKV + row * 3072 + h * 128;
    st.k0 = *(const u32x4*)(src + 1024 + lp * 8); st.k1 = *(const u32x4*)(src + 1024 + (lp + 8) * 8);
    st.q0 = *(const u32x4*)(src + lp * 8); st.q1 = *(const u32x4*)(src + (lp + 8) * 8);
    st.v = *(const u32x4*)(src + 2048 + dvq * 32 + (lp & 3) * 8);
    st.tm = *(const u32x4*)(TMB + (item0 + (c < NCH ? c : NCH - 1)) * 2048 + (tid >> 7) * 1024 + ((tid & 127) >> 2) * 32 + (tid & 3) * 8);
    st.g = GBF[row * 32 + dir * 8 + h]; st.be = GBF[row * 32 + 16 + dir * 8 + h];
    st.gl = GBF[(size_t)gdn_rowof(b_l, dir, s0 + 31) * 32 + dir * 8 + h];
  };
  auto lstore = [&](const Stage& st) __attribute__((always_inline)) {
    const float skb = st.be * __expf(st.g), skd = __expf(st.gl - st.g);
    {
      float f[8]; uint4 o;
      f[0] = lo16(st.k0[0]); f[1] = hi16(st.k0[0]); f[2] = lo16(st.k0[1]); f[3] = hi16(st.k0[1]); f[4] = lo16(st.k0[2]); f[5] = hi16(st.k0[2]); f[6] = lo16(st.k0[3]); f[7] = hi16(st.k0[3]);
      bf16_t* t0 = sKdT + (lp * 8) * 40 + ltok;
#pragma unroll
      for (int e = 0; e < 4; ++e) { const unsigned pk = pack2(f[2 * e] * skd, f[2 * e + 1] * skd); t0[(2 * e) * 40] = (bf16_t)(pk & 0xffffu); t0[(2 * e + 1) * 40] = (bf16_t)(pk >> 16); }
#pragma unroll
      for (int e = 0; e < 8; ++e) f[e] *= skb;
      o = pack8(f); *(uint4*)(sKb + ltok * 136 + lp * 8) = o;
      f[0] = lo16(st.k1[0]); f[1] = hi16(st.k1[0]); f[2] = lo16(st.k1[1]); f[3] = hi16(st.k1[1]); f[4] = lo16(st.k1[2]); f[5] = hi16(st.k1[2]); f[6] = lo16(st.k1[3]); f[7] = hi16(st.k1[3]);
      bf16_t* t1 = sKdT + ((lp + 8) * 8) * 40 + ltok;
#pragma unroll
      for (int e = 0; e < 4; ++e) { const unsigned pk = pack2(f[2 * e] * skd, f[2 * e + 1] * skd); t1[(2 * e) * 40] = (bf16_t)(pk & 0xffffu); t1[(2 * e + 1) * 40] = (bf16_t)(pk >> 16); }
#pragma unroll
      for (int e = 0; e < 8; ++e) f[e] *= skb;
      o = pack8(f); *(uint4*)(sKb + ltok * 136 + (lp + 8) * 8) = o;
    }
    *(u32x4*)(sQ + ltok * 136 + lp * 8) = st.q0; *(u32x4*)(sQ + ltok * 136 + (lp + 8) * 8) = st.q1;
    if (tid < 128) {
      bf16_t* tv = sVbT + (lp * 8) * 40 + ltok;
#pragma unroll
      for (int e = 0; e < 4; ++e) { const unsigned pk = pack2(lo16(st.v[e]) * st.be, hi16(st.v[e]) * st.be); tv[(2 * e) * 40] = (bf16_t)(pk & 0xffffu); tv[(2 * e + 1) * 40] = (bf16_t)(pk >> 16); }
      *(u32x4*)(sT + ((tid & 127) >> 2) * 40 + (tid & 3) * 8) = st.tm;
    } else {
      *(u32x4*)(sM + ((tid & 127) >> 2) * 40 + (tid & 3) * 8) = st.tm;
    }
    if (tid < 32) sG[tid] = st.g;
  };
  f32x4 S[4];
#pragma unroll
  for (int t = 0; t < 4; ++t) S[t] = (f32x4){0.f, 0.f, 0.f, 0.f};
  __syncthreads();
  for (int i = tid; i < 32 * 136 / 2; i += 256) ((unsigned*)sST)[i] = 0u;
  gload(st0, 0); lstore(st0);
  __syncthreads();
  gload(st0, 1);
  __builtin_amdgcn_sched_barrier(0);
  gload(st1, 2);
  __builtin_amdgcn_sched_barrier(0);
  auto body = [&](int c) __attribute__((always_inline)) {
    const int dv = ta * 16 + fr, i0 = tb * 16 + fq * 4;
    {
      f32x4 pr = (f32x4){0.f, 0.f, 0.f, 0.f};
#pragma unroll
      for (int ks = 0; ks < 4; ++ks) {
        const bf16x8 kb = *(const bf16x8*)(sKb + (tb * 16 + fr) * 136 + ks * 32 + fq * 8);
        const bf16x8 sf = *(const bf16x8*)(sST + (ta * 16 + fr) * 136 + ks * 32 + fq * 8);
        pr = __builtin_amdgcn_mfma_f32_16x16x32_bf16(kb, sf, pr, 0, 0, 0);
      }
      const uint2 vb = *(const uint2*)(sVbT + dv * 40 + i0);
      uint2 o; o.x = pack2(lo16(vb.x) - pr[0], hi16(vb.x) - pr[1]); o.y = pack2(lo16(vb.y) - pr[2], hi16(vb.y) - pr[3]);
      *(uint2*)(sXT + dv * 40 + i0) = o;
    }
    __syncthreads();
    {
      const bf16x8 tf = *(const bf16x8*)(sT + (tb * 16 + fr) * 40 + fq * 8);
      const bf16x8 xf = *(const bf16x8*)(sXT + (ta * 16 + fr) * 40 + fq * 8);
      const f32x4 vn = __builtin_amdgcn_mfma_f32_16x16x32_bf16(tf, xf, (f32x4){0.f, 0.f, 0.f, 0.f}, 0, 0, 0);
      uint2 o; o.x = pack2(vn[0], vn[1]); o.y = pack2(vn[2], vn[3]);
      *(uint2*)(sVnT + dv * 40 + i0) = o;
    }
    __syncthreads();
    const float eglast = __expf(sG[31]);
    {
      f32x4 oa = (f32x4){0.f, 0.f, 0.f, 0.f};
#pragma unroll
      for (int ks = 0; ks < 4; ++ks) {
        const bf16x8 qf = *(const bf16x8*)(sQ + (ta * 16 + fr) * 136 + ks * 32 + fq * 8);
        const bf16x8 sf = *(const bf16x8*)(sST + (tb * 16 + fr) * 136 + ks * 32 + fq * 8);
        oa = __builtin_amdgcn_mfma_f32_16x16x32_bf16(sf, qf, oa, 0, 0, 0);
      }
      const int i = ta * 16 + fr;
      oa *= __expf(sG[i]);
      const bf16x8 mf = *(const bf16x8*)(sM + i * 40 + fq * 8);
      const bf16x8 vf = *(const bf16x8*)(sVnT + (tb * 16 + fr) * 40 + fq * 8);
      oa = __builtin_amdgcn_mfma_f32_16x16x32_bf16(vf, mf, oa, 0, 0, 0);
      uint2 o; o.x = pack2(oa[0], oa[1]); o.y = pack2(oa[2], oa[3]);
      *(uint2*)(OUT + (size_t)gdn_rowof(b_l, dir, c * 32 + i) * 1024 + h * 128 + dvq * 32 + tb * 16 + fq * 4) = o;
    }
    {
      const bf16x8 vf = *(const bf16x8*)(sVnT + (ta * 16 + fr) * 40 + fq * 8);
#pragma unroll
      for (int t = 0; t < 4; ++t) {
        const bf16x8 kf = *(const bf16x8*)(sKdT + ((tb * 4 + t) * 16 + fr) * 40 + fq * 8);
        S[t] *= eglast;
        S[t] = __builtin_amdgcn_mfma_f32_16x16x32_bf16(kf, vf, S[t], 0, 0, 0);
      }
    }
    __syncthreads();
#pragma unroll
    for (int t = 0; t < 4; ++t) {
      uint2 o; o.x = pack2(S[t][0], S[t][1]); o.y = pack2(S[t][2], S[t][3]);
      *(uint2*)(sST + (ta * 16 + fr) * 136 + (tb * 4 + t) * 16 + fq * 4) = o;
    }
  };
  for (int c = 0; c < NCH; c += 2) {
    body(c);
    lstore(st0); gload(st0, c + 3);
    __syncthreads();
    body(c + 1);
    if (c + 2 < NCH) lstore(st1);
    gload(st1, c + 4);
    __syncthreads();
  }
}

__device__ __forceinline__ void ssd_chunk_item(const Params& p, int id, unsigned char* smraw) {
  const int tid = TIDX(), lane = tid & 63, w = tid >> 6, fr = lane & 15, fq = lane >> 4;
  const int b_l = id >> 6, head = (id >> 1) & 31, dir = id & 1, grp = head >> 2;
  bf16_t* sC = (bf16_t*)smraw;
  bf16_t* sB = sC + 32 * 136;
  bf16_t* sBT = sB + 32 * 136;
  bf16_t* sXT = sBT + 128 * 40;
  bf16_t* sM = sXT + 64 * 40;
  bf16_t* sST = sM + 32 * 40;
  float* sG = (float*)(sST + 64 * 136);
  const bf16_t* XBC = (const bf16_t*)(p.ws + OFF_XBC);
  const float* DTF = (const float*)(p.ws + OFF_DTF);
  bf16_t* OUT = (bf16_t*)(p.ws + (dir ? OFF_YB : OFF_YF));
  const int ltok = tid & 31, lpart = tid >> 5;
  struct Stage { u32x4 b0, b1, c0, c1, x; float dt, g, gl; };
  Stage st0, st1;
  constexpr int NCH = (256 + 8192) / 32;
  auto gload = [&](Stage& st, int c) __attribute__((always_inline)) {
    const int s0 = (c < NCH ? c : NCH - 1) * 32;
    const size_t row = (size_t)ssd_rowof(b_l, dir, s0 + ltok);
    const bf16_t* xr = XBC + row * 4096;
    st.b0 = *(const u32x4*)(xr + 2048 + grp * 128 + lpart * 8);
    st.b1 = *(const u32x4*)(xr + 2048 + grp * 128 + (lpart + 8) * 8);
    st.c0 = *(const u32x4*)(xr + 3072 + grp * 128 + lpart * 8);
    st.c1 = *(const u32x4*)(xr + 3072 + grp * 128 + (lpart + 8) * 8);
    st.x = *(const u32x4*)(xr + head * 64 + lpart * 8);
    st.dt = DTF[row * 128 + dir * 32 + head];
    st.g = DTF[row * 128 + 64 + dir * 32 + head];
    st.gl = DTF[(size_t)ssd_rowof(b_l, dir, s0 + 31) * 128 + 64 + dir * 32 + head];
  };
  auto lstore = [&](const Stage& st) __attribute__((always_inline)) {
    *(u32x4*)(sB + ltok * 136 + lpart * 8) = st.b0;
    *(u32x4*)(sB + ltok * 136 + (lpart + 8) * 8) = st.b1;
    *(u32x4*)(sC + ltok * 136 + lpart * 8) = st.c0;
    *(u32x4*)(sC + ltok * 136 + (lpart + 8) * 8) = st.c1;
    const float wj = __expf(st.gl - st.g);
    bf16_t* t0 = sBT + (lpart * 8) * 40 + ltok;
    bf16_t* t1 = sBT + ((lpart + 8) * 8) * 40 + ltok;
    bf16_t* tx = sXT + (lpart * 8) * 40 + ltok;
#pragma unroll
    for (int e = 0; e < 4; ++e) {
      const unsigned pa = pack2(lo16(st.b0[e]) * wj, hi16(st.b0[e]) * wj), pb = pack2(lo16(st.b1[e]) * wj, hi16(st.b1[e]) * wj);
      const unsigned px = pack2(lo16(st.x[e]) * st.dt, hi16(st.x[e]) * st.dt);
      t0[(2 * e) * 40] = (bf16_t)(pa & 0xffffu); t0[(2 * e + 1) * 40] = (bf16_t)(pa >> 16);
      t1[(2 * e) * 40] = (bf16_t)(pb & 0xffffu); t1[(2 * e + 1) * 40] = (bf16_t)(pb >> 16);
      tx[(2 * e) * 40] = (bf16_t)(px & 0xffffu); tx[(2 * e + 1) * 40] = (bf16_t)(px >> 16);
    }
    if (tid < 32) sG[tid] = st.g;
  };
  f32x4 S[8];
#pragma unroll
  for (int i = 0; i < 8; ++i) S[i] = (f32x4){0.f, 0.f, 0.f, 0.f};
  __syncthreads();
  for (int i = lane; i < 16 * 136 / 2; i += 64) ((unsigned*)(sST + w * 16 * 136))[i] = 0u;
  gload(st0, 0); lstore(st0);
  __syncthreads();
  gload(st0, 1);
  __builtin_amdgcn_sched_barrier(0);
  gload(st1, 2);
  __builtin_amdgcn_sched_barrier(0);
  auto body = [&](int c) __attribute__((always_inline)) {
    {
      const int ti = w >> 1, tj = w & 1;
      f32x4 cb = (f32x4){0.f, 0.f, 0.f, 0.f};
      if (tj <= ti) {
#pragma unroll
        for (int ks = 0; ks < 4; ++ks) {
          const bf16x8 af = *(const bf16x8*)(sC + (ti * 16 + fr) * 136 + ks * 32 + fq * 8);
          const bf16x8 bf = *(const bf16x8*)(sB + (tj * 16 + fr) * 136 + ks * 32 + fq * 8);
          cb = __builtin_amdgcn_mfma_f32_16x16x32_bf16(bf, af, cb, 0, 0, 0);
        }
      }
      const int i = ti * 16 + fr, j0 = tj * 16 + fq * 4;
      const float gi = sG[i];
      const f32x4 gj = *(const f32x4*)(sG + j0);
      float m[4];
#pragma unroll
      for (int r = 0; r < 4; ++r) { const float e = __expf(fminf(gi - gj[r], 0.f)); m[r] = (j0 + r <= i) ? cb[r] * e : 0.f; }
      uint2 o; o.x = pack2(m[0], m[1]); o.y = pack2(m[2], m[3]);
      *(uint2*)(sM + i * 40 + j0) = o;
    }
    __syncthreads();
    const bf16x8 xfrag = *(const bf16x8*)(sXT + (w * 16 + fr) * 40 + fq * 8);
    const float eglast = __expf(sG[31]);
#pragma unroll
    for (int ti = 0; ti < 2; ++ti) {
      f32x4 y = (f32x4){0.f, 0.f, 0.f, 0.f};
#pragma unroll
      for (int ks = 0; ks < 4; ++ks) {
        const bf16x8 af = *(const bf16x8*)(sC + (ti * 16 + fr) * 136 + ks * 32 + fq * 8);
        const bf16x8 bf = *(const bf16x8*)(sST + (w * 16 + fr) * 136 + ks * 32 + fq * 8);
        y = __builtin_amdgcn_mfma_f32_16x16x32_bf16(bf, af, y, 0, 0, 0);
      }
      const int i = ti * 16 + fr;
      const float eg = __expf(sG[i]);
      y *= eg;
      const bf16x8 mf = *(const bf16x8*)(sM + i * 40 + fq * 8);
      y = __builtin_amdgcn_mfma_f32_16x16x32_bf16(xfrag, mf, y, 0, 0, 0);
      uint2 o; o.x = pack2(y[0], y[1]); o.y = pack2(y[2], y[3]);
      *(uint2*)(OUT + (size_t)ssd_rowof(b_l, dir, c * 32 + i) * 2048 + head * 64 + w * 16 + fq * 4) = o;
    }
#pragma unroll
    for (int tn = 0; tn < 8; ++tn) {
      const bf16x8 bf = *(const bf16x8*)(sBT + (tn * 16 + fr) * 40 + fq * 8);
      S[tn] *= eglast;
      S[tn] = __builtin_amdgcn_mfma_f32_16x16x32_bf16(bf, xfrag, S[tn], 0, 0, 0);
    }
#pragma unroll
    for (int tn = 0; tn < 8; ++tn) {
      uint2 o; o.x = pack2(S[tn][0], S[tn][1]); o.y = pack2(S[tn][2], S[tn][3]);
      *(uint2*)(sST + (w * 16 + fr) * 136 + tn * 16 + fq * 4) = o;
    }
    __syncthreads();
  };
  for (int c = 0; c < NCH; c += 2) {
    body(c);
    lstore(st0); gload(st0, c + 3);
    __syncthreads();
    body(c + 1);
    if (c + 2 < NCH) lstore(st1);
    gload(st1, c + 4);
    __syncthreads();
  }
}

__device__ __forceinline__ void scan_phase(const Params& p, unsigned char* sm, int nb, int v) {
  for (int item = v; item < 256; item += nb) {
    if (item < 128) gdn_chunk_item(p, item, sm); else ssd_chunk_item(p, item - 128, sm);
    __syncthreads();
  }
}

__device__ __forceinline__ void gnorm_phase(const Params& p, int l, int M) {
  const bf16_t* P = (const bf16_t*)(p.ws + OFF_P);
  const bf16_t* OF = (const bf16_t*)(p.ws + OFF_OF); const bf16_t* OB = (const bf16_t*)(p.ws + OFF_OB);
  const bf16_t* YF = (const bf16_t*)(p.ws + OFF_YF); const bf16_t* YB = (const bf16_t*)(p.ws + OFF_YB);
  const bf16_t* XBC = (const bf16_t*)(p.ws + OFF_XBC);
  bf16_t* YA = (bf16_t*)(p.ws + OFF_QKV); bf16_t* YBn = YA + (size_t)MG * 1024;
  const int gtid = BIDX() * 256 + TIDX(), gsz = GDIM() * 256;
  const float* nw = p.gdn_norm_w + l * 128;
  for (int idx0 = gtid; idx0 < M * 128; idx0 += 2 * gsz) {
    const int idx1 = idx0 + gsz; const bool has1 = idx1 < M * 128;
    const int ia[2] = {idx0, has1 ? idx1 : idx0};
    uint4 a[2], b[2], gt[2];
#pragma unroll
    for (int u = 0; u < 2; ++u) { const int r = ia[u] >> 7, c8 = (ia[u] & 127) * 8;
      a[u] = *(const uint4*)(OF + (size_t)r * 1024 + c8); b[u] = *(const uint4*)(OB + (size_t)r * 1024 + c8); gt[u] = *(const uint4*)(P + (size_t)r * LDP + C_GOUT + c8); }
#pragma unroll
    for (int u = 0; u < 2; ++u) {
      const int r = ia[u] >> 7, c8 = (ia[u] & 127) * 8;
      float fa[8], fb[8], fg[8]; UNPACK8(a[u], fa); UNPACK8(b[u], fb); UNPACK8(gt[u], fg);
      float ss = 0.f;
#pragma unroll
      for (int e = 0; e < 8; ++e) { fa[e] += fb[e]; ss += fa[e] * fa[e]; }
      ss += __shfl_xor(ss, 1); ss += __shfl_xor(ss, 2); ss += __shfl_xor(ss, 4); ss += __shfl_xor(ss, 8);
      const float rs = rsqrtf(ss * (1.f / 128.f) + 1e-6f);
      const float4 w0 = *(const float4*)(nw + (c8 & 127)), w1 = *(const float4*)(nw + (c8 & 127) + 4);
      const float wv[8] = {w0.x, w0.y, w0.z, w0.w, w1.x, w1.y, w1.z, w1.w};
#pragma unroll
      for (int e = 0; e < 8; ++e) fa[e] = fa[e] * rs * wv[e] * siluf_(fg[e]);
      if (u == 0 || has1) *(uint4*)(YA + (size_t)r * 1024 + c8) = pack8(fa);
    }
  }
  const float* sw = p.ssm_norm_w + l * 2048; const float* Dk = p.ssm_D + l * 32;
  for (int idx0 = gtid; idx0 < M * 256; idx0 += 2 * gsz) {
    const int idx1 = idx0 + gsz; const bool has1 = idx1 < M * 256;
    const int ia[2] = {idx0, has1 ? idx1 : idx0};
    uint4 a[2], b[2], xx[2], zz[2];
#pragma unroll
    for (int u = 0; u < 2; ++u) { const int r = ia[u] >> 8, c8 = (ia[u] & 255) * 8;
      a[u] = *(const uint4*)(YF + (size_t)r * 2048 + c8); b[u] = *(const uint4*)(YB + (size_t)r * 2048 + c8);
      xx[u] = *(const uint4*)(XBC + (size_t)r * 4096 + c8); zz[u] = *(const uint4*)(P + (size_t)r * LDP + C_Z + c8); }
#pragma unroll
    for (int u = 0; u < 2; ++u) {
      const int r = ia[u] >> 8, c8 = (ia[u] & 255) * 8;
      float fa[8], fb[8], fx[8], fz[8]; UNPACK8(a[u], fa); UNPACK8(b[u], fb); UNPACK8(xx[u], fx); UNPACK8(zz[u], fz);
      const float dsk = Dk[c8 >> 6];
      float ss = 0.f;
#pragma unroll
      for (int e = 0; e < 8; ++e) { fa[e] = (fa[e] + fb[e] + dsk * fx[e]) * siluf_(fz[e]); ss += fa[e] * fa[e]; }
      ss += __shfl_xor(ss, 1); ss += __shfl_xor(ss, 2); ss += __shfl_xor(ss, 4); ss += __shfl_xor(ss, 8); ss += __shfl_xor(ss, 16);
      const float rs = rsqrtf(ss * (1.f / 256.f) + 1e-6f);
      const float4 w0 = *(const float4*)(sw + c8), w1 = *(const float4*)(sw + c8 + 4);
      const float wv[8] = {w0.x, w0.y, w0.z, w0.w, w1.x, w1.y, w1.z, w1.w};
#pragma unroll
      for (int e = 0; e < 8; ++e) fa[e] = fa[e] * rs * wv[e];
      if (u == 0 || has1) *(uint4*)(YBn + (size_t)r * 2048 + c8) = pack8(fa);
    }
  }
}

#define XB_TMO      128
#define XB_XCNT(j)  (256  + 64 * (j))
#define XB_XSUB(j)  (1280 + 64 * (j))
#define XB_XGEN(j)  (2304 + 64 * (j))
#define XB_TOP      3328
#define XB_TOPGEN   3392
#define XCD_BAR_WORDS 3456
#define XB_SPIN_CAP (1u << 18)
#define LAS __attribute__((address_space(3)))

__device__ __forceinline__ unsigned xb_ld(unsigned* p)              { return __hip_atomic_load(p, __ATOMIC_RELAXED, __HIP_MEMORY_SCOPE_AGENT); }
__device__ __forceinline__ unsigned xb_add(unsigned* p, unsigned v) { return __hip_atomic_fetch_add(p, v, __ATOMIC_RELAXED, __HIP_MEMORY_SCOPE_AGENT); }
__device__ __forceinline__ unsigned xb_xcc_id() { return (unsigned)__builtin_amdgcn_s_getreg((3 << 11) | 20) & 0xFu; }
#define XB_SPIN(cond, bar) do { unsigned _sp = 0; while (cond) { __builtin_amdgcn_s_sleep(1); \
    if ((++_sp & 255u) == 0u) { if (xb_ld(&(bar)[XB_TMO])) break; if (_sp > XB_SPIN_CAP) { atomicAdd(&(bar)[XB_TMO], 1u); break; } } } } while (0)

struct XcdBarrier {
    unsigned* bar; unsigned x;
    volatile LAS unsigned* st;
};

__device__ __forceinline__ XcdBarrier xcd_barrier_post(unsigned* bar, volatile LAS unsigned* st) {
    XcdBarrier b; b.bar = bar; b.x = xb_xcc_id(); b.st = st;
    if (threadIdx.x == 0) (void)xb_add(&bar[XB_XCNT(b.x)], 1u);
    return b;
}
__device__ __forceinline__ void xcd_barrier_complete(unsigned* bar, unsigned x, unsigned& nloc, unsigned& nx) {
    const unsigned G = gridDim.x * gridDim.y * gridDim.z;
    unsigned sum, cnt, mine, sp = 0u;
    for (;;) {
        sum = 0u; cnt = 0u; mine = 0u;
#pragma unroll
        for (unsigned j = 0; j < 16; ++j) { const unsigned c = xb_ld(&bar[XB_XCNT(j)]); sum += c; cnt += (c > 0u) ? 1u : 0u; mine = (j == x) ? c : mine; }
        if (sum == G) break;
        __builtin_amdgcn_s_sleep(1);
        if ((++sp & 255u) == 0u) { if (xb_ld(&bar[XB_TMO])) break; if (sp > XB_SPIN_CAP) { atomicAdd(&bar[XB_TMO], 1u); break; } }
    }
    nloc = mine > 0u ? mine : 1u; nx = cnt > 0u ? cnt : 1u;
}

__device__ __forceinline__ void xcd_barrier(const XcdBarrier& b) {
    asm volatile("s_waitcnt vmcnt(0)" ::: "memory");
    __syncthreads();
    if (threadIdx.x == 0) {
        unsigned* bar = b.bar;
        __builtin_amdgcn_s_waitcnt(0);
        unsigned nloc = b.st[0], nx = b.st[1];
        if (nloc == 0u) { xcd_barrier_complete(bar, b.x, nloc, nx); b.st[0] = nloc; b.st[1] = nx; }
        const unsigned old = xb_add(&bar[XB_XSUB(b.x)], 1u);
        const unsigned gen = old / nloc;
        if (old + 1u == (gen + 1u) * nloc) {
            __builtin_amdgcn_fence(__ATOMIC_RELEASE, "agent");
            asm volatile("s_waitcnt vmcnt(0)" ::: "memory");
            const unsigned og = xb_add(&bar[XB_TOP], 1u);
            const unsigned tg = og / nx;
            if (og + 1u == (tg + 1u) * nx) xb_add(&bar[XB_TOPGEN], 1u);
            else XB_SPIN(xb_ld(&bar[XB_TOPGEN]) == tg, bar);
            __builtin_amdgcn_fence(__ATOMIC_ACQUIRE, "agent");
            xb_add(&bar[XB_XGEN(b.x)], 1u);
            asm volatile("s_waitcnt vmcnt(0)" ::: "memory");
        } else {
            XB_SPIN(xb_ld(&bar[XB_XGEN(b.x)]) == gen, bar);
            __builtin_amdgcn_fence(__ATOMIC_ACQUIRE, "agent");
            asm volatile("s_waitcnt vmcnt(0)" ::: "memory");
        }
    }
    __syncthreads();
}

#ifndef STOP_AFTER
#define STOP_AFTER 0
#endif
#define SYNC() { xcd_barrier(xb); if (++nsync == STOP_AFTER) return; }
#define PH(CALL) { CALL; }
__global__ void __launch_bounds__(256, 2) mega(Params p) {
  cg::grid_group grid = cg::this_grid();
  int nsync = 0;
  __shared__ __attribute__((aligned(16))) unsigned char smem[SMEM_BYTES];
  __shared__ uint4 xb_words;
  if (threadIdx.x == 0) xb_words = make_uint4(0u, 0u, 0u, 0u);
  __syncthreads();
  XcdBarrier xb = xcd_barrier_post((unsigned*)(p.ws + OFF_BAR), (volatile LAS unsigned*)&xb_words);
  float* smf = (float*)smem; bf16_t* smh = (bf16_t*)smem;
  for (int l = 0; l < 2; ++l) {
    PH(transpose_phase(p.w_in + (size_t)l * 1024 * IN_DIM, (bf16_t*)(p.ws + OFF_WIN), 1024, IN_DIM, LDP, smf))
    PH(transpose_phase(p.w_proj_gdn + (size_t)l * 1024 * 1024, (bf16_t*)(p.ws + OFF_WPG), 1024, 1024, 1024, smf))
    PH(transpose_phase(p.w_proj_ssm + (size_t)l * 2048 * 1024, (bf16_t*)(p.ws + OFF_WPS), 2048, 1024, 1024, smf))
    PH(transpose_phase(p.w_out + (size_t)l * 1024 * 1024, (bf16_t*)(p.ws + OFF_WOUT), 1024, 1024, 1024, smf))
    PH(transpose_phase(p.w_ff1 + (size_t)l * 1024 * 4096, (bf16_t*)(p.ws + OFF_WFF1), 1024, 4096, 4096, smf))
    PH(transpose_phase(p.w_ff2 + (size_t)l * 4096 * 1024, (bf16_t*)(p.ws + OFF_WFF2), 4096, 1024, 1024, smf))
    if (l == 0) { PH(modpart_phase(p, smf)) grid.sync(); PH(modfinal_phase(p)) }
    SYNC();
    const bool last = (l == 1);
    const int Mpost = last ? MLAT : MG;
    for (int g = 0; g < NGRP; ++g) {
      PH(modulate_phase(p, l, g)) SYNC();
      PH(gemm_inproj_phase(p, smh, 0, GDIM(), BIDX())) SYNC();
      PH(conv_phase(p, l)) SYNC();
      PH(gdn_prep_phase(p, smem)) SYNC();
      {
        const int nb_ = GDIM(), v_ = BIDX();
        if (nb_ >= 512) { if (v_ < 256) { PH(scan_phase(p, smem, 256, v_)) } else { PH(gemm_inproj_phase(p, smh, 1, nb_ - 256, v_ - 256)) } }
        else { PH(scan_phase(p, smem, nb_, v_)) PH(gemm_inproj_phase(p, smh, 1, nb_, v_)) }
      }
      SYNC();
      PH(gnorm_phase(p, l, Mpost)) SYNC();
      PH(gemm_proj_phase(p, Mpost, smh)) SYNC();
      PH(gemm_wout_phase(p, l, g, Mpost, smh)) SYNC();
      PH(ln_phase(p, l, g, Mpost, p.ln1_g + l * D, p.ln1_b + l * D, true)) SYNC();
      PH(gemm_ff1_phase(p, l, Mpost, smh)) SYNC();
      PH(gemm_ff2_phase(p, l, g, Mpost, smh)) SYNC();
      PH(ln_phase(p, l, g, Mpost, p.ln2_g + l * D, p.ln2_b + l * D, false)) SYNC();
    }
  }
}

extern "C" void kernel_launch(void* const* d_in, const int* in_sizes, int n_in, void* d_out, int out_size, void* d_ws, size_t ws_size,
                              hipStream_t stream) {
  static int grid_blocks = 0;
  if (!grid_blocks) {
    int dev = 0, cus = 0, per_cu = 0;
    (void)hipGetDevice(&dev);
    (void)hipDeviceGetAttribute(&cus, hipDeviceAttributeMultiprocessorCount, dev);
    (void)hipOccupancyMaxActiveBlocksPerMultiprocessor(&per_cu, mega, 256, 0);
    if (per_cu > 2) per_cu = 2;
    grid_blocks = cus * per_cu;
    if (ws_size < WS_TOTAL) fprintf(stderr, "workspace too small: %zu < %zu\n", ws_size, WS_TOTAL);
  }
  Params p{};
  const float** pp = (const float**)&p;
  for (int i = 0; i < 28; ++i) pp[i] = (const float*)d_in[i];
  p.out = (float*)d_out;
  p.ws = (unsigned char*)d_ws;
  (void)hipMemsetAsync((unsigned char*)d_ws + OFF_BAR, 0, 16384, stream);
  void* args[] = {&p};
  hipError_t e = hipLaunchCooperativeKernel((void*)mega, dim3(grid_blocks), dim3(256), args, 0, stream);
  if (e != hipSuccess) fprintf(stderr, "cooperative launch failed: %s (grid %d)\n", hipGetErrorString(e), grid_blocks);
}
```

```cpp
#include <hip/hip_runtime.h>
#include <hip/hip_cooperative_groups.h>
#include <cstdio>
namespace cg = cooperative_groups;

typedef unsigned short bf16_t;
typedef short bf16x8 __attribute__((ext_vector_type(8)));
typedef float f32x4 __attribute__((ext_vector_type(4)));
typedef float f32x2 __attribute__((ext_vector_type(2)));
typedef unsigned u32x4 __attribute__((ext_vector_type(4)));

constexpr int D = 1024, SEQ = 8192, LC = 256;
constexpr int G = 2, NGRP = 4;
constexpr int MLAT = G * SEQ, MCTX = G * LC, MG = MLAT + MCTX;
constexpr int IN_DIM = 12384, LDP = 12416;
constexpr int C_GOUT = 3072, C_A = 4096, C_B = 4112, C_Z = 4128, C_XBC = 6176, C_DT = 10272, C_GA = 10336, C_GB = 11360;
constexpr float DN_ALPHA = 1.4142135623730951f;

constexpr size_t SZ_WIN = (size_t)LDP * 1024 * 2;
constexpr size_t OFF_WIN = 0;
constexpr size_t OFF_WPG = OFF_WIN + SZ_WIN;
constexpr size_t OFF_WPS = OFF_WPG + 2097152;
constexpr size_t OFF_WOUT = OFF_WPS + 4194304;
constexpr size_t OFF_WFF1 = OFF_WOUT + 2097152;
constexpr size_t OFF_WFF2 = OFF_WFF1 + 8388608;
constexpr size_t OFF_MODP = OFF_WFF2 + 8388608;
constexpr size_t OFF_MOD = OFF_MODP + (size_t)2 * 16 * 9 * 6144 * 4;
constexpr size_t OFF_XSC = OFF_MOD + (size_t)2 * 9 * 6144 * 4;
constexpr size_t OFF_H = OFF_XSC + (size_t)2048 * 1024 * 4;
constexpr size_t OFF_P = OFF_H + (size_t)MG * 1024 * 2;
constexpr size_t OFF_QKV = OFF_P + (size_t)MG * LDP * 2;
constexpr size_t OFF_XBC = OFF_QKV + (size_t)MG * 3072 * 2;
constexpr size_t OFF_GBF = OFF_XBC + (size_t)MG * 4096 * 2;
constexpr size_t OFF_DTF = OFF_GBF + (size_t)MG * 32 * 4;
constexpr size_t OFF_OF = OFF_DTF + (size_t)MG * 128 * 4;
constexpr size_t OFF_OB = OFF_OF + (size_t)MG * 1024 * 2;
constexpr size_t OFF_YF = OFF_OB + (size_t)MG * 1024 * 2;
constexpr size_t OFF_YB = OFF_YF + (size_t)MG * 2048 * 2;
constexpr size_t OFF_TMB = OFF_YB + (size_t)MG * 2048 * 2;
constexpr int GDN_NITEM = G * 8 * 2 * 264;
constexpr size_t OFF_BAR = OFF_TMB + (size_t)GDN_NITEM * 2048 * 2;
constexpr size_t OFF_HB = OFF_BAR + 16384;
constexpr size_t WS_TOTAL = OFF_HB + (size_t)MG * 1024 * 2;
static_assert(WS_TOTAL <= ((size_t)1024 << 20), "workspace plan exceeds 1 GiB");

struct Params {
  const float *x, *c, *ctx, *c_ctx, *w_mod, *b_mod, *w_in, *gdn_conv_w, *gdn_A_log, *gdn_dt_bias, *gdn_norm_w;
  const float *ssm_conv_w, *ssm_conv_b, *ssm_A_log, *ssm_dt_bias, *ssm_D, *ssm_norm_w, *w_proj_gdn, *w_proj_ssm, *w_out;
  const float *ln1_g, *ln1_b, *w_ff1, *b_ff1, *w_ff2, *b_ff2, *ln2_g, *ln2_b;
  float* out;
  unsigned char* ws;
};

constexpr int SMEM_BYTES = 73728;


__device__ __forceinline__ int TIDX() { int t = threadIdx.x; asm volatile("" : "+v"(t)); return t; }
__device__ __forceinline__ int BIDX() { int t = blockIdx.x; asm volatile("" : "+s"(t)); return t; }
__device__ __forceinline__ int GDIM() { int t = gridDim.x; asm volatile("" : "+s"(t)); return t; }
__device__ __forceinline__ float bf2f(bf16_t b) { return __uint_as_float(((unsigned)b) << 16); }
__device__ __forceinline__ bf16_t f2bf(float f) { unsigned u = __float_as_uint(f); u += 0x7fffu + ((u >> 16) & 1u); return (bf16_t)(u >> 16); }
typedef __bf16 bf16v2 __attribute__((ext_vector_type(2)));
__device__ __forceinline__ unsigned pack2(float a, float b) { const f32x2 v = (f32x2){a, b}; const bf16v2 h = __builtin_convertvector(v, bf16v2); return __builtin_bit_cast(unsigned, h); }
__device__ __forceinline__ float lo16(unsigned v) { return __uint_as_float(v << 16); }
__device__ __forceinline__ float hi16(unsigned v) { return __uint_as_float(v & 0xffff0000u); }
#define UNPACK8(v, f) { f[0] = lo16(v.x); f[1] = hi16(v.x); f[2] = lo16(v.y); f[3] = hi16(v.y); f[4] = lo16(v.z); f[5] = hi16(v.z); f[6] = lo16(v.w); f[7] = hi16(v.w); }
__device__ __forceinline__ uint4 pack8(const float* f) { uint4 r; r.x = pack2(f[0], f[1]); r.y = pack2(f[2], f[3]); r.z = pack2(f[4], f[5]); r.w = pack2(f[6], f[7]); return r; }
__device__ __forceinline__ float sigmoidf_(float x) { return __builtin_amdgcn_rcpf(1.f + __expf(-x)); }
__device__ __forceinline__ float siluf_(float x) { return x * __builtin_amdgcn_rcpf(1.f + __expf(-x)); }
__device__ __forceinline__ float softplusf_(float x) { return x > 20.f ? x : log1pf(__expf(x)); }
template <int CTRL> __device__ __forceinline__ float dppf(float x) { return __builtin_bit_cast(float, __builtin_amdgcn_mov_dpp(__builtin_bit_cast(int, x), CTRL, 0xf, 0xf, true)); }
__device__ __forceinline__ float reduce16(float x) { x += dppf<0xB1>(x); x += dppf<0x4E>(x); x += dppf<0x141>(x); x += dppf<0x140>(x); return x; }

__device__ __forceinline__ float* xs_row(const Params& p, int g, int r) {
  return (r < MLAT) ? p.out + ((size_t)g * MLAT + r) * D : (float*)(p.ws + OFF_XSC) + ((size_t)g * MCTX + (r - MLAT)) * D;
}
__device__ __forceinline__ const float* xin_row(const Params& p, int l, int g, int r) {
  if (l == 0) return (r < MLAT) ? p.x + ((size_t)g * MLAT + r) * D : p.ctx + ((size_t)g * MCTX + (r - MLAT)) * D;
  return xs_row(p, g, r);
}
__device__ __forceinline__ int mod_row(int g, int r) { return r < MLAT ? g * G + r / SEQ : 8; }
__device__ __forceinline__ int gdn_rowof(int b_l, int dir, int s) {
  if (s < 256) { const int i = dir ? 255 - s : s; return MLAT + b_l * 256 + i; }
  const int i = s - 256; return b_l * 8192 + (dir ? 8191 - i : i);
}
__device__ __forceinline__ int ssd_rowof(int b_l, int dir, int s) {
  if (s < 256) { const int i = dir ? 255 - s : s; return MLAT + b_l * 256 + i; }
  const int j = s - 256; const int pos = dir ? 8191 - j : j; return b_l * 8192 + (pos & 127) * 64 + (pos >> 7);
}

__device__ __forceinline__ void transpose_phase(const float* __restrict__ src, bf16_t* __restrict__ dst, int K, int N, int Npad, float* tile) {
  const int tid = TIDX(), tk = K / 64, tn = Npad / 64;
  const int c = tid & 63, r4 = tid >> 6;
  for (int t = BIDX(); t < tk * tn; t += GDIM()) {
    const int kt = t % tk, nt = t / tk, k0 = kt * 64, n0 = nt * 64;
    __syncthreads();
#pragma unroll 4
    for (int i = 0; i < 16; ++i) { const int r = i * 4 + r4, n = n0 + c; tile[r * 65 + c] = (n < N) ? src[(size_t)(k0 + r) * N + n] : 0.f; }
    __syncthreads();
#pragma unroll 4
    for (int i = 0; i < 16; ++i) { const int nn = i * 4 + r4; dst[(size_t)(n0 + nn) * K + k0 + c] = f2bf(tile[c * 65 + nn]); }
  }
}

__device__ __forceinline__ void modpart_phase(const Params& p, float* sm) {
  const int tid = TIDX();
  float* MODP = (float*)(p.ws + OFF_MODP);
  for (int item = BIDX(); item < 2 * 24 * 16; item += GDIM()) {
    const int l = item / 384, rem = item % 384, cbk = rem / 16, ks = rem % 16;
    __syncthreads();
    for (int i = tid; i < 9 * 64; i += 256) { const int r = i / 64, k = ks * 64 + (i % 64); const float v = (r < 8) ? p.c[r * D + k] : p.c_ctx[k]; sm[i] = siluf_(v); }
    __syncthreads();
    const int col = cbk * 256 + tid;
    float acc[9];
#pragma unroll
    for (int r = 0; r < 9; ++r) acc[r] = 0.f;
    const float* wp = p.w_mod + ((size_t)l * D + ks * 64) * 6144 + col;
#pragma unroll 8
    for (int k = 0; k < 64; ++k) { const float w = wp[(size_t)k * 6144];
#pragma unroll
      for (int r = 0; r < 9; ++r) acc[r] += sm[r * 64 + k] * w; }
#pragma unroll
    for (int r = 0; r < 9; ++r) MODP[(((size_t)l * 16 + ks) * 9 + r) * 6144 + col] = acc[r];
  }
}
__device__ __forceinline__ void modfinal_phase(const Params& p) {
  const float* MODP = (const float*)(p.ws + OFF_MODP);
  float* MOD = (float*)(p.ws + OFF_MOD);
  for (int i = BIDX() * 256 + TIDX(); i < 2 * 9 * 6144; i += GDIM() * 256) {
    const int l = i / (9 * 6144), rem = i % (9 * 6144), col = rem % 6144;
    float s = p.b_mod[l * 6144 + col];
    for (int ks = 0; ks < 16; ++ks) s += MODP[((size_t)l * 16 + ks) * 9 * 6144 + rem];
    MOD[i] = s;
  }
}

__device__ __forceinline__ void modulate_phase(const Params& p, int l, int g, size_t hoff) {
  const float* MOD = (const float*)(p.ws + OFF_MOD) + (size_t)l * 9 * 6144;
  bf16_t* H = (bf16_t*)(p.ws + hoff);
  for (int i = BIDX() * 256 + TIDX(); i < MG * 128; i += GDIM() * 256) {
    const int r = i >> 7, ch = (i & 127) * 8;
    const float* xr = xin_row(p, l, g, r) + ch;
    const float* m = MOD + (size_t)mod_row(g, r) * 6144;
    const float4 x0 = *(const float4*)xr, x1 = *(const float4*)(xr + 4);
    const float4 sh0 = *(const float4*)(m + ch), sh1 = *(const float4*)(m + ch + 4);
    const float4 sc0 = *(const float4*)(m + 1024 + ch), sc1 = *(const float4*)(m + 1024 + ch + 4);
    float f[8] = {x0.x * (1.f + sc0.x) + sh0.x, x0.y * (1.f + sc0.y) + sh0.y, x0.z * (1.f + sc0.z) + sh0.z, x0.w * (1.f + sc0.w) + sh0.w,
                  x1.x * (1.f + sc1.x) + sh1.x, x1.y * (1.f + sc1.y) + sh1.y, x1.z * (1.f + sc1.z) + sh1.z, x1.w * (1.f + sc1.w) + sh1.w};
    *(uint4*)(H + (size_t)r * D + ch) = pack8(f);
  }
}

struct Seg { const bf16_t* ap; const bf16_t* bp; int lda, ldb, nk; };

__device__ __forceinline__ bool tile_coord_sub(int it, int nM, int nN, int nb, int v, int& mt, int& nt) {
  long s;
  if ((nb & 7) == 0) { const int per = nb >> 3; s = (long)it * nb + (v & 7) * per + (v >> 3); } else s = (long)it * nb + v;
  if (s >= (long)nM * nN) return false;
  const int band = (int)(s / (8 * nN)), r = (int)(s - (long)band * 8 * nN);
  const int bsz = (nM - band * 8) < 8 ? (nM - band * 8) : 8;
  nt = r / bsz; mt = band * 8 + (r % bsz);
  return true;
}
__device__ __forceinline__ bool tile_coord(int it, int nM, int nN, int& mt, int& nt) { return tile_coord_sub(it, nM, nN, GDIM(), BIDX(), mt, nt); }
__device__ __forceinline__ int inproj_ntile(int part, int e) {
  if (part == 0) return e < 24 ? e : (e == 24 ? 32 : 23 + e);
  return e < 8 ? 24 + e : (e < 23 ? 25 + e : 58 + e);
}

#define ZERO_ACC(acc) { _Pragma("unroll") for (int i_ = 0; i_ < 4; ++i_) { _Pragma("unroll") for (int j_ = 0; j_ < 4; ++j_) acc[i_][j_] = (f32x4){0.f, 0.f, 0.f, 0.f}; } }
#define EPI_LOOP(...) { const int lane_ = TIDX() & 63, w_ = TIDX() >> 6; \
  _Pragma("unroll") for (int i_ = 0; i_ < 4; ++i_) { const int row = m0 + (w_ >> 1) * 64 + i_ * 16 + (lane_ & 15); \
  _Pragma("unroll") for (int j_ = 0; j_ < 4; ++j_) { const int col = n0 + (w_ & 1) * 64 + j_ * 16 + (lane_ >> 4) * 4; f32x4& v = acc[i_][j_]; __VA_ARGS__ } } }

__device__ __forceinline__ int perm_brow(int lr) { return 8 * ((lr & 15) >> 2) + 4 * ((lr >> 4) & 1) + (lr & 3); }
#define EPI8_LOOP(...) { const int lane_ = TIDX() & 63, w_ = TIDX() >> 6; \
  _Pragma("unroll") for (int i_ = 0; i_ < 4; ++i_) { const int row = m0 + (w_ >> 1) * 64 + i_ * 16 + (lane_ & 15); \
  _Pragma("unroll") for (int a_ = 0; a_ < 2; ++a_) { const int col = n0 + (w_ & 1) * 64 + a_ * 32 + (lane_ >> 4) * 8; f32x4& v0 = acc[i_][2 * a_]; f32x4& v1 = acc[i_][2 * a_ + 1]; __VA_ARGS__ } } }

template <class Prob>
__device__ __forceinline__ void gemm_stream(Prob& pr, bf16_t* sm) {
  const int tid = TIDX(), lane = tid & 63, w = tid >> 6, wr = w >> 1, wc = w & 1;
  const int lr = tid >> 3, lk = (tid & 7) * 8;
  const int fr = lane & 15, fq = lane >> 4;
  const int aoff = (wr * 64 + fr) * 72 + fq * 8, boff = 9216 + (wc * 64 + fr) * 72 + fq * 8;
  const int soff = lr * 72 + lk;
  Seg cur, nxt;
  if (!pr.seg(0, cur, lr, lk)) return;
  bool has_nxt = pr.seg(1, nxt, lr, lk);
  u32x4 r0a[4], r0b[4], r1a[4], r1b[4];
#pragma unroll
  for (int i = 0; i < 4; ++i) { r0a[i] = (u32x4){0u, 0u, 0u, 0u}; r0b[i] = r0a[i]; r1a[i] = r0a[i]; r1b[i] = r0a[i]; }
  f32x4 acc[4][4];
#define GS_LOAD(RA, RB, KT) { const int kt_ = (KT); const bf16_t* ap_ = cur.ap; const bf16_t* bp_ = cur.bp; int lda_ = cur.lda, ldb_ = cur.ldb; \
    if (kt_ < cur.nk) { ap_ += kt_ * 64; bp_ += kt_ * 64; } \
    else if (has_nxt) { ap_ = nxt.ap + (kt_ - cur.nk) * 64; bp_ = nxt.bp + (kt_ - cur.nk) * 64; lda_ = nxt.lda; ldb_ = nxt.ldb; } \
      \
    _Pragma("unroll") for (int i = 0; i < 4; ++i) { RA[i] = *(const u32x4*)(ap_ + (size_t)i * 32 * lda_); RB[i] = *(const u32x4*)(bp_ + (size_t)i * 32 * ldb_); } }
#define GS_STORE(RA, RB, KT, STAGE) { bf16_t* st_ = (STAGE) + soff; \
    _Pragma("unroll") for (int i = 0; i < 4; ++i) { *(u32x4*)(st_ + i * 32 * 72) = RA[i]; *(u32x4*)(st_ + 9216 + i * 32 * 72) = RB[i]; } }
#define GS_COMPUTE(STAGE) { const bf16_t* cs_ = (STAGE); bf16x8 af0[4], bf0[4], af1[4], bf1[4]; \
    _Pragma("unroll") for (int i = 0; i < 4; ++i) { af0[i] = *(const bf16x8*)(cs_ + aoff + i * 16 * 72); bf0[i] = *(const bf16x8*)(cs_ + boff + i * 16 * 72); } \
    _Pragma("unroll") for (int i = 0; i < 4; ++i) { af1[i] = *(const bf16x8*)(cs_ + aoff + i * 16 * 72 + 32); bf1[i] = *(const bf16x8*)(cs_ + boff + i * 16 * 72 + 32); } \
    _Pragma("unroll") for (int i = 0; i < 4; ++i) { _Pragma("unroll") for (int j = 0; j < 4; ++j) acc[i][j] = __builtin_amdgcn_mfma_f32_16x16x32_bf16(bf0[j], af0[i], acc[i][j], 0, 0, 0); } \
    _Pragma("unroll") for (int i = 0; i < 4; ++i) { _Pragma("unroll") for (int j = 0; j < 4; ++j) acc[i][j] = __builtin_amdgcn_mfma_f32_16x16x32_bf16(bf1[j], af1[i], acc[i][j], 0, 0, 0); } }
#define GS_SCHED() { __builtin_amdgcn_sched_group_barrier(0x100, 8, 0); \
    _Pragma("unroll") for (int q_ = 0; q_ < 8; ++q_) { __builtin_amdgcn_sched_group_barrier(0x008, 2, 0); __builtin_amdgcn_sched_group_barrier(0x100, 1, 0); __builtin_amdgcn_sched_group_barrier(0x020, 1, 0); } \
    _Pragma("unroll") for (int q_ = 0; q_ < 8; ++q_) { __builtin_amdgcn_sched_group_barrier(0x008, 2, 0); __builtin_amdgcn_sched_group_barrier(0x200, 1, 0); } }
  GS_LOAD(r0a, r0b, 0)
  __syncthreads();
  GS_STORE(r0a, r0b, 0, sm)
  __syncthreads();
  GS_LOAD(r0a, r0b, 1)
  __builtin_amdgcn_sched_barrier(0);
  for (int idx = 0;; ++idx) {
    pr.begin(idx, acc);
    for (int kt = 0; kt < cur.nk; kt += 2) {
      GS_LOAD(r1a, r1b, kt + 2)
      GS_COMPUTE(sm)
      GS_STORE(r0a, r0b, kt + 1, sm + 18432)
      GS_SCHED()
      __syncthreads();
      GS_LOAD(r0a, r0b, kt + 3)
      GS_COMPUTE(sm + 18432)
      GS_STORE(r1a, r1b, kt + 2, sm)
      GS_SCHED()
      __syncthreads();
    }
    pr.end(idx, acc);
    if (!has_nxt) break;
    cur = nxt; has_nxt = pr.seg(idx + 2, nxt, lr, lk);
  }
#undef GS_LOAD
#undef GS_STORE
#undef GS_COMPUTE
#undef GS_SCHED
}

__device__ __forceinline__ void gemm_inproj_phase(const Params& p, bf16_t* sm, int part, int nb, int v, size_t hoff, int e0, int e1) {
  struct Pr {
    const bf16_t* A; const bf16_t* W; bf16_t* P; int nM, nN, part, nb, v, e0;
    __device__ bool seg(int idx, Seg& s, int lr, int lk) const { int mt, e; if (!tile_coord_sub(idx, nM, nN, nb, v, mt, e)) return false; const int nt = inproj_ntile(part, e0 + e);
      s.ap = A + (size_t)(mt * 128 + lr) * D + lk; s.bp = W + (size_t)(nt * 128 + perm_brow(lr)) * D + lk; s.lda = D; s.ldb = D; s.nk = 16; return true; }
    __device__ void begin(int, f32x4 (&acc)[4][4]) const { ZERO_ACC(acc) }
    __device__ void end(int idx, f32x4 (&acc)[4][4]) const { int mt, e; tile_coord_sub(idx, nM, nN, nb, v, mt, e); const int m0 = mt * 128, n0 = inproj_ntile(part, e0 + e) * 128;
      EPI8_LOOP({ uint4 o; o.x = pack2(v0[0], v0[1]); o.y = pack2(v0[2], v0[3]); o.z = pack2(v1[0], v1[1]); o.w = pack2(v1[2], v1[3]); *(uint4*)(P + (size_t)row * LDP + col) = o; }) }
  } pr{(const bf16_t*)(p.ws + hoff), (const bf16_t*)(p.ws + OFF_WIN), (bf16_t*)(p.ws + OFF_P), MG / 128, e1 - e0, part, nb, v, e0};
  gemm_stream(pr, sm);
}
__device__ __forceinline__ void gemm_proj_phase(const Params& p, int M, bf16_t* sm, size_t hoff) {
  struct Pr {
    const bf16_t* YA; const bf16_t* YBn; const bf16_t* Wg; const bf16_t* Ws; const bf16_t* P; bf16_t* U; int nM, nN;
    __device__ bool seg(int idx, Seg& s, int lr, int lk) const { int mt, nt; if (!tile_coord(idx >> 1, nM, nN, mt, nt)) return false;
      if ((idx & 1) == 0) { s.ap = YA + (size_t)(mt * 128 + lr) * 1024 + lk; s.bp = Wg + (size_t)(nt * 128 + perm_brow(lr)) * 1024 + lk; s.lda = 1024; s.ldb = 1024; s.nk = 16; }
      else { s.ap = YBn + (size_t)(mt * 128 + lr) * 2048 + lk; s.bp = Ws + (size_t)(nt * 128 + perm_brow(lr)) * 2048 + lk; s.lda = 2048; s.ldb = 2048; s.nk = 32; }
      return true; }
    __device__ void begin(int idx, f32x4 (&acc)[4][4]) const { if ((idx & 1) == 0) ZERO_ACC(acc) }
    __device__ void end(int idx, f32x4 (&acc)[4][4]) const { int mt, nt; tile_coord(idx >> 1, nM, nN, mt, nt); const int m0 = mt * 128, n0 = nt * 128;
      if ((idx & 1) == 0) {
        EPI8_LOOP({ const uint4 ga = *(const uint4*)(P + (size_t)row * LDP + C_GA + col); const uint4 gb = *(const uint4*)(P + (size_t)row * LDP + C_GB + col);
          v0[0] *= (1.f + __expf(-lo16(gb.x))) / (1.f + __expf(-lo16(ga.x))); v0[1] *= (1.f + __expf(-hi16(gb.x))) / (1.f + __expf(-hi16(ga.x)));
          v0[2] *= (1.f + __expf(-lo16(gb.y))) / (1.f + __expf(-lo16(ga.y))); v0[3] *= (1.f + __expf(-hi16(gb.y))) / (1.f + __expf(-hi16(ga.y)));
          v1[0] *= (1.f + __expf(-lo16(gb.z))) / (1.f + __expf(-lo16(ga.z))); v1[1] *= (1.f + __expf(-hi16(gb.z))) / (1.f + __expf(-hi16(ga.z)));
          v1[2] *= (1.f + __expf(-lo16(gb.w))) / (1.f + __expf(-lo16(ga.w))); v1[3] *= (1.f + __expf(-hi16(gb.w))) / (1.f + __expf(-hi16(ga.w))); })
      } else {
        EPI8_LOOP({ const uint4 gb = *(const uint4*)(P + (size_t)row * LDP + C_GB + col);
          uint4 o; o.x = pack2(v0[0] * sigmoidf_(lo16(gb.x)), v0[1] * sigmoidf_(hi16(gb.x))); o.y = pack2(v0[2] * sigmoidf_(lo16(gb.y)), v0[3] * sigmoidf_(hi16(gb.y)));
          o.z = pack2(v1[0] * sigmoidf_(lo16(gb.z)), v1[1] * sigmoidf_(hi16(gb.z))); o.w = pack2(v1[2] * sigmoidf_(lo16(gb.w)), v1[3] * sigmoidf_(hi16(gb.w)));
          *(uint4*)(U + (size_t)row * D + col) = o; })
      } }
  } pr{(const bf16_t*)(p.ws + OFF_QKV), (const bf16_t*)(p.ws + OFF_QKV) + (size_t)MG * 1024, (const bf16_t*)(p.ws + OFF_WPG), (const bf16_t*)(p.ws + OFF_WPS),
       (const bf16_t*)(p.ws + OFF_P), (bf16_t*)(p.ws + hoff), M / 128, 8};
  gemm_stream(pr, sm);
}
__device__ __forceinline__ void gemm_wout_phase(const Params& p, int l, int g, int M, bf16_t* sm, size_t hoff) {
  struct Pr {
    const Params& p; int l, g; const bf16_t* U; const bf16_t* W; const float* MOD; int nM, nN;
    __device__ bool seg(int idx, Seg& s, int lr, int lk) const { int mt, nt; if (!tile_coord(idx, nM, nN, mt, nt)) return false;
      s.ap = U + (size_t)(mt * 128 + lr) * D + lk; s.bp = W + (size_t)(nt * 128 + perm_brow(lr)) * D + lk; s.lda = D; s.ldb = D; s.nk = 16; return true; }
    __device__ void begin(int, f32x4 (&acc)[4][4]) const { ZERO_ACC(acc) }
    __device__ void end(int idx, f32x4 (&acc)[4][4]) const { int mt, nt; tile_coord(idx, nM, nN, mt, nt); const int m0 = mt * 128, n0 = nt * 128;
      EPI8_LOOP({ const float* xp = xin_row(p, l, g, row) + col; const float* gp = MOD + (size_t)mod_row(g, row) * 6144 + 2048 + col; float* op = xs_row(p, g, row) + col;
        const float4 xa = *(const float4*)xp, xb = *(const float4*)(xp + 4), ga = *(const float4*)gp, gb = *(const float4*)(gp + 4);
        float4 oa, ob; oa.x = DN_ALPHA * xa.x + ga.x * v0[0]; oa.y = DN_ALPHA * xa.y + ga.y * v0[1]; oa.z = DN_ALPHA * xa.z + ga.z * v0[2]; oa.w = DN_ALPHA * xa.w + ga.w * v0[3];
        ob.x = DN_ALPHA * xb.x + gb.x * v1[0]; ob.y = DN_ALPHA * xb.y + gb.y * v1[1]; ob.z = DN_ALPHA * xb.z + gb.z * v1[2]; ob.w = DN_ALPHA * xb.w + gb.w * v1[3];
        *(float4*)op = oa; *(float4*)(op + 4) = ob; }) }
  } pr{p, l, g, (const bf16_t*)(p.ws + hoff), (const bf16_t*)(p.ws + OFF_WOUT), (const float*)(p.ws + OFF_MOD) + (size_t)l * 9 * 6144, M / 128, 8};
  gemm_stream(pr, sm);
}
__device__ __forceinline__ void gemm_ff1_phase(const Params& p, int l, int M, bf16_t* sm, size_t hoff) {
  struct Pr {
    const bf16_t* H; const bf16_t* W; bf16_t* HID; const float* b1; int nM, nN;
    __device__ bool seg(int idx, Seg& s, int lr, int lk) const { int mt, nt; if (!tile_coord(idx, nM, nN, mt, nt)) return false;
      s.ap = H + (size_t)(mt * 128 + lr) * D + lk; s.bp = W + (size_t)(nt * 128 + perm_brow(lr)) * D + lk; s.lda = D; s.ldb = D; s.nk = 16; return true; }
    __device__ void begin(int, f32x4 (&acc)[4][4]) const { ZERO_ACC(acc) }
    __device__ void end(int idx, f32x4 (&acc)[4][4]) const { int mt, nt; tile_coord(idx, nM, nN, mt, nt); const int m0 = mt * 128, n0 = nt * 128;
      EPI8_LOOP({ const float4 ba = *(const float4*)(b1 + col), bb = *(const float4*)(b1 + col + 4);
        const float t0 = fmaxf(v0[0] + ba.x, 0.f), t1 = fmaxf(v0[1] + ba.y, 0.f), t2 = fmaxf(v0[2] + ba.z, 0.f), t3 = fmaxf(v0[3] + ba.w, 0.f);
        const float t4 = fmaxf(v1[0] + bb.x, 0.f), t5 = fmaxf(v1[1] + bb.y, 0.f), t6 = fmaxf(v1[2] + bb.z, 0.f), t7 = fmaxf(v1[3] + bb.w, 0.f);
        uint4 o; o.x = pack2(t0 * t0, t1 * t1); o.y = pack2(t2 * t2, t3 * t3); o.z = pack2(t4 * t4, t5 * t5); o.w = pack2(t6 * t6, t7 * t7);
        *(uint4*)(HID + (size_t)row * 4096 + col) = o; }) }
  } pr{(const bf16_t*)(p.ws + hoff), (const bf16_t*)(p.ws + OFF_WFF1), (bf16_t*)(p.ws + OFF_XBC), p.b_ff1 + (size_t)l * 4096, M / 128, 32};
  gemm_stream(pr, sm);
}
__device__ __forceinline__ void gemm_ff2_phase(const Params& p, int l, int g, int M, bf16_t* sm) {
  struct Pr {
    const Params& p; int g; const bf16_t* HID; const bf16_t* W; const float* MOD; const float* b2; int nM, nN;
    __device__ bool seg(int idx, Seg& s, int lr, int lk) const { int mt, nt; if (!tile_coord(idx, nM, nN, mt, nt)) return false;
      s.ap = HID + (size_t)(mt * 128 + lr) * 4096 + lk; s.bp = W + (size_t)(nt * 128 + perm_brow(lr)) * 4096 + lk; s.lda = 4096; s.ldb = 4096; s.nk = 64; return true; }
    __device__ void begin(int, f32x4 (&acc)[4][4]) const { ZERO_ACC(acc) }
    __device__ void end(int idx, f32x4 (&acc)[4][4]) const { int mt, nt; tile_coord(idx, nM, nN, mt, nt); const int m0 = mt * 128, n0 = nt * 128;
      EPI8_LOOP({ float* xp = xs_row(p, g, row) + col; const float* gp = MOD + (size_t)mod_row(g, row) * 6144 + 5120 + col;
        const float4 xa = *(const float4*)xp, xb = *(const float4*)(xp + 4), ba = *(const float4*)(b2 + col), bb = *(const float4*)(b2 + col + 4), ga = *(const float4*)gp, gb = *(const float4*)(gp + 4);
        float4 oa, ob; oa.x = DN_ALPHA * xa.x + ga.x * (v0[0] + ba.x); oa.y = DN_ALPHA * xa.y + ga.y * (v0[1] + ba.y); oa.z = DN_ALPHA * xa.z + ga.z * (v0[2] + ba.z); oa.w = DN_ALPHA * xa.w + ga.w * (v0[3] + ba.w);
        ob.x = DN_ALPHA * xb.x + gb.x * (v1[0] + bb.x); ob.y = DN_ALPHA * xb.y + gb.y * (v1[1] + bb.y); ob.z = DN_ALPHA * xb.z + gb.z * (v1[2] + bb.z); ob.w = DN_ALPHA * xb.w + gb.w * (v1[3] + bb.w);
        *(float4*)xp = oa; *(float4*)(xp + 4) = ob; }) }
  } pr{p, g, (const bf16_t*)(p.ws + OFF_XBC), (const bf16_t*)(p.ws + OFF_WFF2), (const float*)(p.ws + OFF_MOD) + (size_t)l * 9 * 6144, p.b_ff2 + (size_t)l * 1024, M / 128, 8};
  gemm_stream(pr, sm);
}

__device__ __forceinline__ void ln_phase(const Params& p, int l, int g, int M, const float* gam, const float* bet, bool write_h2, size_t hoff) {
  const int lane = TIDX() & 63;
  const float* MOD = (const float*)(p.ws + OFF_MOD) + (size_t)l * 9 * 6144;
  bf16_t* H = (bf16_t*)(p.ws + hoff);
  const int stride = GDIM() * 4;
  for (int r0 = BIDX() * 4 + (TIDX() >> 6); r0 < M; r0 += 2 * stride) {
    const int r1 = r0 + stride; const bool has1 = r1 < M;
    float* xr0 = xs_row(p, g, r0); float* xr1 = xs_row(p, g, has1 ? r1 : r0);
    float4 v0[4], v1[4];
#pragma unroll
    for (int i = 0; i < 4; ++i) { v0[i] = *(const float4*)(xr0 + (i * 64 + lane) * 4); v1[i] = *(const float4*)(xr1 + (i * 64 + lane) * 4); }
    float s0 = 0.f, s1 = 0.f;
#pragma unroll
    for (int i = 0; i < 4; ++i) { s0 += v0[i].x + v0[i].y + v0[i].z + v0[i].w; s1 += v1[i].x + v1[i].y + v1[i].z + v1[i].w; }
#pragma unroll
    for (int o = 32; o >= 1; o >>= 1) { s0 += __shfl_xor(s0, o); s1 += __shfl_xor(s1, o); }
    const float mu0 = s0 * (1.f / 1024.f), mu1 = s1 * (1.f / 1024.f);
    float q0 = 0.f, q1 = 0.f;
#pragma unroll
    for (int i = 0; i < 4; ++i) {
      v0[i].x -= mu0; v0[i].y -= mu0; v0[i].z -= mu0; v0[i].w -= mu0; q0 += v0[i].x * v0[i].x + v0[i].y * v0[i].y + v0[i].z * v0[i].z + v0[i].w * v0[i].w;
      v1[i].x -= mu1; v1[i].y -= mu1; v1[i].z -= mu1; v1[i].w -= mu1; q1 += v1[i].x * v1[i].x + v1[i].y * v1[i].y + v1[i].z * v1[i].z + v1[i].w * v1[i].w;
    }
#pragma unroll
    for (int o = 32; o >= 1; o >>= 1) { q0 += __shfl_xor(q0, o); q1 += __shfl_xor(q1, o); }
    const float rs0 = rsqrtf(q0 * (1.f / 1024.f) + 1e-5f), rs1 = rsqrtf(q1 * (1.f / 1024.f) + 1e-5f);
    const float* m0 = MOD + (size_t)mod_row(g, r0) * 6144;
    const float* m1 = MOD + (size_t)mod_row(g, has1 ? r1 : r0) * 6144;
#pragma unroll
    for (int i = 0; i < 4; ++i) {
      const int ch = (i * 64 + lane) * 4;
      const float4 gg = *(const float4*)(gam + ch), bb = *(const float4*)(bet + ch);
      float4 o0, o1;
      o0.x = v0[i].x * rs0 * gg.x + bb.x; o0.y = v0[i].y * rs0 * gg.y + bb.y; o0.z = v0[i].z * rs0 * gg.z + bb.z; o0.w = v0[i].w * rs0 * gg.w + bb.w;
      o1.x = v1[i].x * rs1 * gg.x + bb.x; o1.y = v1[i].y * rs1 * gg.y + bb.y; o1.z = v1[i].z * rs1 * gg.z + bb.z; o1.w = v1[i].w * rs1 * gg.w + bb.w;
      *(float4*)(xr0 + ch) = o0;
      if (has1) *(float4*)(xr1 + ch) = o1;
      if (write_h2) {
        const float4 sh0 = *(const float4*)(m0 + 3072 + ch), sc0 = *(const float4*)(m0 + 4096 + ch);
        uint2 h; h.x = pack2(o0.x * (1.f + sc0.x) + sh0.x, o0.y * (1.f + sc0.y) + sh0.y); h.y = pack2(o0.z * (1.f + sc0.z) + sh0.z, o0.w * (1.f + sc0.w) + sh0.w);
        *(uint2*)(H + (size_t)r0 * D + ch) = h;
        if (has1) {
          const float4 sh1 = *(const float4*)(m1 + 3072 + ch), sc1 = *(const float4*)(m1 + 4096 + ch);
          h.x = pack2(o1.x * (1.f + sc1.x) + sh1.x, o1.y * (1.f + sc1.y) + sh1.y); h.y = pack2(o1.z * (1.f + sc1.z) + sh1.z, o1.w * (1.f + sc1.w) + sh1.w);
          *(uint2*)(H + (size_t)r1 * D + ch) = h;
        }
      }
    }
  }
}

__device__ __forceinline__ void conv_phase(const Params& p, int l) {
  const bf16_t* P = (const bf16_t*)(p.ws + OFF_P);
  bf16_t* QKV = (bf16_t*)(p.ws + OFF_QKV); bf16_t* XBC = (bf16_t*)(p.ws + OFF_XBC);
  float* GBF = (float*)(p.ws + OFF_GBF); float* DTF = (float*)(p.ws + OFF_DTF);
  const int nb = GDIM(), bid = BIDX(), tid = TIDX();
  const int vb = ((nb & 7) == 0) ? (bid & 7) * (nb >> 3) + (bid >> 3) : bid;
  const int gtid = vb * 256 + tid, gsz = nb * 256;
  {
    const float* cw = p.gdn_conv_w + (size_t)l * 5 * 3072;
    const int c = tid & 127, hh = tid >> 7;
    for (int item = vb; item < (MG / 32) * 3; item += nb) {
      const int third = item % 3, pp = item / 3;
      const int ch0 = third * 1024 + c * 8;
      const int t0 = (pp * 2 + hh) * 16;
      int lo, hi;
      if (t0 < MLAT) { lo = t0 & ~63; hi = lo + 64; } else { lo = MLAT + ((t0 - MLAT) & ~255); hi = lo + 256; }
      u32x4 raw[20];
#pragma unroll
      for (int i = 0; i < 20; ++i) { const int row = t0 - 2 + i; raw[i] = (row >= lo && row < hi) ? *(const u32x4*)(P + (size_t)row * LDP + ch0) : (u32x4){0u, 0u, 0u, 0u}; }
      float wt[5][8];
#pragma unroll
      for (int j = 0; j < 5; ++j) { const float4 w0 = *(const float4*)(cw + j * 3072 + ch0), w1 = *(const float4*)(cw + j * 3072 + ch0 + 4);
        wt[j][0] = w0.x; wt[j][1] = w0.y; wt[j][2] = w0.z; wt[j][3] = w0.w; wt[j][4] = w1.x; wt[j][5] = w1.y; wt[j][6] = w1.z; wt[j][7] = w1.w; }
      const float qsc = (third == 0) ? 0.08838834764831845f : 1.f;
#pragma unroll
      for (int t = 0; t < 16; ++t) {
        float acc[8];
#pragma unroll
        for (int e = 0; e < 8; ++e) acc[e] = 0.f;
#pragma unroll
        for (int j = 0; j < 5; ++j) {
          const u32x4 rw = raw[t + j];
#pragma unroll
          for (int e = 0; e < 4; ++e) { acc[2 * e] += lo16(rw[e]) * wt[j][2 * e]; acc[2 * e + 1] += hi16(rw[e]) * wt[j][2 * e + 1]; }
        }
        float ss = 0.f;
#pragma unroll
        for (int e = 0; e < 8; ++e) { acc[e] = siluf_(acc[e]); ss += acc[e] * acc[e]; }
        ss += __shfl_xor(ss, 1); ss += __shfl_xor(ss, 2); ss += __shfl_xor(ss, 4); ss += __shfl_xor(ss, 8);
        const float sc = (third < 2) ? rsqrtf(ss + 1e-6f) * qsc : 1.f;
#pragma unroll
        for (int e = 0; e < 8; ++e) acc[e] *= sc;
        *(uint4*)(QKV + (size_t)(t0 + t) * 3072 + ch0) = pack8(acc);
      }
    }
  }
  {
    const float* sw = p.ssm_conv_w + (size_t)l * 5 * 4096; const float* sb = p.ssm_conv_b + (size_t)l * 4096;
    constexpr int nLat = G * 64 * 8 * 2, nCtx = (MCTX / 16) * 2;
    float wt[5][8], bs[8];
    int cur_half = -1;
    for (int item = vb; item < nLat + nCtx; item += nb) {
      int half, base, stride, p0, seglen;
      if (item < nLat) { half = item & 1; const int piece = (item >> 1) & 7, cl = (item >> 4) & 63, b_l = item >> 10; base = b_l * 8192 + cl; stride = 64; p0 = piece * 16; seglen = 128; }
      else { const int i2 = item - nLat; half = i2 & 1; const int piece = i2 >> 1; base = MLAT + (piece >> 4) * 256; stride = 1; p0 = (piece & 15) * 16; seglen = 256; }
      const int ch0 = (half * 256 + tid) * 8;
      u32x4 raw[20];
#pragma unroll
      for (int i = 0; i < 20; ++i) { const int pq = p0 - 2 + i; raw[i] = (pq >= 0 && pq < seglen) ? *(const u32x4*)(P + (size_t)(base + pq * stride) * LDP + C_XBC + ch0) : (u32x4){0u, 0u, 0u, 0u}; }
      if (half != cur_half) {
        cur_half = half;
        const float4 b0 = *(const float4*)(sb + ch0), b1 = *(const float4*)(sb + ch0 + 4);
        bs[0] = b0.x; bs[1] = b0.y; bs[2] = b0.z; bs[3] = b0.w; bs[4] = b1.x; bs[5] = b1.y; bs[6] = b1.z; bs[7] = b1.w;
#pragma unroll
        for (int j = 0; j < 5; ++j) { const float4 w0 = *(const float4*)(sw + j * 4096 + ch0), w1 = *(const float4*)(sw + j * 4096 + ch0 + 4);
          wt[j][0] = w0.x; wt[j][1] = w0.y; wt[j][2] = w0.z; wt[j][3] = w0.w; wt[j][4] = w1.x; wt[j][5] = w1.y; wt[j][6] = w1.z; wt[j][7] = w1.w; }
      }
#pragma unroll
      for (int t = 0; t < 16; ++t) {
        float acc[8];
#pragma unroll
        for (int e = 0; e < 8; ++e) acc[e] = bs[e];
#pragma unroll
        for (int j = 0; j < 5; ++j) {
          const u32x4 rw = raw[t + j];
#pragma unroll
          for (int e = 0; e < 4; ++e) { acc[2 * e] += lo16(rw[e]) * wt[j][2 * e]; acc[2 * e + 1] += hi16(rw[e]) * wt[j][2 * e + 1]; }
        }
#pragma unroll
        for (int e = 0; e < 8; ++e) acc[e] = siluf_(acc[e]);
        *(uint4*)(XBC + (size_t)(base + (p0 + t) * stride) * 4096 + ch0) = pack8(acc);
      }
    }
  }
  for (int idx = gtid; idx < MG * 16; idx += gsz) {
    const int r = idx >> 4, dh = idx & 15;
    GBF[(size_t)r * 32 + 16 + dh] = sigmoidf_(bf2f(P[(size_t)r * LDP + C_B + dh]));
  }
  for (int idx = gtid; idx < G * 2 * 264 * 8; idx += gsz) {
    const int h = idx & 7; int t = idx >> 3; const int chunk = t % 264; t /= 264; const int dir = t & 1, b_l = t >> 1;
    const int dh = dir * 8 + h;
    const float bias = p.gdn_dt_bias[l * 16 + dh], aneg = -__expf(p.gdn_A_log[l * 16 + dh]);
    float cum = 0.f;
    for (int ub = 0; ub < 32; ub += 8) {
      float av[8];
#pragma unroll
      for (int u = 0; u < 8; ++u) av[u] = bf2f(P[(size_t)gdn_rowof(b_l, dir, chunk * 32 + ub + u) * LDP + C_A + dh]);
#pragma unroll
      for (int u = 0; u < 8; ++u) {
        cum += aneg * softplusf_(av[u] + bias);
        GBF[(size_t)gdn_rowof(b_l, dir, chunk * 32 + ub + u) * 32 + dh] = cum;
      }
    }
  }
  for (int idx = gtid; idx < G * 2 * 264 * 32; idx += gsz) {
    const int head = idx & 31; int t = idx >> 5; const int chunk = t % 264; t /= 264; const int dir = t & 1, b_l = t >> 1;
    const int dh = dir * 32 + head;
    const float bias = p.ssm_dt_bias[l * 64 + dh], aneg = -__expf(p.ssm_A_log[l * 64 + dh]);
    float cum = 0.f;
    for (int ub = 0; ub < 32; ub += 8) {
      float dtv[8];
#pragma unroll
      for (int u = 0; u < 8; ++u) dtv[u] = bf2f(P[(size_t)ssd_rowof(b_l, dir, chunk * 32 + ub + u) * LDP + C_DT + dh]);
#pragma unroll
      for (int u = 0; u < 8; ++u) {
        const size_t row = (size_t)ssd_rowof(b_l, dir, chunk * 32 + ub + u);
        const float dt = softplusf_(dtv[u] + bias);
        cum += dt * aneg;
        DTF[row * 128 + dh] = dt;
        DTF[row * 128 + 64 + dh] = cum;
      }
    }
  }
}

__device__ __forceinline__ void gdn_prep_phase(const Params& p, unsigned char* smraw) {
  const int tid = TIDX(), lane = tid & 63, w = tid >> 6, fr = lane & 15, fq = lane >> 4, ti = w >> 1, tj = w & 1;
  bf16_t* sK = (bf16_t*)smraw;
  bf16_t* sQ = sK + 32 * 136;
  bf16_t* sP = sQ + 32 * 136;
  bf16_t* sPT = sP + 2 * 1280;
  bf16_t* sR = sPT + 2 * 1280;
  float* sG = (float*)(sR + 2 * 1280);
  const bf16_t* QKV = (const bf16_t*)(p.ws + OFF_QKV);
  const float* GBF = (const float*)(p.ws + OFF_GBF);
  bf16_t* TMB = (bf16_t*)(p.ws + OFF_TMB);
  const int ltok = tid & 31, lp = tid >> 5;
  const int i = ti * 16 + fr, j0 = tj * 16 + fq * 4;
  for (int item = BIDX(); item < GDN_NITEM; item += GDIM()) {
    const int chunk = item % 264; const int t = item / 264; const int dir = t & 1, h = (t >> 1) & 7, b_l = t >> 4;
    const size_t row = (size_t)gdn_rowof(b_l, dir, chunk * 32 + ltok);
    const bf16_t* src = QKV + row * 3072 + h * 128;
    const u32x4 k0 = *(const u32x4*)(src + 1024 + lp * 8), k1 = *(const u32x4*)(src + 1024 + (lp + 8) * 8);
    const u32x4 q0 = *(const u32x4*)(src + lp * 8), q1 = *(const u32x4*)(src + (lp + 8) * 8);
    float g_ = 0.f, b_ = 0.f;
    if (tid < 32) { g_ = GBF[row * 32 + dir * 8 + h]; b_ = GBF[row * 32 + 16 + dir * 8 + h]; }
    __syncthreads();
    *(u32x4*)(sK + ltok * 136 + lp * 8) = k0; *(u32x4*)(sK + ltok * 136 + (lp + 8) * 8) = k1;
    *(u32x4*)(sQ + ltok * 136 + lp * 8) = q0; *(u32x4*)(sQ + ltok * 136 + (lp + 8) * 8) = q1;
    if (tid < 32) { sG[tid] = g_; sG[32 + tid] = b_; }
    __syncthreads();
    {
      f32x4 kk = (f32x4){0.f, 0.f, 0.f, 0.f}, qk = kk;
#pragma unroll
      for (int ks = 0; ks < 4; ++ks) {
        const bf16x8 kj = *(const bf16x8*)(sK + (tj * 16 + fr) * 136 + ks * 32 + fq * 8);
        const bf16x8 ki = *(const bf16x8*)(sK + (ti * 16 + fr) * 136 + ks * 32 + fq * 8);
        const bf16x8 qi = *(const bf16x8*)(sQ + (ti * 16 + fr) * 136 + ks * 32 + fq * 8);
        kk = __builtin_amdgcn_mfma_f32_16x16x32_bf16(kj, ki, kk, 0, 0, 0);
        qk = __builtin_amdgcn_mfma_f32_16x16x32_bf16(kj, qi, qk, 0, 0, 0);
      }
      const float gi = sG[i], bi = sG[32 + i];
      float n[4], nt[4], rr[4], m[4];
#pragma unroll
      for (int r = 0; r < 4; ++r) {
        const int j = j0 + r; const float gj = sG[j], bj = sG[32 + j];
        n[r] = (j < i) ? -bi * kk[r] * __expf(gi - gj) : 0.f;
        nt[r] = (i < j) ? -bj * kk[r] * __expf(gj - gi) : 0.f;
        m[r] = (j <= i) ? qk[r] * __expf(gi - gj) : 0.f;
        rr[r] = n[r] + ((i == j) ? 1.f : 0.f);
      }
      uint2 o;
      o.x = pack2(n[0], n[1]); o.y = pack2(n[2], n[3]); *(uint2*)(sP + i * 40 + j0) = o;
      o.x = pack2(nt[0], nt[1]); o.y = pack2(nt[2], nt[3]); *(uint2*)(sPT + i * 40 + j0) = o;
      o.x = pack2(rr[0], rr[1]); o.y = pack2(rr[2], rr[3]); *(uint2*)(sR + i * 40 + j0) = o;
      o.x = pack2(m[0], m[1]); o.y = pack2(m[2], m[3]); *(uint2*)(TMB + (size_t)item * 2048 + 1024 + i * 32 + j0) = o;
    }
    __syncthreads();
    int pc = 0, rc = 0;
#pragma unroll
    for (int st = 1; st <= 5; ++st) {
      const bf16_t* Pc = sP + pc * 1280; const bf16_t* PTc = sPT + pc * 1280; const bf16_t* Rc = sR + rc * 1280;
      const bf16x8 p_i = *(const bf16x8*)(Pc + (ti * 16 + fr) * 40 + fq * 8);
      const bf16x8 p_j = *(const bf16x8*)(Pc + (tj * 16 + fr) * 40 + fq * 8);
      const bf16x8 pt_i = *(const bf16x8*)(PTc + (ti * 16 + fr) * 40 + fq * 8);
      const bf16x8 pt_j = *(const bf16x8*)(PTc + (tj * 16 + fr) * 40 + fq * 8);
      const f32x4 z = (f32x4){0.f, 0.f, 0.f, 0.f};
      if (st >= 2) {
        const bf16x8 r_i = *(const bf16x8*)(Rc + (ti * 16 + fr) * 40 + fq * 8);
        const uint2 rin = *(const uint2*)(Rc + i * 40 + j0);
        f32x4 racc = (f32x4){lo16(rin.x), hi16(rin.x), lo16(rin.y), hi16(rin.y)};
        racc = __builtin_amdgcn_mfma_f32_16x16x32_bf16(pt_j, r_i, racc, 0, 0, 0);
        uint2 o; o.x = pack2(racc[0], racc[1]); o.y = pack2(racc[2], racc[3]);
        if (st < 5) *(uint2*)(sR + (rc ^ 1) * 1280 + i * 40 + j0) = o;
        else *(uint2*)(TMB + (size_t)item * 2048 + i * 32 + j0) = o;
      }
      if (st <= 4) {
        const f32x4 pn = __builtin_amdgcn_mfma_f32_16x16x32_bf16(pt_j, p_i, z, 0, 0, 0);
        const f32x4 ptn = __builtin_amdgcn_mfma_f32_16x16x32_bf16(p_j, pt_i, z, 0, 0, 0);
        uint2 o; o.x = pack2(pn[0], pn[1]); o.y = pack2(pn[2], pn[3]); *(uint2*)(sP + (pc ^ 1) * 1280 + i * 40 + j0) = o;
        o.x = pack2(ptn[0], ptn[1]); o.y = pack2(ptn[2], ptn[3]); *(uint2*)(sPT + (pc ^ 1) * 1280 + i * 40 + j0) = o;
      }
      if (st < 5) __syncthreads();
      pc ^= 1; if (st >= 2) rc ^= 1;
    }
  }
}

__device__ __forceinline__ void gdn_chunk_item(const Params& p, int id, unsigned char* smraw) {
  const int tid = TIDX(), lane = tid & 63, w = tid >> 6, fr = lane & 15, fq = lane >> 4, ta = w >> 1, tb = w & 1;
  const int b_l = id >> 6, h = (id >> 3) & 7, dir = (id >> 2) & 1, dvq = id & 3;
  bf16_t* sKb = (bf16_t*)smraw;
  bf16_t* sQ = sKb + 32 * 136;
  bf16_t* sKdT = sQ + 32 * 136;
  bf16_t* sVbT = sKdT + 128 * 40;
  bf16_t* sT = sVbT + 32 * 40;
  bf16_t* sM = sT + 32 * 40;
  bf16_t* sXT = sM + 32 * 40;
  bf16_t* sVnT = sXT + 32 * 40;
  bf16_t* sST = sVnT + 32 * 40;
  float* sG = (float*)(sST + 32 * 136);
  const bf16_t* QKV = (const bf16_t*)(p.ws + OFF_QKV);
  const float* GBF = (const float*)(p.ws + OFF_GBF);
  const bf16_t* TMB = (const bf16_t*)(p.ws + OFF_TMB);
  bf16_t* OUT = (bf16_t*)(p.ws + (dir ? OFF_OB : OFF_OF));
  const int ltok = tid & 31, lp = tid >> 5;
  const size_t item0 = (size_t)((b_l * 8 + h) * 2 + dir) * 264;
  struct Stage { u32x4 k0, k1, q0, q1, v, tm; float g, be, gl; };
  Stage st0, st1;
  constexpr int NCH = (256 + 8192) / 32;
  auto gload = [&](Stage& st, int c) __attribute__((always_inline)) {
    const int s0 = (c < NCH ? c : NCH - 1) * 32;
    const size_t row = (size_t)gdn_rowof(b_l, dir, s0 + ltok);
    const bf16_t* src = QKV + row * 3072 + h * 128;
    st.k0 = *(const u32x4*)(src + 1024 + lp * 8); st.k1 = *(const u32x4*)(src + 1024 + (lp + 8) * 8);
    st.q0 = *(const u32x4*)(src + lp * 8); st.q1 = *(const u32x4*)(src + (lp + 8) * 8);
    st.v = *(const u32x4*)(src + 2048 + dvq * 32 + (lp & 3) * 8);
    st.tm = *(const u32x4*)(TMB + (item0 + (c < NCH ? c : NCH - 1)) * 2048 + (tid >> 7) * 1024 + ((tid & 127) >> 2) * 32 + (tid & 3) * 8);
    st.g = GBF[row * 32 + dir * 8 + h]; st.be = GBF[row * 32 + 16 + dir * 8 + h];
    st.gl = GBF[(size_t)gdn_rowof(b_l, dir, s0 + 31) * 32 + dir * 8 + h];
  };
  auto lstore = [&](const Stage& st) __attribute__((always_inline)) {
    const float skb = st.be * __expf(st.g), skd = __expf(st.gl - st.g);
    {
      float f[8]; uint4 o;
      f[0] = lo16(st.k0[0]); f[1] = hi16(st.k0[0]); f[2] = lo16(st.k0[1]); f[3] = hi16(st.k0[1]); f[4] = lo16(st.k0[2]); f[5] = hi16(st.k0[2]); f[6] = lo16(st.k0[3]); f[7] = hi16(st.k0[3]);
      bf16_t* t0 = sKdT + (lp * 8) * 40 + ltok;
#pragma unroll
      for (int e = 0; e < 4; ++e) { const unsigned pk = pack2(f[2 * e] * skd, f[2 * e + 1] * skd); t0[(2 * e) * 40] = (bf16_t)(pk & 0xffffu); t0[(2 * e + 1) * 40] = (bf16_t)(pk >> 16); }
#pragma unroll
      for (int e = 0; e < 8; ++e) f[e] *= skb;
      o = pack8(f); *(uint4*)(sKb + ltok * 136 + lp * 8) = o;
      f[0] = lo16(st.k1[0]); f[1] = hi16(st.k1[0]); f[2] = lo16(st.k1[1]); f[3] = hi16(st.k1[1]); f[4] = lo16(st.k1[2]); f[5] = hi16(st.k1[2]); f[6] = lo16(st.k1[3]); f[7] = hi16(st.k1[3]);
      bf16_t* t1 = sKdT + ((lp + 8) * 8) * 40 + ltok;
#pragma unroll
      for (int e = 0; e < 4; ++e) { const unsigned pk = pack2(f[2 * e] * skd, f[2 * e + 1] * skd); t1[(2 * e) * 40] = (bf16_t)(pk & 0xffffu); t1[(2 * e + 1) * 40] = (bf16_t)(pk >> 16); }
#pragma unroll
      for (int e = 0; e < 8; ++e) f[e] *= skb;
      o = pack8(f); *(uint4*)(sKb + ltok * 136 + (lp + 8) * 8) = o;
    }
    *(u32x4*)(sQ + ltok * 136 + lp * 8) = st.q0; *(u32x4*)(sQ + ltok * 136 + (lp + 8) * 8) = st.q1;
    if (tid < 128) {
      bf16_t* tv = sVbT + (lp * 8) * 40 + ltok;
#pragma unroll
      for (int e = 0; e < 4; ++e) { const unsigned pk = pack2(lo16(st.v[e]) * st.be, hi16(st.v[e]) * st.be); tv[(2 * e) * 40] = (bf16_t)(pk & 0xffffu); tv[(2 * e + 1) * 40] = (bf16_t)(pk >> 16); }
      *(u32x4*)(sT + ((tid & 127) >> 2) * 40 + (tid & 3) * 8) = st.tm;
    } else {
      *(u32x4*)(sM + ((tid & 127) >> 2) * 40 + (tid & 3) * 8) = st.tm;
    }
    if (tid < 32) sG[tid] = st.g;
  };
  f32x4 S[4];
#pragma unroll
  for (int t = 0; t < 4; ++t) S[t] = (f32x4){0.f, 0.f, 0.f, 0.f};
  __syncthreads();
  for (int i = tid; i < 32 * 136 / 2; i += 256) ((unsigned*)sST)[i] = 0u;
  gload(st0, 0); lstore(st0);
  __syncthreads();
  gload(st0, 1);
  __builtin_amdgcn_sched_barrier(0);
  gload(st1, 2);
  __builtin_amdgcn_sched_barrier(0);
  auto body = [&](int c) __attribute__((always_inline)) {
    const int dv = ta * 16 + fr, i0 = tb * 16 + fq * 4;
    {
      f32x4 pr = (f32x4){0.f, 0.f, 0.f, 0.f};
#pragma unroll
      for (int ks = 0; ks < 4; ++ks) {
        const bf16x8 kb = *(const bf16x8*)(sKb + (tb * 16 + fr) * 136 + ks * 32 + fq * 8);
        const bf16x8 sf = *(const bf16x8*)(sST + (ta * 16 + fr) * 136 + ks * 32 + fq * 8);
        pr = __builtin_amdgcn_mfma_f32_16x16x32_bf16(kb, sf, pr, 0, 0, 0);
      }
      const uint2 vb = *(const uint2*)(sVbT + dv * 40 + i0);
      uint2 o; o.x = pack2(lo16(vb.x) - pr[0], hi16(vb.x) - pr[1]); o.y = pack2(lo16(vb.y) - pr[2], hi16(vb.y) - pr[3]);
      *(uint2*)(sXT + dv * 40 + i0) = o;
    }
    __syncthreads();
    {
      const bf16x8 tf = *(const bf16x8*)(sT + (tb * 16 + fr) * 40 + fq * 8);
      const bf16x8 xf = *(const bf16x8*)(sXT + (ta * 16 + fr) * 40 + fq * 8);
      const f32x4 vn = __builtin_amdgcn_mfma_f32_16x16x32_bf16(tf, xf, (f32x4){0.f, 0.f, 0.f, 0.f}, 0, 0, 0);
      uint2 o; o.x = pack2(vn[0], vn[1]); o.y = pack2(vn[2], vn[3]);
      *(uint2*)(sVnT + dv * 40 + i0) = o;
    }
    __syncthreads();
    const float eglast = __expf(sG[31]);
    {
      f32x4 oa = (f32x4){0.f, 0.f, 0.f, 0.f};
#pragma unroll
      for (int ks = 0; ks < 4; ++ks) {
        const bf16x8 qf = *(const bf16x8*)(sQ + (ta * 16 + fr) * 136 + ks * 32 + fq * 8);
        const bf16x8 sf = *(const bf16x8*)(sST + (tb * 16 + fr) * 136 + ks * 32 + fq * 8);
        oa = __builtin_amdgcn_mfma_f32_16x16x32_bf16(sf, qf, oa, 0, 0, 0);
      }
      const int i = ta * 16 + fr;
      oa *= __expf(sG[i]);
      const bf16x8 mf = *(const bf16x8*)(sM + i * 40 + fq * 8);
      const bf16x8 vf = *(const bf16x8*)(sVnT + (tb * 16 + fr) * 40 + fq * 8);
      oa = __builtin_amdgcn_mfma_f32_16x16x32_bf16(vf, mf, oa, 0, 0, 0);
      uint2 o; o.x = pack2(oa[0], oa[1]); o.y = pack2(oa[2], oa[3]);
      *(uint2*)(OUT + (size_t)gdn_rowof(b_l, dir, c * 32 + i) * 1024 + h * 128 + dvq * 32 + tb * 16 + fq * 4) = o;
    }
    {
      const bf16x8 vf = *(const bf16x8*)(sVnT + (ta * 16 + fr) * 40 + fq * 8);
#pragma unroll
      for (int t = 0; t < 4; ++t) {
        const bf16x8 kf = *(const bf16x8*)(sKdT + ((tb * 4 + t) * 16 + fr) * 40 + fq * 8);
        S[t] *= eglast;
        S[t] = __builtin_amdgcn_mfma_f32_16x16x32_bf16(kf, vf, S[t], 0, 0, 0);
      }
    }
    __syncthreads();
#pragma unroll
    for (int t = 0; t < 4; ++t) {
      uint2 o; o.x = pack2(S[t][0], S[t][1]); o.y = pack2(S[t][2], S[t][3]);
      *(uint2*)(sST + (ta * 16 + fr) * 136 + (tb * 4 + t) * 16 + fq * 4) = o;
    }
  };
  for (int c = 0; c < NCH; c += 2) {
    body(c);
    lstore(st0); gload(st0, c + 3);
    __syncthreads();
    body(c + 1);
    if (c + 2 < NCH) lstore(st1);
    gload(st1, c + 4);
    __syncthreads();
  }
}

__device__ __forceinline__ void ssd_chunk_item(const Params& p, int id, unsigned char* smraw) {
  const int tid = TIDX(), lane = tid & 63, w = tid >> 6, fr = lane & 15, fq = lane >> 4;
  const int b_l = id >> 6, head = (id >> 1) & 31, dir = id & 1, grp = head >> 2;
  bf16_t* sC = (bf16_t*)smraw;
  bf16_t* sB = sC + 32 * 136;
  bf16_t* sBT = sB + 32 * 136;
  bf16_t* sXT = sBT + 128 * 40;
  bf16_t* sM = sXT + 64 * 40;
  bf16_t* sST = sM + 32 * 40;
  float* sG = (float*)(sST + 64 * 136);
  const bf16_t* XBC = (const bf16_t*)(p.ws + OFF_XBC);
  const float* DTF = (const float*)(p.ws + OFF_DTF);
  bf16_t* OUT = (bf16_t*)(p.ws + (dir ? OFF_YB : OFF_YF));
  const int ltok = tid & 31, lpart = tid >> 5;
  struct Stage { u32x4 b0, b1, c0, c1, x; float dt, g, gl; };
  Stage st0, st1;
  constexpr int NCH = (256 + 8192) / 32;
  auto gload = [&](Stage& st, int c) __attribute__((always_inline)) {
    const int s0 = (c < NCH ? c : NCH - 1) * 32;
    const size_t row = (size_t)ssd_rowof(b_l, dir, s0 + ltok);
    const bf16_t* xr = XBC + row * 4096;
    st.b0 = *(const u32x4*)(xr + 2048 + grp * 128 + lpart * 8);
    st.b1 = *(const u32x4*)(xr + 2048 + grp * 128 + (lpart + 8) * 8);
    st.c0 = *(const u32x4*)(xr + 3072 + grp * 128 + lpart * 8);
    st.c1 = *(const u32x4*)(xr + 3072 + grp * 128 + (lpart + 8) * 8);
    st.x = *(const u32x4*)(xr + head * 64 + lpart * 8);
    st.dt = DTF[row * 128 + dir * 32 + head];
    st.g = DTF[row * 128 + 64 + dir * 32 + head];
    st.gl = DTF[(size_t)ssd_rowof(b_l, dir, s0 + 31) * 128 + 64 + dir * 32 + head];
  };
  auto lstore = [&](const Stage& st) __attribute__((always_inline)) {
    *(u32x4*)(sB + ltok * 136 + lpart * 8) = st.b0;
    *(u32x4*)(sB + ltok * 136 + (lpart + 8) * 8) = st.b1;
    *(u32x4*)(sC + ltok * 136 + lpart * 8) = st.c0;
    *(u32x4*)(sC + ltok * 136 + (lpart + 8) * 8) = st.c1;
    const float wj = __expf(st.gl - st.g);
    bf16_t* t0 = sBT + (lpart * 8) * 40 + ltok;
    bf16_t* t1 = sBT + ((lpart + 8) * 8) * 40 + ltok;
    bf16_t* tx = sXT + (lpart * 8) * 40 + ltok;
#pragma unroll
    for (int e = 0; e < 4; ++e) {
      const unsigned pa = pack2(lo16(st.b0[e]) * wj, hi16(st.b0[e]) * wj), pb = pack2(lo16(st.b1[e]) * wj, hi16(st.b1[e]) * wj);
      const unsigned px = pack2(lo16(st.x[e]) * st.dt, hi16(st.x[e]) * st.dt);
      t0[(2 * e) * 40] = (bf16_t)(pa & 0xffffu); t0[(2 * e + 1) * 40] = (bf16_t)(pa >> 16);
      t1[(2 * e) * 40] = (bf16_t)(pb & 0xffffu); t1[(2 * e + 1) * 40] = (bf16_t)(pb >> 16);
      tx[(2 * e) * 40] = (bf16_t)(px & 0xffffu); tx[(2 * e + 1) * 40] = (bf16_t)(px >> 16);
    }
    if (tid < 32) sG[tid] = st.g;
  };
  f32x4 S[8];
#pragma unroll
  for (int i = 0; i < 8; ++i) S[i] = (f32x4){0.f, 0.f, 0.f, 0.f};
  __syncthreads();
  for (int i = lane; i < 16 * 136 / 2; i += 64) ((unsigned*)(sST + w * 16 * 136))[i] = 0u;
  gload(st0, 0); lstore(st0);
  __syncthreads();
  gload(st0, 1);
  __builtin_amdgcn_sched_barrier(0);
  gload(st1, 2);
  __builtin_amdgcn_sched_barrier(0);
  auto body = [&](int c) __attribute__((always_inline)) {
    {
      const int ti = w >> 1, tj = w & 1;
      f32x4 cb = (f32x4){0.f, 0.f, 0.f, 0.f};
      if (tj <= ti) {
#pragma unroll
        for (int ks = 0; ks < 4; ++ks) {
          const bf16x8 af = *(const bf16x8*)(sC + (ti * 16 + fr) * 136 + ks * 32 + fq * 8);
          const bf16x8 bf = *(const bf16x8*)(sB + (tj * 16 + fr) * 136 + ks * 32 + fq * 8);
          cb = __builtin_amdgcn_mfma_f32_16x16x32_bf16(bf, af, cb, 0, 0, 0);
        }
      }
      const int i = ti * 16 + fr, j0 = tj * 16 + fq * 4;
      const float gi = sG[i];
      const f32x4 gj = *(const f32x4*)(sG + j0);
      float m[4];
#pragma unroll
      for (int r = 0; r < 4; ++r) { const float e = __expf(fminf(gi - gj[r], 0.f)); m[r] = (j0 + r <= i) ? cb[r] * e : 0.f; }
      uint2 o; o.x = pack2(m[0], m[1]); o.y = pack2(m[2], m[3]);
      *(uint2*)(sM + i * 40 + j0) = o;
    }
    __syncthreads();
    const bf16x8 xfrag = *(const bf16x8*)(sXT + (w * 16 + fr) * 40 + fq * 8);
    const float eglast = __expf(sG[31]);
#pragma unroll
    for (int ti = 0; ti < 2; ++ti) {
      f32x4 y = (f32x4){0.f, 0.f, 0.f, 0.f};
#pragma unroll
      for (int ks = 0; ks < 4; ++ks) {
        const bf16x8 af = *(const bf16x8*)(sC + (ti * 16 + fr) * 136 + ks * 32 + fq * 8);
        const bf16x8 bf = *(const bf16x8*)(sST + (w * 16 + fr) * 136 + ks * 32 + fq * 8);
        y = __builtin_amdgcn_mfma_f32_16x16x32_bf16(bf, af, y, 0, 0, 0);
      }
      const int i = ti * 16 + fr;
      const float eg = __expf(sG[i]);
      y *= eg;
      const bf16x8 mf = *(const bf16x8*)(sM + i * 40 + fq * 8);
      y = __builtin_amdgcn_mfma_f32_16x16x32_bf16(xfrag, mf, y, 0, 0, 0);
      uint2 o; o.x = pack2(y[0], y[1]); o.y = pack2(y[2], y[3]);
      *(uint2*)(OUT + (size_t)ssd_rowof(b_l, dir, c * 32 + i) * 2048 + head * 64 + w * 16 + fq * 4) = o;
    }
#pragma unroll
    for (int tn = 0; tn < 8; ++tn) {
      const bf16x8 bf = *(const bf16x8*)(sBT + (tn * 16 + fr) * 40 + fq * 8);
      S[tn] *= eglast;
      S[tn] = __builtin_amdgcn_mfma_f32_16x16x32_bf16(bf, xfrag, S[tn], 0, 0, 0);
    }
#pragma unroll
    for (int tn = 0; tn < 8; ++tn) {
      uint2 o; o.x = pack2(S[tn][0], S[tn][1]); o.y = pack2(S[tn][2], S[tn][3]);
      *(uint2*)(sST + (w * 16 + fr) * 136 + tn * 16 + fq * 4) = o;
    }
    __syncthreads();
  };
  for (int c = 0; c < NCH; c += 2) {
    body(c);
    lstore(st0); gload(st0, c + 3);
    __syncthreads();
    body(c + 1);
    if (c + 2 < NCH) lstore(st1);
    gload(st1, c + 4);
    __syncthreads();
  }
}

__device__ __forceinline__ void scan_phase(const Params& p, unsigned char* sm, int nb, int v) {
  for (int item = v; item < 256; item += nb) {
    if (item < 128) gdn_chunk_item(p, item, sm); else ssd_chunk_item(p, item - 128, sm);
    __syncthreads();
  }
}

__device__ __forceinline__ void gnorm_phase(const Params& p, int l, int M) {
  const bf16_t* P = (const bf16_t*)(p.ws + OFF_P);
  const bf16_t* OF = (const bf16_t*)(p.ws + OFF_OF); const bf16_t* OB = (const bf16_t*)(p.ws + OFF_OB);
  const bf16_t* YF = (const bf16_t*)(p.ws + OFF_YF); const bf16_t* YB = (const bf16_t*)(p.ws + OFF_YB);
  const bf16_t* XBC = (const bf16_t*)(p.ws + OFF_XBC);
  bf16_t* YA = (bf16_t*)(p.ws + OFF_QKV); bf16_t* YBn = YA + (size_t)MG * 1024;
  const int gtid = BIDX() * 256 + TIDX(), gsz = GDIM() * 256;
  const float* nw = p.gdn_norm_w + l * 128;
  for (int idx0 = gtid; idx0 < M * 128; idx0 += 2 * gsz) {
    const int idx1 = idx0 + gsz; const bool has1 = idx1 < M * 128;
    const int ia[2] = {idx0, has1 ? idx1 : idx0};
    uint4 a[2], b[2], gt[2];
#pragma unroll
    for (int u = 0; u < 2; ++u) { const int r = ia[u] >> 7, c8 = (ia[u] & 127) * 8;
      a[u] = *(const uint4*)(OF + (size_t)r * 1024 + c8); b[u] = *(const uint4*)(OB + (size_t)r * 1024 + c8); gt[u] = *(const uint4*)(P + (size_t)r * LDP + C_GOUT + c8); }
#pragma unroll
    for (int u = 0; u < 2; ++u) {
      const int r = ia[u] >> 7, c8 = (ia[u] & 127) * 8;
      float fa[8], fb[8], fg[8]; UNPACK8(a[u], fa); UNPACK8(b[u], fb); UNPACK8(gt[u], fg);
      float ss = 0.f;
#pragma unroll
      for (int e = 0; e < 8; ++e) { fa[e] += fb[e]; ss += fa[e] * fa[e]; }
      ss += __shfl_xor(ss, 1); ss += __shfl_xor(ss, 2); ss += __shfl_xor(ss, 4); ss += __shfl_xor(ss, 8);
      const float rs = rsqrtf(ss * (1.f / 128.f) + 1e-6f);
      const float4 w0 = *(const float4*)(nw + (c8 & 127)), w1 = *(const float4*)(nw + (c8 & 127) + 4);
      const float wv[8] = {w0.x, w0.y, w0.z, w0.w, w1.x, w1.y, w1.z, w1.w};
#pragma unroll
      for (int e = 0; e < 8; ++e) fa[e] = fa[e] * rs * wv[e] * siluf_(fg[e]);
      if (u == 0 || has1) *(uint4*)(YA + (size_t)r * 1024 + c8) = pack8(fa);
    }
  }
  const float* sw = p.ssm_norm_w + l * 2048; const float* Dk = p.ssm_D + l * 32;
  for (int idx0 = gtid; idx0 < M * 256; idx0 += 2 * gsz) {
    const int idx1 = idx0 + gsz; const bool has1 = idx1 < M * 256;
    const int ia[2] = {idx0, has1 ? idx1 : idx0};
    uint4 a[2], b[2], xx[2], zz[2];
#pragma unroll
    for (int u = 0; u < 2; ++u) { const int r = ia[u] >> 8, c8 = (ia[u] & 255) * 8;
      a[u] = *(const uint4*)(YF + (size_t)r * 2048 + c8); b[u] = *(const uint4*)(YB + (size_t)r * 2048 + c8);
      xx[u] = *(const uint4*)(XBC + (size_t)r * 4096 + c8); zz[u] = *(const uint4*)(P + (size_t)r * LDP + C_Z + c8); }
#pragma unroll
    for (int u = 0; u < 2; ++u) {
      const int r = ia[u] >> 8, c8 = (ia[u] & 255) * 8;
      float fa[8], fb[8], fx[8], fz[8]; UNPACK8(a[u], fa); UNPACK8(b[u], fb); UNPACK8(xx[u], fx); UNPACK8(zz[u], fz);
      const float dsk = Dk[c8 >> 6];
      float ss = 0.f;
#pragma unroll
      for (int e = 0; e < 8; ++e) { fa[e] = (fa[e] + fb[e] + dsk * fx[e]) * siluf_(fz[e]); ss += fa[e] * fa[e]; }
      ss += __shfl_xor(ss, 1); ss += __shfl_xor(ss, 2); ss += __shfl_xor(ss, 4); ss += __shfl_xor(ss, 8); ss += __shfl_xor(ss, 16);
      const float rs = rsqrtf(ss * (1.f / 256.f) + 1e-6f);
      const float4 w0 = *(const float4*)(sw + c8), w1 = *(const float4*)(sw + c8 + 4);
      const float wv[8] = {w0.x, w0.y, w0.z, w0.w, w1.x, w1.y, w1.z, w1.w};
#pragma unroll
      for (int e = 0; e < 8; ++e) fa[e] = fa[e] * rs * wv[e];
      if (u == 0 || has1) *(uint4*)(YBn + (size_t)r * 2048 + c8) = pack8(fa);
    }
  }
}

#define XB_TMO      128
#define XB_XCNT(j)  (256  + 64 * (j))
#define XB_XSUB(j)  (1280 + 64 * (j))
#define XB_XGEN(j)  (2304 + 64 * (j))
#define XB_TOP      3328
#define XB_TOPGEN   3392
#define XCD_BAR_WORDS 3456
#define XB_SPIN_CAP (1u << 18)
#define LAS __attribute__((address_space(3)))

__device__ __forceinline__ unsigned xb_ld(unsigned* p)              { return __hip_atomic_load(p, __ATOMIC_RELAXED, __HIP_MEMORY_SCOPE_AGENT); }
__device__ __forceinline__ unsigned xb_add(unsigned* p, unsigned v) { return __hip_atomic_fetch_add(p, v, __ATOMIC_RELAXED, __HIP_MEMORY_SCOPE_AGENT); }
__device__ __forceinline__ unsigned xb_xcc_id() { return (unsigned)__builtin_amdgcn_s_getreg((3 << 11) | 20) & 0xFu; }
#define XB_SPIN(cond, bar) do { unsigned _sp = 0; while (cond) { __builtin_amdgcn_s_sleep(1); \
    if ((++_sp & 255u) == 0u) { if (xb_ld(&(bar)[XB_TMO])) break; if (_sp > XB_SPIN_CAP) { atomicAdd(&(bar)[XB_TMO], 1u); break; } } } } while (0)

struct XcdBarrier {
    unsigned* bar; unsigned x;
    volatile LAS unsigned* st;
};

__device__ __forceinline__ XcdBarrier xcd_barrier_post(unsigned* bar, volatile LAS unsigned* st) {
    XcdBarrier b; b.bar = bar; b.x = xb_xcc_id(); b.st = st;
    if (threadIdx.x == 0) (void)xb_add(&bar[XB_XCNT(b.x)], 1u);
    return b;
}
__device__ __forceinline__ void xcd_barrier_complete(unsigned* bar, unsigned x, unsigned& nloc, unsigned& nx) {
    const unsigned G = gridDim.x * gridDim.y * gridDim.z;
    unsigned sum, cnt, mine, sp = 0u;
    for (;;) {
        sum = 0u; cnt = 0u; mine = 0u;
#pragma unroll
        for (unsigned j = 0; j < 16; ++j) { const unsigned c = xb_ld(&bar[XB_XCNT(j)]); sum += c; cnt += (c > 0u) ? 1u : 0u; mine = (j == x) ? c : mine; }
        if (sum == G) break;
        __builtin_amdgcn_s_sleep(1);
        if ((++sp & 255u) == 0u) { if (xb_ld(&bar[XB_TMO])) break; if (sp > XB_SPIN_CAP) { atomicAdd(&bar[XB_TMO], 1u); break; } }
    }
    nloc = mine > 0u ? mine : 1u; nx = cnt > 0u ? cnt : 1u;
}

__device__ __forceinline__ void xcd_barrier(const XcdBarrier& b) {
    asm volatile("s_waitcnt vmcnt(0)" ::: "memory");
    __syncthreads();
    if (threadIdx.x == 0) {
        unsigned* bar = b.bar;
        __builtin_amdgcn_s_waitcnt(0);
        unsigned nloc = b.st[0], nx = b.st[1];
        if (nloc == 0u) { xcd_barrier_complete(bar, b.x, nloc, nx); b.st[0] = nloc; b.st[1] = nx; }
        const unsigned old = xb_add(&bar[XB_XSUB(b.x)], 1u);
        const unsigned gen = old / nloc;
        if (old + 1u == (gen + 1u) * nloc) {
            __builtin_amdgcn_fence(__ATOMIC_RELEASE, "agent");
            asm volatile("s_waitcnt vmcnt(0)" ::: "memory");
            const unsigned og = xb_add(&bar[XB_TOP], 1u);
            const unsigned tg = og / nx;
            if (og + 1u == (tg + 1u) * nx) xb_add(&bar[XB_TOPGEN], 1u);
            else XB_SPIN(xb_ld(&bar[XB_TOPGEN]) == tg, bar);
            __builtin_amdgcn_fence(__ATOMIC_ACQUIRE, "agent");
            xb_add(&bar[XB_XGEN(b.x)], 1u);
            asm volatile("s_waitcnt vmcnt(0)" ::: "memory");
        } else {
            XB_SPIN(xb_ld(&bar[XB_XGEN(b.x)]) == gen, bar);
            __builtin_amdgcn_fence(__ATOMIC_ACQUIRE, "agent");
            asm volatile("s_waitcnt vmcnt(0)" ::: "memory");
        }
    }
    __syncthreads();
}

#ifndef STOP_AFTER
#define STOP_AFTER 0
#endif
#define SYNC() { xcd_barrier(xb); if (++nsync == STOP_AFTER) return; }
#define PH(CALL) { CALL; }
__global__ void __launch_bounds__(256, 2) mega(Params p) {
  cg::grid_group grid = cg::this_grid();
  int nsync = 0;
  __shared__ __attribute__((aligned(16))) unsigned char smem[SMEM_BYTES];
  __shared__ uint4 xb_words;
  if (threadIdx.x == 0) xb_words = make_uint4(0u, 0u, 0u, 0u);
  __syncthreads();
  XcdBarrier xb = xcd_barrier_post((unsigned*)(p.ws + OFF_BAR), (volatile LAS unsigned*)&xb_words);
  float* smf = (float*)smem; bf16_t* smh = (bf16_t*)smem;
  for (int l = 0; l < 2; ++l) {
    PH(transpose_phase(p.w_in + (size_t)l * 1024 * IN_DIM, (bf16_t*)(p.ws + OFF_WIN), 1024, IN_DIM, LDP, smf))
    PH(transpose_phase(p.w_proj_gdn + (size_t)l * 1024 * 1024, (bf16_t*)(p.ws + OFF_WPG), 1024, 1024, 1024, smf))
    PH(transpose_phase(p.w_proj_ssm + (size_t)l * 2048 * 1024, (bf16_t*)(p.ws + OFF_WPS), 2048, 1024, 1024, smf))
    PH(transpose_phase(p.w_out + (size_t)l * 1024 * 1024, (bf16_t*)(p.ws + OFF_WOUT), 1024, 1024, 1024, smf))
    PH(transpose_phase(p.w_ff1 + (size_t)l * 1024 * 4096, (bf16_t*)(p.ws + OFF_WFF1), 1024, 4096, 4096, smf))
    PH(transpose_phase(p.w_ff2 + (size_t)l * 4096 * 1024, (bf16_t*)(p.ws + OFF_WFF2), 4096, 1024, 1024, smf))
    if (l == 0) { PH(modpart_phase(p, smf)) grid.sync(); PH(modfinal_phase(p)) }
    SYNC();
    const bool last = (l == 1);
    const int Mpost = last ? MLAT : MG;
    constexpr int PRE = 19;
    PH(modulate_phase(p, l, 0, OFF_H)) SYNC();
    PH(gemm_inproj_phase(p, smh, 0, GDIM(), BIDX(), OFF_H, 0, 58)) SYNC();
    for (int g = 0; g < NGRP; ++g) {
      const bool more = (g + 1 < NGRP);
      const size_t hcur = (g & 1) ? OFF_HB : OFF_H, hnxt = (g & 1) ? OFF_H : OFF_HB;
      PH(conv_phase(p, l))
      if (more) { PH(modulate_phase(p, l, g + 1, hnxt)) }
      SYNC();
      PH(gdn_prep_phase(p, smem)) SYNC();
      {
        const int nb_ = GDIM(), v_ = BIDX();
        if (nb_ >= 512) {
          if (v_ < 256) { PH(scan_phase(p, smem, 256, v_)) }
          else { PH(gemm_inproj_phase(p, smh, 1, nb_ - 256, v_ - 256, hcur, 0, 39)) if (more) { PH(gemm_inproj_phase(p, smh, 0, nb_ - 256, v_ - 256, hnxt, 0, PRE)) } }
        } else {
          PH(scan_phase(p, smem, nb_, v_)) PH(gemm_inproj_phase(p, smh, 1, nb_, v_, hcur, 0, 39))
          if (more) { PH(gemm_inproj_phase(p, smh, 0, nb_, v_, hnxt, 0, PRE)) }
        }
      }
      SYNC();
      PH(gnorm_phase(p, l, Mpost)) SYNC();
      PH(gemm_proj_phase(p, Mpost, smh, hcur)) SYNC();
      PH(gemm_wout_phase(p, l, g, Mpost, smh, hcur)) SYNC();
      PH(ln_phase(p, l, g, Mpost, p.ln1_g + l * D, p.ln1_b + l * D, true, hcur)) SYNC();
      PH(gemm_ff1_phase(p, l, Mpost, smh, hcur)) SYNC();
      PH(gemm_ff2_phase(p, l, g, Mpost, smh)) SYNC();
      PH(ln_phase(p, l, g, Mpost, p.ln2_g + l * D, p.ln2_b + l * D, false, hcur)) SYNC();
      if (more) { PH(gemm_inproj_phase(p, smh, 0, GDIM(), BIDX(), hnxt, PRE, 58)) SYNC(); }
    }
  }
}

extern "C" void kernel_launch(void* const* d_in, const int* in_sizes, int n_in, void* d_out, int out_size, void* d_ws, size_t ws_size,
                              hipStream_t stream) {
  static int grid_blocks = 0;
  if (!grid_blocks) {
    int dev = 0, cus = 0, per_cu = 0;
    (void)hipGetDevice(&dev);
    (void)hipDeviceGetAttribute(&cus, hipDeviceAttributeMultiprocessorCount, dev);
    (void)hipOccupancyMaxActiveBlocksPerMultiprocessor(&per_cu, mega, 256, 0);
    if (per_cu > 2) per_cu = 2;
    grid_blocks = cus * per_cu;
    if (ws_size < WS_TOTAL) fprintf(stderr, "workspace too small: %zu < %zu\n", ws_size, WS_TOTAL);
  }
  Params p{};
  const float** pp = (const float**)&p;
  for (int i = 0; i < 28; ++i) pp[i] = (const float*)d_in[i];
  p.out = (float*)d_out;
  p.ws = (unsigned char*)d_ws;
  (void)hipMemsetAsync((unsigned char*)d_ws + OFF_BAR, 0, 16384, stream);
  void* args[] = {&p};
  hipError_t e = hipLaunchCooperativeKernel((void*)mega, dim3(grid_blocks), dim3(256), args, 0, stream);
  if (e != hipSuccess) fprintf(stderr, "cooperative launch failed: %s (grid %d)\n", hipGetErrorString(e), grid_blocks);
}
```

```cpp
#include <hip/hip_runtime.h>
#include <hip/hip_cooperative_groups.h>
#include <cstdio>
namespace cg = cooperative_groups;

typedef unsigned short bf16_t;
typedef short bf16x8 __attribute__((ext_vector_type(8)));
typedef float f32x4 __attribute__((ext_vector_type(4)));
typedef float f32x2 __attribute__((ext_vector_type(2)));
typedef unsigned u32x4 __attribute__((ext_vector_type(4)));

constexpr int D = 1024, SEQ = 8192, LC = 256;
constexpr int G = 2, NGRP = 4;
constexpr int MLAT = G * SEQ, MCTX = G * LC, MG = MLAT + MCTX;
constexpr int IN_DIM = 12384, LDP = 12416;
constexpr int C_GOUT = 3072, C_A = 4096, C_B = 4112, C_Z = 4128, C_XBC = 6176, C_DT = 10272, C_GA = 10336, C_GB = 11360;
constexpr float DN_ALPHA = 1.4142135623730951f;

constexpr size_t SZ_WIN = (size_t)LDP * 1024 * 2;
constexpr size_t OFF_WIN = 0;
constexpr size_t OFF_WPG = OFF_WIN + SZ_WIN;
constexpr size_t OFF_WPS = OFF_WPG + 2097152;
constexpr size_t OFF_WOUT = OFF_WPS + 4194304;
constexpr size_t OFF_WFF1 = OFF_WOUT + 2097152;
constexpr size_t OFF_WFF2 = OFF_WFF1 + 8388608;
constexpr size_t OFF_MODP = OFF_WFF2 + 8388608;
constexpr size_t OFF_MOD = OFF_MODP + (size_t)2 * 16 * 9 * 6144 * 4;
constexpr size_t OFF_XSC = OFF_MOD + (size_t)2 * 9 * 6144 * 4;
constexpr size_t OFF_H = OFF_XSC + (size_t)2048 * 1024 * 4;
constexpr size_t OFF_P = OFF_H + (size_t)MG * 1024 * 2;
constexpr size_t OFF_QKV = OFF_P + (size_t)MG * LDP * 2;
constexpr size_t OFF_XBC = OFF_QKV + (size_t)MG * 3072 * 2;
constexpr size_t OFF_GBF = OFF_XBC + (size_t)MG * 4096 * 2;
constexpr size_t OFF_DTF = OFF_GBF + (size_t)MG * 32 * 4;
constexpr size_t OFF_OF = OFF_DTF + (size_t)MG * 128 * 4;
constexpr size_t OFF_OB = OFF_OF + (size_t)MG * 1024 * 2;
constexpr size_t OFF_YF = OFF_OB + (size_t)MG * 1024 * 2;
constexpr size_t OFF_YB = OFF_YF + (size_t)MG * 2048 * 2;
constexpr size_t OFF_TMB = OFF_YB + (size_t)MG * 2048 * 2;
constexpr int GDN_NITEM = G * 8 * 2 * 264;
constexpr size_t OFF_BAR = OFF_TMB + (size_t)GDN_NITEM * 2048 * 2;
constexpr size_t OFF_HB = OFF_BAR + 16384;
constexpr size_t WS_TOTAL = OFF_HB + (size_t)MG * 1024 * 2;
static_assert(WS_TOTAL <= ((size_t)1024 << 20), "workspace plan exceeds 1 GiB");

struct Params {
  const float *x, *c, *ctx, *c_ctx, *w_mod, *b_mod, *w_in, *gdn_conv_w, *gdn_A_log, *gdn_dt_bias, *gdn_norm_w;
  const float *ssm_conv_w, *ssm_conv_b, *ssm_A_log, *ssm_dt_bias, *ssm_D, *ssm_norm_w, *w_proj_gdn, *w_proj_ssm, *w_out;
  const float *ln1_g, *ln1_b, *w_ff1, *b_ff1, *w_ff2, *b_ff2, *ln2_g, *ln2_b;
  float* out;
  unsigned char* ws;
};

constexpr int SMEM_BYTES = 73728;


__device__ __forceinline__ int TIDX() { int t = threadIdx.x; asm volatile("" : "+v"(t)); return t; }
__device__ __forceinline__ int BIDX() { int t = blockIdx.x; asm volatile("" : "+s"(t)); return t; }
__device__ __forceinline__ int GDIM() { int t = gridDim.x; asm volatile("" : "+s"(t)); return t; }
__device__ __forceinline__ float bf2f(bf16_t b) { return __uint_as_float(((unsigned)b) << 16); }
__device__ __forceinline__ bf16_t f2bf(float f) { unsigned u = __float_as_uint(f); u += 0x7fffu + ((u >> 16) & 1u); return (bf16_t)(u >> 16); }
typedef __bf16 bf16v2 __attribute__((ext_vector_type(2)));
__device__ __forceinline__ unsigned pack2(float a, float b) { const f32x2 v = (f32x2){a, b}; const bf16v2 h = __builtin_convertvector(v, bf16v2); return __builtin_bit_cast(unsigned, h); }
__device__ __forceinline__ float lo16(unsigned v) { return __uint_as_float(v << 16); }
__device__ __forceinline__ float hi16(unsigned v) { return __uint_as_float(v & 0xffff0000u); }
#define UNPACK8(v, f) { f[0] = lo16(v.x); f[1] = hi16(v.x); f[2] = lo16(v.y); f[3] = hi16(v.y); f[4] = lo16(v.z); f[5] = hi16(v.z); f[6] = lo16(v.w); f[7] = hi16(v.w); }
__device__ __forceinline__ uint4 pack8(const float* f) { uint4 r; r.x = pack2(f[0], f[1]); r.y = pack2(f[2], f[3]); r.z = pack2(f[4], f[5]); r.w = pack2(f[6], f[7]); return r; }
__device__ __forceinline__ float sigmoidf_(float x) { return __builtin_amdgcn_rcpf(1.f + __expf(-x)); }
__device__ __forceinline__ float siluf_(float x) { return x * __builtin_amdgcn_rcpf(1.f + __expf(-x)); }
__device__ __forceinline__ float softplusf_(float x) { return x > 20.f ? x : log1pf(__expf(x)); }
template <int CTRL> __device__ __forceinline__ float dppf(float x) { return __builtin_bit_cast(float, __builtin_amdgcn_mov_dpp(__builtin_bit_cast(int, x), CTRL, 0xf, 0xf, true)); }
__device__ __forceinline__ float reduce16(float x) { x += dppf<0xB1>(x); x += dppf<0x4E>(x); x += dppf<0x141>(x); x += dppf<0x140>(x); return x; }

__device__ __forceinline__ float* xs_row(const Params& p, int g, int r) {
  return (r < MLAT) ? p.out + ((size_t)g * MLAT + r) * D : (float*)(p.ws + OFF_XSC) + ((size_t)g * MCTX + (r - MLAT)) * D;
}
__device__ __forceinline__ const float* xin_row(const Params& p, int l, int g, int r) {
  if (l == 0) return (r < MLAT) ? p.x + ((size_t)g * MLAT + r) * D : p.ctx + ((size_t)g * MCTX + (r - MLAT)) * D;
  return xs_row(p, g, r);
}
__device__ __forceinline__ int mod_row(int g, int r) { return r < MLAT ? g * G + r / SEQ : 8; }
__device__ __forceinline__ int gdn_rowof(int b_l, int dir, int s) {
  if (s < 256) { const int i = dir ? 255 - s : s; return MLAT + b_l * 256 + i; }
  const int i = s - 256; return b_l * 8192 + (dir ? 8191 - i : i);
}
__device__ __forceinline__ int ssd_rowof(int b_l, int dir, int s) {
  if (s < 256) { const int i = dir ? 255 - s : s; return MLAT + b_l * 256 + i; }
  const int j = s - 256; const int pos = dir ? 8191 - j : j; return b_l * 8192 + (pos & 127) * 64 + (pos >> 7);
}

__device__ __forceinline__ void transpose_phase(const float* __restrict__ src, bf16_t* __restrict__ dst, int K, int N, int Npad, float* tile) {
  const int tid = TIDX(), tk = K / 64, tn = Npad / 64;
  const int c = tid & 63, r4 = tid >> 6;
  for (int t = BIDX(); t < tk * tn; t += GDIM()) {
    const int kt = t % tk, nt = t / tk, k0 = kt * 64, n0 = nt * 64;
    __syncthreads();
#pragma unroll 4
    for (int i = 0; i < 16; ++i) { const int r = i * 4 + r4, n = n0 + c; tile[r * 65 + c] = (n < N) ? src[(size_t)(k0 + r) * N + n] : 0.f; }
    __syncthreads();
#pragma unroll 4
    for (int i = 0; i < 16; ++i) { const int nn = i * 4 + r4; dst[(size_t)(n0 + nn) * K + k0 + c] = f2bf(tile[c * 65 + nn]); }
  }
}

__device__ __forceinline__ void modpart_phase(const Params& p, float* sm) {
  const int tid = TIDX();
  float* MODP = (float*)(p.ws + OFF_MODP);
  for (int item = BIDX(); item < 2 * 24 * 16; item += GDIM()) {
    const int l = item / 384, rem = item % 384, cbk = rem / 16, ks = rem % 16;
    __syncthreads();
    for (int i = tid; i < 9 * 64; i += 256) { const int r = i / 64, k = ks * 64 + (i % 64); const float v = (r < 8) ? p.c[r * D + k] : p.c_ctx[k]; sm[i] = siluf_(v); }
    __syncthreads();
    const int col = cbk * 256 + tid;
    float acc[9];
#pragma unroll
    for (int r = 0; r < 9; ++r) acc[r] = 0.f;
    const float* wp = p.w_mod + ((size_t)l * D + ks * 64) * 6144 + col;
#pragma unroll 8
    for (int k = 0; k < 64; ++k) { const float w = wp[(size_t)k * 6144];
#pragma unroll
      for (int r = 0; r < 9; ++r) acc[r] += sm[r * 64 + k] * w; }
#pragma unroll
    for (int r = 0; r < 9; ++r) MODP[(((size_t)l * 16 + ks) * 9 + r) * 6144 + col] = acc[r];
  }
}
__device__ __forceinline__ void modfinal_phase(const Params& p) {
  const float* MODP = (const float*)(p.ws + OFF_MODP);
  float* MOD = (float*)(p.ws + OFF_MOD);
  for (int i = BIDX() * 256 + TIDX(); i < 2 * 9 * 6144; i += GDIM() * 256) {
    const int l = i / (9 * 6144), rem = i % (9 * 6144), col = rem % 6144;
    float s = p.b_mod[l * 6144 + col];
    for (int ks = 0; ks < 16; ++ks) s += MODP[((size_t)l * 16 + ks) * 9 * 6144 + rem];
    MOD[i] = s;
  }
}

__device__ __forceinline__ void modulate_phase(const Params& p, int l, int g, size_t hoff) {
  const float* MOD = (const float*)(p.ws + OFF_MOD) + (size_t)l * 9 * 6144;
  bf16_t* H = (bf16_t*)(p.ws + hoff);
  for (int i = BIDX() * 256 + TIDX(); i < MG * 128; i += GDIM() * 256) {
    const int r = i >> 7, ch = (i & 127) * 8;
    const float* xr = xin_row(p, l, g, r) + ch;
    const float* m = MOD + (size_t)mod_row(g, r) * 6144;
    const float4 x0 = *(const float4*)xr, x1 = *(const float4*)(xr + 4);
    const float4 sh0 = *(const float4*)(m + ch), sh1 = *(const float4*)(m + ch + 4);
    const float4 sc0 = *(const float4*)(m + 1024 + ch), sc1 = *(const float4*)(m + 1024 + ch + 4);
    float f[8] = {x0.x * (1.f + sc0.x) + sh0.x, x0.y * (1.f + sc0.y) + sh0.y, x0.z * (1.f + sc0.z) + sh0.z, x0.w * (1.f + sc0.w) + sh0.w,
                  x1.x * (1.f + sc1.x) + sh1.x, x1.y * (1.f + sc1.y) + sh1.y, x1.z * (1.f + sc1.z) + sh1.z, x1.w * (1.f + sc1.w) + sh1.w};
    *(uint4*)(H + (size_t)r * D + ch) = pack8(f);
  }
}

struct Seg { const bf16_t* ap; const bf16_t* bp; int lda, ldb, nk; };

__device__ __forceinline__ bool tile_coord_sub(int it, int nM, int nN, int nb, int v, int& mt, int& nt) {
  long s;
  if ((nb & 7) == 0) { const int per = nb >> 3; s = (long)it * nb + (v & 7) * per + (v >> 3); } else s = (long)it * nb + v;
  if (s >= (long)nM * nN) return false;
  const int band = (int)(s / (8 * nN)), r = (int)(s - (long)band * 8 * nN);
  const int bsz = (nM - band * 8) < 8 ? (nM - band * 8) : 8;
  nt = r / bsz; mt = band * 8 + (r % bsz);
  return true;
}
__device__ __forceinline__ bool tile_coord(int it, int nM, int nN, int& mt, int& nt) { return tile_coord_sub(it, nM, nN, GDIM(), BIDX(), mt, nt); }
__device__ __forceinline__ int inproj_ntile(int part, int e) {
  if (part == 0) return e < 24 ? e : (e == 24 ? 32 : 23 + e);
  return e < 8 ? 24 + e : (e < 23 ? 25 + e : 58 + e);
}

#define ZERO_ACC(acc) { _Pragma("unroll") for (int i_ = 0; i_ < 4; ++i_) { _Pragma("unroll") for (int j_ = 0; j_ < 4; ++j_) acc[i_][j_] = (f32x4){0.f, 0.f, 0.f, 0.f}; } }
#define EPI_LOOP(...) { const int lane_ = TIDX() & 63, w_ = TIDX() >> 6; \
  _Pragma("unroll") for (int i_ = 0; i_ < 4; ++i_) { const int row = m0 + (w_ >> 1) * 64 + i_ * 16 + (lane_ & 15); \
  _Pragma("unroll") for (int j_ = 0; j_ < 4; ++j_) { const int col = n0 + (w_ & 1) * 64 + j_ * 16 + (lane_ >> 4) * 4; f32x4& v = acc[i_][j_]; __VA_ARGS__ } } }

__device__ __forceinline__ int perm_brow(int lr) { return 8 * ((lr & 15) >> 2) + 4 * ((lr >> 4) & 1) + (lr & 3); }
#define EPI8_LOOP(...) { const int lane_ = TIDX() & 63, w_ = TIDX() >> 6; \
  _Pragma("unroll") for (int i_ = 0; i_ < 4; ++i_) { const int row = m0 + (w_ >> 1) * 64 + i_ * 16 + (lane_ & 15); \
  _Pragma("unroll") for (int a_ = 0; a_ < 2; ++a_) { const int col = n0 + (w_ & 1) * 64 + a_ * 32 + (lane_ >> 4) * 8; f32x4& v0 = acc[i_][2 * a_]; f32x4& v1 = acc[i_][2 * a_ + 1]; __VA_ARGS__ } } }

template <class Prob>
__device__ __forceinline__ void gemm_stream(Prob& pr, bf16_t* sm) {
  const int tid = TIDX(), lane = tid & 63, w = tid >> 6, wr = w >> 1, wc = w & 1;
  const int lr = tid >> 3, lk = (tid & 7) * 8;
  const int fr = lane & 15, fq = lane >> 4;
  const int aoff = (wr * 64 + fr) * 72 + fq * 8, boff = 9216 + (wc * 64 + fr) * 72 + fq * 8;
  const int soff = lr * 72 + lk;
  Seg cur, nxt;
  if (!pr.seg(0, cur, lr, lk)) return;
  bool has_nxt = pr.seg(1, nxt, lr, lk);
  u32x4 r0a[4], r0b[4], r1a[4], r1b[4];
#pragma unroll
  for (int i = 0; i < 4; ++i) { r0a[i] = (u32x4){0u, 0u, 0u, 0u}; r0b[i] = r0a[i]; r1a[i] = r0a[i]; r1b[i] = r0a[i]; }
  f32x4 acc[4][4];
#define GS_LOAD(RA, RB, KT) { const int kt_ = (KT); const bf16_t* ap_ = cur.ap; const bf16_t* bp_ = cur.bp; int lda_ = cur.lda, ldb_ = cur.ldb; \
    if (kt_ < cur.nk) { ap_ += kt_ * 64; bp_ += kt_ * 64; } \
    else if (has_nxt) { ap_ = nxt.ap + (kt_ - cur.nk) * 64; bp_ = nxt.bp + (kt_ - cur.nk) * 64; lda_ = nxt.lda; ldb_ = nxt.ldb; } \
      \
    _Pragma("unroll") for (int i = 0; i < 4; ++i) { RA[i] = *(const u32x4*)(ap_ + (size_t)i * 32 * lda_); RB[i] = *(const u32x4*)(bp_ + (size_t)i * 32 * ldb_); } }
#define GS_STORE(RA, RB, KT, STAGE) { bf16_t* st_ = (STAGE) + soff; \
    _Pragma("unroll") for (int i = 0; i < 4; ++i) { *(u32x4*)(st_ + i * 32 * 72) = RA[i]; *(u32x4*)(st_ + 9216 + i * 32 * 72) = RB[i]; } }
#define GS_COMPUTE(STAGE) { const bf16_t* cs_ = (STAGE); bf16x8 af0[4], bf0[4], af1[4], bf1[4]; \
    _Pragma("unroll") for (int i = 0; i < 4; ++i) { af0[i] = *(const bf16x8*)(cs_ + aoff + i * 16 * 72); bf0[i] = *(const bf16x8*)(cs_ + boff + i * 16 * 72); } \
    _Pragma("unroll") for (int i = 0; i < 4; ++i) { af1[i] = *(const bf16x8*)(cs_ + aoff + i * 16 * 72 + 32); bf1[i] = *(const bf16x8*)(cs_ + boff + i * 16 * 72 + 32); } \
    _Pragma("unroll") for (int i = 0; i < 4; ++i) { _Pragma("unroll") for (int j = 0; j < 4; ++j) acc[i][j] = __builtin_amdgcn_mfma_f32_16x16x32_bf16(bf0[j], af0[i], acc[i][j], 0, 0, 0); } \
    _Pragma("unroll") for (int i = 0; i < 4; ++i) { _Pragma("unroll") for (int j = 0; j < 4; ++j) acc[i][j] = __builtin_amdgcn_mfma_f32_16x16x32_bf16(bf1[j], af1[i], acc[i][j], 0, 0, 0); } }
#define GS_SCHED() { __builtin_amdgcn_sched_group_barrier(0x100, 8, 0); \
    _Pragma("unroll") for (int q_ = 0; q_ < 8; ++q_) { __builtin_amdgcn_sched_group_barrier(0x008, 2, 0); __builtin_amdgcn_sched_group_barrier(0x100, 1, 0); __builtin_amdgcn_sched_group_barrier(0x020, 1, 0); } \
    _Pragma("unroll") for (int q_ = 0; q_ < 8; ++q_) { __builtin_amdgcn_sched_group_barrier(0x008, 2, 0); __builtin_amdgcn_sched_group_barrier(0x200, 1, 0); } }
  GS_LOAD(r0a, r0b, 0)
  __syncthreads();
  GS_STORE(r0a, r0b, 0, sm)
  __syncthreads();
  GS_LOAD(r0a, r0b, 1)
  __builtin_amdgcn_sched_barrier(0);
  for (int idx = 0;; ++idx) {
    pr.begin(idx, acc);
    for (int kt = 0; kt < cur.nk; kt += 2) {
      GS_LOAD(r1a, r1b, kt + 2)
      GS_COMPUTE(sm)
      GS_STORE(r0a, r0b, kt + 1, sm + 18432)
      GS_SCHED()
      __syncthreads();
      GS_LOAD(r0a, r0b, kt + 3)
      GS_COMPUTE(sm + 18432)
      GS_STORE(r1a, r1b, kt + 2, sm)
      GS_SCHED()
      __syncthreads();
    }
    pr.end(idx, acc);
    if (!has_nxt) break;
    cur = nxt; has_nxt = pr.seg(idx + 2, nxt, lr, lk);
  }
#undef GS_LOAD
#undef GS_STORE
#undef GS_COMPUTE
#undef GS_SCHED
}

__device__ __forceinline__ void gemm_inproj_phase(const Params& p, bf16_t* sm, int part, int nb, int v, size_t hoff, int e0, int e1) {
  struct Pr {
    const bf16_t* A; const bf16_t* W; bf16_t* P; int nM, nN, part, nb, v, e0;
    __device__ bool seg(int idx, Seg& s, int lr, int lk) const { int mt, e; if (!tile_coord_sub(idx, nM, nN, nb, v, mt, e)) return false; const int nt = inproj_ntile(part, e0 + e);
      s.ap = A + (size_t)(mt * 128 + lr) * D + lk; s.bp = W + (size_t)(nt * 128 + perm_brow(lr)) * D + lk; s.lda = D; s.ldb = D; s.nk = 16; return true; }
    __device__ void begin(int, f32x4 (&acc)[4][4]) const { ZERO_ACC(acc) }
    __device__ void end(int idx, f32x4 (&acc)[4][4]) const { int mt, e; tile_coord_sub(idx, nM, nN, nb, v, mt, e); const int m0 = mt * 128, n0 = inproj_ntile(part, e0 + e) * 128;
      EPI8_LOOP({ uint4 o; o.x = pack2(v0[0], v0[1]); o.y = pack2(v0[2], v0[3]); o.z = pack2(v1[0], v1[1]); o.w = pack2(v1[2], v1[3]); *(uint4*)(P + (size_t)row * LDP + col) = o; }) }
  } pr{(const bf16_t*)(p.ws + hoff), (const bf16_t*)(p.ws + OFF_WIN), (bf16_t*)(p.ws + OFF_P), MG / 128, e1 - e0, part, nb, v, e0};
  gemm_stream(pr, sm);
}
__device__ __forceinline__ void gemm_proj_phase(const Params& p, int M, bf16_t* sm, size_t hoff) {
  struct Pr {
    const bf16_t* YA; const bf16_t* YBn; const bf16_t* Wg; const bf16_t* Ws; const bf16_t* P; bf16_t* U; int nM, nN;
    __device__ bool seg(int idx, Seg& s, int lr, int lk) const { int mt, nt; if (!tile_coord(idx >> 1, nM, nN, mt, nt)) return false;
      if ((idx & 1) == 0) { s.ap = YA + (size_t)(mt * 128 + lr) * 1024 + lk; s.bp = Wg + (size_t)(nt * 128 + perm_brow(lr)) * 1024 + lk; s.lda = 1024; s.ldb = 1024; s.nk = 16; }
      else { s.ap = YBn + (size_t)(mt * 128 + lr) * 2048 + lk; s.bp = Ws + (size_t)(nt * 128 + perm_brow(lr)) * 2048 + lk; s.lda = 2048; s.ldb = 2048; s.nk = 32; }
      return true; }
    __device__ void begin(int idx, f32x4 (&acc)[4][4]) const { if ((idx & 1) == 0) ZERO_ACC(acc) }
    __device__ void end(int idx, f32x4 (&acc)[4][4]) const { int mt, nt; tile_coord(idx >> 1, nM, nN, mt, nt); const int m0 = mt * 128, n0 = nt * 128;
      if ((idx & 1) == 0) {
        EPI8_LOOP({ const uint4 ga = *(const uint4*)(P + (size_t)row * LDP + C_GA + col); const uint4 gb = *(const uint4*)(P + (size_t)row * LDP + C_GB + col);
          v0[0] *= (1.f + __expf(-lo16(gb.x))) / (1.f + __expf(-lo16(ga.x))); v0[1] *= (1.f + __expf(-hi16(gb.x))) / (1.f + __expf(-hi16(ga.x)));
          v0[2] *= (1.f + __expf(-lo16(gb.y))) / (1.f + __expf(-lo16(ga.y))); v0[3] *= (1.f + __expf(-hi16(gb.y))) / (1.f + __expf(-hi16(ga.y)));
          v1[0] *= (1.f + __expf(-lo16(gb.z))) / (1.f + __expf(-lo16(ga.z))); v1[1] *= (1.f + __expf(-hi16(gb.z))) / (1.f + __expf(-hi16(ga.z)));
          v1[2] *= (1.f + __expf(-lo16(gb.w))) / (1.f + __expf(-lo16(ga.w))); v1[3] *= (1.f + __expf(-hi16(gb.w))) / (1.f + __expf(-hi16(ga.w))); })
      } else {
        EPI8_LOOP({ const uint4 gb = *(const uint4*)(P + (size_t)row * LDP + C_GB + col);
          uint4 o; o.x = pack2(v0[0] * sigmoidf_(lo16(gb.x)), v0[1] * sigmoidf_(hi16(gb.x))); o.y = pack2(v0[2] * sigmoidf_(lo16(gb.y)), v0[3] * sigmoidf_(hi16(gb.y)));
          o.z = pack2(v1[0] * sigmoidf_(lo16(gb.z)), v1[1] * sigmoidf_(hi16(gb.z))); o.w = pack2(v1[2] * sigmoidf_(lo16(gb.w)), v1[3] * sigmoidf_(hi16(gb.w)));
          *(uint4*)(U + (size_t)row * D + col) = o; })
      } }
  } pr{(const bf16_t*)(p.ws + OFF_QKV), (const bf16_t*)(p.ws + OFF_QKV) + (size_t)MG * 1024, (const bf16_t*)(p.ws + OFF_WPG), (const bf16_t*)(p.ws + OFF_WPS),
       (const bf16_t*)(p.ws + OFF_P), (bf16_t*)(p.ws + hoff), M / 128, 8};
  gemm_stream(pr, sm);
}
__device__ __forceinline__ void gemm_wout_phase(const Params& p, int l, int g, int M, bf16_t* sm, size_t hoff) {
  struct Pr {
    const Params& p; int l, g; const bf16_t* U; const bf16_t* W; const float* MOD; int nM, nN;
    __device__ bool seg(int idx, Seg& s, int lr, int lk) const { int mt, nt; if (!tile_coord(idx, nM, nN, mt, nt)) return false;
      s.ap = U + (size_t)(mt * 128 + lr) * D + lk; s.bp = W + (size_t)(nt * 128 + perm_brow(lr)) * D + lk; s.lda = D; s.ldb = D; s.nk = 16; return true; }
    __device__ void begin(int, f32x4 (&acc)[4][4]) const { ZERO_ACC(acc) }
    __device__ void end(int idx, f32x4 (&acc)[4][4]) const { int mt, nt; tile_coord(idx, nM, nN, mt, nt); const int m0 = mt * 128, n0 = nt * 128;
      EPI8_LOOP({ const float* xp = xin_row(p, l, g, row) + col; const float* gp = MOD + (size_t)mod_row(g, row) * 6144 + 2048 + col; float* op = xs_row(p, g, row) + col;
        const float4 xa = *(const float4*)xp, xb = *(const float4*)(xp + 4), ga = *(const float4*)gp, gb = *(const float4*)(gp + 4);
        float4 oa, ob; oa.x = DN_ALPHA * xa.x + ga.x * v0[0]; oa.y = DN_ALPHA * xa.y + ga.y * v0[1]; oa.z = DN_ALPHA * xa.z + ga.z * v0[2]; oa.w = DN_ALPHA * xa.w + ga.w * v0[3];
        ob.x = DN_ALPHA * xb.x + gb.x * v1[0]; ob.y = DN_ALPHA * xb.y + gb.y * v1[1]; ob.z = DN_ALPHA * xb.z + gb.z * v1[2]; ob.w = DN_ALPHA * xb.w + gb.w * v1[3];
        *(float4*)op = oa; *(float4*)(op + 4) = ob; }) }
  } pr{p, l, g, (const bf16_t*)(p.ws + hoff), (const bf16_t*)(p.ws + OFF_WOUT), (const float*)(p.ws + OFF_MOD) + (size_t)l * 9 * 6144, M / 128, 8};
  gemm_stream(pr, sm);
}
__device__ __forceinline__ void gemm_ff1_phase(const Params& p, int l, int M, bf16_t* sm, size_t hoff) {
  struct Pr {
    const bf16_t* H; const bf16_t* W; bf16_t* HID; const float* b1; int nM, nN;
    __device__ bool seg(int idx, Seg& s, int lr, int lk) const { int mt, nt; if (!tile_coord(idx, nM, nN, mt, nt)) return false;
      s.ap = H + (size_t)(mt * 128 + lr) * D + lk; s.bp = W + (size_t)(nt * 128 + perm_brow(lr)) * D + lk; s.lda = D; s.ldb = D; s.nk = 16; return true; }
    __device__ void begin(int, f32x4 (&acc)[4][4]) const { ZERO_ACC(acc) }
    __device__ void end(int idx, f32x4 (&acc)[4][4]) const { int mt, nt; tile_coord(idx, nM, nN, mt, nt); const int m0 = mt * 128, n0 = nt * 128;
      EPI8_LOOP({ const float4 ba = *(const float4*)(b1 + col), bb = *(const float4*)(b1 + col + 4);
        const float t0 = fmaxf(v0[0] + ba.x, 0.f), t1 = fmaxf(v0[1] + ba.y, 0.f), t2 = fmaxf(v0[2] + ba.z, 0.f), t3 = fmaxf(v0[3] + ba.w, 0.f);
        const float t4 = fmaxf(v1[0] + bb.x, 0.f), t5 = fmaxf(v1[1] + bb.y, 0.f), t6 = fmaxf(v1[2] + bb.z, 0.f), t7 = fmaxf(v1[3] + bb.w, 0.f);
        uint4 o; o.x = pack2(t0 * t0, t1 * t1); o.y = pack2(t2 * t2, t3 * t3); o.z = pack2(t4 * t4, t5 * t5); o.w = pack2(t6 * t6, t7 * t7);
        *(uint4*)(HID + (size_t)row * 4096 + col) = o; }) }
  } pr{(const bf16_t*)(p.ws + hoff), (const bf16_t*)(p.ws + OFF_WFF1), (bf16_t*)(p.ws + OFF_XBC), p.b_ff1 + (size_t)l * 4096, M / 128, 32};
  gemm_stream(pr, sm);
}
__device__ __forceinline__ void gemm_ff2_phase(const Params& p, int l, int g, int M, bf16_t* sm) {
  struct Pr {
    const Params& p; int g; const bf16_t* HID; const bf16_t* W; const float* MOD; const float* b2; int nM, nN;
    __device__ bool seg(int idx, Seg& s, int lr, int lk) const { int mt, nt; if (!tile_coord(idx, nM, nN, mt, nt)) return false;
      s.ap = HID + (size_t)(mt * 128 + lr) * 4096 + lk; s.bp = W + (size_t)(nt * 128 + perm_brow(lr)) * 4096 + lk; s.lda = 4096; s.ldb = 4096; s.nk = 64; return true; }
    __device__ void begin(int, f32x4 (&acc)[4][4]) const { ZERO_ACC(acc) }
    __device__ void end(int idx, f32x4 (&acc)[4][4]) const { int mt, nt; tile_coord(idx, nM, nN, mt, nt); const int m0 = mt * 128, n0 = nt * 128;
      EPI8_LOOP({ float* xp = xs_row(p, g, row) + col; const float* gp = MOD + (size_t)mod_row(g, row) * 6144 + 5120 + col;
        const float4 xa = *(const float4*)xp, xb = *(const float4*)(xp + 4), ba = *(const float4*)(b2 + col), bb = *(const float4*)(b2 + col + 4), ga = *(const float4*)gp, gb = *(const float4*)(gp + 4);
        float4 oa, ob; oa.x = DN_ALPHA * xa.x + ga.x * (v0[0] + ba.x); oa.y = DN_ALPHA * xa.y + ga.y * (v0[1] + ba.y); oa.z = DN_ALPHA * xa.z + ga.z * (v0[2] + ba.z); oa.w = DN_ALPHA * xa.w + ga.w * (v0[3] + ba.w);
        ob.x = DN_ALPHA * xb.x + gb.x * (v1[0] + bb.x); ob.y = DN_ALPHA * xb.y + gb.y * (v1[1] + bb.y); ob.z = DN_ALPHA * xb.z + gb.z * (v1[2] + bb.z); ob.w = DN_ALPHA * xb.w + gb.w * (v1[3] + bb.w);
        *(float4*)xp = oa; *(float4*)(xp + 4) = ob; }) }
  } pr{p, g, (const bf16_t*)(p.ws + OFF_XBC), (const bf16_t*)(p.ws + OFF_WFF2), (const float*)(p.ws + OFF_MOD) + (size_t)l * 9 * 6144, p.b_ff2 + (size_t)l * 1024, M / 128, 8};
  gemm_stream(pr, sm);
}

__device__ __forceinline__ void ln_phase(const Params& p, int l, int g, int M, const float* gam, const float* bet, bool write_h2, size_t hoff) {
  const int lane = TIDX() & 63;
  const float* MOD = (const float*)(p.ws + OFF_MOD) + (size_t)l * 9 * 6144;
  bf16_t* H = (bf16_t*)(p.ws + hoff);
  const int stride = GDIM() * 4;
  for (int r0 = BIDX() * 4 + (TIDX() >> 6); r0 < M; r0 += 2 * stride) {
    const int r1 = r0 + stride; const bool has1 = r1 < M;
    float* xr0 = xs_row(p, g, r0); float* xr1 = xs_row(p, g, has1 ? r1 : r0);
    float4 v0[4], v1[4];
#pragma unroll
    for (int i = 0; i < 4; ++i) { v0[i] = *(const float4*)(xr0 + (i * 64 + lane) * 4); v1[i] = *(const float4*)(xr1 + (i * 64 + lane) * 4); }
    float s0 = 0.f, s1 = 0.f;
#pragma unroll
    for (int i = 0; i < 4; ++i) { s0 += v0[i].x + v0[i].y + v0[i].z + v0[i].w; s1 += v1[i].x + v1[i].y + v1[i].z + v1[i].w; }
#pragma unroll
    for (int o = 32; o >= 1; o >>= 1) { s0 += __shfl_xor(s0, o); s1 += __shfl_xor(s1, o); }
    const float mu0 = s0 * (1.f / 1024.f), mu1 = s1 * (1.f / 1024.f);
    float q0 = 0.f, q1 = 0.f;
#pragma unroll
    for (int i = 0; i < 4; ++i) {
      v0[i].x -= mu0; v0[i].y -= mu0; v0[i].z -= mu0; v0[i].w -= mu0; q0 += v0[i].x * v0[i].x + v0[i].y * v0[i].y + v0[i].z * v0[i].z + v0[i].w * v0[i].w;
      v1[i].x -= mu1; v1[i].y -= mu1; v1[i].z -= mu1; v1[i].w -= mu1; q1 += v1[i].x * v1[i].x + v1[i].y * v1[i].y + v1[i].z * v1[i].z + v1[i].w * v1[i].w;
    }
#pragma unroll
    for (int o = 32; o >= 1; o >>= 1) { q0 += __shfl_xor(q0, o); q1 += __shfl_xor(q1, o); }
    const float rs0 = rsqrtf(q0 * (1.f / 1024.f) + 1e-5f), rs1 = rsqrtf(q1 * (1.f / 1024.f) + 1e-5f);
    const float* m0 = MOD + (size_t)mod_row(g, r0) * 6144;
    const float* m1 = MOD + (size_t)mod_row(g, has1 ? r1 : r0) * 6144;
#pragma unroll
    for (int i = 0; i < 4; ++i) {
      const int ch = (i * 64 + lane) * 4;
      const float4 gg = *(const float4*)(gam + ch), bb = *(const float4*)(bet + ch);
      float4 o0, o1;
      o0.x = v0[i].x * rs0 * gg.x + bb.x; o0.y = v0[i].y * rs0 * gg.y + bb.y; o0.z = v0[i].z * rs0 * gg.z + bb.z; o0.w = v0[i].w * rs0 * gg.w + bb.w;
      o1.x = v1[i].x * rs1 * gg.x + bb.x; o1.y = v1[i].y * rs1 * gg.y + bb.y; o1.z = v1[i].z * rs1 * gg.z + bb.z; o1.w = v1[i].w * rs1 * gg.w + bb.w;
      *(float4*)(xr0 + ch) = o0;
      if (has1) *(float4*)(xr1 + ch) = o1;
      if (write_h2) {
        const float4 sh0 = *(const float4*)(m0 + 3072 + ch), sc0 = *(const float4*)(m0 + 4096 + ch);
        uint2 h; h.x = pack2(o0.x * (1.f + sc0.x) + sh0.x, o0.y * (1.f + sc0.y) + sh0.y); h.y = pack2(o0.z * (1.f + sc0.z) + sh0.z, o0.w * (1.f + sc0.w) + sh0.w);
        *(uint2*)(H + (size_t)r0 * D + ch) = h;
        if (has1) {
          const float4 sh1 = *(const float4*)(m1 + 3072 + ch), sc1 = *(const float4*)(m1 + 4096 + ch);
          h.x = pack2(o1.x * (1.f + sc1.x) + sh1.x, o1.y * (1.f + sc1.y) + sh1.y); h.y = pack2(o1.z * (1.f + sc1.z) + sh1.z, o1.w * (1.f + sc1.w) + sh1.w);
          *(uint2*)(H + (size_t)r1 * D + ch) = h;
        }
      }
    }
  }
}

__device__ __forceinline__ void conv_phase(const Params& p, int l) {
  const bf16_t* P = (const bf16_t*)(p.ws + OFF_P);
  bf16_t* QKV = (bf16_t*)(p.ws + OFF_QKV); bf16_t* XBC = (bf16_t*)(p.ws + OFF_XBC);
  float* GBF = (float*)(p.ws + OFF_GBF); float* DTF = (float*)(p.ws + OFF_DTF);
  const int nb = GDIM(), bid = BIDX(), tid = TIDX();
  const int vb = ((nb & 7) == 0) ? (bid & 7) * (nb >> 3) + (bid >> 3) : bid;
  const int gtid = vb * 256 + tid, gsz = nb * 256;
  {
    const float* cw = p.gdn_conv_w + (size_t)l * 5 * 3072;
    const int c = tid & 127, hh = tid >> 7;
    for (int item = vb; item < (MG / 32) * 3; item += nb) {
      const int third = item % 3, pp = item / 3;
      const int ch0 = third * 1024 + c * 8;
      const int t0 = (pp * 2 + hh) * 16;
      int lo, hi;
      if (t0 < MLAT) { lo = t0 & ~63; hi = lo + 64; } else { lo = MLAT + ((t0 - MLAT) & ~255); hi = lo + 256; }
      u32x4 raw[20];
#pragma unroll
      for (int i = 0; i < 20; ++i) { const int row = t0 - 2 + i; raw[i] = (row >= lo && row < hi) ? *(const u32x4*)(P + (size_t)row * LDP + ch0) : (u32x4){0u, 0u, 0u, 0u}; }
      float wt[5][8];
#pragma unroll
      for (int j = 0; j < 5; ++j) { const float4 w0 = *(const float4*)(cw + j * 3072 + ch0), w1 = *(const float4*)(cw + j * 3072 + ch0 + 4);
        wt[j][0] = w0.x; wt[j][1] = w0.y; wt[j][2] = w0.z; wt[j][3] = w0.w; wt[j][4] = w1.x; wt[j][5] = w1.y; wt[j][6] = w1.z; wt[j][7] = w1.w; }
      const float qsc = (third == 0) ? 0.08838834764831845f : 1.f;
#pragma unroll
      for (int t = 0; t < 16; ++t) {
        float acc[8];
#pragma unroll
        for (int e = 0; e < 8; ++e) acc[e] = 0.f;
#pragma unroll
        for (int j = 0; j < 5; ++j) {
          const u32x4 rw = raw[t + j];
#pragma unroll
          for (int e = 0; e < 4; ++e) { acc[2 * e] += lo16(rw[e]) * wt[j][2 * e]; acc[2 * e + 1] += hi16(rw[e]) * wt[j][2 * e + 1]; }
        }
        float ss = 0.f;
#pragma unroll
        for (int e = 0; e < 8; ++e) { acc[e] = siluf_(acc[e]); ss += acc[e] * acc[e]; }
        ss += __shfl_xor(ss, 1); ss += __shfl_xor(ss, 2); ss += __shfl_xor(ss, 4); ss += __shfl_xor(ss, 8);
        const float sc = (third < 2) ? rsqrtf(ss + 1e-6f) * qsc : 1.f;
#pragma unroll
        for (int e = 0; e < 8; ++e) acc[e] *= sc;
        *(uint4*)(QKV + (size_t)(t0 + t) * 3072 + ch0) = pack8(acc);
      }
    }
  }
  {
    const float* sw = p.ssm_conv_w + (size_t)l * 5 * 4096; const float* sb = p.ssm_conv_b + (size_t)l * 4096;
    constexpr int nLat = G * 64 * 8 * 2, nCtx = (MCTX / 16) * 2;
    float wt[5][8], bs[8];
    int cur_half = -1;
    for (int item = vb; item < nLat + nCtx; item += nb) {
      int half, base, stride, p0, seglen;
      if (item < nLat) { half = item & 1; const int piece = (item >> 1) & 7, cl = (item >> 4) & 63, b_l = item >> 10; base = b_l * 8192 + cl; stride = 64; p0 = piece * 16; seglen = 128; }
      else { const int i2 = item - nLat; half = i2 & 1; const int piece = i2 >> 1; base = MLAT + (piece >> 4) * 256; stride = 1; p0 = (piece & 15) * 16; seglen = 256; }
      const int ch0 = (half * 256 + tid) * 8;
      u32x4 raw[20];
#pragma unroll
      for (int i = 0; i < 20; ++i) { const int pq = p0 - 2 + i; raw[i] = (pq >= 0 && pq < seglen) ? *(const u32x4*)(P + (size_t)(base + pq * stride) * LDP + C_XBC + ch0) : (u32x4){0u, 0u, 0u, 0u}; }
      if (half != cur_half) {
        cur_half = half;
        const float4 b0 = *(const float4*)(sb + ch0), b1 = *(const float4*)(sb + ch0 + 4);
        bs[0] = b0.x; bs[1] = b0.y; bs[2] = b0.z; bs[3] = b0.w; bs[4] = b1.x; bs[5] = b1.y; bs[6] = b1.z; bs[7] = b1.w;
#pragma unroll
        for (int j = 0; j < 5; ++j) { const float4 w0 = *(const float4*)(sw + j * 4096 + ch0), w1 = *(const float4*)(sw + j * 4096 + ch0 + 4);
          wt[j][0] = w0.x; wt[j][1] = w0.y; wt[j][2] = w0.z; wt[j][3] = w0.w; wt[j][4] = w1.x; wt[j][5] = w1.y; wt[j][6] = w1.z; wt[j][7] = w1.w; }
      }
#pragma unroll
      for (int t = 0; t < 16; ++t) {
        float acc[8];
#pragma unroll
        for (int e = 0; e < 8; ++e) acc[e] = bs[e];
#pragma unroll
        for (int j = 0; j < 5; ++j) {
          const u32x4 rw = raw[t + j];
#pragma unroll
          for (int e = 0; e < 4; ++e) { acc[2 * e] += lo16(rw[e]) * wt[j][2 * e]; acc[2 * e + 1] += hi16(rw[e]) * wt[j][2 * e + 1]; }
        }
#pragma unroll
        for (int e = 0; e < 8; ++e) acc[e] = siluf_(acc[e]);
        *(uint4*)(XBC + (size_t)(base + (p0 + t) * stride) * 4096 + ch0) = pack8(acc);
      }
    }
  }
  for (int idx = gtid; idx < MG * 16; idx += gsz) {
    const int r = idx >> 4, dh = idx & 15;
    GBF[(size_t)r * 32 + 16 + dh] = sigmoidf_(bf2f(P[(size_t)r * LDP + C_B + dh]));
  }
  for (int idx = gtid; idx < G * 2 * 264 * 8; idx += gsz) {
    const int h = idx & 7; int t = idx >> 3; const int chunk = t % 264; t /= 264; const int dir = t & 1, b_l = t >> 1;
    const int dh = dir * 8 + h;
    const float bias = p.gdn_dt_bias[l * 16 + dh], aneg = -__expf(p.gdn_A_log[l * 16 + dh]);
    float cum = 0.f;
    for (int ub = 0; ub < 32; ub += 8) {
      float av[8];
#pragma unroll
      for (int u = 0; u < 8; ++u) av[u] = bf2f(P[(size_t)gdn_rowof(b_l, dir, chunk * 32 + ub + u) * LDP + C_A + dh]);
#pragma unroll
      for (int u = 0; u < 8; ++u) {
        cum += aneg * softplusf_(av[u] + bias);
        GBF[(size_t)gdn_rowof(b_l, dir, chunk * 32 + ub + u) * 32 + dh] = cum;
      }
    }
  }
  for (int idx = gtid; idx < G * 2 * 264 * 32; idx += gsz) {
    const int head = idx & 31; int t = idx >> 5; const int chunk = t % 264; t /= 264; const int dir = t & 1, b_l = t >> 1;
    const int dh = dir * 32 + head;
    const float bias = p.ssm_dt_bias[l * 64 + dh], aneg = -__expf(p.ssm_A_log[l * 64 + dh]);
    float cum = 0.f;
    for (int ub = 0; ub < 32; ub += 8) {
      float dtv[8];
#pragma unroll
      for (int u = 0; u < 8; ++u) dtv[u] = bf2f(P[(size_t)ssd_rowof(b_l, dir, chunk * 32 + ub + u) * LDP + C_DT + dh]);
#pragma unroll
      for (int u = 0; u < 8; ++u) {
        const size_t row = (size_t)ssd_rowof(b_l, dir, chunk * 32 + ub + u);
        const float dt = softplusf_(dtv[u] + bias);
        cum += dt * aneg;
        DTF[row * 128 + dh] = dt;
        DTF[row * 128 + 64 + dh] = cum;
      }
    }
  }
}

__device__ __forceinline__ void gdn_prep_phase(const Params& p, unsigned char* smraw) {
  const int tid = TIDX(), lane = tid & 63, w = tid >> 6, fr = lane & 15, fq = lane >> 4, ti = w >> 1, tj = w & 1;
  bf16_t* sK = (bf16_t*)smraw;
  bf16_t* sQ = sK + 32 * 136;
  bf16_t* sP = sQ + 32 * 136;
  bf16_t* sPT = sP + 2 * 1280;
  bf16_t* sR = sPT + 2 * 1280;
  float* sG = (float*)(sR + 2 * 1280);
  const bf16_t* QKV = (const bf16_t*)(p.ws + OFF_QKV);
  const float* GBF = (const float*)(p.ws + OFF_GBF);
  bf16_t* TMB = (bf16_t*)(p.ws + OFF_TMB);
  const int ltok = tid & 31, lp = tid >> 5;
  const int i = ti * 16 + fr, j0 = tj * 16 + fq * 4;
  for (int item = BIDX(); item < GDN_NITEM; item += GDIM()) {
    const int chunk = item % 264; const int t = item / 264; const int dir = t & 1, h = (t >> 1) & 7, b_l = t >> 4;
    const size_t row = (size_t)gdn_rowof(b_l, dir, chunk * 32 + ltok);
    const bf16_t* src = QKV + row * 3072 + h * 128;
    const u32x4 k0 = *(const u32x4*)(src + 1024 + lp * 8), k1 = *(const u32x4*)(src + 1024 + (lp + 8) * 8);
    const u32x4 q0 = *(const u32x4*)(src + lp * 8), q1 = *(const u32x4*)(src + (lp + 8) * 8);
    float g_ = 0.f, b_ = 0.f;
    if (tid < 32) { g_ = GBF[row * 32 + dir * 8 + h]; b_ = GBF[row * 32 + 16 + dir * 8 + h]; }
    __syncthreads();
    *(u32x4*)(sK + ltok * 136 + lp * 8) = k0; *(u32x4*)(sK + ltok * 136 + (lp + 8) * 8) = k1;
    *(u32x4*)(sQ + ltok * 136 + lp * 8) = q0; *(u32x4*)(sQ + ltok * 136 + (lp + 8) * 8) = q1;
    if (tid < 32) { sG[tid] = g_; sG[32 + tid] = b_; }
    __syncthreads();
    {
      f32x4 kk = (f32x4){0.f, 0.f, 0.f, 0.f}, qk = kk;
#pragma unroll
      for (int ks = 0; ks < 4; ++ks) {
        const bf16x8 kj = *(const bf16x8*)(sK + (tj * 16 + fr) * 136 + ks * 32 + fq * 8);
        const bf16x8 ki = *(const bf16x8*)(sK + (ti * 16 + fr) * 136 + ks * 32 + fq * 8);
        const bf16x8 qi = *(const bf16x8*)(sQ + (ti * 16 + fr) * 136 + ks * 32 + fq * 8);
        kk = __builtin_amdgcn_mfma_f32_16x16x32_bf16(kj, ki, kk, 0, 0, 0);
        qk = __builtin_amdgcn_mfma_f32_16x16x32_bf16(kj, qi, qk, 0, 0, 0);
      }
      const float gi = sG[i], bi = sG[32 + i];
      float n[4], nt[4], rr[4], m[4];
#pragma unroll
      for (int r = 0; r < 4; ++r) {
        const int j = j0 + r; const float gj = sG[j], bj = sG[32 + j];
        n[r] = (j < i) ? -bi * kk[r] * __expf(gi - gj) : 0.f;
        nt[r] = (i < j) ? -bj * kk[r] * __expf(gj - gi) : 0.f;
        m[r] = (j <= i) ? qk[r] * __expf(gi - gj) : 0.f;
        rr[r] = n[r] + ((i == j) ? 1.f : 0.f);
      }
      uint2 o;
      o.x = pack2(n[0], n[1]); o.y = pack2(n[2], n[3]); *(uint2*)(sP + i * 40 + j0) = o;
      o.x = pack2(nt[0], nt[1]); o.y = pack2(nt[2], nt[3]); *(uint2*)(sPT + i * 40 + j0) = o;
      o.x = pack2(rr[0], rr[1]); o.y = pack2(rr[2], rr[3]); *(uint2*)(sR + i * 40 + j0) = o;
      o.x = pack2(m[0], m[1]); o.y = pack2(m[2], m[3]); *(uint2*)(TMB + (size_t)item * 2048 + 1024 + i * 32 + j0) = o;
    }
    __syncthreads();
    int pc = 0, rc = 0;
#pragma unroll
    for (int st = 1; st <= 5; ++st) {
      const bf16_t* Pc = sP + pc * 1280; const bf16_t* PTc = sPT + pc * 1280; const bf16_t* Rc = sR + rc * 1280;
      const bf16x8 p_i = *(const bf16x8*)(Pc + (ti * 16 + fr) * 40 + fq * 8);
      const bf16x8 p_j = *(const bf16x8*)(Pc + (tj * 16 + fr) * 40 + fq * 8);
      const bf16x8 pt_i = *(const bf16x8*)(PTc + (ti * 16 + fr) * 40 + fq * 8);
      const bf16x8 pt_j = *(const bf16x8*)(PTc + (tj * 16 + fr) * 40 + fq * 8);
      const f32x4 z = (f32x4){0.f, 0.f, 0.f, 0.f};
      if (st >= 2) {
        const bf16x8 r_i = *(const bf16x8*)(Rc + (ti * 16 + fr) * 40 + fq * 8);
        const uint2 rin = *(const uint2*)(Rc + i * 40 + j0);
        f32x4 racc = (f32x4){lo16(rin.x), hi16(rin.x), lo16(rin.y), hi16(rin.y)};
        racc = __builtin_amdgcn_mfma_f32_16x16x32_bf16(pt_j, r_i, racc, 0, 0, 0);
        uint2 o; o.x = pack2(racc[0], racc[1]); o.y = pack2(racc[2], racc[3]);
        if (st < 5) *(uint2*)(sR + (rc ^ 1) * 1280 + i * 40 + j0) = o;
        else *(uint2*)(TMB + (size_t)item * 2048 + i * 32 + j0) = o;
      }
      if (st <= 4) {
        const f32x4 pn = __builtin_amdgcn_mfma_f32_16x16x32_bf16(pt_j, p_i, z, 0, 0, 0);
        const f32x4 ptn = __builtin_amdgcn_mfma_f32_16x16x32_bf16(p_j, pt_i, z, 0, 0, 0);
        uint2 o; o.x = pack2(pn[0], pn[1]); o.y = pack2(pn[2], pn[3]); *(uint2*)(sP + (pc ^ 1) * 1280 + i * 40 + j0) = o;
        o.x = pack2(ptn[0], ptn[1]); o.y = pack2(ptn[2], ptn[3]); *(uint2*)(sPT + (pc ^ 1) * 1280 + i * 40 + j0) = o;
      }
      if (st < 5) __syncthreads();
      pc ^= 1; if (st >= 2) rc ^= 1;
    }
  }
}

__device__ __forceinline__ void gdn_chunk_item(const Params& p, int id, unsigned char* smraw) {
  const int tid = TIDX(), lane = tid & 63, w = tid >> 6, fr = lane & 15, fq = lane >> 4, ta = w >> 1, tb = w & 1;
  const int b_l = id >> 6, h = (id >> 3) & 7, dir = (id >> 2) & 1, dvq = id & 3;
  bf16_t* sKb = (bf16_t*)smraw;
  bf16_t* sQ = sKb + 32 * 136;
  bf16_t* sKdT = sQ + 32 * 136;
  bf16_t* sVbT = sKdT + 128 * 40;
  bf16_t* sT = sVbT + 32 * 40;
  bf16_t* sM = sT + 32 * 40;
  bf16_t* sXT = sM + 32 * 40;
  bf16_t* sVnT = sXT + 32 * 40;
  bf16_t* sST = sVnT + 32 * 40;
  float* sG = (float*)(sST + 32 * 136);
  const bf16_t* QKV = (const bf16_t*)(p.ws + OFF_QKV);
  const float* GBF = (const float*)(p.ws + OFF_GBF);
  const bf16_t* TMB = (const bf16_t*)(p.ws + OFF_TMB);
  bf16_t* OUT = (bf16_t*)(p.ws + (dir ? OFF_OB : OFF_OF));
  const int ltok = tid & 31, lp = tid >> 5;
  const size_t item0 = (size_t)((b_l * 8 + h) * 2 + dir) * 264;
  struct Stage { u32x4 k0, k1, q0, q1, v, tm; float g, be, gl; };
  Stage st0, st1;
  constexpr int NCH = (256 + 8192) / 32;
  auto gload = [&](Stage& st, int c) __attribute__((always_inline)) {
    const int s0 = (c < NCH ? c : NCH - 1) * 32;
    const size_t row = (size_t)gdn_rowof(b_l, dir, s0 + ltok);
    const bf16_t* src = QKV + row * 3072 + h * 128;
    st.k0 = *(const u32x4*)(src + 1024 + lp * 8); st.k1 = *(const u32x4*)(src + 1024 + (lp + 8) * 8);
    st.q0 = *(const u32x4*)(src + lp * 8); st.q1 = *(const u32x4*)(src + (lp + 8) * 8);
    st.v = *(const u32x4*)(src + 2048 + dvq * 32 + (lp & 3) * 8);
    st.tm = *(const u32x4*)(TMB + (item0 + (c < NCH ? c : NCH - 1)) * 2048 + (tid >> 7) * 1024 + ((tid & 127) >> 2) * 32 + (tid & 3) * 8);
    st.g = GBF[row * 32 + dir * 8 + h]; st.be = GBF[row * 32 + 16 + dir * 8 + h];
    st.gl = GBF[(size_t)gdn_rowof(b_l, dir, s0 + 31) * 32 + dir * 8 + h];
  };
  auto lstore = [&](const Stage& st) __attribute__((always_inline)) {
    const float skb = st.be * __expf(st.g), skd = __expf(st.gl - st.g);
    {
      float f[8]; uint4 o;
      f[0] = lo16(st.k0[0]); f[1] = hi16(st.k0[0]); f[2] = lo16(st.k0[1]); f[3] = hi16(st.k0[1]); f[4] = lo16(st.k0[2]); f[5] = hi16(st.k0[2]); f[6] = lo16(st.k0[3]); f[7] = hi16(st.k0[3]);
      bf16_t* t0 = sKdT + (lp * 8) * 40 + ltok;
#pragma unroll
      for (int e = 0; e < 4; ++e) { const unsigned pk = pack2(f[2 * e] * skd, f[2 * e + 1] * skd); t0[(2 * e) * 40] = (bf16_t)(pk & 0xffffu); t0[(2 * e + 1) * 40] = (bf16_t)(pk >> 16); }
#pragma unroll
      for (int e = 0; e < 8; ++e) f[e] *= skb;
      o = pack8(f); *(uint4*)(sKb + ltok * 136 + lp * 8) = o;
      f[0] = lo16(st.k1[0]); f[1] = hi16(st.k1[0]); f[2] = lo16(st.k1[1]); f[3] = hi16(st.k1[1]); f[4] = lo16(st.k1[2]); f[5] = hi16(st.k1[2]); f[6] = lo16(st.k1[3]); f[7] = hi16(st.k1[3]);
      bf16_t* t1 = sKdT + ((lp + 8) * 8) * 40 + ltok;
#pragma unroll
      for (int e = 0; e < 4; ++e) { const unsigned pk = pack2(f[2 * e] * skd, f[2 * e + 1] * skd); t1[(2 * e) * 40] = (bf16_t)(pk & 0xffffu); t1[(2 * e + 1) * 40] = (bf16_t)(pk >> 16); }
#pragma unroll
      for (int e = 0; e < 8; ++e) f[e] *= skb;
      o = pack8(f); *(uint4*)(sKb + ltok * 136 + (lp + 8) * 8) = o;
    }
    *(u32x4*)(sQ + ltok * 136 + lp * 8) = st.q0; *(u32x4*)(sQ + ltok * 136 + (lp + 8) * 8) = st.q1;
    if (tid < 128) {
      bf16_t* tv = sVbT + (lp * 8) * 40 + ltok;
#pragma unroll
      for (int e = 0; e < 4; ++e) { const unsigned pk = pack2(lo16(st.v[e]) * st.be, hi16(st.v[e]) * st.be); tv[(2 * e) * 40] = (bf16_t)(pk & 0xffffu); tv[(2 * e + 1) * 40] = (bf16_t)(pk >> 16); }
      *(u32x4*)(sT + ((tid & 127) >> 2) * 40 + (tid & 3) * 8) = st.tm;
    } else {
      *(u32x4*)(sM + ((tid & 127) >> 2) * 40 + (tid & 3) * 8) = st.tm;
    }
    if (tid < 32) sG[tid] = st.g;
  };
  f32x4 S[4];
#pragma unroll
  for (int t = 0; t < 4; ++t) S[t] = (f32x4){0.f, 0.f, 0.f, 0.f};
  __syncthreads();
  for (int i = tid; i < 32 * 136 / 2; i += 256) ((unsigned*)sST)[i] = 0u;
  gload(st0, 0); lstore(st0);
  __syncthreads();
  gload(st0, 1);
  __builtin_amdgcn_sched_barrier(0);
  gload(st1, 2);
  __builtin_amdgcn_sched_barrier(0);
  auto body = [&](int c) __attribute__((always_inline)) {
    const int dv = ta * 16 + fr, i0 = tb * 16 + fq * 4;
    {
      f32x4 pr = (f32x4){0.f, 0.f, 0.f, 0.f};
#pragma unroll
      for (int ks = 0; ks < 4; ++ks) {
        const bf16x8 kb = *(const bf16x8*)(sKb + (tb * 16 + fr) * 136 + ks * 32 + fq * 8);
        const bf16x8 sf = *(const bf16x8*)(sST + (ta * 16 + fr) * 136 + ks * 32 + fq * 8);
        pr = __builtin_amdgcn_mfma_f32_16x16x32_bf16(kb, sf, pr, 0, 0, 0);
      }
      const uint2 vb = *(const uint2*)(sVbT + dv * 40 + i0);
      uint2 o; o.x = pack2(lo16(vb.x) - pr[0], hi16(vb.x) - pr[1]); o.y = pack2(lo16(vb.y) - pr[2], hi16(vb.y) - pr[3]);
      *(uint2*)(sXT + dv * 40 + i0) = o;
    }
    __syncthreads();
    {
      const bf16x8 tf = *(const bf16x8*)(sT + (tb * 16 + fr) * 40 + fq * 8);
      const bf16x8 xf = *(const bf16x8*)(sXT + (ta * 16 + fr) * 40 + fq * 8);
      const f32x4 vn = __builtin_amdgcn_mfma_f32_16x16x32_bf16(tf, xf, (f32x4){0.f, 0.f, 0.f, 0.f}, 0, 0, 0);
      uint2 o; o.x = pack2(vn[0], vn[1]); o.y = pack2(vn[2], vn[3]);
      *(uint2*)(sVnT + dv * 40 + i0) = o;
    }
    __syncthreads();
    const float eglast = __expf(sG[31]);
    {
      f32x4 oa = (f32x4){0.f, 0.f, 0.f, 0.f};
#pragma unroll
      for (int ks = 0; ks < 4; ++ks) {
        const bf16x8 qf = *(const bf16x8*)(sQ + (ta * 16 + fr) * 136 + ks * 32 + fq * 8);
        const bf16x8 sf = *(const bf16x8*)(sST + (tb * 16 + fr) * 136 + ks * 32 + fq * 8);
        oa = __builtin_amdgcn_mfma_f32_16x16x32_bf16(sf, qf, oa, 0, 0, 0);
      }
      const int i = ta * 16 + fr;
      oa *= __expf(sG[i]);
      const bf16x8 mf = *(const bf16x8*)(sM + i * 40 + fq * 8);
      const bf16x8 vf = *(const bf16x8*)(sVnT + (tb * 16 + fr) * 40 + fq * 8);
      oa = __builtin_amdgcn_mfma_f32_16x16x32_bf16(vf, mf, oa, 0, 0, 0);
      uint2 o; o.x = pack2(oa[0], oa[1]); o.y = pack2(oa[2], oa[3]);
      *(uint2*)(OUT + (size_t)gdn_rowof(b_l, dir, c * 32 + i) * 1024 + h * 128 + dvq * 32 + tb * 16 + fq * 4) = o;
    }
    {
      const bf16x8 vf = *(const bf16x8*)(sVnT + (ta * 16 + fr) * 40 + fq * 8);
#pragma unroll
      for (int t = 0; t < 4; ++t) {
        const bf16x8 kf = *(const bf16x8*)(sKdT + ((tb * 4 + t) * 16 + fr) * 40 + fq * 8);
        S[t] *= eglast;
        S[t] = __builtin_amdgcn_mfma_f32_16x16x32_bf16(kf, vf, S[t], 0, 0, 0);
      }
    }
    __syncthreads();
#pragma unroll
    for (int t = 0; t < 4; ++t) {
      uint2 o; o.x = pack2(S[t][0], S[t][1]); o.y = pack2(S[t][2], S[t][3]);
      *(uint2*)(sST + (ta * 16 + fr) * 136 + (tb * 4 + t) * 16 + fq * 4) = o;
    }
  };
  for (int c = 0; c < NCH; c += 2) {
    body(c);
    lstore(st0); gload(st0, c + 3);
    __syncthreads();
    body(c + 1);
    if (c + 2 < NCH) lstore(st1);
    gload(st1, c + 4);
    __syncthreads();
  }
}

__device__ __forceinline__ void ssd_chunk_item(const Params& p, int id, unsigned char* smraw) {
  const int tid = TIDX(), lane = tid & 63, w = tid >> 6, fr = lane & 15, fq = lane >> 4;
  const int b_l = id >> 6, head = (id >> 1) & 31, dir = id & 1, grp = head >> 2;
  bf16_t* sC = (bf16_t*)smraw;
  bf16_t* sB = sC + 32 * 136;
  bf16_t* sBT = sB + 32 * 136;
  bf16_t* sXT = sBT + 128 * 40;
  bf16_t* sM = sXT + 64 * 40;
  bf16_t* sST = sM + 32 * 40;
  float* sG = (float*)(sST + 64 * 136);
  const bf16_t* XBC = (const bf16_t*)(p.ws + OFF_XBC);
  const float* DTF = (const float*)(p.ws + OFF_DTF);
  bf16_t* OUT = (bf16_t*)(p.ws + (dir ? OFF_YB : OFF_YF));
  const int ltok = tid & 31, lpart = tid >> 5;
  struct Stage { u32x4 b0, b1, c0, c1, x; float dt, g, gl; };
  Stage st0, st1;
  constexpr int NCH = (256 + 8192) / 32;
  auto gload = [&](Stage& st, int c) __attribute__((always_inline)) {
    const int s0 = (c < NCH ? c : NCH - 1) * 32;
    const size_t row = (size_t)ssd_rowof(b_l, dir, s0 + ltok);
    const bf16_t* xr = XBC + row * 4096;
    st.b0 = *(const u32x4*)(xr + 2048 + grp * 128 + lpart * 8);
    st.b1 = *(const u32x4*)(xr + 2048 + grp * 128 + (lpart + 8) * 8);
    st.c0 = *(const u32x4*)(xr + 3072 + grp * 128 + lpart * 8);
    st.c1 = *(const u32x4*)(xr + 3072 + grp * 128 + (lpart + 8) * 8);
    st.x = *(const u32x4*)(xr + head * 64 + lpart * 8);
    st.dt = DTF[row * 128 + dir * 32 + head];
    st.g = DTF[row * 128 + 64 + dir * 32 + head];
    st.gl = DTF[(size_t)ssd_rowof(b_l, dir, s0 + 31) * 128 + 64 + dir * 32 + head];
  };
  auto lstore = [&](const Stage& st) __attribute__((always_inline)) {
    *(u32x4*)(sB + ltok * 136 + lpart * 8) = st.b0;
    *(u32x4*)(sB + ltok * 136 + (lpart + 8) * 8) = st.b1;
    *(u32x4*)(sC + ltok * 136 + lpart * 8) = st.c0;
    *(u32x4*)(sC + ltok * 136 + (lpart + 8) * 8) = st.c1;
    const float wj = __expf(st.gl - st.g);
    bf16_t* t0 = sBT + (lpart * 8) * 40 + ltok;
    bf16_t* t1 = sBT + ((lpart + 8) * 8) * 40 + ltok;
    bf16_t* tx = sXT + (lpart * 8) * 40 + ltok;
#pragma unroll
    for (int e = 0; e < 4; ++e) {
      const unsigned pa = pack2(lo16(st.b0[e]) * wj, hi16(st.b0[e]) * wj), pb = pack2(lo16(st.b1[e]) * wj, hi16(st.b1[e]) * wj);
      const unsigned px = pack2(lo16(st.x[e]) * st.dt, hi16(st.x[e]) * st.dt);
      t0[(2 * e) * 40] = (bf16_t)(pa & 0xffffu); t0[(2 * e + 1) * 40] = (bf16_t)(pa >> 16);
      t1[(2 * e) * 40] = (bf16_t)(pb & 0xffffu); t1[(2 * e + 1) * 40] = (bf16_t)(pb >> 16);
      tx[(2 * e) * 40] = (bf16_t)(px & 0xffffu); tx[(2 * e + 1) * 40] = (bf16_t)(px >> 16);
    }
    if (tid < 32) sG[tid] = st.g;
  };
  f32x4 S[8];
#pragma unroll
  for (int i = 0; i < 8; ++i) S[i] = (f32x4){0.f, 0.f, 0.f, 0.f};
  __syncthreads();
  for (int i = lane; i < 16 * 136 / 2; i += 64) ((unsigned*)(sST + w * 16 * 136))[i] = 0u;
  gload(st0, 0); lstore(st0);
  __syncthreads();
  gload(st0, 1);
  __builtin_amdgcn_sched_barrier(0);
  gload(st1, 2);
  __builtin_amdgcn_sched_barrier(0);
  auto body = [&](int c) __attribute__((always_inline)) {
    {
      const int ti = w >> 1, tj = w & 1;
      f32x4 cb = (f32x4){0.f, 0.f, 0.f, 0.f};
      if (tj <= ti) {
#pragma unroll
        for (int ks = 0; ks < 4; ++ks) {
          const bf16x8 af = *(const bf16x8*)(sC + (ti * 16 + fr) * 136 + ks * 32 + fq * 8);
          const bf16x8 bf = *(const bf16x8*)(sB + (tj * 16 + fr) * 136 + ks * 32 + fq * 8);
          cb = __builtin_amdgcn_mfma_f32_16x16x32_bf16(bf, af, cb, 0, 0, 0);
        }
      }
      const int i = ti * 16 + fr, j0 = tj * 16 + fq * 4;
      const float gi = sG[i];
      const f32x4 gj = *(const f32x4*)(sG + j0);
      float m[4];
#pragma unroll
      for (int r = 0; r < 4; ++r) { const float e = __expf(fminf(gi - gj[r], 0.f)); m[r] = (j0 + r <= i) ? cb[r] * e : 0.f; }
      uint2 o; o.x = pack2(m[0], m[1]); o.y = pack2(m[2], m[3]);
      *(uint2*)(sM + i * 40 + j0) = o;
    }
    __syncthreads();
    const bf16x8 xfrag = *(const bf16x8*)(sXT + (w * 16 + fr) * 40 + fq * 8);
    const float eglast = __expf(sG[31]);
#pragma unroll
    for (int ti = 0; ti < 2; ++ti) {
      f32x4 y = (f32x4){0.f, 0.f, 0.f, 0.f};
#pragma unroll
      for (int ks = 0; ks < 4; ++ks) {
        const bf16x8 af = *(const bf16x8*)(sC + (ti * 16 + fr) * 136 + ks * 32 + fq * 8);
        const bf16x8 bf = *(const bf16x8*)(sST + (w * 16 + fr) * 136 + ks * 32 + fq * 8);
        y = __builtin_amdgcn_mfma_f32_16x16x32_bf16(bf, af, y, 0, 0, 0);
      }
      const int i = ti * 16 + fr;
      const float eg = __expf(sG[i]);
      y *= eg;
      const bf16x8 mf = *(const bf16x8*)(sM + i * 40 + fq * 8);
      y = __builtin_amdgcn_mfma_f32_16x16x32_bf16(xfrag, mf, y, 0, 0, 0);
      uint2 o; o.x = pack2(y[0], y[1]); o.y = pack2(y[2], y[3]);
      *(uint2*)(OUT + (size_t)ssd_rowof(b_l, dir, c * 32 + i) * 2048 + head * 64 + w * 16 + fq * 4) = o;
    }
#pragma unroll
    for (int tn = 0; tn < 8; ++tn) {
      const bf16x8 bf = *(const bf16x8*)(sBT + (tn * 16 + fr) * 40 + fq * 8);
      S[tn] *= eglast;
      S[tn] = __builtin_amdgcn_mfma_f32_16x16x32_bf16(bf, xfrag, S[tn], 0, 0, 0);
    }
#pragma unroll
    for (int tn = 0; tn < 8; ++tn) {
      uint2 o; o.x = pack2(S[tn][0], S[tn][1]); o.y = pack2(S[tn][2], S[tn][3]);
      *(uint2*)(sST + (w * 16 + fr) * 136 + tn * 16 + fq * 4) = o;
    }
    __syncthreads();
  };
  for (int c = 0; c < NCH; c += 2) {
    body(c);
    lstore(st0); gload(st0, c + 3);
    __syncthreads();
    body(c + 1);
    if (c + 2 < NCH) lstore(st1);
    gload(st1, c + 4);
    __syncthreads();
  }
}

__device__ __forceinline__ void scan_phase(const Params& p, unsigned char* sm, int nb, int v) {
  for (int item = v; item < 256; item += nb) {
    if (item < 128) gdn_chunk_item(p, item, sm); else ssd_chunk_item(p, item - 128, sm);
    __syncthreads();
  }
}

__device__ __forceinline__ void gnorm_phase(const Params& p, int l, int M) {
  const bf16_t* P = (const bf16_t*)(p.ws + OFF_P);
  const bf16_t* OF = (const bf16_t*)(p.ws + OFF_OF); const bf16_t* OB = (const bf16_t*)(p.ws + OFF_OB);
  const bf16_t* YF = (const bf16_t*)(p.ws + OFF_YF); const bf16_t* YB = (const bf16_t*)(p.ws + OFF_YB);
  const bf16_t* XBC = (const bf16_t*)(p.ws + OFF_XBC);
  bf16_t* YA = (bf16_t*)(p.ws + OFF_QKV); bf16_t* YBn = YA + (size_t)MG * 1024;
  const int gtid = BIDX() * 256 + TIDX(), gsz = GDIM() * 256;
  const float* nw = p.gdn_norm_w + l * 128;
  for (int idx0 = gtid; idx0 < M * 128; idx0 += 2 * gsz) {
    const int idx1 = idx0 + gsz; const bool has1 = idx1 < M * 128;
    const int ia[2] = {idx0, has1 ? idx1 : idx0};
    uint4 a[2], b[2], gt[2];
#pragma unroll
    for (int u = 0; u < 2; ++u) { const int r = ia[u] >> 7, c8 = (ia[u] & 127) * 8;
      a[u] = *(const uint4*)(OF + (size_t)r * 1024 + c8); b[u] = *(const uint4*)(OB + (size_t)r * 1024 + c8); gt[u] = *(const uint4*)(P + (size_t)r * LDP + C_GOUT + c8); }
#pragma unroll
    for (int u = 0; u < 2; ++u) {
      const int r = ia[u] >> 7, c8 = (ia[u] & 127) * 8;
      float fa[8], fb[8], fg[8]; UNPACK8(a[u], fa); UNPACK8(b[u], fb); UNPACK8(gt[u], fg);
      float ss = 0.f;
#pragma unroll
      for (int e = 0; e < 8; ++e) { fa[e] += fb[e]; ss += fa[e] * fa[e]; }
      ss += __shfl_xor(ss, 1); ss += __shfl_xor(ss, 2); ss += __shfl_xor(ss, 4); ss += __shfl_xor(ss, 8);
      const float rs = rsqrtf(ss * (1.f / 128.f) + 1e-6f);
      const float4 w0 = *(const float4*)(nw + (c8 & 127)), w1 = *(const float4*)(nw + (c8 & 127) + 4);
      const float wv[8] = {w0.x, w0.y, w0.z, w0.w, w1.x, w1.y, w1.z, w1.w};
#pragma unroll
      for (int e = 0; e < 8; ++e) fa[e] = fa[e] * rs * wv[e] * siluf_(fg[e]);
      if (u == 0 || has1) *(uint4*)(YA + (size_t)r * 1024 + c8) = pack8(fa);
    }
  }
  const float* sw = p.ssm_norm_w + l * 2048; const float* Dk = p.ssm_D + l * 32;
  for (int idx0 = gtid; idx0 < M * 256; idx0 += 2 * gsz) {
    const int idx1 = idx0 + gsz; const bool has1 = idx1 < M * 256;
    const int ia[2] = {idx0, has1 ? idx1 : idx0};
    uint4 a[2], b[2], xx[2], zz[2];
#pragma unroll
    for (int u = 0; u < 2; ++u) { const int r = ia[u] >> 8, c8 = (ia[u] & 255) * 8;
      a[u] = *(const uint4*)(YF + (size_t)r * 2048 + c8); b[u] = *(const uint4*)(YB + (size_t)r * 2048 + c8);
      xx[u] = *(const uint4*)(XBC + (size_t)r * 4096 + c8); zz[u] = *(const uint4*)(P + (size_t)r * LDP + C_Z + c8); }
#pragma unroll
    for (int u = 0; u < 2; ++u) {
      const int r = ia[u] >> 8, c8 = (ia[u] & 255) * 8;
      float fa[8], fb[8], fx[8], fz[8]; UNPACK8(a[u], fa); UNPACK8(b[u], fb); UNPACK8(xx[u], fx); UNPACK8(zz[u], fz);
      const float dsk = Dk[c8 >> 6];
      float ss = 0.f;
#pragma unroll
      for (int e = 0; e < 8; ++e) { fa[e] = (fa[e] + fb[e] + dsk * fx[e]) * siluf_(fz[e]); ss += fa[e] * fa[e]; }
      ss += __shfl_xor(ss, 1); ss += __shfl_xor(ss, 2); ss += __shfl_xor(ss, 4); ss += __shfl_xor(ss, 8); ss += __shfl_xor(ss, 16);
      const float rs = rsqrtf(ss * (1.f / 256.f) + 1e-6f);
      const float4 w0 = *(const float4*)(sw + c8), w1 = *(const float4*)(sw + c8 + 4);
      const float wv[8] = {w0.x, w0.y, w0.z, w0.w, w1.x, w1.y, w1.z, w1.w};
#pragma unroll
      for (int e = 0; e < 8; ++e) fa[e] = fa[e] * rs * wv[e];
      if (u == 0 || has1) *(uint4*)(YBn + (size_t)r * 2048 + c8) = pack8(fa);
    }
  }
}

#define XB_TMO      128
#define XB_XCNT(j)  (256  + 64 * (j))
#define XB_XSUB(j)  (1280 + 64 * (j))
#define XB_XGEN(j)  (2304 + 64 * (j))
#define XB_TOP      3328
#define XB_TOPGEN   3392
#define XCD_BAR_WORDS 3456
#define XB_SPIN_CAP (1u << 18)
#define LAS __attribute__((address_space(3)))

__device__ __forceinline__ unsigned xb_ld(unsigned* p)              { return __hip_atomic_load(p, __ATOMIC_RELAXED, __HIP_MEMORY_SCOPE_AGENT); }
__device__ __forceinline__ unsigned xb_add(unsigned* p, unsigned v) { return __hip_atomic_fetch_add(p, v, __ATOMIC_RELAXED, __HIP_MEMORY_SCOPE_AGENT); }
__device__ __forceinline__ unsigned xb_xcc_id() { return (unsigned)__builtin_amdgcn_s_getreg((3 << 11) | 20) & 0xFu; }
#define XB_SPIN(cond, bar) do { unsigned _sp = 0; while (cond) { __builtin_amdgcn_s_sleep(1); \
    if ((++_sp & 255u) == 0u) { if (xb_ld(&(bar)[XB_TMO])) break; if (_sp > XB_SPIN_CAP) { atomicAdd(&(bar)[XB_TMO], 1u); break; } } } } while (0)

struct XcdBarrier {
    unsigned* bar; unsigned x;
    volatile LAS unsigned* st;
};

__device__ __forceinline__ XcdBarrier xcd_barrier_post(unsigned* bar, volatile LAS unsigned* st) {
    XcdBarrier b; b.bar = bar; b.x = xb_xcc_id(); b.st = st;
    if (threadIdx.x == 0) (void)xb_add(&bar[XB_XCNT(b.x)], 1u);
    return b;
}
__device__ __forceinline__ void xcd_barrier_complete(unsigned* bar, unsigned x, unsigned& nloc, unsigned& nx) {
    const unsigned G = gridDim.x * gridDim.y * gridDim.z;
    unsigned sum, cnt, mine, sp = 0u;
    for (;;) {
        sum = 0u; cnt = 0u; mine = 0u;
#pragma unroll
        for (unsigned j = 0; j < 16; ++j) { const unsigned c = xb_ld(&bar[XB_XCNT(j)]); sum += c; cnt += (c > 0u) ? 1u : 0u; mine = (j == x) ? c : mine; }
        if (sum == G) break;
        __builtin_amdgcn_s_sleep(1);
        if ((++sp & 255u) == 0u) { if (xb_ld(&bar[XB_TMO])) break; if (sp > XB_SPIN_CAP) { atomicAdd(&bar[XB_TMO], 1u); break; } }
    }
    nloc = mine > 0u ? mine : 1u; nx = cnt > 0u ? cnt : 1u;
}

__device__ __forceinline__ void xcd_barrier(const XcdBarrier& b) {
    asm volatile("s_waitcnt vmcnt(0)" ::: "memory");
    __syncthreads();
    if (threadIdx.x == 0) {
        unsigned* bar = b.bar;
        __builtin_amdgcn_s_waitcnt(0);
        unsigned nloc = b.st[0], nx = b.st[1];
        if (nloc == 0u) { xcd_barrier_complete(bar, b.x, nloc, nx); b.st[0] = nloc; b.st[1] = nx; }
        const unsigned old = xb_add(&bar[XB_XSUB(b.x)], 1u);
        const unsigned gen = old / nloc;
        if (old + 1u == (gen + 1u) * nloc) {
            __builtin_amdgcn_fence(__ATOMIC_RELEASE, "agent");
            asm volatile("s_waitcnt vmcnt(0)" ::: "memory");
            const unsigned og = xb_add(&bar[XB_TOP], 1u);
            const unsigned tg = og / nx;
            if (og + 1u == (tg + 1u) * nx) xb_add(&bar[XB_TOPGEN], 1u);
            else XB_SPIN(xb_ld(&bar[XB_TOPGEN]) == tg, bar);
            __builtin_amdgcn_fence(__ATOMIC_ACQUIRE, "agent");
            xb_add(&bar[XB_XGEN(b.x)], 1u);
            asm volatile("s_waitcnt vmcnt(0)" ::: "memory");
        } else {
            XB_SPIN(xb_ld(&bar[XB_XGEN(b.x)]) == gen, bar);
            __builtin_amdgcn_fence(__ATOMIC_ACQUIRE, "agent");
            asm volatile("s_waitcnt vmcnt(0)" ::: "memory");
        }
    }
    __syncthreads();
}

#ifndef STOP_AFTER
#define STOP_AFTER 0
#endif
#define SYNC() { xcd_barrier(xb); if (++nsync == STOP_AFTER) return; }
#define PH(CALL) { CALL; }
__global__ void __launch_bounds__(256, 2) mega(Params p) {
  cg::grid_group grid = cg::this_grid();
  int nsync = 0;
  __shared__ __attribute__((aligned(16))) unsigned char smem[SMEM_BYTES];
  __shared__ uint4 xb_words;
  if (threadIdx.x == 0) xb_words = make_uint4(0u, 0u, 0u, 0u);
  __syncthreads();
  XcdBarrier xb = xcd_barrier_post((unsigned*)(p.ws + OFF_BAR), (volatile LAS unsigned*)&xb_words);
  float* smf = (float*)smem; bf16_t* smh = (bf16_t*)smem;
  for (int l = 0; l < 2; ++l) {
    PH(transpose_phase(p.w_in + (size_t)l * 1024 * IN_DIM, (bf16_t*)(p.ws + OFF_WIN), 1024, IN_DIM, LDP, smf))
    PH(transpose_phase(p.w_proj_gdn + (size_t)l * 1024 * 1024, (bf16_t*)(p.ws + OFF_WPG), 1024, 1024, 1024, smf))
    PH(transpose_phase(p.w_proj_ssm + (size_t)l * 2048 * 1024, (bf16_t*)(p.ws + OFF_WPS), 2048, 1024, 1024, smf))
    PH(transpose_phase(p.w_out + (size_t)l * 1024 * 1024, (bf16_t*)(p.ws + OFF_WOUT), 1024, 1024, 1024, smf))
    PH(transpose_phase(p.w_ff1 + (size_t)l * 1024 * 4096, (bf16_t*)(p.ws + OFF_WFF1), 1024, 4096, 4096, smf))
    PH(transpose_phase(p.w_ff2 + (size_t)l * 4096 * 1024, (bf16_t*)(p.ws + OFF_WFF2), 4096, 1024, 1024, smf))
    if (l == 0) { PH(modpart_phase(p, smf)) grid.sync(); PH(modfinal_phase(p)) }
    SYNC();
    const bool last = (l == 1);
    const int Mpost = last ? MLAT : MG;
    constexpr int PRE = 19;
    PH(modulate_phase(p, l, 0, OFF_H)) SYNC();
    PH(gemm_inproj_phase(p, smh, 0, GDIM(), BIDX(), OFF_H, 0, 58)) SYNC();
    for (int g = 0; g < NGRP; ++g) {
      const bool more = (g + 1 < NGRP);
      const size_t hcur = (g & 1) ? OFF_HB : OFF_H, hnxt = (g & 1) ? OFF_H : OFF_HB;
      PH(conv_phase(p, l))
      if (more) { PH(modulate_phase(p, l, g + 1, hnxt)) }
      SYNC();
      PH(gdn_prep_phase(p, smem)) SYNC();
      {
        const int nb_ = GDIM(), v_ = BIDX();
        if (nb_ >= 512) {
          if (v_ < 256) { PH(scan_phase(p, smem, 256, v_)) }
          else if (nb_ == 512) {
            const bool heavy = v_ < 384; const int vv = heavy ? v_ - 256 : v_ - 384;
            PH(gemm_inproj_phase(p, smh, 1, 128, vv, hcur, heavy ? 0 : 24, heavy ? 24 : 39))
            if (more) { PH(gemm_inproj_phase(p, smh, 0, 128, vv, hnxt, heavy ? 0 : 12, heavy ? 12 : PRE)) }
          }
          else { PH(gemm_inproj_phase(p, smh, 1, nb_ - 256, v_ - 256, hcur, 0, 39)) if (more) { PH(gemm_inproj_phase(p, smh, 0, nb_ - 256, v_ - 256, hnxt, 0, PRE)) } }
        } else {
          PH(scan_phase(p, smem, nb_, v_)) PH(gemm_inproj_phase(p, smh, 1, nb_, v_, hcur, 0, 39))
          if (more) { PH(gemm_inproj_phase(p, smh, 0, nb_, v_, hnxt, 0, PRE)) }
        }
      }
      SYNC();
      PH(gnorm_phase(p, l, Mpost)) SYNC();
      PH(gemm_proj_phase(p, Mpost, smh, hcur)) SYNC();
      PH(gemm_wout_phase(p, l, g, Mpost, smh, hcur)) SYNC();
      PH(ln_phase(p, l, g, Mpost, p.ln1_g + l * D, p.ln1_b + l * D, true, hcur)) SYNC();
      PH(gemm_ff1_phase(p, l, Mpost, smh, hcur)) SYNC();
      PH(gemm_ff2_phase(p, l, g, Mpost, smh)) SYNC();
      PH(ln_phase(p, l, g, Mpost, p.ln2_g + l * D, p.ln2_b + l * D, false, hcur)) SYNC();
      if (more) { PH(gemm_inproj_phase(p, smh, 0, GDIM(), BIDX(), hnxt, PRE, 58)) SYNC(); }
    }
  }
}

extern "C" void kernel_launch(void* const* d_in, const int* in_sizes, int n_in, void* d_out, int out_size, void* d_ws, size_t ws_size,
                              hipStream_t stream) {
  static int grid_blocks = 0;
  if (!grid_blocks) {
    int dev = 0, cus = 0, per_cu = 0;
    (void)hipGetDevice(&dev);
    (void)hipDeviceGetAttribute(&cus, hipDeviceAttributeMultiprocessorCount, dev);
    (void)hipOccupancyMaxActiveBlocksPerMultiprocessor(&per_cu, mega, 256, 0);
    if (per_cu > 2) per_cu = 2;
    grid_blocks = cus * per_cu;
    if (ws_size < WS_TOTAL) fprintf(stderr, "workspace too small: %zu < %zu\n", ws_size, WS_TOTAL);
  }
  Params p{};
  const float** pp = (const float**)&p;
  for (int i = 0; i < 28; ++i) pp[i] = (const float*)d_in[i];
  p.out = (float*)d_out;
  p.ws = (unsigned char*)d_ws;
  (void)hipMemsetAsync((unsigned char*)d_ws + OFF_BAR, 0, 16384, stream);
  void* args[] = {&p};
  hipError_t e = hipLaunchCooperativeKernel((void*)mega, dim3(grid_blocks), dim3(256), args, 0, stream);
  if (e != hipSuccess) fprintf(stderr, "cooperative launch failed: %s (grid %d)\n", hipGetErrorString(e), grid_blocks);
}
```
